# Optimizing an MI355X kernel written in HIP

```python
import jax, jax.numpy as jnp
from jax import lax
import numpy as np


D_MODEL = 1024
BATCH = 4
SEQ = 8192
DEPTH = 4

N_MIXERS = 2
N_ATTN_LAYERS = (DEPTH + 1) // 2
N_POOL_LAYERS = DEPTH // 2
N_HEADS = 16
QK_NOPE_DIM = 64
QK_ROPE_DIM = 32
V_HEAD_DIM = 64
Q_LORA_RANK = 256
KV_LORA_RANK = 128
ROPE_THETA = 10000.0
Q_BLOCK = 128
POOL_WINDOWS = (2, 4, 8, 16)
N_POOL_GROUPS = 4
POOL_GROUP_DIM = D_MODEL // N_POOL_GROUPS
N_EXPERT_GROUPS = 8
EXPERTS_PER_GROUP = 8
N_EXPERTS = N_EXPERT_GROUPS * EXPERTS_PER_GROUP
TOP_K_IN_GROUP = 2
D_EXPERT = 256
EXPERT_BLOCK = 128
DEEPNORM_ALPHA = (2 * DEPTH) ** 0.25
DEEPNORM_BETA = (8 * DEPTH) ** -0.25
LN_EPS = 1e-5
RMS_EPS = 1e-6

kernel_name = 'mla_pool_hier_moe_deepnorm'


def layer_norm(x, g, b):
    xf = x.astype(jnp.float32)
    mu = jnp.mean(xf, axis=-1, keepdims=True)
    var = jnp.mean(jnp.square(xf - mu), axis=-1, keepdims=True)
    y = (xf - mu) * lax.rsqrt(var + LN_EPS) * g.astype(jnp.float32) + b.astype(jnp.float32)
    return y.astype(x.dtype)


def rms_norm(x, g):
    xf = x.astype(jnp.float32)
    y = xf * lax.rsqrt(jnp.mean(jnp.square(xf), axis=-1, keepdims=True) + RMS_EPS)
    return (y * g.astype(jnp.float32)).astype(x.dtype)


def rope_tables(positions):
    inv_freq = ROPE_THETA ** (-jnp.arange(0, QK_ROPE_DIM, 2, dtype=jnp.float32) / QK_ROPE_DIM)
    ang = positions.astype(jnp.float32)[..., None] * inv_freq
    return jnp.cos(ang), jnp.sin(ang)


def apply_rope(x, cos, sin):
    xf = x.astype(jnp.float32)
    half = xf.shape[-1] // 2
    x1, x2 = xf[..., :half], xf[..., half:]
    y = jnp.concatenate([x1 * cos - x2 * sin, x2 * cos + x1 * sin], axis=-1)
    return y.astype(x.dtype)


def mla_mixer(x, cos, sin, w_in, q_norm, w_uq, kv_norm, w_ukv, w_o):
    B, S, _ = x.shape
    lat = x @ w_in
    c_q = rms_norm(lat[..., :Q_LORA_RANK], q_norm)
    c_kv = rms_norm(lat[..., Q_LORA_RANK:Q_LORA_RANK + KV_LORA_RANK], kv_norm)
    k_rope = apply_rope(lat[..., Q_LORA_RANK + KV_LORA_RANK:], cos, sin)
    q = (c_q @ w_uq).reshape(B, S, N_HEADS, QK_NOPE_DIM + QK_ROPE_DIM)
    q_nope = q[..., :QK_NOPE_DIM]
    q_rope = apply_rope(q[..., QK_NOPE_DIM:], cos[:, :, None, :], sin[:, :, None, :])
    kv = (c_kv @ w_ukv).reshape(B, S, N_HEADS, QK_NOPE_DIM + V_HEAD_DIM)
    k_nope, v = kv[..., :QK_NOPE_DIM], kv[..., QK_NOPE_DIM:]
    scale = (QK_NOPE_DIM + QK_ROPE_DIM) ** -0.5
    outs = []
    for qs in range(0, S, Q_BLOCK):
        qe = qs + Q_BLOCK
        s = (jnp.einsum('bqhd,bkhd->bhqk', q_nope[:, qs:qe], k_nope[:, :qe],
                        preferred_element_type=jnp.float32)
             + jnp.einsum('bqhr,bkr->bhqk', q_rope[:, qs:qe], k_rope[:, :qe],
                          preferred_element_type=jnp.float32)) * scale
        causal = jnp.arange(qe)[None, :] <= jnp.arange(qs, qe)[:, None]
        s = jnp.where(causal, s, -jnp.inf)
        p = jax.nn.softmax(s, axis=-1).astype(v.dtype)
        outs.append(jnp.einsum('bhqk,bkhd->bqhd', p, v[:, :qe]))
    o = jnp.concatenate(outs, axis=1).reshape(B, S, N_HEADS * V_HEAD_DIM)
    return o @ w_o


def pool_mixer(x, w, b, scale):
    B, S, D = x.shape
    xf = x.astype(jnp.float32)
    cs = jnp.concatenate([jnp.zeros((B, 1, D), jnp.float32), jnp.cumsum(xf, axis=1)], axis=1)
    t = jnp.arange(S)
    means = []
    for gi, win in enumerate(POOL_WINDOWS):
        sl = slice(gi * POOL_GROUP_DIM, (gi + 1) * POOL_GROUP_DIM)
        hi = cs[:, 1:, sl]
        lo = cs[:, jnp.maximum(t + 1 - win, 0), sl]
        cnt = jnp.minimum(t + 1, win).astype(jnp.float32)[:, None]
        means.append((hi - lo) / cnt)
    pooled = jnp.concatenate(means, axis=-1) - xf
    y = jnp.einsum('bsgc,gcd->bsgd', pooled.reshape(B, S, N_POOL_GROUPS, POOL_GROUP_DIM),
                   w.astype(jnp.float32)).reshape(B, S, D) + b.astype(jnp.float32)
    return (y * scale.astype(jnp.float32)).astype(x.dtype)


def hier_moe(h, w_grp, b_grp, w_exp, b_exp, w1, w3, w2):
    B, S, D = h.shape
    tok = h.reshape(-1, D)
    N = tok.shape[0]
    hf = tok.astype(jnp.float32)
    g_logits = hf @ w_grp.astype(jnp.float32) + b_grp.astype(jnp.float32)
    g_prob = jax.nn.softmax(g_logits, axis=-1)
    g_sel = jnp.argmax(g_logits, axis=-1)
    g_gate = jnp.take_along_axis(g_prob, g_sel[:, None], axis=-1)
    e_logits = (hf @ w_exp.astype(jnp.float32) + b_exp.astype(jnp.float32)).reshape(N, N_EXPERT_GROUPS, EXPERTS_PER_GROUP)
    e_logits = jnp.take_along_axis(e_logits, g_sel[:, None, None], axis=1)[:, 0]
    e_prob = jax.nn.softmax(e_logits, axis=-1)
    top_p, top_i = lax.top_k(e_prob, TOP_K_IN_GROUP)
    gate = g_gate * top_p / jnp.sum(top_p, axis=-1, keepdims=True)
    expert = g_sel[:, None] * EXPERTS_PER_GROUP + top_i
    A = N * TOP_K_IN_GROUP
    flat_e = expert.reshape(-1).astype(jnp.int32)
    flat_tok = jnp.repeat(jnp.arange(N, dtype=jnp.int32), TOP_K_IN_GROUP)
    flat_gate = gate.reshape(-1)
    order = jnp.argsort(flat_e)
    e_sorted, tok_sorted, gate_sorted = flat_e[order], flat_tok[order], flat_gate[order]
    counts = jnp.bincount(flat_e, length=N_EXPERTS)
    padded = (counts + EXPERT_BLOCK - 1) // EXPERT_BLOCK * EXPERT_BLOCK
    start = jnp.cumsum(counts) - counts
    pend = jnp.cumsum(padded)
    pstart = pend - padded
    dest = pstart[e_sorted] + (jnp.arange(A, dtype=jnp.int32) - start[e_sorted])
    n_blocks = (A + N_EXPERTS * (EXPERT_BLOCK - 1) + EXPERT_BLOCK - 1) // EXPERT_BLOCK
    rows = jnp.zeros((n_blocks * EXPERT_BLOCK, D), tok.dtype).at[dest].set(tok[tok_sorted])
    blk_e = jnp.minimum(jnp.searchsorted(pend, jnp.arange(n_blocks) * EXPERT_BLOCK, side='right'), N_EXPERTS - 1)

    def expert_block(args):
        xb, e = args
        hb = jax.nn.silu(xb @ w1[e]) * (xb @ w3[e])
        return hb @ w2[e]

    y_rows = lax.map(expert_block, (rows.reshape(n_blocks, EXPERT_BLOCK, D), blk_e)).reshape(-1, D)
    y = y_rows[dest].astype(jnp.float32) * gate_sorted[:, None]
    out = jnp.zeros((N, D), jnp.float32).at[tok_sorted].add(y)
    return out.reshape(B, S, D).astype(h.dtype)


def setup_inputs(seed: int = 0) -> dict:
    key = jax.random.key(seed)
    ks = jax.random.split(key, 24)
    f32 = jnp.float32
    nrm = lambda k, shape, s: jax.random.normal(k, shape, f32) * s
    LAT = Q_LORA_RANK + KV_LORA_RANK + QK_ROPE_DIM
    return {
        'x': jax.random.normal(ks[0], (BATCH, SEQ, D_MODEL), f32),
        'positions': (jnp.arange(SEQ, dtype=jnp.int32)[None, :]
                      + jax.random.randint(ks[1], (BATCH, 1), 0, 4096, dtype=jnp.int32)),
        'ln_g': 1.0 + nrm(ks[2], (DEPTH, 2, D_MODEL), 0.02),
        'ln_b': nrm(ks[3], (DEPTH, 2, D_MODEL), 0.02),
        'mla_w_in': nrm(ks[4], (N_ATTN_LAYERS, D_MODEL, LAT), D_MODEL ** -0.5),
        'mla_q_norm': 1.0 + nrm(ks[5], (N_ATTN_LAYERS, Q_LORA_RANK), 0.02),
        'mla_w_uq': nrm(ks[6], (N_ATTN_LAYERS, Q_LORA_RANK, N_HEADS * (QK_NOPE_DIM + QK_ROPE_DIM)), Q_LORA_RANK ** -0.5),
        'mla_kv_norm': 1.0 + nrm(ks[7], (N_ATTN_LAYERS, KV_LORA_RANK), 0.02),
        'mla_w_ukv': nrm(ks[8], (N_ATTN_LAYERS, KV_LORA_RANK, N_HEADS * (QK_NOPE_DIM + V_HEAD_DIM)), KV_LORA_RANK ** -0.5),
        'mla_w_o': nrm(ks[9], (N_ATTN_LAYERS, N_HEADS * V_HEAD_DIM, D_MODEL), (N_HEADS * V_HEAD_DIM) ** -0.5 * DEEPNORM_BETA),
        'pool_w': nrm(ks[10], (N_POOL_LAYERS, N_POOL_GROUPS, POOL_GROUP_DIM, POOL_GROUP_DIM), POOL_GROUP_DIM ** -0.5 * DEEPNORM_BETA),
        'pool_b': nrm(ks[11], (N_POOL_LAYERS, D_MODEL), 0.02),
        'pool_scale': 1.0 + nrm(ks[12], (N_POOL_LAYERS, D_MODEL), 0.1),
        'moe_w_grp': nrm(ks[13], (DEPTH, D_MODEL, N_EXPERT_GROUPS), D_MODEL ** -0.5),
        'moe_b_grp': nrm(ks[14], (DEPTH, N_EXPERT_GROUPS), 0.01),
        'moe_w_exp': nrm(ks[15], (DEPTH, D_MODEL, N_EXPERTS), D_MODEL ** -0.5),
        'moe_b_exp': nrm(ks[16], (DEPTH, N_EXPERTS), 0.01),
        'moe_w1': nrm(ks[17], (DEPTH, N_EXPERTS, D_MODEL, D_EXPERT), D_MODEL ** -0.5),
        'moe_w3': nrm(ks[18], (DEPTH, N_EXPERTS, D_MODEL, D_EXPERT), D_MODEL ** -0.5),
        'moe_w2': nrm(ks[19], (DEPTH, N_EXPERTS, D_EXPERT, D_MODEL), D_EXPERT ** -0.5 * DEEPNORM_BETA),
    }


def reference(x, positions, ln_g, ln_b, mla_w_in, mla_q_norm, mla_w_uq, mla_kv_norm, mla_w_ukv, mla_w_o,
              pool_w, pool_b, pool_scale, moe_w_grp, moe_b_grp, moe_w_exp, moe_b_exp, moe_w1, moe_w3, moe_w2):
    cos, sin = rope_tables(positions)
    for i in range(DEPTH):
        j = i // N_MIXERS
        if i % N_MIXERS == 0:
            f = mla_mixer(x, cos, sin, mla_w_in[j], mla_q_norm[j], mla_w_uq[j],
                          mla_kv_norm[j], mla_w_ukv[j], mla_w_o[j])
        else:
            f = pool_mixer(x, pool_w[j], pool_b[j], pool_scale[j])
        x = layer_norm(DEEPNORM_ALPHA * x + f, ln_g[i, 0], ln_b[i, 0])
        f = hier_moe(x, moe_w_grp[i], moe_b_grp[i], moe_w_exp[i], moe_b_exp[i],
                     moe_w1[i], moe_w3[i], moe_w2[i])
        x = layer_norm(DEEPNORM_ALPHA * x + f, ln_g[i, 1], ln_b[i, 1])
    return x
```

```cpp
#include <hip/hip_runtime.h>
#include <cstdio>
#include <cstdint>

#ifndef MK_ONE_LAUNCH
#define MK_ONE_LAUNCH 1
#endif

#define LAS __attribute__((address_space(3)))
#define GAS __attribute__((address_space(1)))

constexpr int D_MODEL = 1024, BATCH = 4, SEQ = 8192, DEPTH = 4, NTOK = BATCH * SEQ;
constexpr int N_HEADS = 16, QK_NOPE = 64, QK_ROPE = 32, V_HEAD = 64, Q_LORA = 256, KV_LORA = 128, LAT = Q_LORA + KV_LORA + QK_ROPE;
constexpr int QPITCH = N_HEADS * (QK_NOPE + QK_ROPE);
constexpr int N_GROUPS = 8, EPG = 8, N_EXPERTS = 64, D_EXPERT = 256;
constexpr int MAX_TILES = 320;
constexpr float DN_ALPHA = 1.681792830507429f;
constexpr float LN_EPS = 1e-5f, RMS_EPS = 1e-6f;
constexpr float QSCALE = 0.14724444602590306f;
constexpr int LGP = 80;

constexpr size_t MiB = 1u << 20;
constexpr size_t WS_CTL = 0, CTL_ZERO_BYTES = 1 * MiB;
constexpr size_t WS_COS = 1 * MiB, WS_SIN = 3 * MiB;
constexpr size_t WS_CNT = 5 * MiB;
constexpr size_t WS_TILE = 5 * MiB + 65536;
constexpr size_t WS_AE = 5 * MiB + 131072, WS_APOS = WS_AE + 262144, WS_AG = WS_APOS + 262144;
constexpr size_t WS_RSLOT = 6 * MiB, WS_RGATE = 6 * MiB + 512 * 1024;
constexpr size_t WS_WIN = 8 * MiB;
constexpr size_t WS_WUQ = 10 * MiB;
constexpr size_t WS_WUK = 12 * MiB;
constexpr size_t WS_WUV = 13 * MiB;
constexpr size_t WS_WO = 14 * MiB;
constexpr size_t WS_WP = 18 * MiB;
constexpr size_t WS_WR = 19 * MiB;
constexpr size_t WS_W13 = 24 * MiB;
constexpr size_t WS_W2T = 88 * MiB;
constexpr size_t WS_ZB = 120 * MiB;
constexpr size_t WS_XHL = 248 * MiB;
constexpr size_t WS_R1 = 376 * MiB;
constexpr size_t WS_LAT = WS_R1;
constexpr size_t WS_CQ = WS_R1 + 64 * MiB;
constexpr size_t WS_CKV = WS_R1 + 80 * MiB;
constexpr size_t WS_KR = WS_R1 + 88 * MiB;
constexpr size_t WS_Q = WS_R1 + 92 * MiB;
constexpr size_t WS_KN = WS_R1 + 188 * MiB;
constexpr size_t WS_VT = WS_R1 + 252 * MiB;
constexpr size_t WS_O = WS_R1 + 316 * MiB;
constexpr size_t WS_POOLED = WS_R1;
constexpr size_t WS_LG = WS_R1;
constexpr size_t WS_XS = WS_R1 + 12 * MiB;
constexpr size_t WS_HS = WS_R1 + 172 * MiB;
constexpr size_t WS_Y = WS_R1 + 212 * MiB;
constexpr size_t WS_END = WS_R1 + 384 * MiB;
static_assert(WS_O + 64 * MiB <= WS_END && WS_Y + 128 * MiB <= WS_END, "ws map");

constexpr int CW_TMO = 0, CW_CODE = 1, CW_BAR = 4096;

constexpr int RING_OFF = 0, RING_BYTES = 131072;
constexpr int LDSCTL_OFF = RING_BYTES, MISC_OFF = LDSCTL_OFF + 320;
constexpr int LDS_BYTES = 147456;

typedef unsigned short bf16_t;
typedef short bf16x8 __attribute__((ext_vector_type(8)));
typedef float f32x4 __attribute__((ext_vector_type(4)));
typedef float f32x16 __attribute__((ext_vector_type(16)));
typedef unsigned u32x4 __attribute__((ext_vector_type(4)));
typedef unsigned u32x2 __attribute__((ext_vector_type(2)));
typedef float f32x2_t __attribute__((ext_vector_type(2)));
typedef __bf16 bf16x2_t __attribute__((ext_vector_type(2)));
#define RLX_AGENT __ATOMIC_RELAXED, __HIP_MEMORY_SCOPE_AGENT
#define LDS_WAIT() asm volatile("s_waitcnt lgkmcnt(0)" ::: "memory")
#define VM_WAIT() asm volatile("s_waitcnt vmcnt(0)" ::: "memory")

__device__ __forceinline__ unsigned cvtpk(float lo, float hi) { f32x2_t v = {lo, hi}; bf16x2_t b = __builtin_convertvector(v, bf16x2_t); return __builtin_bit_cast(unsigned, b); }
__device__ __forceinline__ int opaque(int x) { asm volatile("" : "+v"(x)); return x; }
__device__ __forceinline__ int opaque_s(int x) { asm volatile("" : "+s"(x)); return x; }
__device__ __forceinline__ float bflo(unsigned u) { return __uint_as_float(u << 16); }
__device__ __forceinline__ float bfhi(unsigned u) { return __uint_as_float(u & 0xffff0000u); }
__device__ __forceinline__ float wave_sum(float v) {
#pragma unroll
    for (int o = 1; o < 64; o <<= 1) v += __shfl_xor(v, o);
    return v;
}
__device__ __forceinline__ void split4(const f32x4 v, u32x2& h, u32x2& l) {
    h.x = cvtpk(v.x, v.y); h.y = cvtpk(v.z, v.w);
    l.x = cvtpk(v.x - bflo(h.x), v.y - bfhi(h.x)); l.y = cvtpk(v.z - bflo(h.y), v.w - bfhi(h.y));
}
__device__ __forceinline__ f32x4 join4(const u32x2 h, const u32x2 l) {
    return (f32x4){bflo(h.x) + bflo(l.x), bfhi(h.x) + bfhi(l.x), bflo(h.y) + bflo(l.y), bfhi(h.y) + bfhi(l.y)};
}
__device__ __forceinline__ f32x4 bf4(const u32x2 h) { return (f32x4){bflo(h.x), bfhi(h.x), bflo(h.y), bfhi(h.y)}; }

namespace pg8 {
constexpr int BM = 256, BK = 64, HALF = 128, HTB = HALF * BK * 2, STAGE_BYTES = 8 * HTB, NXCD = 8, WGM = 8;
__host__ __device__ __forceinline__ int lds_byte(int r, int c) { const int st = (r >> 4) * 2 + (c >> 5), rr = r & 15, cc = c & 31, ob = rr * 64 + cc * 2; return st * 1024 + (ob ^ (((ob >> 9) & 1) << 5)); }
__host__ __device__ __forceinline__ void stage_rc(int b, int& R, int& C) { const int st = b / 1024, sb = b % 1024, swz = sb ^ (((sb >> 9) & 1) << 5); R = (st >> 1) * 16 + swz / 64; C = (st & 1) * 32 + (swz % 64) / 2; }
__host__ __device__ __forceinline__ int perm32(int rho) { const int n = rho >> 4, i = rho & 15; return 8 * (i >> 2) + 4 * n + (i & 3); }

struct Unit { int pm, pn; };
struct Gemm { int lda, ldb, K; };

struct DenseOrder {
    int nM, nN, nwg, G, c;
    const char* A; const char* B; size_t a_pm, a_pn, b_pn;
    __device__ __forceinline__ void init(int M, int N, int G_, int c_, const void* A_, size_t a_pm_, size_t a_pn_, const void* B_, size_t b_pn_) {
        nM = M / BM; nN = N / BM; nwg = nM * nN; G = G_; c = c_; A = (const char*)A_; B = (const char*)B_; a_pm = a_pm_; a_pn = a_pn_; b_pn = b_pn_; }
    __device__ __forceinline__ bool next(int i, Unit& u) const {
        const long L = (long)i * G + c; if (L >= nwg) return false;
        int wgid = (int)L; { const int q = nwg / NXCD, r = nwg % NXCD, xcd = wgid % NXCD, off = wgid / NXCD; wgid = (xcd < r ? xcd * (q + 1) : r * (q + 1) + (xcd - r) * q) + off; }
        const int nig = WGM * nN, gid = wgid / nig, fm = gid * WGM, gsz = (nM - fm) < WGM ? (nM - fm) : WGM;
        u.pm = fm + ((wgid % nig) % gsz); u.pn = (wgid % nig) / gsz; return true;
    }
    __device__ __forceinline__ const char* a_base(const Unit& u) const { return A + (size_t)u.pm * a_pm + (size_t)u.pn * a_pn; }
    __device__ __forceinline__ const char* b_base(const Unit& u) const { return B + (size_t)u.pn * b_pn; }
};
struct MoeOrder {
    const int* tile_e; int ntiles, nN, nwg, G, c;
    const char* A; const char* W; size_t a_tile, w_e, w_pn;
    __device__ __forceinline__ void init(const int* tile_e_, int ntiles_, int nN_, int G_, int c_, const void* A_, size_t a_tile_, const void* W_, size_t w_e_, size_t w_pn_) {
        tile_e = tile_e_; ntiles = ntiles_; nN = nN_; nwg = ntiles_ * nN_; G = G_; c = c_; A = (const char*)A_; a_tile = a_tile_; W = (const char*)W_; w_e = w_e_; w_pn = w_pn_; }
    __device__ __forceinline__ bool next(int i, Unit& u) const {
        const long L = (long)i * G + c; if (L >= nwg) return false;
        int wgid = (int)L; { const int q = nwg / NXCD, r = nwg % NXCD, xcd = wgid % NXCD, off = wgid / NXCD; wgid = (xcd < r ? xcd * (q + 1) : r * (q + 1) + (xcd - r) * q) + off; }
        u.pm = wgid / nN; u.pn = wgid % nN; return true;
    }
    __device__ __forceinline__ const char* a_base(const Unit& u) const { return A + (size_t)u.pm * a_tile; }
    __device__ __forceinline__ const char* b_base(const Unit& u) const { const int e = __builtin_amdgcn_readfirstlane(tile_e[u.pm]); return W + (size_t)e * w_e + (size_t)u.pn * w_pn; }
};

#define ACC_T const f32x4 (&acc)[2][2][4][2]
struct EpiBf16 {
    static constexpr bool PERM = true;
    bf16_t* O; size_t ldc;
    __device__ __forceinline__ void operator()(ACC_T, const Unit& u, int wr, int wc, int fr, int fq) const {
        const int row0 = u.pm * BM + wr * 64 + fr, col0 = u.pn * BM + wc * 32 + 8 * fq;
#pragma unroll
        for (int ai = 0; ai < 2; ++ai)
#pragma unroll
            for (int m = 0; m < 4; ++m) { bf16_t* rowp = O + (size_t)(row0 + ai * HALF + m * 16) * ldc + col0;
#pragma unroll
                for (int bj = 0; bj < 2; ++bj) { const f32x4 v0 = acc[ai][bj][m][0], v1 = acc[ai][bj][m][1];
                    u32x4 w; w.x = cvtpk(v0[0], v0[1]); w.y = cvtpk(v0[2], v0[3]); w.z = cvtpk(v1[0], v1[1]); w.w = cvtpk(v1[2], v1[3]);
                    *(u32x4*)(rowp + bj * HALF) = w; } }
    }
};
struct EpiF32 {
    static constexpr bool PERM = false;
    float* O; size_t ldc;
    __device__ __forceinline__ void operator()(ACC_T, const Unit& u, int wr, int wc, int fr, int fq) const {
        const int row0 = u.pm * BM + wr * 64 + fr, col0 = u.pn * BM + wc * 32 + 4 * fq;
#pragma unroll
        for (int ai = 0; ai < 2; ++ai)
#pragma unroll
            for (int m = 0; m < 4; ++m) { float* rowp = O + (size_t)(row0 + ai * HALF + m * 16) * ldc + col0;
#pragma unroll
                for (int bj = 0; bj < 2; ++bj)
#pragma unroll
                    for (int n = 0; n < 2; ++n) *(f32x4*)(rowp + bj * HALF + n * 16) = acc[ai][bj][m][n]; }
    }
};
struct EpiQ {
    static constexpr bool PERM = true;
    bf16_t* Q; const float* cs; const float* sn;
    __device__ __forceinline__ void operator()(ACC_T, const Unit& u, int wr, int wc, int fr, int fq) const {
        const int row0 = u.pm * BM + wr * 64 + fr;
        if (u.pn < 4) {
#pragma unroll
            for (int ai = 0; ai < 2; ++ai)
#pragma unroll
                for (int m = 0; m < 4; ++m) { const int row = row0 + ai * HALF + m * 16;
#pragma unroll
                    for (int bj = 0; bj < 2; ++bj) { const int col = u.pn * BM + bj * HALF + wc * 32 + 8 * fq; const f32x4 v0 = acc[ai][bj][m][0], v1 = acc[ai][bj][m][1];
                        u32x4 w; w.x = cvtpk(v0[0], v0[1]); w.y = cvtpk(v0[2], v0[3]); w.z = cvtpk(v1[0], v1[1]); w.w = cvtpk(v1[2], v1[3]);
                        *(u32x4*)(Q + (size_t)row * QPITCH + (col >> 6) * 96 + (col & 63)) = w; } }
        } else {
            const int head = (u.pn - 4) * 8 + 2 * wc + (fq >> 1), i0 = 8 * (fq & 1);
#pragma unroll
            for (int ai = 0; ai < 2; ++ai)
#pragma unroll
                for (int m = 0; m < 4; ++m) { const int row = row0 + ai * HALF + m * 16;
                    const f32x4 c0 = *(const f32x4*)(cs + (size_t)row * 16 + i0), c1 = *(const f32x4*)(cs + (size_t)row * 16 + i0 + 4);
                    const f32x4 s0 = *(const f32x4*)(sn + (size_t)row * 16 + i0), s1 = *(const f32x4*)(sn + (size_t)row * 16 + i0 + 4);
                    const f32x4 a0 = acc[ai][0][m][0], a1 = acc[ai][0][m][1], b0 = acc[ai][1][m][0], b1 = acc[ai][1][m][1];
                    const f32x4 y10 = a0 * c0 - b0 * s0, y11 = a1 * c1 - b1 * s1, y20 = b0 * c0 + a0 * s0, y21 = b1 * c1 + a1 * s1;
                    u32x4 w1, w2; w1.x = cvtpk(y10[0], y10[1]); w1.y = cvtpk(y10[2], y10[3]); w1.z = cvtpk(y11[0], y11[1]); w1.w = cvtpk(y11[2], y11[3]);
                    w2.x = cvtpk(y20[0], y20[1]); w2.y = cvtpk(y20[2], y20[3]); w2.z = cvtpk(y21[0], y21[1]); w2.w = cvtpk(y21[2], y21[3]);
                    bf16_t* qp = Q + (size_t)row * QPITCH + head * 96 + 64 + i0;
                    *(u32x4*)qp = w1; *(u32x4*)(qp + 16) = w2; asm volatile("" ::: "memory"); }
        }
    }
};
struct EpiRes {
    static constexpr bool PERM = false;
    const bf16_t* X; float* Z;
    __device__ __forceinline__ void operator()(ACC_T, const Unit& u, int wr, int wc, int fr, int fq) const {
        const int row0 = u.pm * BM + wr * 64 + fr, col0 = u.pn * BM + wc * 32 + 4 * fq;
#pragma unroll
        for (int ai = 0; ai < 2; ++ai)
#pragma unroll
            for (int m = 0; m < 4; ++m) { const size_t row = row0 + ai * HALF + m * 16; const bf16_t* xr = X + row * 2048 + col0; float* zr = Z + row * 1024 + col0;
#pragma unroll
                for (int bj = 0; bj < 2; ++bj)
#pragma unroll
                    for (int n = 0; n < 2; ++n) { const int c = bj * HALF + n * 16; const f32x4 x = join4(*(const u32x2*)(xr + c), *(const u32x2*)(xr + 1024 + c));
                        *(f32x4*)(zr + c) = x * DN_ALPHA + acc[ai][bj][m][n]; } }
    }
};
struct EpiPool {
    static constexpr bool PERM = false;
    const bf16_t* X; float* Z; const float* bias; const float* scale;
    __device__ __forceinline__ void operator()(ACC_T, const Unit& u, int wr, int wc, int fr, int fq) const {
        const int row0 = u.pm * BM + wr * 64 + fr, col0 = u.pn * BM + wc * 32 + 4 * fq;
#pragma unroll
        for (int bj = 0; bj < 2; ++bj)
#pragma unroll
            for (int n = 0; n < 2; ++n) { const int c = bj * HALF + n * 16;
                const f32x4 bv = *(const f32x4*)(bias + col0 + c), sv = *(const f32x4*)(scale + col0 + c);
#pragma unroll
                for (int ai = 0; ai < 2; ++ai) {
#pragma unroll
                    for (int m = 0; m < 4; ++m) { const size_t row = row0 + ai * HALF + m * 16; const bf16_t* xr = X + row * 2048 + col0 + c;
                        const f32x4 x = join4(*(const u32x2*)xr, *(const u32x2*)(xr + 1024));
                        *(f32x4*)(Z + row * 1024 + col0 + c) = x * DN_ALPHA + (acc[ai][bj][m][n] + bv) * sv; }
                    asm volatile("" ::: "memory"); } }
    }
};
struct EpiRouter {
    static constexpr bool PERM = false;
    float* LG;
    __device__ __forceinline__ void operator()(ACC_T, const Unit& u, int wr, int wc, int fr, int fq) const {
        const int row0 = u.pm * BM + wr * 64 + fr;
#pragma unroll
        for (int ai = 0; ai < 2; ++ai)
#pragma unroll
            for (int m = 0; m < 4; ++m) { float* lr = LG + (size_t)(row0 + ai * HALF + m * 16) * LGP;
#pragma unroll
                for (int n = 0; n < 2; ++n) { const int j = wc * 32 + 16 * n + 4 * fq; if (j < 72) *(f32x4*)(lr + j) = acc[ai][0][m][n] + acc[ai][1][m][n]; } }
    }
};
struct EpiSwiglu {
    static constexpr bool PERM = true;
    bf16_t* H;
    __device__ __forceinline__ void operator()(ACC_T, const Unit& u, int wr, int wc, int fr, int fq) const {
        const int row0 = u.pm * BM + wr * 64 + fr, col0 = u.pn * HALF + wc * 32 + 8 * fq;
#pragma unroll
        for (int ai = 0; ai < 2; ++ai)
#pragma unroll
            for (int m = 0; m < 4; ++m) { float h[8];
#pragma unroll
                for (int n = 0; n < 2; ++n)
#pragma unroll
                    for (int e = 0; e < 4; ++e) { const float a = acc[ai][0][m][n][e], b = acc[ai][1][m][n][e];
                        h[n * 4 + e] = a * __builtin_amdgcn_rcpf(1.0f + __builtin_amdgcn_exp2f(-1.4426950408889634f * a)) * b; }
                u32x4 w; w.x = cvtpk(h[0], h[1]); w.y = cvtpk(h[2], h[3]); w.z = cvtpk(h[4], h[5]); w.w = cvtpk(h[6], h[7]);
                *(u32x4*)(H + (size_t)(row0 + ai * HALF + m * 16) * D_EXPERT + col0) = w; }
    }
};
struct EpiMoeOut {
    static constexpr bool PERM = true;
    bf16_t* Y; const int* rslot; const float* rgate;
    __device__ __forceinline__ void operator()(ACC_T, const Unit& u, int wr, int wc, int fr, int fq) const {
        const int row0 = u.pm * BM + wr * 64 + fr, col0 = u.pn * BM + wc * 32 + 8 * fq;
#pragma unroll
        for (int ai = 0; ai < 2; ++ai)
#pragma unroll
            for (int m = 0; m < 4; ++m) { const int row = row0 + ai * HALF + m * 16; const int slot = rslot[row]; const float g = rgate[row];
                if (slot >= 0) { bf16_t* yp = Y + (size_t)slot * D_MODEL + col0;
#pragma unroll
                    for (int bj = 0; bj < 2; ++bj) { const f32x4 v0 = acc[ai][bj][m][0] * g, v1 = acc[ai][bj][m][1] * g;
                        u32x4 w; w.x = cvtpk(v0[0], v0[1]); w.y = cvtpk(v0[2], v0[3]); w.z = cvtpk(v1[0], v1[1]); w.w = cvtpk(v1[2], v1[3]);
                        *(u32x4*)(yp + bj * HALF) = w; } }
                if (m & 1) asm volatile("" ::: "memory"); }
    }
};
#undef ACC_T

template <class Epi, class Sched, bool ALIGN_EPI>
__device__ __forceinline__ void gemm_phase(LAS unsigned char* lds, const Gemm g, const Sched& S, const Epi& E) {
    const int tid = opaque(threadIdx.x), wid = __builtin_amdgcn_readfirstlane(tid >> 6), lane = tid & 63, wr = wid >> 2, wc = wid & 3, fr = lane & 15, fq = lane >> 4;
    const int K = opaque_s(g.K), nt = K / BK;
    unsigned voffA[2], voffB[2];
#pragma unroll
    for (int i = 0; i < 2; ++i) { int R, C; stage_rc(tid * 16 + i * 8192, R, C); const int Rb = Epi::PERM ? ((R & ~31) + perm32(R & 31)) : R;
        voffA[i] = (unsigned)(R * g.lda + C) * 2u; voffB[i] = (unsigned)(Rb * g.ldb + C) * 2u; }
    const size_t kstep = (size_t)(BK * 2);
    const size_t hstepA = (size_t)HALF * g.lda * 2, hstepB = (size_t)HALF * g.ldb * 2;
    const unsigned ldsw = (unsigned)wid * 1024u;
    const int aoff = lds_byte(wr * 64 + fr, fq * 8), boff = lds_byte(wc * 32 + fr, fq * 8);
#define PG8_SA(b, h) (((b) * 2 + (h)) * HTB)
#define PG8_SB(b, h) ((4 + (b) * 2 + (h)) * HTB)
#define PG8_STAGE(bufoff, gbase, voff) do { _Pragma("unroll") for (int _i = 0; _i < 2; ++_i) \
        __builtin_amdgcn_global_load_lds((const unsigned*)((const char*)(gbase) + (voff)[_i]), (LAS unsigned*)(lds + (bufoff) + ldsw + _i * 8192), 16, 0, 0); } while (0)
#define PG8_LDA(dst, b, h) do { _Pragma("unroll") for (int m = 0; m < 4; ++m) _Pragma("unroll") for (int k = 0; k < 2; ++k) dst[m][k] = *(const LAS bf16x8*)(lds + PG8_SA(b, h) + aoff + m * 2048 + k * 1024); } while (0)
#define PG8_LDB(dst, b, h) do { _Pragma("unroll") for (int n = 0; n < 2; ++n) _Pragma("unroll") for (int k = 0; k < 2; ++k) dst[n][k] = *(const LAS bf16x8*)(lds + PG8_SB(b, h) + boff + n * 2048 + k * 1024); } while (0)
#define PG8_MMA(ai, bj, At, Bt) do { __builtin_amdgcn_s_setprio(1); _Pragma("unroll") for (int m = 0; m < 4; ++m) _Pragma("unroll") for (int n = 0; n < 2; ++n) _Pragma("unroll") for (int k = 0; k < 2; ++k) \
        acc[ai][bj][m][n] = __builtin_amdgcn_mfma_f32_16x16x32_bf16(Bt[n][k], At[m][k], acc[ai][bj][m][n], 0, 0, 0); __builtin_amdgcn_s_setprio(0); } while (0)
#define PG8_WAIT_V(n) asm volatile("s_waitcnt vmcnt(" #n ")" ::: "memory")
#define PG8_WAIT_L(n) asm volatile("s_waitcnt lgkmcnt(" #n ")" ::: "memory")
#define PG8_BAR __builtin_amdgcn_s_barrier()
#define PG8_SCHED __builtin_amdgcn_sched_barrier(0)
    Unit cur, nxt; int ui = 0;
    if (!S.next(0, cur)) return;
    f32x4 acc[2][2][4][2];
#pragma unroll
    for (int a = 0; a < 2; ++a)
#pragma unroll
        for (int b = 0; b < 2; ++b)
#pragma unroll
            for (int m = 0; m < 4; ++m)
#pragma unroll
                for (int n = 0; n < 2; ++n) acc[a][b][m][n] = (f32x4){0.f, 0.f, 0.f, 0.f};
    bf16x8 At[4][2], B0[2][2], B1[2][2];
    const char* cA = S.a_base(cur); const char* cB = S.b_base(cur);
    PG8_STAGE(PG8_SB(0, 0), cB, voffB); PG8_STAGE(PG8_SB(0, 1), cB + hstepB, voffB); PG8_STAGE(PG8_SA(0, 0), cA, voffA); PG8_STAGE(PG8_SA(0, 1), cA + hstepA, voffA);
    if (wr == 1) PG8_BAR;
    PG8_WAIT_V(2); PG8_BAR;
    PG8_STAGE(PG8_SB(1, 0), cB + kstep, voffB); PG8_STAGE(PG8_SA(1, 0), cA + kstep, voffA); PG8_STAGE(PG8_SB(1, 1), cB + hstepB + kstep, voffB);
    PG8_WAIT_V(6); PG8_BAR;
    for (;;) {
        const bool has_next = S.next(ui + 1, nxt);
        const char* nA = has_next ? S.a_base(nxt) : cA; const char* nB = has_next ? S.b_base(nxt) : cB;
#pragma nounroll
        for (int t = 0; t < nt; t += 2) {
            const bool last = (t == nt - 2);
            const char* a1 = cA + (size_t)(t + 1) * kstep;
            const char* a2 = last ? nA : cA + (size_t)(t + 2) * kstep; const char* b2 = last ? nB : cB + (size_t)(t + 2) * kstep;
            const char* a3 = a2 + kstep; const char* b3 = b2 + kstep;
            PG8_LDB(B0, 0, 0); PG8_LDB(B1, 0, 1); PG8_SCHED; PG8_LDA(At, 0, 0); PG8_STAGE(PG8_SA(1, 1), a1 + hstepA, voffA);
            PG8_WAIT_V(8); PG8_WAIT_L(0); PG8_BAR; PG8_MMA(0, 0, At, B0); PG8_MMA(0, 1, At, B1); PG8_BAR; PG8_SCHED;
            PG8_LDA(At, 0, 1); PG8_STAGE(PG8_SB(0, 0), b2, voffB); PG8_STAGE(PG8_SB(0, 1), b2 + hstepB, voffB); PG8_STAGE(PG8_SA(0, 0), a2, voffA);
            PG8_WAIT_V(8); PG8_WAIT_L(0); PG8_BAR; PG8_MMA(1, 0, At, B0); PG8_MMA(1, 1, At, B1); PG8_BAR; PG8_SCHED;
            PG8_LDB(B0, 1, 0); PG8_LDB(B1, 1, 1); PG8_SCHED; PG8_LDA(At, 1, 0); PG8_STAGE(PG8_SA(0, 1), a2 + hstepA, voffA);
            PG8_WAIT_V(8); PG8_WAIT_L(0); PG8_BAR; PG8_MMA(0, 0, At, B0); PG8_MMA(0, 1, At, B1); PG8_BAR; PG8_SCHED;
            PG8_LDA(At, 1, 1); PG8_STAGE(PG8_SB(1, 0), b3, voffB); PG8_STAGE(PG8_SB(1, 1), b3 + hstepB, voffB); PG8_STAGE(PG8_SA(1, 0), a3, voffA);
            PG8_WAIT_V(8); PG8_WAIT_L(0); PG8_BAR; PG8_MMA(1, 0, At, B0); PG8_MMA(1, 1, At, B1); PG8_BAR; PG8_SCHED;
        }
        if constexpr (ALIGN_EPI) { if (wr == 0) PG8_BAR; }
        E(acc, cur, wr, wc, fr, fq);
        if (!has_next) break;
#pragma unroll
        for (int a = 0; a < 2; ++a)
#pragma unroll
            for (int b = 0; b < 2; ++b)
#pragma unroll
                for (int m = 0; m < 4; ++m)
#pragma unroll
                    for (int n = 0; n < 2; ++n) acc[a][b][m][n] = (f32x4){0.f, 0.f, 0.f, 0.f};
        cur = nxt; cA = nA; cB = nB; ++ui;
        if constexpr (ALIGN_EPI) { if (wr == 1) PG8_BAR; }
    }
    PG8_WAIT_V(0);
    if constexpr (!ALIGN_EPI) { if (wr == 0) PG8_BAR; }
    PG8_BAR;
#undef PG8_SA
#undef PG8_SB
#undef PG8_STAGE
#undef PG8_LDA
#undef PG8_LDB
#undef PG8_MMA
#undef PG8_WAIT_V
#undef PG8_WAIT_L
#undef PG8_BAR
#undef PG8_SCHED
}
}

namespace att {
constexpr int KSLOT = 12288, VSLOT = 8192, LDS_K = 0, LDS_V = 3 * KSLOT, LDS_BYTES = LDS_V + 3 * VSLOT;
constexpr float THR = 6.0f;
__device__ __forceinline__ void attn_unit(int b, int h, int qb, const bf16_t* __restrict__ Q, const bf16_t* __restrict__ KN, const bf16_t* __restrict__ KR, const bf16_t* __restrict__ VT, bf16_t* __restrict__ O, LAS unsigned char* lds) {
    const int tid = opaque(threadIdx.x), lane = tid & 63, r32 = lane & 31, hi = lane >> 5;
    const int w = __builtin_amdgcn_readfirstlane(tid >> 6);
    const size_t tok0 = (size_t)b * SEQ;
    const int q0 = qb * 256, NT = 4 * (qb + 1);
    const bf16_t* ksrc = KN + (tok0 + lane) * 1024 + h * 64 + 8 * w;
    const bf16_t* rsrc = KR + (tok0 + lane) * 32 + 8 * (w & 3);
    const bf16_t* vsrc = VT + (size_t)(h * 64 + lane) * NTOK + tok0 + 8 * w;
#define ATT_ISSUE(t, slot) do { \
        __builtin_amdgcn_global_load_lds((const unsigned*)(ksrc + (size_t)(t) * 65536), (LAS unsigned*)(lds + LDS_K + (slot) * KSLOT + w * 1024), 16, 0, 0); \
        if (w < 4) __builtin_amdgcn_global_load_lds((const unsigned*)(rsrc + (size_t)(t) * 2048), (LAS unsigned*)(lds + LDS_K + (slot) * KSLOT + (8 + w) * 1024), 16, 0, 0); \
        __builtin_amdgcn_global_load_lds((const unsigned*)(vsrc + (size_t)(t) * 64), (LAS unsigned*)(lds + LDS_V + (slot) * VSLOT + w * 1024), 16, 0, 0); } while (0)
    ATT_ISSUE(0, 0); ATT_ISSUE(1, 1);
    bf16x8 qr[6];
    { const bf16_t* qp = Q + (tok0 + q0 + w * 32 + r32) * QPITCH + h * 96 + hi * 8;
#pragma unroll
      for (int d0 = 0; d0 < 6; ++d0) qr[d0] = *(const bf16x8*)(qp + d0 * 16); }
    const int kvp = (r32 & 19) | ((r32 & 4) << 1) | ((r32 & 8) >> 1);
    const int kfoff = hi * 1024 + kvp * 16, vfoff = hi * 1024 + r32 * 16;
    float mhat = 0.f, lsum = 0.f;
    f32x16 o0 = {}, o1 = {}, negm = {};
    const int qrel = w * 32 + r32;
    int slot = 0;
    for (int t = 0; t < NT; ++t) {
        if (t == 0 || t + 1 >= NT) asm volatile("s_waitcnt vmcnt(0)" ::: "memory");
        else if (w < 4) asm volatile("s_waitcnt vmcnt(3)" ::: "memory");
        else asm volatile("s_waitcnt vmcnt(2)" ::: "memory");
        __builtin_amdgcn_s_barrier();
        asm volatile("" ::: "memory");
        if (t + 2 < NT) { const int s2 = (slot == 0) ? 2 : slot - 1; ATT_ISSUE(t + 2, s2); }
        const int jb = t - (NT - 4);
        const bool active = (jb < 0) || (jb <= (w >> 1));
        if (active) {
            const LAS unsigned char* kb = lds + LDS_K + slot * KSLOT + kfoff;
            const LAS unsigned char* vb = lds + LDS_V + slot * VSLOT + vfoff;
            f32x16 p0 = negm, p1 = negm;
#pragma unroll
            for (int d0 = 0; d0 < 6; ++d0) {
                const bf16x8 k0 = *(const LAS bf16x8*)(kb + d0 * 2048), k1 = *(const LAS bf16x8*)(kb + d0 * 2048 + 512);
                p0 = __builtin_amdgcn_mfma_f32_32x32x16_bf16(k0, qr[d0], p0, 0, 0, 0);
                p1 = __builtin_amdgcn_mfma_f32_32x32x16_bf16(k1, qr[d0], p1, 0, 0, 0);
            }
            if (jb >= 0) {
                const int kb0 = 64 * jb + 8 * hi;
#pragma unroll
                for (int r = 0; r < 16; ++r) { const int key = kb0 + (r & 3) + 4 * ((r >> 2) & 1) + 16 * (r >> 3);
                    if (key > qrel) p0[r] = -INFINITY; if (key + 32 > qrel) p1[r] = -INFINITY; }
            }
            float rm = fmaxf(p0[0], p1[0]);
#pragma unroll
            for (int r = 1; r < 16; ++r) rm = fmaxf(rm, fmaxf(p0[r], p1[r]));
            { auto rr = __builtin_amdgcn_permlane32_swap(__float_as_uint(rm), __float_as_uint(rm), false, false); rm = fmaxf(__uint_as_float(rr[0]), __uint_as_float(rr[1])); }
            if (t == 0) {
                mhat = rm;
#pragma unroll
                for (int r = 0; r < 16; ++r) { p0[r] -= rm; p1[r] -= rm; negm[r] = -mhat; }
            } else if (__any(rm > THR)) {
                const float dl = fmaxf(rm, 0.f); mhat += dl;
                const float f = __builtin_amdgcn_exp2f(-dl); lsum *= f;
#pragma unroll
                for (int r = 0; r < 16; ++r) { p0[r] -= dl; p1[r] -= dl; o0[r] *= f; o1[r] *= f; negm[r] = -mhat; }
            }
            float sacc = 0.f;
#pragma unroll
            for (int r = 0; r < 16; ++r) { p0[r] = __builtin_amdgcn_exp2f(p0[r]); p1[r] = __builtin_amdgcn_exp2f(p1[r]); sacc += p0[r] + p1[r]; }
            lsum += sacc;
            u32x4 pw[4];
#pragma unroll
            for (int i = 0; i < 2; ++i) {
                pw[i] = (u32x4){cvtpk(p0[8 * i], p0[8 * i + 1]), cvtpk(p0[8 * i + 2], p0[8 * i + 3]), cvtpk(p0[8 * i + 4], p0[8 * i + 5]), cvtpk(p0[8 * i + 6], p0[8 * i + 7])};
                pw[2 + i] = (u32x4){cvtpk(p1[8 * i], p1[8 * i + 1]), cvtpk(p1[8 * i + 2], p1[8 * i + 3]), cvtpk(p1[8 * i + 4], p1[8 * i + 5]), cvtpk(p1[8 * i + 6], p1[8 * i + 7])};
            }
#pragma unroll
            for (int kc2 = 0; kc2 < 4; ++kc2) {
                const bf16x8 v0 = *(const LAS bf16x8*)(vb + kc2 * 2048), v1 = *(const LAS bf16x8*)(vb + kc2 * 2048 + 512);
                const bf16x8 pf = __builtin_bit_cast(bf16x8, pw[kc2]);
                o0 = __builtin_amdgcn_mfma_f32_32x32x16_bf16(v0, pf, o0, 0, 0, 0);
                o1 = __builtin_amdgcn_mfma_f32_32x32x16_bf16(v1, pf, o1, 0, 0, 0);
            }
        }
        slot = (slot == 2) ? 0 : slot + 1;
    }
    { auto rr = __builtin_amdgcn_permlane32_swap(__float_as_uint(lsum), __float_as_uint(lsum), false, false); lsum = __uint_as_float(rr[0]) + __uint_as_float(rr[1]); }
    const float inv = 1.0f / lsum;
    bf16_t* op = O + (tok0 + q0 + w * 32 + r32) * 1024 + h * 64 + 4 * hi;
#pragma unroll
    for (int g = 0; g < 4; ++g) {
        u32x2 a, c; a.x = cvtpk(o0[4 * g] * inv, o0[4 * g + 1] * inv); a.y = cvtpk(o0[4 * g + 2] * inv, o0[4 * g + 3] * inv);
        c.x = cvtpk(o1[4 * g] * inv, o1[4 * g + 1] * inv); c.y = cvtpk(o1[4 * g + 2] * inv, o1[4 * g + 3] * inv);
        *(u32x2*)(op + 8 * g) = a; *(u32x2*)(op + 32 + 8 * g) = c;
    }
    asm volatile("s_waitcnt lgkmcnt(0)" ::: "memory");
    __builtin_amdgcn_s_barrier();
#undef ATT_ISSUE
}
}

#define XB_TMO      128
#define XB_XCNT(j)  (256  + 64 * (j))
#define XB_XSUB(j)  (1280 + 64 * (j))
#define XB_XGEN(j)  (2304 + 64 * (j))
#define XB_TOP      3328
#define XB_TOPGEN   3392
#define XCD_BAR_WORDS 3456
#define XB_SPIN_CAP (1u << 18)
__device__ __forceinline__ unsigned xb_ld(unsigned* p)              { return __hip_atomic_load(p, __ATOMIC_RELAXED, __HIP_MEMORY_SCOPE_AGENT); }
__device__ __forceinline__ unsigned xb_add(unsigned* p, unsigned v) { return __hip_atomic_fetch_add(p, v, __ATOMIC_RELAXED, __HIP_MEMORY_SCOPE_AGENT); }
__device__ __forceinline__ unsigned xb_xcc_id() { return (unsigned)__builtin_amdgcn_s_getreg((3 << 11) | 20) & 0xFu; }
#define XB_SPIN(cond, bar) do { unsigned _sp = 0; while (cond) { __builtin_amdgcn_s_sleep(1); \
    if ((++_sp & 255u) == 0u) { if (xb_ld(&(bar)[XB_TMO])) break; if (_sp > XB_SPIN_CAP) { atomicAdd(&(bar)[XB_TMO], 1u); break; } } } } while (0)
struct XcdBarrier { unsigned* bar; unsigned x; volatile LAS unsigned* st; };
__device__ __forceinline__ XcdBarrier xcd_barrier_post(unsigned* bar, volatile LAS unsigned* st) {
    XcdBarrier b; b.bar = bar; b.x = xb_xcc_id(); b.st = st;
    if (threadIdx.x == 0) (void)xb_add(&bar[XB_XCNT(b.x)], 1u);
    return b;
}
__device__ __forceinline__ void xcd_barrier_complete(unsigned* bar, unsigned x, unsigned& nloc, unsigned& nx) {
    const unsigned G = gridDim.x * gridDim.y * gridDim.z;
    unsigned sum, cnt, mine, sp = 0u;
    for (;;) {
        sum = 0u; cnt = 0u; mine = 0u;
#pragma unroll
        for (unsigned j = 0; j < 16; ++j) { const unsigned c = xb_ld(&bar[XB_XCNT(j)]); sum += c; cnt += (c > 0u) ? 1u : 0u; mine = (j == x) ? c : mine; }
        if (sum == G) break;
        __builtin_amdgcn_s_sleep(1);
        if ((++sp & 255u) == 0u) { if (xb_ld(&bar[XB_TMO])) break; if (sp > XB_SPIN_CAP) { atomicAdd(&bar[XB_TMO], 1u); break; } }
    }
    nloc = mine > 0u ? mine : 1u; nx = cnt > 0u ? cnt : 1u;
}
__device__ __forceinline__ void xcd_barrier(const XcdBarrier& b) {
    asm volatile("s_waitcnt vmcnt(0)" ::: "memory");
    __syncthreads();
    if (threadIdx.x == 0) {
        unsigned* bar = b.bar;
        __builtin_amdgcn_s_waitcnt(0);
        unsigned nloc = b.st[0], nx = b.st[1];
        if (nloc == 0u) { xcd_barrier_complete(bar, b.x, nloc, nx); b.st[0] = nloc; b.st[1] = nx; }
        const unsigned old = xb_add(&bar[XB_XSUB(b.x)], 1u);
        const unsigned gen = old / nloc;
        if (old + 1u == (gen + 1u) * nloc) {
            __builtin_amdgcn_fence(__ATOMIC_RELEASE, "agent");
            asm volatile("s_waitcnt vmcnt(0)" ::: "memory");
            const unsigned og = xb_add(&bar[XB_TOP], 1u);
            const unsigned tg = og / nx;
            if (og + 1u == (tg + 1u) * nx) xb_add(&bar[XB_TOPGEN], 1u);
            else XB_SPIN(xb_ld(&bar[XB_TOPGEN]) == tg, bar);
            __builtin_amdgcn_fence(__ATOMIC_ACQUIRE, "agent");
            xb_add(&bar[XB_XGEN(b.x)], 1u);
            asm volatile("s_waitcnt vmcnt(0)" ::: "memory");
        } else {
            XB_SPIN(xb_ld(&bar[XB_XGEN(b.x)]) == gen, bar);
            __builtin_amdgcn_fence(__ATOMIC_ACQUIRE, "agent");
            asm volatile("s_waitcnt vmcnt(0)" ::: "memory");
        }
    }
    __syncthreads();
}

struct Args { const void* in[20]; float* out; unsigned char* ws; int ph_lo, ph_hi; };
typedef const __attribute__((address_space(4))) Args* KArgs;
__device__ __forceinline__ KArgs kargs() { KArgs p = (KArgs)__builtin_amdgcn_kernarg_segment_ptr(); asm volatile("" : "+s"(p)); return p; }
constexpr int NWAVES = 8;
constexpr int PPL = 12;
constexpr int NPHASE = 1 + DEPTH * PPL;

__constant__ double c_invf[16] = {1.0, 0.5623413251903491, 0.31622776601683794, 0.1778279410038923, 0.1, 0.05623413251903491, 0.03162277660168379, 0.01778279410038923,
                                  0.01, 0.005623413251903491, 0.0031622776601683794, 0.0017782794100389228, 0.001, 0.0005623413251903491, 0.00031622776601683794, 0.00017782794100389227};

__device__ __forceinline__ void transpose_item(const float* __restrict__ W, int ldw, int k0, int n0, bf16_t* __restrict__ WT, int ldt, int drow0, float mul, LAS float* scr, int lane) {
#pragma unroll 8
    for (int i = 0; i < 32; ++i) { const int kk = 2 * i + (lane >> 5); scr[kk * 33 + (lane & 31)] = W[(size_t)(k0 + kk) * ldw + n0 + (lane & 31)]; }
    LDS_WAIT(); asm volatile("" ::: "memory");
    const int c = lane & 7;
#pragma unroll
    for (int j = 0; j < 4; ++j) { const int n = (lane >> 3) + 8 * j; const LAS float* s = scr + (8 * c) * 33 + n;
        u32x4 o; o.x = cvtpk(s[0 * 33] * mul, s[1 * 33] * mul); o.y = cvtpk(s[2 * 33] * mul, s[3 * 33] * mul); o.z = cvtpk(s[4 * 33] * mul, s[5 * 33] * mul); o.w = cvtpk(s[6 * 33] * mul, s[7 * 33] * mul);
        *(u32x4*)(WT + (size_t)(drow0 + n) * ldt + k0 + 8 * c) = o; }
    LDS_WAIT(); asm volatile("" ::: "memory");
}

__device__ __forceinline__ void sincos_d(double a, float& s, float& c) {
    const double TWO_PI_HI = 6.283185307179586, TWO_PI_LO = 2.4492935982947064e-16, INV_2PI = 0.15915494309189535;
    const double n = __builtin_rint(a * INV_2PI);
    double r = __builtin_fma(-n, TWO_PI_HI, a); r = __builtin_fma(-n, TWO_PI_LO, r);
    const double HALF_PI = 1.5707963267948966, HALF_PI_LO = 6.123233995736766e-17;
    const double qd = __builtin_rint(r * 0.6366197723675814);
    double y = __builtin_fma(-qd, HALF_PI, r); y = __builtin_fma(-qd, HALF_PI_LO, y);
    const int q = ((int)qd) & 3;
    const double y2 = y * y;
    double sp = -7.647163731819816e-13; sp = sp * y2 + 1.6059043836821613e-10; sp = sp * y2 - 2.505210838544172e-08; sp = sp * y2 + 2.7557319223985893e-06; sp = sp * y2 - 0.0001984126984126984;
    sp = sp * y2 + 0.008333333333333333; sp = sp * y2 - 0.16666666666666666; sp = y + y * y2 * sp;
    double cp = 4.779477332387385e-14; cp = cp * y2 - 1.1470745597729725e-11; cp = cp * y2 + 2.08767569878681e-09; cp = cp * y2 - 2.755731922398589e-07; cp = cp * y2 + 2.48015873015873e-05;
    cp = cp * y2 - 0.001388888888888889; cp = cp * y2 + 0.041666666666666664; cp = cp * y2 - 0.5; cp = 1.0 + y2 * cp;
    double ss, cc;
    if (q == 0) { ss = sp; cc = cp; } else if (q == 1) { ss = cp; cc = -sp; } else if (q == 2) { ss = -sp; cc = -cp; } else { ss = -cp; cc = sp; }
    s = (float)ss; c = (float)cc;
}

__global__ void __launch_bounds__(NWAVES * 64, 2) mk_fwd(Args args_unused) {
    extern __shared__ __attribute__((aligned(16))) unsigned char lds_raw[];
    LAS unsigned char* lds = (LAS unsigned char*)lds_raw;
    volatile LAS unsigned* MISC = (volatile LAS unsigned*)(lds + MISC_OFF);
    int tid = threadIdx.x, lane = tid & 63, wave = __builtin_amdgcn_readfirstlane(tid >> 6);
    const int G = gridDim.x, bx = blockIdx.x;
    const int vcu = (G % 8 == 0) ? (bx % 8) * (G / 8) + bx / 8 : bx;
    int gw = vcu * NWAVES + wave; const int NGW = G * NWAVES;
#define ws (kargs()->ws)
    unsigned* ctl = (unsigned*)(ws + WS_CTL);
    for (int u = tid; u < (LDS_BYTES - LDSCTL_OFF) / 4; u += NWAVES * 64) ((LAS unsigned*)(lds + LDSCTL_OFF))[u] = 0u;
    __syncthreads();
    XcdBarrier bar; bar.bar = ctl + CW_BAR; bar.x = 0; bar.st = nullptr;
#if MK_ONE_LAUNCH
    bar = xcd_barrier_post(ctl + CW_BAR, MISC + 8);
#endif
    const int lo = kargs()->ph_lo, hi = kargs()->ph_hi;
#ifndef MK_PH_MASK
#define MK_PH_MASK 0xffffffffu
#endif
#define PHON(b) ((MK_PH_MASK >> (b)) & 1u)
#define IN(k) (lo <= (k) && (k) < hi)
#if MK_ONE_LAUNCH
#define SEAM(k) do { if ((k) + 1 < hi) xcd_barrier(bar); } while (0)
#else
#define SEAM(k) do { } while (0)
#endif
#define in_x ((const float*)kargs()->in[0])
#define in_pos ((const int*)kargs()->in[1])
#define ln_g ((const float*)kargs()->in[2])
#define ln_b ((const float*)kargs()->in[3])
#define w_in ((const float*)kargs()->in[4])
#define q_norm ((const float*)kargs()->in[5])
#define w_uq ((const float*)kargs()->in[6])
#define kv_norm ((const float*)kargs()->in[7])
#define w_ukv ((const float*)kargs()->in[8])
#define w_o ((const float*)kargs()->in[9])
#define pool_w ((const float*)kargs()->in[10])
#define pool_b ((const float*)kargs()->in[11])
#define pool_scale ((const float*)kargs()->in[12])
#define w_grp ((const float*)kargs()->in[13])
#define b_grp ((const float*)kargs()->in[14])
#define w_exp ((const float*)kargs()->in[15])
#define b_exp ((const float*)kargs()->in[16])
#define w1 ((const float*)kargs()->in[17])
#define w3 ((const float*)kargs()->in[18])
#define w2 ((const float*)kargs()->in[19])
#define COS ((float*)(ws + WS_COS))
#define SIN ((float*)(ws + WS_SIN))
#define CNT ((int*)(ws + WS_CNT))
#define TILE ((int*)(ws + WS_TILE))
#define AE ((int*)(ws + WS_AE))
#define APOS ((int*)(ws + WS_APOS))
#define AG ((float*)(ws + WS_AG))
#define RSLOT ((int*)(ws + WS_RSLOT))
#define RGATE ((float*)(ws + WS_RGATE))
#define WIN ((bf16_t*)(ws + WS_WIN))
#define WUQ ((bf16_t*)(ws + WS_WUQ))
#define WUK ((bf16_t*)(ws + WS_WUK))
#define WUV ((bf16_t*)(ws + WS_WUV))
#define WO ((bf16_t*)(ws + WS_WO))
#define WP ((bf16_t*)(ws + WS_WP))
#define WR ((bf16_t*)(ws + WS_WR))
#define W13 ((bf16_t*)(ws + WS_W13))
#define W2T ((bf16_t*)(ws + WS_W2T))
#define ZB ((float*)(ws + WS_ZB))
#define XHL ((bf16_t*)(ws + WS_XHL))
#define LATB ((float*)(ws + WS_LAT))
#define CQ ((bf16_t*)(ws + WS_CQ))
#define CKV ((bf16_t*)(ws + WS_CKV))
#define KR ((bf16_t*)(ws + WS_KR))
#define QB ((bf16_t*)(ws + WS_Q))
#define KN ((bf16_t*)(ws + WS_KN))
#define VT ((bf16_t*)(ws + WS_VT))
#define OB ((bf16_t*)(ws + WS_O))
#define POOLED ((bf16_t*)(ws + WS_POOLED))
#define LG ((float*)(ws + WS_LG))
#define XS ((bf16_t*)(ws + WS_XS))
#define HS ((bf16_t*)(ws + WS_HS))
#define YB ((bf16_t*)(ws + WS_Y))
    LAS float* scr = (LAS float*)(lds + RING_OFF + wave * 16384);

    if (PHON(12) && IN(0)) {
        for (int m = gw; m < NTOK; m += NGW) {
            const f32x4* xr = (const f32x4*)(in_x + (size_t)m * D_MODEL) + lane; u32x2* oh = (u32x2*)(XHL + (size_t)m * 2048) + lane;
#pragma unroll
            for (int j = 0; j < 4; ++j) { u32x2 h, l; split4(xr[64 * j], h, l); oh[64 * j] = h; oh[256 + 64 * j] = l; }
        }
        for (int idx = gw * 64 + lane; idx < NTOK * 16; idx += NGW * 64) { float s, c; sincos_d((double)in_pos[idx >> 4] * c_invf[idx & 15], s, c); COS[idx] = c; SIN[idx] = s; }
        for (int idx = gw * 64 + lane; idx < DEPTH * 256 * 2048; idx += NGW * 64) {
            const int l = idx >> 19, row = (idx >> 11) & 255, kk = idx & 2047, k = kk & 1023, second = kk >> 10;
            const int j = row < 72 ? row : ((row >= 128 && row < 200) ? row - 128 : -1);
            float v = 0.f;
            if (j >= 0) { const float wv = (j < 8) ? w_grp[((size_t)l * 1024 + k) * 8 + j] : w_exp[((size_t)l * 1024 + k) * 64 + (j - 8)];
                const float whi = bflo(cvtpk(wv, 0.f)); v = (row < 72) ? whi : (second ? 0.f : (wv - whi)); }
            WR[idx] = (bf16_t)(cvtpk(v, 0.f) & 0xffffu);
        }
        for (int idx = gw * 64 + lane; idx < 2 * 96 * 1024 / 8; idx += NGW * 64) { const int j = idx / (96 * 128), r = idx % (96 * 128); *(u32x4*)(WIN + ((size_t)j * 512 + 416) * 1024 + (size_t)r * 8) = (u32x4){0u, 0u, 0u, 0u}; }
        constexpr int I_IN = 16 * 13, I_UQ = 4 * 48, I_UKV = 2 * 64, I_O = 16 * 32, I_P = 4 * 8;
        constexpr int NIT = 2 * (I_IN + I_UQ + I_UKV + I_O) + 8 * I_P;
        for (int it = gw; it < NIT; it += NGW) {
            int r = it;
            if (r < 2 * I_IN) { const int j = r / I_IN, q = r % I_IN, kb = q / 13, nb = q % 13;
                transpose_item(w_in + (size_t)j * 1024 * LAT, LAT, 64 * kb, 32 * nb, WIN + (size_t)j * 512 * 1024, 1024, 32 * nb, 1.f, scr, lane); continue; } r -= 2 * I_IN;
            if (r < 2 * I_UQ) { const int j = r / I_UQ, q = r % I_UQ, kb = q / 48, nb = q % 48; const int n0 = 32 * nb, head = n0 / 96, r0 = n0 % 96;
                if (r0 < 64) transpose_item(w_uq + (size_t)j * 256 * QPITCH, QPITCH, 64 * kb, n0, WUQ + (size_t)j * 1536 * 256, 256, head * 64 + r0, QSCALE, scr, lane);
                else {
                    const float* W = w_uq + (size_t)j * 256 * QPITCH; bf16_t* WT = WUQ + (size_t)j * 1536 * 256; const int k0 = 64 * kb;
#pragma unroll 8
                    for (int i = 0; i < 32; ++i) { const int kk = 2 * i + (lane >> 5); scr[kk * 33 + (lane & 31)] = W[(size_t)(k0 + kk) * QPITCH + n0 + (lane & 31)]; }
                    LDS_WAIT(); asm volatile("" ::: "memory");
                    const int c = lane & 7;
#pragma unroll
                    for (int jj = 0; jj < 4; ++jj) { const int n = (lane >> 3) + 8 * jj; const LAS float* s = scr + (8 * c) * 33 + n;
                        const int drow = 1024 + (head >> 3) * 256 + (head & 7) * 16 + (n < 16 ? n : 128 + n - 16);
                        u32x4 o; o.x = cvtpk(s[0 * 33] * QSCALE, s[1 * 33] * QSCALE); o.y = cvtpk(s[2 * 33] * QSCALE, s[3 * 33] * QSCALE); o.z = cvtpk(s[4 * 33] * QSCALE, s[5 * 33] * QSCALE); o.w = cvtpk(s[6 * 33] * QSCALE, s[7 * 33] * QSCALE);
                        *(u32x4*)(WT + (size_t)drow * 256 + k0 + 8 * c) = o; }
                    LDS_WAIT(); asm volatile("" ::: "memory");
                }
                continue; } r -= 2 * I_UQ;
            if (r < 2 * I_UKV) { const int j = r / I_UKV, q = r % I_UKV, kb = q / 64, nb = q % 64; const int n0 = 32 * nb, head = n0 >> 7, r0 = n0 & 127;
                if (r0 < 64) transpose_item(w_ukv + (size_t)j * 128 * 2048, 2048, 64 * kb, n0, WUK + (size_t)j * 1024 * 128, 128, head * 64 + r0, 1.f, scr, lane);
                else transpose_item(w_ukv + (size_t)j * 128 * 2048, 2048, 64 * kb, n0, WUV + (size_t)j * 1024 * 128, 128, head * 64 + r0 - 64, 1.f, scr, lane);
                continue; } r -= 2 * I_UKV;
            if (r < 2 * I_O) { const int j = r / I_O, q = r % I_O, kb = q / 32, nb = q % 32;
                transpose_item(w_o + (size_t)j * 1024 * 1024, 1024, 64 * kb, 32 * nb, WO + (size_t)j * 1024 * 1024, 1024, 32 * nb, 1.f, scr, lane); continue; } r -= 2 * I_O;
            { const int jg = r / I_P, q = r % I_P, kb = q / 8, nb = q % 8;
                transpose_item(pool_w + (size_t)jg * 65536, 256, 64 * kb, 32 * nb, WP + (size_t)jg * 65536, 256, 32 * nb, 1.f, scr, lane); }
        }
        SEAM(0);
    }

    for (int l = 0; l < DEPTH; ++l) {
        const int pb = 1 + PPL * l, j = l >> 1;
        tid = opaque(threadIdx.x); lane = tid & 63; wave = __builtin_amdgcn_readfirstlane(tid >> 6); gw = vcu * NWAVES + wave; scr = (LAS float*)(lds + RING_OFF + wave * 16384);
        const bool mla = (l & 1) == 0;
#define MOE_WEIGHT_CONV() do { \
            constexpr int I13 = 64 * 16 * 8, I2 = 64 * 4 * 32; \
            for (int it = gw; it < 2 * I13 + I2; it += NGW) { int r = it; \
                if (r < 2 * I13) { const int which = r / I13, q = r % I13, e = q >> 7, kb = (q >> 3) & 15, nb = q & 7; const int n0 = 32 * nb; \
                    const float* W = (which ? w3 : w1) + ((size_t)l * 64 + e) * 1024 * 256; \
                    transpose_item(W, 256, 64 * kb, n0, W13 + (size_t)e * 512 * 1024, 1024, (n0 >> 7) * 256 + (n0 & 127) + which * 128, 1.f, scr, lane); } \
                else { r -= 2 * I13; const int e = r >> 7, kb = (r >> 5) & 3, nb = r & 31; \
                    transpose_item(w2 + ((size_t)l * 64 + e) * 256 * 1024, 1024, 64 * kb, 32 * nb, W2T + (size_t)e * 1024 * 256, 256, 32 * nb, 1.f, scr, lane); } } } while (0)

        if (mla) {
            if (PHON(0) && IN(pb + 0)) {
                pg8::Gemm g{2048, 1024, 1024}; pg8::DenseOrder S; S.init(NTOK, 512, G, bx, XHL, (size_t)256 * 2048 * 2, 0, WIN + (size_t)j * 512 * 1024, (size_t)256 * 1024 * 2);
                pg8::EpiF32 E{LATB, 512};
                pg8::gemm_phase<pg8::EpiF32, pg8::DenseOrder, true>(lds + RING_OFF, g, S, E);
                MOE_WEIGHT_CONV();
                SEAM(pb + 0);
            }
            if (PHON(1) && IN(pb + 1)) {
                const float* gq = q_norm + j * 256; const float* gk = kv_norm + j * 128;
                const f32x4 gqv = *(const f32x4*)(gq + 4 * lane); const f32x4 gkv = *(const f32x4*)(gk + 4 * (lane & 31));
                for (int m = gw; m < NTOK; m += NGW) {
                    const float* lr = LATB + (size_t)m * 512;
                    const f32x4 a = *(const f32x4*)(lr + 4 * lane), c = *(const f32x4*)(lr + 256 + 4 * lane);
                    const float sq = wave_sum(a.x * a.x + a.y * a.y + a.z * a.z + a.w * a.w);
                    const float sk = wave_sum(lane < 32 ? (c.x * c.x + c.y * c.y + c.z * c.z + c.w * c.w) : 0.f);
                    const float rq = 1.0f / sqrtf(sq * (1.f / 256.f) + RMS_EPS), rk = 1.0f / sqrtf(sk * (1.f / 128.f) + RMS_EPS);
                    { u32x2 o; o.x = cvtpk(a.x * rq * gqv.x, a.y * rq * gqv.y); o.y = cvtpk(a.z * rq * gqv.z, a.w * rq * gqv.w); *((u32x2*)(CQ + (size_t)m * 256) + lane) = o; }
                    if (lane < 32) { u32x2 o; o.x = cvtpk(c.x * rk * gkv.x, c.y * rk * gkv.y); o.y = cvtpk(c.z * rk * gkv.z, c.w * rk * gkv.w); *((u32x2*)(CKV + (size_t)m * 128) + lane) = o; }
                    f32x4 p; p.x = __shfl_xor(c.x, 4); p.y = __shfl_xor(c.y, 4); p.z = __shfl_xor(c.z, 4); p.w = __shfl_xor(c.w, 4);
                    if (lane >= 32 && lane < 40) {
                        const f32x4 cv = *(const f32x4*)(COS + (size_t)m * 16 + 4 * (lane & 3)), sv = *(const f32x4*)(SIN + (size_t)m * 16 + 4 * (lane & 3));
                        f32x4 y; if (lane < 36) y = c * cv - p * sv; else y = c * cv + p * sv;
                        u32x2 o; o.x = cvtpk(y.x, y.y); o.y = cvtpk(y.z, y.w); *((u32x2*)(KR + (size_t)m * 32) + (lane - 32)) = o;
                    }
                }
                SEAM(pb + 1);
            }
            if (PHON(2) && IN(pb + 2)) {
                { pg8::Gemm g{256, 256, 256}; pg8::DenseOrder S; S.init(NTOK, 1536, G, bx, CQ, (size_t)256 * 256 * 2, 0, WUQ + (size_t)j * 1536 * 256, (size_t)256 * 256 * 2);
                  pg8::EpiQ E{QB, COS, SIN};
                  pg8::gemm_phase<pg8::EpiQ, pg8::DenseOrder, true>(lds + RING_OFF, g, S, E); }
                { pg8::Gemm g{128, 128, 128}; pg8::DenseOrder S; S.init(NTOK, 1024, G, bx, CKV, (size_t)256 * 128 * 2, 0, WUK + (size_t)j * 1024 * 128, (size_t)256 * 128 * 2);
                  pg8::EpiBf16 E{KN, 1024};
                  pg8::gemm_phase<pg8::EpiBf16, pg8::DenseOrder, true>(lds + RING_OFF, g, S, E); }
                { pg8::Gemm g{128, 128, 128}; pg8::DenseOrder S; S.init(1024, NTOK, G, bx, WUV + (size_t)j * 1024 * 128, (size_t)256 * 128 * 2, 0, CKV, (size_t)256 * 128 * 2);
                  pg8::EpiBf16 E{VT, (size_t)NTOK};
                  pg8::gemm_phase<pg8::EpiBf16, pg8::DenseOrder, true>(lds + RING_OFF, g, S, E); }
                SEAM(pb + 2);
            }
            if (PHON(3) && IN(pb + 3)) {
                for (int i = 0;; ++i) {
                    const int L = i * G + vcu; if (L >= 2048) break;
                    const int sl = L & 255, rnd = L >> 8, s = sl & 7, bh = (sl >> 3) + 32 * (rnd >> 2), k = rnd & 3;
                    const int qb = (k == 0) ? s : (k == 1) ? 15 - s : (k == 2) ? 16 + s : 31 - s;
                    att::attn_unit(bh >> 4, bh & 15, qb, QB, KN, KR, VT, OB, lds + RING_OFF);
                }
                SEAM(pb + 3);
            }
            if (PHON(4) && IN(pb + 4)) {
                pg8::Gemm g{1024, 1024, 1024}; pg8::DenseOrder S; S.init(NTOK, 1024, G, bx, OB, (size_t)256 * 1024 * 2, 0, WO + (size_t)j * 1024 * 1024, (size_t)256 * 1024 * 2);
                pg8::EpiRes E{XHL, ZB};
                pg8::gemm_phase<pg8::EpiRes, pg8::DenseOrder, true>(lds + RING_OFF, g, S, E);
                SEAM(pb + 4);
            }
        } else {
            if (PHON(13) && IN(pb + 0)) {
                for (int it = gw; it < 4 * (NTOK / 64); it += NGW) {
                    const int grp = it & 3, chunk = it >> 2, t0 = chunk * 64, s0 = t0 & (SEQ - 1), win = 2 << grp;
                    const bf16_t* xb = XHL + (size_t)grp * 256 + 4 * lane;
                    f32x4 S4 = {0.f, 0.f, 0.f, 0.f};
                    for (int jj = 1; jj < win; ++jj) { if (s0 - jj >= 0) { const bf16_t* p = xb + (size_t)(t0 - jj) * 2048; S4 += join4(*(const u32x2*)p, *(const u32x2*)(p + 1024)); } }
                    for (int tt = 0; tt < 64; ++tt) {
                        const int t = t0 + tt, s = s0 + tt; const bf16_t* p = xb + (size_t)t * 2048;
                        const f32x4 xv = join4(*(const u32x2*)p, *(const u32x2*)(p + 1024));
                        S4 += xv;
                        const float rc = 1.0f / (float)((s + 1 < win) ? s + 1 : win);
                        const f32x4 pv = S4 * rc - xv;
                        u32x2 o; o.x = cvtpk(pv.x, pv.y); o.y = cvtpk(pv.z, pv.w); *(u32x2*)(POOLED + (size_t)t * 1024 + grp * 256 + 4 * lane) = o;
                        if (s - win + 1 >= 0) { const bf16_t* pp = xb + (size_t)(t - win + 1) * 2048; S4 -= join4(*(const u32x2*)pp, *(const u32x2*)(pp + 1024)); }
                    }
                }
                MOE_WEIGHT_CONV();
                SEAM(pb + 0);
            }
            if (PHON(14) && IN(pb + 1)) {
                pg8::Gemm g{1024, 256, 256}; pg8::DenseOrder S; S.init(NTOK, 1024, G, bx, POOLED, (size_t)256 * 1024 * 2, (size_t)256 * 2, WP + (size_t)j * 4 * 65536, (size_t)65536 * 2);
                pg8::EpiPool E{XHL, ZB, pool_b + j * 1024, pool_scale + j * 1024};
                pg8::gemm_phase<pg8::EpiPool, pg8::DenseOrder, true>(lds + RING_OFF, g, S, E);
                SEAM(pb + 1);
            }
        }
        if (PHON(5) && IN(pb + 5)) {
            f32x4 gv[4], bv[4];
#pragma unroll
            for (int jj = 0; jj < 4; ++jj) { gv[jj] = *(const f32x4*)(ln_g + (size_t)(l * 2 + 0) * 1024 + 4 * lane + 256 * jj); bv[jj] = *(const f32x4*)(ln_b + (size_t)(l * 2 + 0) * 1024 + 4 * lane + 256 * jj); }
            for (int m = gw; m < NTOK; m += NGW) {
                const f32x4* zr = (const f32x4*)(ZB + (size_t)m * 1024) + lane; f32x4 v[4]; float s = 0.f;
#pragma unroll
                for (int jj = 0; jj < 4; ++jj) { v[jj] = zr[64 * jj]; s += (v[jj].x + v[jj].y) + (v[jj].z + v[jj].w); }
                const float mean = wave_sum(s) * (1.f / 1024.f); float s2 = 0.f;
#pragma unroll
                for (int jj = 0; jj < 4; ++jj) { v[jj] = v[jj] - mean; s2 += (v[jj].x * v[jj].x + v[jj].y * v[jj].y) + (v[jj].z * v[jj].z + v[jj].w * v[jj].w); }
                const float rstd = 1.0f / sqrtf(wave_sum(s2) * (1.f / 1024.f) + LN_EPS);
                u32x2* oh = (u32x2*)(XHL + (size_t)m * 2048) + lane;
#pragma unroll
                for (int jj = 0; jj < 4; ++jj) { const f32x4 y = v[jj] * rstd * gv[jj] + bv[jj]; u32x2 h, lo2; split4(y, h, lo2); oh[64 * jj] = h; oh[256 + 64 * jj] = lo2; }
            }
            SEAM(pb + 5);
        }
        if (PHON(6) && IN(pb + 6)) {
            pg8::Gemm g{2048, 2048, 2048}; pg8::DenseOrder S; S.init(NTOK, 256, G, bx, XHL, (size_t)256 * 2048 * 2, 0, WR + (size_t)l * 256 * 2048, 0);
            pg8::EpiRouter E{LG};
            pg8::gemm_phase<pg8::EpiRouter, pg8::DenseOrder, true>(lds + RING_OFF, g, S, E);
            SEAM(pb + 6);
        }
        if (PHON(7) && IN(pb + 7)) {
            LAS int* hist = (LAS int*)(lds + RING_OFF);
            const float* bg = b_grp + l * 8; const float* be = b_exp + l * 64;
            for (int c = bx; c < 256; c += G) {
                if (tid < 64) hist[tid] = 0;
                __syncthreads();
                if (tid < 128) {
                    const int t = c * 128 + tid; const float* lg = LG + (size_t)t * LGP;
                    const f32x4 g0 = *(const f32x4*)lg, g1 = *(const f32x4*)(lg + 4);
                    float gl[8] = {g0.x + bg[0], g0.y + bg[1], g0.z + bg[2], g0.w + bg[3], g1.x + bg[4], g1.y + bg[5], g1.z + bg[6], g1.w + bg[7]};
                    int gs = 0; float gm = gl[0];
#pragma unroll
                    for (int i = 1; i < 8; ++i) if (gl[i] > gm) { gm = gl[i]; gs = i; }
                    float se = 0.f;
#pragma unroll
                    for (int i = 0; i < 8; ++i) se += __expf(gl[i] - gm);
                    const float ggate = 1.0f / se;
                    const f32x4 e0 = *(const f32x4*)(lg + 8 + gs * 8), e1 = *(const f32x4*)(lg + 12 + gs * 8);
                    const f32x4 b0 = *(const f32x4*)(be + gs * 8), b1 = *(const f32x4*)(be + gs * 8 + 4);
                    float el[8] = {e0.x + b0.x, e0.y + b0.y, e0.z + b0.z, e0.w + b0.w, e1.x + b1.x, e1.y + b1.y, e1.z + b1.z, e1.w + b1.w};
                    int i1 = 0; float m1 = el[0];
#pragma unroll
                    for (int i = 1; i < 8; ++i) if (el[i] > m1) { m1 = el[i]; i1 = i; }
                    int i2 = -1; float m2 = -INFINITY;
#pragma unroll
                    for (int i = 0; i < 8; ++i) if (i != i1 && el[i] > m2) { m2 = el[i]; i2 = i; }
                    const float x2 = __expf(m2 - m1), rs = 1.0f / (1.0f + x2);
                    const int ex1 = gs * 8 + i1, ex2 = gs * 8 + i2;
                    const int p1 = __hip_atomic_fetch_add(&hist[ex1], 1, __ATOMIC_RELAXED, __HIP_MEMORY_SCOPE_WORKGROUP), p2 = __hip_atomic_fetch_add(&hist[ex2], 1, __ATOMIC_RELAXED, __HIP_MEMORY_SCOPE_WORKGROUP);
                    AE[2 * t] = ex1; AE[2 * t + 1] = ex2; APOS[2 * t] = p1; APOS[2 * t + 1] = p2; AG[2 * t] = ggate * rs; AG[2 * t + 1] = ggate * x2 * rs;
                }
                __syncthreads();
                if (tid < 64) CNT[c * 64 + tid] = hist[tid];
                __syncthreads();
            }
            SEAM(pb + 7);
        }
        if (PHON(8) && IN(pb + 8)) {
            LAS int* part = (LAS int*)(lds + RING_OFF); LAS int* pstart = part + 512; LAS int* tot = pstart + 64; LAS int* base = tot + 64; LAS int* misc = base + 64;
            { const int e = tid & 63, p = tid >> 6; int s = 0; for (int c = 32 * p; c < 32 * p + 32; ++c) s += CNT[c * 64 + e]; part[p * 64 + e] = s; }
            __syncthreads();
            if (tid < 64) { int s = 0; for (int p = 0; p < 8; ++p) s += part[p * 64 + tid]; tot[tid] = s; }
            __syncthreads();
            if (tid == 0) { int a = 0; for (int e = 0; e < 64; ++e) { pstart[e] = a; a += (tot[e] + 255) & ~255; } misc[0] = a >> 8; }
            __syncthreads();
            if (bx == 0) {
                const int ntl = misc[0];
                for (int i = tid; i < MAX_TILES; i += NWAVES * 64) { int ee = 0; for (int e = 0; e < 64; ++e) if (pstart[e] <= i * 256) ee = e; TILE[i] = (i < ntl) ? ee : 0; }
                if (tid == 0) TILE[MAX_TILES] = ntl;
            }
            for (int e = bx; e < 64; e += G) { const int r0 = pstart[e] + tot[e], r1 = pstart[e] + ((tot[e] + 255) & ~255); for (int r = r0 + tid; r < r1; r += NWAVES * 64) { RSLOT[r] = -1; RGATE[r] = 0.f; } }
            for (int c = bx; c < 256; c += G) {
                __syncthreads();
                { const int e = tid & 63, p = tid >> 6; int s = 0; for (int cc = 32 * p; cc < 32 * p + 32 && cc < c; ++cc) s += CNT[cc * 64 + e]; part[p * 64 + e] = s; }
                __syncthreads();
                if (tid < 64) { int s = pstart[tid]; for (int p = 0; p < 8; ++p) s += part[p * 64 + tid]; base[tid] = s; }
                __syncthreads();
                for (int i = 0; i < 32; ++i) {
                    const int ga = c * 256 + wave * 32 + i, t = ga >> 1;
                    const int e = AE[ga], dest = base[e] + APOS[ga];
                    const u32x4* src = (const u32x4*)(XHL + (size_t)t * 2048); u32x4* dst = (u32x4*)(XS + (size_t)dest * 1024);
                    const u32x4 v0 = src[lane], v1 = src[64 + lane]; dst[lane] = v0; dst[64 + lane] = v1;
                    if (lane == 0) { RSLOT[dest] = ga; RGATE[dest] = AG[ga]; }
                }
            }
            SEAM(pb + 8);
        }
        if (PHON(9) && IN(pb + 9)) {
            const int ntl = TILE[MAX_TILES];
            pg8::Gemm g{1024, 1024, 1024}; pg8::MoeOrder S; S.init(TILE, ntl, 2, G, bx, XS, (size_t)256 * 1024 * 2, W13, (size_t)512 * 1024 * 2, (size_t)256 * 1024 * 2);
            pg8::EpiSwiglu E{HS};
            pg8::gemm_phase<pg8::EpiSwiglu, pg8::MoeOrder, true>(lds + RING_OFF, g, S, E);
            SEAM(pb + 9);
        }
        if (PHON(10) && IN(pb + 10)) {
            const int ntl = TILE[MAX_TILES];
            pg8::Gemm g{256, 256, 256}; pg8::MoeOrder S; S.init(TILE, ntl, 4, G, bx, HS, (size_t)256 * 256 * 2, W2T, (size_t)1024 * 256 * 2, (size_t)256 * 256 * 2);
            pg8::EpiMoeOut E{YB, RSLOT, RGATE};
            pg8::gemm_phase<pg8::EpiMoeOut, pg8::MoeOrder, true>(lds + RING_OFF, g, S, E);
            SEAM(pb + 10);
        }
        if (PHON(11) && IN(pb + 11)) {
            f32x4 gv[4], bv[4];
#pragma unroll
            for (int jj = 0; jj < 4; ++jj) { gv[jj] = *(const f32x4*)(ln_g + (size_t)(l * 2 + 1) * 1024 + 4 * lane + 256 * jj); bv[jj] = *(const f32x4*)(ln_b + (size_t)(l * 2 + 1) * 1024 + 4 * lane + 256 * jj); }
            const bool lastl = (l == DEPTH - 1);
            for (int m = gw; m < NTOK; m += NGW) {
                u32x2* xh = (u32x2*)(XHL + (size_t)m * 2048) + lane;
                const u32x2* y0 = (const u32x2*)(YB + (size_t)(2 * m) * 1024) + lane; const u32x2* y1 = (const u32x2*)(YB + (size_t)(2 * m + 1) * 1024) + lane;
                f32x4 v[4]; float s = 0.f;
#pragma unroll
                for (int jj = 0; jj < 4; ++jj) { v[jj] = join4(xh[64 * jj], xh[256 + 64 * jj]) * DN_ALPHA + (bf4(y0[64 * jj]) + bf4(y1[64 * jj])); s += (v[jj].x + v[jj].y) + (v[jj].z + v[jj].w); }
                const float mean = wave_sum(s) * (1.f / 1024.f); float s2 = 0.f;
#pragma unroll
                for (int jj = 0; jj < 4; ++jj) { v[jj] = v[jj] - mean; s2 += (v[jj].x * v[jj].x + v[jj].y * v[jj].y) + (v[jj].z * v[jj].z + v[jj].w * v[jj].w); }
                const float rstd = 1.0f / sqrtf(wave_sum(s2) * (1.f / 1024.f) + LN_EPS);
                if (lastl) { f32x4* orow = (f32x4*)(kargs()->out + (size_t)m * 1024) + lane;
#pragma unroll
                    for (int jj = 0; jj < 4; ++jj) orow[64 * jj] = v[jj] * rstd * gv[jj] + bv[jj];
                } else {
#pragma unroll
                    for (int jj = 0; jj < 4; ++jj) { const f32x4 y = v[jj] * rstd * gv[jj] + bv[jj]; u32x2 h, lo2; split4(y, h, lo2); xh[64 * jj] = h; xh[256 + 64 * jj] = lo2; }
                }
            }
            SEAM(pb + 11);
        }
    }
#undef IN
#undef SEAM
}
#undef ws
#undef in_x
#undef in_pos
#undef ln_g
#undef ln_b
#undef w_in
#undef q_norm
#undef w_uq
#undef kv_norm
#undef w_ukv
#undef w_o
#undef pool_w
#undef pool_b
#undef pool_scale
#undef w_grp
#undef b_grp
#undef w_exp
#undef b_exp
#undef w1
#undef w3
#undef w2
#undef COS
#undef SIN
#undef CNT
#undef TILE
#undef AE
#undef APOS
#undef AG
#undef RSLOT
#undef RGATE
#undef WIN
#undef WUQ
#undef WUK
#undef WUV
#undef WO
#undef WP
#undef WR
#undef W13
#undef W2T
#undef ZB
#undef XHL
#undef LATB
#undef CQ
#undef CKV
#undef KR
#undef QB
#undef KN
#undef VT
#undef OB
#undef POOLED
#undef LG
#undef XS
#undef HS
#undef YB

static bool phase_exists(int p) {
    if (p == 0) return true;
    const int l = (p - 1) / PPL, k = (p - 1) % PPL;
    if (k >= 5) return true;
    return (l & 1) == 0 ? true : (k < 2);
}
extern "C" void kernel_launch(void* const* d_in, const int* in_sizes, int n_in, void* d_out, int out_size, void* d_ws, size_t ws_size, hipStream_t stream) {
    static int grid = 0;
    if (grid == 0) {
        if (n_in != 20 || in_sizes[0] != NTOK * D_MODEL || out_size != NTOK * D_MODEL || ws_size < WS_END) { fprintf(stderr, "kernel_launch: unexpected shapes / workspace (%zu < %zu)\n", ws_size, (size_t)WS_END); grid = -1; return; }
        int dev = 0, cus = 0, per_cu = 0;
        if (hipGetDevice(&dev) != hipSuccess || hipDeviceGetAttribute(&cus, hipDeviceAttributeMultiprocessorCount, dev) != hipSuccess) { grid = -1; return; }
        if (hipFuncSetAttribute((const void*)mk_fwd, hipFuncAttributeMaxDynamicSharedMemorySize, LDS_BYTES) != hipSuccess) { fprintf(stderr, "kernel_launch: hipFuncSetAttribute failed\n"); grid = -1; return; }
        if (hipOccupancyMaxActiveBlocksPerMultiprocessor(&per_cu, (const void*)mk_fwd, NWAVES * 64, LDS_BYTES) != hipSuccess || per_cu < 1) fprintf(stderr, "kernel_launch: occupancy query reports %d\n", per_cu);
        (void)hipGetLastError();
        grid = cus;
    }
    if (grid < 0) return;
    if (hipMemsetAsync((char*)d_ws + WS_CTL, 0, CTL_ZERO_BYTES, stream) != hipSuccess) return;
    Args a{};
    for (int i = 0; i < 20; ++i) a.in[i] = d_in[i];
    a.out = (float*)d_out; a.ws = (unsigned char*)d_ws;
#if MK_ONE_LAUNCH
    a.ph_lo = 0; a.ph_hi = NPHASE;
    hipLaunchKernelGGL(mk_fwd, dim3(grid), dim3(NWAVES * 64), LDS_BYTES, stream, a);
#else
    for (int p = 0; p < NPHASE; ++p) {
        if (!phase_exists(p)) continue;
        a.ph_lo = p; a.ph_hi = p + 1;
        hipLaunchKernelGGL(mk_fwd, dim3(grid), dim3(NWAVES * 64), LDS_BYTES, stream, a);
    }
#endif
}
```

```cpp
#include <hip/hip_runtime.h>
#include <cstdio>
#include <cstdint>

#ifndef MK_ONE_LAUNCH
#define MK_ONE_LAUNCH 1
#endif

#define LAS __attribute__((address_space(3)))
#define GAS __attribute__((address_space(1)))

constexpr int D_MODEL = 1024, BATCH = 4, SEQ = 8192, DEPTH = 4, NTOK = BATCH * SEQ;
constexpr int N_HEADS = 16, QK_NOPE = 64, QK_ROPE = 32, V_HEAD = 64, Q_LORA = 256, KV_LORA = 128, LAT = Q_LORA + KV_LORA + QK_ROPE;
constexpr int QPITCH = N_HEADS * (QK_NOPE + QK_ROPE);
constexpr int N_GROUPS = 8, EPG = 8, N_EXPERTS = 64, D_EXPERT = 256;
constexpr int MAX_TILES = 320;
constexpr float DN_ALPHA = 1.681792830507429f;
constexpr float LN_EPS = 1e-5f, RMS_EPS = 1e-6f;
constexpr float QSCALE = 0.14724444602590306f;
constexpr int LGP = 80;

constexpr size_t MiB = 1u << 20;
constexpr size_t WS_CTL = 0, CTL_ZERO_BYTES = 1 * MiB;
constexpr size_t WS_COS = 1 * MiB, WS_SIN = 3 * MiB;
constexpr size_t WS_CNT = 5 * MiB;
constexpr size_t WS_TILE = 5 * MiB + 65536;
constexpr size_t WS_AE = 5 * MiB + 131072, WS_APOS = WS_AE + 262144, WS_AG = WS_APOS + 262144;
constexpr size_t WS_RSLOT = 6 * MiB, WS_RGATE = 6 * MiB + 512 * 1024;
constexpr size_t WS_WIN = 8 * MiB;
constexpr size_t WS_WUQ = 10 * MiB;
constexpr size_t WS_WUK = 12 * MiB;
constexpr size_t WS_WUV = 13 * MiB;
constexpr size_t WS_WO = 14 * MiB;
constexpr size_t WS_WP = 18 * MiB;
constexpr size_t WS_WR = 19 * MiB;
constexpr size_t WS_W13 = 24 * MiB;
constexpr size_t WS_W2T = 88 * MiB;
constexpr size_t WS_FB = 120 * MiB;
constexpr size_t WS_XHL = 248 * MiB;
constexpr size_t WS_R1 = 376 * MiB;
constexpr size_t WS_LAT = WS_R1;
constexpr size_t WS_CQ = WS_R1 + 64 * MiB;
constexpr size_t WS_CKV = WS_R1 + 80 * MiB;
constexpr size_t WS_KR = WS_R1 + 88 * MiB;
constexpr size_t WS_Q = WS_R1 + 92 * MiB;
constexpr size_t WS_KN = WS_R1 + 188 * MiB;
constexpr size_t WS_VT = WS_R1 + 252 * MiB;
constexpr size_t WS_O = WS_R1 + 316 * MiB;
constexpr size_t WS_POOLED = WS_R1;
constexpr size_t WS_LG = WS_R1;
constexpr size_t WS_XS = WS_R1 + 20 * MiB;
constexpr size_t WS_HS = WS_R1 + 180 * MiB;
constexpr size_t WS_Y = WS_R1 + 220 * MiB;
constexpr size_t WS_END = WS_R1 + 384 * MiB;
static_assert(WS_O + 64 * MiB <= WS_END && WS_Y + 128 * MiB <= WS_END, "ws map");

constexpr int CW_TMO = 0, CW_CODE = 1, CW_BAR = 4096;

constexpr int RING_OFF = 0, RING_BYTES = 131072, SCR_WAVE = 17408;
constexpr int LDSCTL_OFF = 8 * SCR_WAVE, MISC_OFF = LDSCTL_OFF + 320;
constexpr int LDS_BYTES = 147456;

typedef unsigned short bf16_t;
typedef short bf16x8 __attribute__((ext_vector_type(8)));
typedef float f32x4 __attribute__((ext_vector_type(4)));
typedef float f32x16 __attribute__((ext_vector_type(16)));
typedef unsigned u32x4 __attribute__((ext_vector_type(4)));
typedef unsigned u32x2 __attribute__((ext_vector_type(2)));
typedef float f32x2_t __attribute__((ext_vector_type(2)));
typedef __bf16 bf16x2_t __attribute__((ext_vector_type(2)));
#define RLX_AGENT __ATOMIC_RELAXED, __HIP_MEMORY_SCOPE_AGENT
#define LDS_WAIT() asm volatile("s_waitcnt lgkmcnt(0)" ::: "memory")
#define VM_WAIT() asm volatile("s_waitcnt vmcnt(0)" ::: "memory")

__device__ __forceinline__ unsigned cvtpk(float lo, float hi) { f32x2_t v = {lo, hi}; bf16x2_t b = __builtin_convertvector(v, bf16x2_t); return __builtin_bit_cast(unsigned, b); }
__device__ __forceinline__ int opaque(int x) { asm volatile("" : "+v"(x)); return x; }
__device__ __forceinline__ int opaque_s(int x) { asm volatile("" : "+s"(x)); return x; }
__device__ __forceinline__ float bflo(unsigned u) { return __uint_as_float(u << 16); }
__device__ __forceinline__ float bfhi(unsigned u) { return __uint_as_float(u & 0xffff0000u); }
__device__ __forceinline__ float wave_sum(float v) {
#pragma unroll
    for (int o = 1; o < 64; o <<= 1) v += __shfl_xor(v, o);
    return v;
}
__device__ __forceinline__ void split4(const f32x4 v, u32x2& h, u32x2& l) {
    h.x = cvtpk(v.x, v.y); h.y = cvtpk(v.z, v.w);
    l.x = cvtpk(v.x - bflo(h.x), v.y - bfhi(h.x)); l.y = cvtpk(v.z - bflo(h.y), v.w - bfhi(h.y));
}
__device__ __forceinline__ f32x4 join4(const u32x2 h, const u32x2 l) {
    return (f32x4){bflo(h.x) + bflo(l.x), bfhi(h.x) + bfhi(l.x), bflo(h.y) + bflo(l.y), bfhi(h.y) + bfhi(l.y)};
}
__device__ __forceinline__ f32x4 bf4(const u32x2 h) { return (f32x4){bflo(h.x), bfhi(h.x), bflo(h.y), bfhi(h.y)}; }

namespace pg8 {
constexpr int BM = 256, BK = 64, HALF = 128, HTB = HALF * BK * 2, STAGE_BYTES = 8 * HTB, NXCD = 8, WGM = 8;
__host__ __device__ __forceinline__ int lds_byte(int r, int c) { const int st = (r >> 4) * 2 + (c >> 5), rr = r & 15, cc = c & 31, ob = rr * 64 + cc * 2; return st * 1024 + (ob ^ (((ob >> 9) & 1) << 5)); }
__host__ __device__ __forceinline__ void stage_rc(int b, int& R, int& C) { const int st = b / 1024, sb = b % 1024, swz = sb ^ (((sb >> 9) & 1) << 5); R = (st >> 1) * 16 + swz / 64; C = (st & 1) * 32 + (swz % 64) / 2; }
__host__ __device__ __forceinline__ int perm32(int rho) { const int n = rho >> 4, i = rho & 15; return 8 * (i >> 2) + 4 * n + (i & 3); }

struct Unit { int pm, pn; };
struct Gemm { int lda, ldb, K; };

struct DenseOrder {
    int nM, nN, nwg, G, c;
    const char* A; const char* B; size_t a_pm, a_pn, b_pn;
    __device__ __forceinline__ void init(int M, int N, int G_, int c_, const void* A_, size_t a_pm_, size_t a_pn_, const void* B_, size_t b_pn_) {
        nM = M / BM; nN = N / BM; nwg = nM * nN; G = G_; c = c_; A = (const char*)A_; B = (const char*)B_; a_pm = a_pm_; a_pn = a_pn_; b_pn = b_pn_; }
    __device__ __forceinline__ bool next(int i, Unit& u) const {
        const long L = (long)i * G + c; if (L >= nwg) return false;
        int wgid = (int)L; { const int q = nwg / NXCD, r = nwg % NXCD, xcd = wgid % NXCD, off = wgid / NXCD; wgid = (xcd < r ? xcd * (q + 1) : r * (q + 1) + (xcd - r) * q) + off; }
        const int nig = WGM * nN, gid = wgid / nig, fm = gid * WGM, gsz = (nM - fm) < WGM ? (nM - fm) : WGM;
        u.pm = fm + ((wgid % nig) % gsz); u.pn = (wgid % nig) / gsz; return true;
    }
    __device__ __forceinline__ const char* a_base(const Unit& u) const { return A + (size_t)u.pm * a_pm + (size_t)u.pn * a_pn; }
    __device__ __forceinline__ const char* b_base(const Unit& u) const { return B + (size_t)u.pn * b_pn; }
};
struct MoeOrder {
    const int* tile_e; int ntiles, nN, nwg, G, c;
    const char* A; const char* W; size_t a_tile, w_e, w_pn;
    __device__ __forceinline__ void init(const int* tile_e_, int ntiles_, int nN_, int G_, int c_, const void* A_, size_t a_tile_, const void* W_, size_t w_e_, size_t w_pn_) {
        tile_e = tile_e_; ntiles = ntiles_; nN = nN_; nwg = ntiles_ * nN_; G = G_; c = c_; A = (const char*)A_; a_tile = a_tile_; W = (const char*)W_; w_e = w_e_; w_pn = w_pn_; }
    __device__ __forceinline__ bool next(int i, Unit& u) const {
        const long L = (long)i * G + c; if (L >= nwg) return false;
        int wgid = (int)L; { const int q = nwg / NXCD, r = nwg % NXCD, xcd = wgid % NXCD, off = wgid / NXCD; wgid = (xcd < r ? xcd * (q + 1) : r * (q + 1) + (xcd - r) * q) + off; }
        u.pm = wgid / nN; u.pn = wgid % nN; return true;
    }
    __device__ __forceinline__ const char* a_base(const Unit& u) const { return A + (size_t)u.pm * a_tile; }
    __device__ __forceinline__ const char* b_base(const Unit& u) const { const int e = __builtin_amdgcn_readfirstlane(tile_e[u.pm]); return W + (size_t)e * w_e + (size_t)u.pn * w_pn; }
};

#define ACC_T const f32x4 (&acc)[2][2][4][2]
struct EpiBf16 {
    static constexpr bool PERM = true;
    bf16_t* O; size_t ldc;
    __device__ __forceinline__ void operator()(ACC_T, const Unit& u, int wr, int wc, int fr, int fq) const {
        const int row0 = u.pm * BM + wr * 64 + fr, col0 = u.pn * BM + wc * 32 + 8 * fq;
#pragma unroll
        for (int ai = 0; ai < 2; ++ai)
#pragma unroll
            for (int m = 0; m < 4; ++m) { bf16_t* rowp = O + (size_t)(row0 + ai * HALF + m * 16) * ldc + col0;
#pragma unroll
                for (int bj = 0; bj < 2; ++bj) { const f32x4 v0 = acc[ai][bj][m][0], v1 = acc[ai][bj][m][1];
                    u32x4 w; w.x = cvtpk(v0[0], v0[1]); w.y = cvtpk(v0[2], v0[3]); w.z = cvtpk(v1[0], v1[1]); w.w = cvtpk(v1[2], v1[3]);
                    *(u32x4*)(rowp + bj * HALF) = w; } }
    }
};
struct EpiF32 {
    static constexpr bool PERM = false;
    float* O; size_t ldc;
    __device__ __forceinline__ void operator()(ACC_T, const Unit& u, int wr, int wc, int fr, int fq) const {
        const int row0 = u.pm * BM + wr * 64 + fr, col0 = u.pn * BM + wc * 32 + 4 * fq;
#pragma unroll
        for (int ai = 0; ai < 2; ++ai)
#pragma unroll
            for (int m = 0; m < 4; ++m) { float* rowp = O + (size_t)(row0 + ai * HALF + m * 16) * ldc + col0;
#pragma unroll
                for (int bj = 0; bj < 2; ++bj)
#pragma unroll
                    for (int n = 0; n < 2; ++n) *(f32x4*)(rowp + bj * HALF + n * 16) = acc[ai][bj][m][n]; }
    }
};
struct EpiQ {
    static constexpr bool PERM = true;
    bf16_t* Q; const float* cs; const float* sn;
    __device__ __forceinline__ void operator()(ACC_T, const Unit& u, int wr, int wc, int fr, int fq) const {
        const int row0 = u.pm * BM + wr * 64 + fr;
        if (u.pn < 4) {
#pragma unroll
            for (int ai = 0; ai < 2; ++ai)
#pragma unroll
                for (int m = 0; m < 4; ++m) { const int row = row0 + ai * HALF + m * 16;
#pragma unroll
                    for (int bj = 0; bj < 2; ++bj) { const int col = u.pn * BM + bj * HALF + wc * 32 + 8 * fq; const f32x4 v0 = acc[ai][bj][m][0], v1 = acc[ai][bj][m][1];
                        u32x4 w; w.x = cvtpk(v0[0], v0[1]); w.y = cvtpk(v0[2], v0[3]); w.z = cvtpk(v1[0], v1[1]); w.w = cvtpk(v1[2], v1[3]);
                        *(u32x4*)(Q + (size_t)row * QPITCH + (col >> 6) * 96 + (col & 63)) = w; } }
        } else {
            const int head = (u.pn - 4) * 8 + 2 * wc + (fq >> 1), i0 = 8 * (fq & 1);
#pragma unroll
            for (int ai = 0; ai < 2; ++ai)
#pragma unroll
                for (int m = 0; m < 4; ++m) { const int row = row0 + ai * HALF + m * 16;
                    const f32x4 c0 = *(const f32x4*)(cs + (size_t)row * 16 + i0), c1 = *(const f32x4*)(cs + (size_t)row * 16 + i0 + 4);
                    const f32x4 s0 = *(const f32x4*)(sn + (size_t)row * 16 + i0), s1 = *(const f32x4*)(sn + (size_t)row * 16 + i0 + 4);
                    const f32x4 a0 = acc[ai][0][m][0], a1 = acc[ai][0][m][1], b0 = acc[ai][1][m][0], b1 = acc[ai][1][m][1];
                    const f32x4 y10 = a0 * c0 - b0 * s0, y11 = a1 * c1 - b1 * s1, y20 = b0 * c0 + a0 * s0, y21 = b1 * c1 + a1 * s1;
                    u32x4 w1, w2; w1.x = cvtpk(y10[0], y10[1]); w1.y = cvtpk(y10[2], y10[3]); w1.z = cvtpk(y11[0], y11[1]); w1.w = cvtpk(y11[2], y11[3]);
                    w2.x = cvtpk(y20[0], y20[1]); w2.y = cvtpk(y20[2], y20[3]); w2.z = cvtpk(y21[0], y21[1]); w2.w = cvtpk(y21[2], y21[3]);
                    bf16_t* qp = Q + (size_t)row * QPITCH + head * 96 + 64 + i0;
                    *(u32x4*)qp = w1; *(u32x4*)(qp + 16) = w2; asm volatile("" ::: "memory"); }
        }
    }
};
struct EpiPool {
    static constexpr bool PERM = true;
    bf16_t* F; const float* bias; const float* scale;
    __device__ __forceinline__ void operator()(ACC_T, const Unit& u, int wr, int wc, int fr, int fq) const {
        const int row0 = u.pm * BM + wr * 64 + fr, col0 = u.pn * BM + wc * 32 + 8 * fq;
#pragma unroll
        for (int bj = 0; bj < 2; ++bj) { const int c = col0 + bj * HALF;
            const f32x4 b0 = *(const f32x4*)(bias + c), b1 = *(const f32x4*)(bias + c + 4), s0 = *(const f32x4*)(scale + c), s1 = *(const f32x4*)(scale + c + 4);
#pragma unroll
            for (int ai = 0; ai < 2; ++ai)
#pragma unroll
                for (int m = 0; m < 4; ++m) { const f32x4 v0 = (acc[ai][bj][m][0] + b0) * s0, v1 = (acc[ai][bj][m][1] + b1) * s1;
                    u32x4 w; w.x = cvtpk(v0[0], v0[1]); w.y = cvtpk(v0[2], v0[3]); w.z = cvtpk(v1[0], v1[1]); w.w = cvtpk(v1[2], v1[3]);
                    *(u32x4*)(F + (size_t)(row0 + ai * HALF + m * 16) * 1024 + c) = w; } }
    }
};
struct EpiRouter {
    static constexpr bool PERM = false;
    float* LG;
    __device__ __forceinline__ void operator()(ACC_T, const Unit& u, int wr, int wc, int fr, int fq) const {
        const int row0 = u.pm * BM + wr * 64 + fr;
#pragma unroll
        for (int ai = 0; ai < 2; ++ai)
#pragma unroll
            for (int m = 0; m < 4; ++m) { float* lr = LG + ((size_t)u.pn * NTOK + (size_t)(row0 + ai * HALF + m * 16)) * LGP;
#pragma unroll
                for (int n = 0; n < 2; ++n) { const int j = wc * 32 + 16 * n + 4 * fq; if (j < 72) *(f32x4*)(lr + j) = acc[ai][0][m][n] + acc[ai][1][m][n]; } }
    }
};
struct EpiSwiglu {
    static constexpr bool PERM = true;
    bf16_t* H;
    __device__ __forceinline__ void operator()(ACC_T, const Unit& u, int wr, int wc, int fr, int fq) const {
        const int row0 = u.pm * BM + wr * 64 + fr, col0 = u.pn * HALF + wc * 32 + 8 * fq;
#pragma unroll
        for (int ai = 0; ai < 2; ++ai)
#pragma unroll
            for (int m = 0; m < 4; ++m) { float h[8];
#pragma unroll
                for (int n = 0; n < 2; ++n)
#pragma unroll
                    for (int e = 0; e < 4; ++e) { const float a = acc[ai][0][m][n][e], b = acc[ai][1][m][n][e];
                        h[n * 4 + e] = a * __builtin_amdgcn_rcpf(1.0f + __builtin_amdgcn_exp2f(-1.4426950408889634f * a)) * b; }
                u32x4 w; w.x = cvtpk(h[0], h[1]); w.y = cvtpk(h[2], h[3]); w.z = cvtpk(h[4], h[5]); w.w = cvtpk(h[6], h[7]);
                *(u32x4*)(H + (size_t)(row0 + ai * HALF + m * 16) * D_EXPERT + col0) = w; }
    }
};
struct EpiMoeOut {
    static constexpr bool PERM = true;
    bf16_t* Y; const int* rslot; const float* rgate;
    __device__ __forceinline__ void operator()(ACC_T, const Unit& u, int wr, int wc, int fr, int fq) const {
        const int row0 = u.pm * BM + wr * 64 + fr, col0 = u.pn * BM + wc * 32 + 8 * fq;
#pragma unroll
        for (int ai = 0; ai < 2; ++ai)
#pragma unroll
            for (int m = 0; m < 4; ++m) { const int row = row0 + ai * HALF + m * 16; const int slot = rslot[row]; const float g = rgate[row];
                if (slot >= 0) { bf16_t* yp = Y + (size_t)slot * D_MODEL + col0;
#pragma unroll
                    for (int bj = 0; bj < 2; ++bj) { const f32x4 v0 = acc[ai][bj][m][0] * g, v1 = acc[ai][bj][m][1] * g;
                        u32x4 w; w.x = cvtpk(v0[0], v0[1]); w.y = cvtpk(v0[2], v0[3]); w.z = cvtpk(v1[0], v1[1]); w.w = cvtpk(v1[2], v1[3]);
                        *(u32x4*)(yp + bj * HALF) = w; } }
                if (m & 1) asm volatile("" ::: "memory"); }
    }
};
#undef ACC_T

template <class Epi, class Sched, bool ALIGN_EPI>
__device__ __forceinline__ void gemm_phase(LAS unsigned char* lds, const Gemm g, const Sched& S, const Epi& E) {
    const int tid = opaque(threadIdx.x), wid = __builtin_amdgcn_readfirstlane(tid >> 6), lane = tid & 63, wr = wid >> 2, wc = wid & 3, fr = lane & 15, fq = lane >> 4;
    const int K = opaque_s(g.K), nt = K / BK;
    unsigned voffA[2], voffB[2];
#pragma unroll
    for (int i = 0; i < 2; ++i) { int R, C; stage_rc(tid * 16 + i * 8192, R, C); const int Rb = Epi::PERM ? ((R & ~31) + perm32(R & 31)) : R;
        voffA[i] = (unsigned)(R * g.lda + C) * 2u; voffB[i] = (unsigned)(Rb * g.ldb + C) * 2u; }
    const size_t kstep = (size_t)(BK * 2);
    const size_t hstepA = (size_t)HALF * g.lda * 2, hstepB = (size_t)HALF * g.ldb * 2;
    const unsigned ldsw = (unsigned)wid * 1024u;
    const int aoff = lds_byte(wr * 64 + fr, fq * 8), boff = lds_byte(wc * 32 + fr, fq * 8);
#define PG8_SA(b, h) (((b) * 2 + (h)) * HTB)
#define PG8_SB(b, h) ((4 + (b) * 2 + (h)) * HTB)
#define PG8_STAGE(bufoff, gbase, voff) do { _Pragma("unroll") for (int _i = 0; _i < 2; ++_i) \
        __builtin_amdgcn_global_load_lds((const unsigned*)((const char*)(gbase) + (voff)[_i]), (LAS unsigned*)(lds + (bufoff) + ldsw + _i * 8192), 16, 0, 0); } while (0)
#define PG8_LDA(dst, b, h) do { _Pragma("unroll") for (int m = 0; m < 4; ++m) _Pragma("unroll") for (int k = 0; k < 2; ++k) dst[m][k] = *(const LAS bf16x8*)(lds + PG8_SA(b, h) + aoff + m * 2048 + k * 1024); } while (0)
#define PG8_LDB(dst, b, h) do { _Pragma("unroll") for (int n = 0; n < 2; ++n) _Pragma("unroll") for (int k = 0; k < 2; ++k) dst[n][k] = *(const LAS bf16x8*)(lds + PG8_SB(b, h) + boff + n * 2048 + k * 1024); } while (0)
#define PG8_MMA(ai, bj, At, Bt) do { __builtin_amdgcn_s_setprio(1); _Pragma("unroll") for (int m = 0; m < 4; ++m) _Pragma("unroll") for (int n = 0; n < 2; ++n) _Pragma("unroll") for (int k = 0; k < 2; ++k) \
        acc[ai][bj][m][n] = __builtin_amdgcn_mfma_f32_16x16x32_bf16(Bt[n][k], At[m][k], acc[ai][bj][m][n], 0, 0, 0); __builtin_amdgcn_s_setprio(0); } while (0)
#define PG8_WAIT_V(n) asm volatile("s_waitcnt vmcnt(" #n ")" ::: "memory")
#define PG8_WAIT_L(n) asm volatile("s_waitcnt lgkmcnt(" #n ")" ::: "memory")
#define PG8_BAR __builtin_amdgcn_s_barrier()
#define PG8_SCHED __builtin_amdgcn_sched_barrier(0)
    Unit cur, nxt; int ui = 0;
    if (!S.next(0, cur)) return;
    f32x4 acc[2][2][4][2];
#pragma unroll
    for (int a = 0; a < 2; ++a)
#pragma unroll
        for (int b = 0; b < 2; ++b)
#pragma unroll
            for (int m = 0; m < 4; ++m)
#pragma unroll
                for (int n = 0; n < 2; ++n) acc[a][b][m][n] = (f32x4){0.f, 0.f, 0.f, 0.f};
    bf16x8 At[4][2], B0[2][2], B1[2][2];
    const char* cA = S.a_base(cur); const char* cB = S.b_base(cur);
    PG8_STAGE(PG8_SB(0, 0), cB, voffB); PG8_STAGE(PG8_SB(0, 1), cB + hstepB, voffB); PG8_STAGE(PG8_SA(0, 0), cA, voffA); PG8_STAGE(PG8_SA(0, 1), cA + hstepA, voffA);
    if (wr == 1) PG8_BAR;
    PG8_WAIT_V(2); PG8_BAR;
    PG8_STAGE(PG8_SB(1, 0), cB + kstep, voffB); PG8_STAGE(PG8_SA(1, 0), cA + kstep, voffA); PG8_STAGE(PG8_SB(1, 1), cB + hstepB + kstep, voffB);
    PG8_WAIT_V(6); PG8_BAR;
    for (;;) {
        const bool has_next = S.next(ui + 1, nxt);
        const char* nA = has_next ? S.a_base(nxt) : cA; const char* nB = has_next ? S.b_base(nxt) : cB;
#pragma nounroll
        for (int t = 0; t < nt; t += 2) {
            const bool last = (t == nt - 2);
            const char* a1 = cA + (size_t)(t + 1) * kstep;
            const char* a2 = last ? nA : cA + (size_t)(t + 2) * kstep; const char* b2 = last ? nB : cB + (size_t)(t + 2) * kstep;
            const char* a3 = a2 + kstep; const char* b3 = b2 + kstep;
            PG8_LDB(B0, 0, 0); PG8_LDB(B1, 0, 1); PG8_SCHED; PG8_LDA(At, 0, 0); PG8_STAGE(PG8_SA(1, 1), a1 + hstepA, voffA);
            PG8_WAIT_V(8); PG8_WAIT_L(0); PG8_BAR; PG8_MMA(0, 0, At, B0); PG8_MMA(0, 1, At, B1); PG8_BAR; PG8_SCHED;
            PG8_LDA(At, 0, 1); PG8_STAGE(PG8_SB(0, 0), b2, voffB); PG8_STAGE(PG8_SB(0, 1), b2 + hstepB, voffB); PG8_STAGE(PG8_SA(0, 0), a2, voffA);
            PG8_WAIT_V(8); PG8_WAIT_L(0); PG8_BAR; PG8_MMA(1, 0, At, B0); PG8_MMA(1, 1, At, B1); PG8_BAR; PG8_SCHED;
            PG8_LDB(B0, 1, 0); PG8_LDB(B1, 1, 1); PG8_SCHED; PG8_LDA(At, 1, 0); PG8_STAGE(PG8_SA(0, 1), a2 + hstepA, voffA);
            PG8_WAIT_V(8); PG8_WAIT_L(0); PG8_BAR; PG8_MMA(0, 0, At, B0); PG8_MMA(0, 1, At, B1); PG8_BAR; PG8_SCHED;
            PG8_LDA(At, 1, 1); PG8_STAGE(PG8_SB(1, 0), b3, voffB); PG8_STAGE(PG8_SB(1, 1), b3 + hstepB, voffB); PG8_STAGE(PG8_SA(1, 0), a3, voffA);
            PG8_WAIT_V(8); PG8_WAIT_L(0); PG8_BAR; PG8_MMA(1, 0, At, B0); PG8_MMA(1, 1, At, B1); PG8_BAR; PG8_SCHED;
        }
        if constexpr (ALIGN_EPI) { if (wr == 0) PG8_BAR; }
        E(acc, cur, wr, wc, fr, fq);
        if (!has_next) break;
#pragma unroll
        for (int a = 0; a < 2; ++a)
#pragma unroll
            for (int b = 0; b < 2; ++b)
#pragma unroll
                for (int m = 0; m < 4; ++m)
#pragma unroll
                    for (int n = 0; n < 2; ++n) acc[a][b][m][n] = (f32x4){0.f, 0.f, 0.f, 0.f};
        cur = nxt; cA = nA; cB = nB; ++ui;
        if constexpr (ALIGN_EPI) { if (wr == 1) PG8_BAR; }
    }
    PG8_WAIT_V(0);
    if constexpr (!ALIGN_EPI) { if (wr == 0) PG8_BAR; }
    PG8_BAR;
#undef PG8_SA
#undef PG8_SB
#undef PG8_STAGE
#undef PG8_LDA
#undef PG8_LDB
#undef PG8_MMA
#undef PG8_WAIT_V
#undef PG8_WAIT_L
#undef PG8_BAR
#undef PG8_SCHED
}
}

namespace att {
constexpr int KSLOT = 12288, VSLOT = 8192, LDS_K = 0, LDS_V = 3 * KSLOT, LDS_BYTES = LDS_V + 3 * VSLOT;
constexpr float THR = 6.0f;
__device__ __forceinline__ void attn_unit(int b, int h, int qb, const bf16_t* __restrict__ Q, const bf16_t* __restrict__ KN, const bf16_t* __restrict__ KR, const bf16_t* __restrict__ VT, bf16_t* __restrict__ O, LAS unsigned char* lds) {
    const int tid = opaque(threadIdx.x), lane = tid & 63, r32 = lane & 31, hi = lane >> 5;
    const int w = __builtin_amdgcn_readfirstlane(tid >> 6);
    const size_t tok0 = (size_t)b * SEQ;
    const int q0 = qb * 256, NT = 4 * (qb + 1);
    const bf16_t* ksrc = KN + (tok0 + lane) * 1024 + h * 64 + 8 * w;
    const bf16_t* rsrc = KR + (tok0 + lane) * 32 + 8 * (w & 3);
    const bf16_t* vsrc = VT + (size_t)(h * 64 + lane) * NTOK + tok0 + 8 * w;
#define ATT_ISSUE(t, slot) do { \
        __builtin_amdgcn_global_load_lds((const unsigned*)(ksrc + (size_t)(t) * 65536), (LAS unsigned*)(lds + LDS_K + (slot) * KSLOT + w * 1024), 16, 0, 0); \
        if (w < 4) __builtin_amdgcn_global_load_lds((const unsigned*)(rsrc + (size_t)(t) * 2048), (LAS unsigned*)(lds + LDS_K + (slot) * KSLOT + (8 + w) * 1024), 16, 0, 0); \
        __builtin_amdgcn_global_load_lds((const unsigned*)(vsrc + (size_t)(t) * 64), (LAS unsigned*)(lds + LDS_V + (slot) * VSLOT + w * 1024), 16, 0, 0); } while (0)
    ATT_ISSUE(0, 0); ATT_ISSUE(1, 1);
    bf16x8 qr[6];
    { const bf16_t* qp = Q + (tok0 + q0 + w * 32 + r32) * QPITCH + h * 96 + hi * 8;
#pragma unroll
      for (int d0 = 0; d0 < 6; ++d0) qr[d0] = *(const bf16x8*)(qp + d0 * 16); }
    const int kvp = (r32 & 19) | ((r32 & 4) << 1) | ((r32 & 8) >> 1);
    const int kfoff = hi * 1024 + kvp * 16, vfoff = hi * 1024 + r32 * 16;
    float mhat = 0.f, lsum = 0.f;
    f32x16 o0 = {}, o1 = {}, negm = {};
    const int qrel = w * 32 + r32;
    int slot = 0;
    for (int t = 0; t < NT; ++t) {
        if (t == 0 || t + 1 >= NT) asm volatile("s_waitcnt vmcnt(0)" ::: "memory");
        else if (w < 4) asm volatile("s_waitcnt vmcnt(3)" ::: "memory");
        else asm volatile("s_waitcnt vmcnt(2)" ::: "memory");
        __builtin_amdgcn_s_barrier();
        asm volatile("" ::: "memory");
        if (t + 2 < NT) { const int s2 = (slot == 0) ? 2 : slot - 1; ATT_ISSUE(t + 2, s2); }
        const int jb = t - (NT - 4);
        const bool active = (jb < 0) || (jb <= (w >> 1));
        if (active) {
            const LAS unsigned char* kb = lds + LDS_K + slot * KSLOT + kfoff;
            const LAS unsigned char* vb = lds + LDS_V + slot * VSLOT + vfoff;
            f32x16 p0 = negm, p1 = negm;
#pragma unroll
            for (int d0 = 0; d0 < 6; ++d0) {
                const bf16x8 k0 = *(const LAS bf16x8*)(kb + d0 * 2048), k1 = *(const LAS bf16x8*)(kb + d0 * 2048 + 512);
                p0 = __builtin_amdgcn_mfma_f32_32x32x16_bf16(k0, qr[d0], p0, 0, 0, 0);
                p1 = __builtin_amdgcn_mfma_f32_32x32x16_bf16(k1, qr[d0], p1, 0, 0, 0);
            }
            if (jb >= 0) {
                const int kb0 = 64 * jb + 8 * hi;
#pragma unroll
                for (int r = 0; r < 16; ++r) { const int key = kb0 + (r & 3) + 4 * ((r >> 2) & 1) + 16 * (r >> 3);
                    if (key > qrel) p0[r] = -INFINITY; if (key + 32 > qrel) p1[r] = -INFINITY; }
            }
            float rm = fmaxf(p0[0], p1[0]);
#pragma unroll
            for (int r = 1; r < 16; ++r) rm = fmaxf(rm, fmaxf(p0[r], p1[r]));
            { auto rr = __builtin_amdgcn_permlane32_swap(__float_as_uint(rm), __float_as_uint(rm), false, false); rm = fmaxf(__uint_as_float(rr[0]), __uint_as_float(rr[1])); }
            if (t == 0) {
                mhat = rm;
#pragma unroll
                for (int r = 0; r < 16; ++r) { p0[r] -= rm; p1[r] -= rm; negm[r] = -mhat; }
            } else if (__any(rm > THR)) {
                const float dl = fmaxf(rm, 0.f); mhat += dl;
                const float f = __builtin_amdgcn_exp2f(-dl); lsum *= f;
#pragma unroll
                for (int r = 0; r < 16; ++r) { p0[r] -= dl; p1[r] -= dl; o0[r] *= f; o1[r] *= f; negm[r] = -mhat; }
            }
            float sacc = 0.f;
#pragma unroll
            for (int r = 0; r < 16; ++r) { p0[r] = __builtin_amdgcn_exp2f(p0[r]); p1[r] = __builtin_amdgcn_exp2f(p1[r]); sacc += p0[r] + p1[r]; }
            lsum += sacc;
            u32x4 pw[4];
#pragma unroll
            for (int i = 0; i < 2; ++i) {
                pw[i] = (u32x4){cvtpk(p0[8 * i], p0[8 * i + 1]), cvtpk(p0[8 * i + 2], p0[8 * i + 3]), cvtpk(p0[8 * i + 4], p0[8 * i + 5]), cvtpk(p0[8 * i + 6], p0[8 * i + 7])};
                pw[2 + i] = (u32x4){cvtpk(p1[8 * i], p1[8 * i + 1]), cvtpk(p1[8 * i + 2], p1[8 * i + 3]), cvtpk(p1[8 * i + 4], p1[8 * i + 5]), cvtpk(p1[8 * i + 6], p1[8 * i + 7])};
            }
#pragma unroll
            for (int kc2 = 0; kc2 < 4; ++kc2) {
                const bf16x8 v0 = *(const LAS bf16x8*)(vb + kc2 * 2048), v1 = *(const LAS bf16x8*)(vb + kc2 * 2048 + 512);
                const bf16x8 pf = __builtin_bit_cast(bf16x8, pw[kc2]);
                o0 = __builtin_amdgcn_mfma_f32_32x32x16_bf16(v0, pf, o0, 0, 0, 0);
                o1 = __builtin_amdgcn_mfma_f32_32x32x16_bf16(v1, pf, o1, 0, 0, 0);
            }
        }
        slot = (slot == 2) ? 0 : slot + 1;
    }
    { auto rr = __builtin_amdgcn_permlane32_swap(__float_as_uint(lsum), __float_as_uint(lsum), false, false); lsum = __uint_as_float(rr[0]) + __uint_as_float(rr[1]); }
    const float inv = 1.0f / lsum;
    bf16_t* op = O + (tok0 + q0 + w * 32 + r32) * 1024 + h * 64 + 4 * hi;
#pragma unroll
    for (int g = 0; g < 4; ++g) {
        u32x2 a, c; a.x = cvtpk(o0[4 * g] * inv, o0[4 * g + 1] * inv); a.y = cvtpk(o0[4 * g + 2] * inv, o0[4 * g + 3] * inv);
        c.x = cvtpk(o1[4 * g] * inv, o1[4 * g + 1] * inv); c.y = cvtpk(o1[4 * g + 2] * inv, o1[4 * g + 3] * inv);
        *(u32x2*)(op + 8 * g) = a; *(u32x2*)(op + 32 + 8 * g) = c;
    }
    asm volatile("s_waitcnt lgkmcnt(0)" ::: "memory");
    __builtin_amdgcn_s_barrier();
#undef ATT_ISSUE
}
}

#define XB_TMO      128
#define XB_XCNT(j)  (256  + 64 * (j))
#define XB_XSUB(j)  (1280 + 64 * (j))
#define XB_XGEN(j)  (2304 + 64 * (j))
#define XB_TOP      3328
#define XB_TOPGEN   3392
#define XCD_BAR_WORDS 3456
#define XB_SPIN_CAP (1u << 18)
__device__ __forceinline__ unsigned xb_ld(unsigned* p)              { return __hip_atomic_load(p, __ATOMIC_RELAXED, __HIP_MEMORY_SCOPE_AGENT); }
__device__ __forceinline__ unsigned xb_add(unsigned* p, unsigned v) { return __hip_atomic_fetch_add(p, v, __ATOMIC_RELAXED, __HIP_MEMORY_SCOPE_AGENT); }
__device__ __forceinline__ unsigned xb_xcc_id() { return (unsigned)__builtin_amdgcn_s_getreg((3 << 11) | 20) & 0xFu; }
#define XB_SPIN(cond, bar) do { unsigned _sp = 0; while (cond) { __builtin_amdgcn_s_sleep(1); \
    if ((++_sp & 255u) == 0u) { if (xb_ld(&(bar)[XB_TMO])) break; if (_sp > XB_SPIN_CAP) { atomicAdd(&(bar)[XB_TMO], 1u); break; } } } } while (0)
struct XcdBarrier { unsigned* bar; unsigned x; volatile LAS unsigned* st; };
__device__ __forceinline__ XcdBarrier xcd_barrier_post(unsigned* bar, volatile LAS unsigned* st) {
    XcdBarrier b; b.bar = bar; b.x = xb_xcc_id(); b.st = st;
    if (threadIdx.x == 0) (void)xb_add(&bar[XB_XCNT(b.x)], 1u);
    return b;
}
__device__ __forceinline__ void xcd_barrier_complete(unsigned* bar, unsigned x, unsigned& nloc, unsigned& nx) {
    const unsigned G = gridDim.x * gridDim.y * gridDim.z;
    unsigned sum, cnt, mine, sp = 0u;
    for (;;) {
        sum = 0u; cnt = 0u; mine = 0u;
#pragma unroll
        for (unsigned j = 0; j < 16; ++j) { const unsigned c = xb_ld(&bar[XB_XCNT(j)]); sum += c; cnt += (c > 0u) ? 1u : 0u; mine = (j == x) ? c : mine; }
        if (sum == G) break;
        __builtin_amdgcn_s_sleep(1);
        if ((++sp & 255u) == 0u) { if (xb_ld(&bar[XB_TMO])) break; if (sp > XB_SPIN_CAP) { atomicAdd(&bar[XB_TMO], 1u); break; } }
    }
    nloc = mine > 0u ? mine : 1u; nx = cnt > 0u ? cnt : 1u;
}
__device__ __forceinline__ void xcd_barrier(const XcdBarrier& b) {
    asm volatile("s_waitcnt vmcnt(0)" ::: "memory");
    __syncthreads();
    if (threadIdx.x == 0) {
        unsigned* bar = b.bar;
        __builtin_amdgcn_s_waitcnt(0);
        unsigned nloc = b.st[0], nx = b.st[1];
        if (nloc == 0u) { xcd_barrier_complete(bar, b.x, nloc, nx); b.st[0] = nloc; b.st[1] = nx; }
        const unsigned old = xb_add(&bar[XB_XSUB(b.x)], 1u);
        const unsigned gen = old / nloc;
        if (old + 1u == (gen + 1u) * nloc) {
            __builtin_amdgcn_fence(__ATOMIC_RELEASE, "agent");
            asm volatile("s_waitcnt vmcnt(0)" ::: "memory");
            const unsigned og = xb_add(&bar[XB_TOP], 1u);
            const unsigned tg = og / nx;
            if (og + 1u == (tg + 1u) * nx) xb_add(&bar[XB_TOPGEN], 1u);
            else XB_SPIN(xb_ld(&bar[XB_TOPGEN]) == tg, bar);
            __builtin_amdgcn_fence(__ATOMIC_ACQUIRE, "agent");
            xb_add(&bar[XB_XGEN(b.x)], 1u);
            asm volatile("s_waitcnt vmcnt(0)" ::: "memory");
        } else {
            XB_SPIN(xb_ld(&bar[XB_XGEN(b.x)]) == gen, bar);
            __builtin_amdgcn_fence(__ATOMIC_ACQUIRE, "agent");
            asm volatile("s_waitcnt vmcnt(0)" ::: "memory");
        }
    }
    __syncthreads();
}

struct Args { const void* in[20]; float* out; unsigned char* ws; int ph_lo, ph_hi; };
typedef const __attribute__((address_space(4))) Args* KArgs;
__device__ __forceinline__ KArgs kargs() { KArgs p = (KArgs)__builtin_amdgcn_kernarg_segment_ptr(); asm volatile("" : "+s"(p)); return p; }
constexpr int NWAVES = 8;
constexpr int PPL = 12;
constexpr int NPHASE = 1 + DEPTH * PPL;

__constant__ double c_invf[16] = {1.0, 0.5623413251903491, 0.31622776601683794, 0.1778279410038923, 0.1, 0.05623413251903491, 0.03162277660168379, 0.01778279410038923,
                                  0.01, 0.005623413251903491, 0.0031622776601683794, 0.0017782794100389228, 0.001, 0.0005623413251903491, 0.00031622776601683794, 0.00017782794100389227};

__device__ __forceinline__ void transpose_item(const float* __restrict__ W, int ldw, int k0, int n0, bf16_t* __restrict__ WT, int ldt, int drow0, float mul, LAS float* scr, int lane) {
#pragma unroll 8
    for (int i = 0; i < 32; ++i) { const int kk = 2 * i + (lane >> 5); scr[kk * 33 + (lane & 31)] = W[(size_t)(k0 + kk) * ldw + n0 + (lane & 31)]; }
    LDS_WAIT(); asm volatile("" ::: "memory");
    const int c = lane & 7;
#pragma unroll
    for (int j = 0; j < 4; ++j) { const int n = (lane >> 3) + 8 * j; const LAS float* s = scr + (8 * c) * 33 + n;
        u32x4 o; o.x = cvtpk(s[0 * 33] * mul, s[1 * 33] * mul); o.y = cvtpk(s[2 * 33] * mul, s[3 * 33] * mul); o.z = cvtpk(s[4 * 33] * mul, s[5 * 33] * mul); o.w = cvtpk(s[6 * 33] * mul, s[7 * 33] * mul);
        *(u32x4*)(WT + (size_t)(drow0 + n) * ldt + k0 + 8 * c) = o; }
    LDS_WAIT(); asm volatile("" ::: "memory");
}

__device__ __forceinline__ void transpose_item64(const float* __restrict__ W, int ldw, int k0, int n0, bf16_t* __restrict__ WT, int ldt, int drow0, LAS float* scr, int lane) {
    f32x4 v[16];
    const float* src = W + (size_t)(k0 + (lane >> 4)) * ldw + n0 + 4 * (lane & 15);
#pragma unroll
    for (int i = 0; i < 16; ++i) v[i] = *(const f32x4*)(src + (size_t)(4 * i) * ldw);
#pragma unroll
    for (int i = 0; i < 16; ++i) *(LAS f32x4*)(scr + (4 * i + (lane >> 4)) * 68 + 4 * (lane & 15)) = v[i];
    LDS_WAIT(); asm volatile("" ::: "memory");
    bf16_t* dst = WT + (size_t)(drow0 + lane) * ldt + k0;
#pragma unroll
    for (int c = 0; c < 8; ++c) { const LAS float* sp = scr + (8 * c) * 68 + lane;
        u32x4 o; o.x = cvtpk(sp[0], sp[68]); o.y = cvtpk(sp[2 * 68], sp[3 * 68]); o.z = cvtpk(sp[4 * 68], sp[5 * 68]); o.w = cvtpk(sp[6 * 68], sp[7 * 68]);
        *(u32x4*)(dst + 8 * c) = o; }
    LDS_WAIT(); asm volatile("" ::: "memory");
}

__device__ __forceinline__ void sincos_d(double a, float& s, float& c) {
    const double TWO_PI_HI = 6.283185307179586, TWO_PI_LO = 2.4492935982947064e-16, INV_2PI = 0.15915494309189535;
    const double n = __builtin_rint(a * INV_2PI);
    double r = __builtin_fma(-n, TWO_PI_HI, a); r = __builtin_fma(-n, TWO_PI_LO, r);
    const double HALF_PI = 1.5707963267948966, HALF_PI_LO = 6.123233995736766e-17;
    const double qd = __builtin_rint(r * 0.6366197723675814);
    double y = __builtin_fma(-qd, HALF_PI, r); y = __builtin_fma(-qd, HALF_PI_LO, y);
    const int q = ((int)qd) & 3;
    const double y2 = y * y;
    double sp = -7.647163731819816e-13; sp = sp * y2 + 1.6059043836821613e-10; sp = sp * y2 - 2.505210838544172e-08; sp = sp * y2 + 2.7557319223985893e-06; sp = sp * y2 - 0.0001984126984126984;
    sp = sp * y2 + 0.008333333333333333; sp = sp * y2 - 0.16666666666666666; sp = y + y * y2 * sp;
    double cp = 4.779477332387385e-14; cp = cp * y2 - 1.1470745597729725e-11; cp = cp * y2 + 2.08767569878681e-09; cp = cp * y2 - 2.755731922398589e-07; cp = cp * y2 + 2.48015873015873e-05;
    cp = cp * y2 - 0.001388888888888889; cp = cp * y2 + 0.041666666666666664; cp = cp * y2 - 0.5; cp = 1.0 + y2 * cp;
    double ss, cc;
    if (q == 0) { ss = sp; cc = cp; } else if (q == 1) { ss = cp; cc = -sp; } else if (q == 2) { ss = -sp; cc = -cp; } else { ss = -cp; cc = sp; }
    s = (float)ss; c = (float)cc;
}

__global__ void __launch_bounds__(NWAVES * 64, 2) mk_fwd(Args args_unused) {
    extern __shared__ __attribute__((aligned(16))) unsigned char lds_raw[];
    LAS unsigned char* lds = (LAS unsigned char*)lds_raw;
    volatile LAS unsigned* MISC = (volatile LAS unsigned*)(lds + MISC_OFF);
    int tid = threadIdx.x, lane = tid & 63, wave = __builtin_amdgcn_readfirstlane(tid >> 6);
    const int G = gridDim.x, bx = blockIdx.x;
    const int vcu = (G % 8 == 0) ? (bx % 8) * (G / 8) + bx / 8 : bx;
    int gw = vcu * NWAVES + wave; const int NGW = G * NWAVES;
#define ws (kargs()->ws)
    unsigned* ctl = (unsigned*)(ws + WS_CTL);
    for (int u = tid; u < (LDS_BYTES - LDSCTL_OFF) / 4; u += NWAVES * 64) ((LAS unsigned*)(lds + LDSCTL_OFF))[u] = 0u;
    __syncthreads();
    XcdBarrier bar; bar.bar = ctl + CW_BAR; bar.x = 0; bar.st = nullptr;
#if MK_ONE_LAUNCH
    bar = xcd_barrier_post(ctl + CW_BAR, MISC + 8);
#endif
    const int lo = kargs()->ph_lo, hi = kargs()->ph_hi;
#ifndef MK_REP_MASK
#define MK_REP_MASK 0u
#endif
#define NREP(b) (1 + (int)((MK_REP_MASK >> (b)) & 1u))
#ifndef MK_PH_MASK
#define MK_PH_MASK 0xffffffffu
#endif
#define PHON(b) ((MK_PH_MASK >> (b)) & 1u)
#define IN(k) (lo <= (k) && (k) < hi)
#if MK_ONE_LAUNCH
#define SEAM(k) do { if ((k) + 1 < hi) xcd_barrier(bar); } while (0)
#else
#define SEAM(k) do { } while (0)
#endif
#define in_x ((const float*)kargs()->in[0])
#define in_pos ((const int*)kargs()->in[1])
#define ln_g ((const float*)kargs()->in[2])
#define ln_b ((const float*)kargs()->in[3])
#define w_in ((const float*)kargs()->in[4])
#define q_norm ((const float*)kargs()->in[5])
#define w_uq ((const float*)kargs()->in[6])
#define kv_norm ((const float*)kargs()->in[7])
#define w_ukv ((const float*)kargs()->in[8])
#define w_o ((const float*)kargs()->in[9])
#define pool_w ((const float*)kargs()->in[10])
#define pool_b ((const float*)kargs()->in[11])
#define pool_scale ((const float*)kargs()->in[12])
#define w_grp ((const float*)kargs()->in[13])
#define b_grp ((const float*)kargs()->in[14])
#define w_exp ((const float*)kargs()->in[15])
#define b_exp ((const float*)kargs()->in[16])
#define w1 ((const float*)kargs()->in[17])
#define w3 ((const float*)kargs()->in[18])
#define w2 ((const float*)kargs()->in[19])
#define COS ((float*)(ws + WS_COS))
#define SIN ((float*)(ws + WS_SIN))
#define CNT ((int*)(ws + WS_CNT))
#define TILE ((int*)(ws + WS_TILE))
#define AE ((int*)(ws + WS_AE))
#define APOS ((int*)(ws + WS_APOS))
#define AG ((float*)(ws + WS_AG))
#define RSLOT ((int*)(ws + WS_RSLOT))
#define RGATE ((float*)(ws + WS_RGATE))
#define WIN ((bf16_t*)(ws + WS_WIN))
#define WUQ ((bf16_t*)(ws + WS_WUQ))
#define WUK ((bf16_t*)(ws + WS_WUK))
#define WUV ((bf16_t*)(ws + WS_WUV))
#define WO ((bf16_t*)(ws + WS_WO))
#define WP ((bf16_t*)(ws + WS_WP))
#define WR ((bf16_t*)(ws + WS_WR))
#define W13 ((bf16_t*)(ws + WS_W13))
#define W2T ((bf16_t*)(ws + WS_W2T))
#define FB ((bf16_t*)(ws + WS_FB))
#define XHL ((bf16_t*)(ws + WS_XHL))
#define LATB ((float*)(ws + WS_LAT))
#define CQ ((bf16_t*)(ws + WS_CQ))
#define CKV ((bf16_t*)(ws + WS_CKV))
#define KR ((bf16_t*)(ws + WS_KR))
#define QB ((bf16_t*)(ws + WS_Q))
#define KN ((bf16_t*)(ws + WS_KN))
#define VT ((bf16_t*)(ws + WS_VT))
#define OB ((bf16_t*)(ws + WS_O))
#define POOLED ((bf16_t*)(ws + WS_POOLED))
#define LG ((float*)(ws + WS_LG))
#define XS ((bf16_t*)(ws + WS_XS))
#define HS ((bf16_t*)(ws + WS_HS))
#define YB ((bf16_t*)(ws + WS_Y))
    LAS float* scr = (LAS float*)(lds + RING_OFF + wave * SCR_WAVE);

    if (PHON(12) && IN(0)) {
        for (int m = gw; m < NTOK; m += NGW) {
            const f32x4* xr = (const f32x4*)(in_x + (size_t)m * D_MODEL) + lane; u32x2* oh = (u32x2*)(XHL + (size_t)m * 2048) + lane;
#pragma unroll
            for (int j = 0; j < 4; ++j) { u32x2 h, l; split4(xr[64 * j], h, l); oh[64 * j] = h; oh[256 + 64 * j] = l; }
        }
        for (int idx = gw * 64 + lane; idx < NTOK * 16; idx += NGW * 64) { float s, c; sincos_d((double)in_pos[idx >> 4] * c_invf[idx & 15], s, c); COS[idx] = c; SIN[idx] = s; }
        for (int idx = gw * 64 + lane; idx < DEPTH * 2 * 256 * 1024; idx += NGW * 64) {
            const int l = idx >> 19, ks = (idx >> 18) & 1, row = (idx >> 10) & 255, k = idx & 1023;
            const int j = row < 72 ? row : ((row >= 128 && row < 200) ? row - 128 : -1);
            float v = 0.f;
            if (j >= 0 && !(ks == 1 && row >= 128)) { const float wv = (j < 8) ? w_grp[((size_t)l * 1024 + k) * 8 + j] : w_exp[((size_t)l * 1024 + k) * 64 + (j - 8)];
                const float whi = bflo(cvtpk(wv, 0.f)); v = (row < 72) ? whi : (wv - whi); }
            WR[idx] = (bf16_t)(cvtpk(v, 0.f) & 0xffffu);
        }
        for (int idx = gw * 64 + lane; idx < 2 * 96 * 1024 / 8; idx += NGW * 64) { const int j = idx / (96 * 128), r = idx % (96 * 128); *(u32x4*)(WIN + ((size_t)j * 512 + 416) * 1024 + (size_t)r * 8) = (u32x4){0u, 0u, 0u, 0u}; }
        constexpr int I_IN = 16 * 13, I_UQ = 4 * 48, I_UKV = 2 * 64, I_O = 16 * 32, I_P = 4 * 8;
        constexpr int NIT = 2 * (I_IN + I_UQ + I_UKV + I_O) + 8 * I_P;
        for (int it = gw; it < NIT; it += NGW) {
            int r = it;
            if (r < 2 * I_IN) { const int j = r / I_IN, q = r % I_IN, kb = q / 13, nb = q % 13;
                transpose_item(w_in + (size_t)j * 1024 * LAT, LAT, 64 * kb, 32 * nb, WIN + (size_t)j * 512 * 1024, 1024, 32 * nb, 1.f, scr, lane); continue; } r -= 2 * I_IN;
            if (r < 2 * I_UQ) { const int j = r / I_UQ, q = r % I_UQ, kb = q / 48, nb = q % 48; const int n0 = 32 * nb, head = n0 / 96, r0 = n0 % 96;
                if (r0 < 64) transpose_item(w_uq + (size_t)j * 256 * QPITCH, QPITCH, 64 * kb, n0, WUQ + (size_t)j * 1536 * 256, 256, head * 64 + r0, QSCALE, scr, lane);
                else {
                    const float* W = w_uq + (size_t)j * 256 * QPITCH; bf16_t* WT = WUQ + (size_t)j * 1536 * 256; const int k0 = 64 * kb;
#pragma unroll 8
                    for (int i = 0; i < 32; ++i) { const int kk = 2 * i + (lane >> 5); scr[kk * 33 + (lane & 31)] = W[(size_t)(k0 + kk) * QPITCH + n0 + (lane & 31)]; }
                    LDS_WAIT(); asm volatile("" ::: "memory");
                    const int c = lane & 7;
#pragma unroll
                    for (int jj = 0; jj < 4; ++jj) { const int n = (lane >> 3) + 8 * jj; const LAS float* s = scr + (8 * c) * 33 + n;
                        const int drow = 1024 + (head >> 3) * 256 + (head & 7) * 16 + (n < 16 ? n : 128 + n - 16);
                        u32x4 o; o.x = cvtpk(s[0 * 33] * QSCALE, s[1 * 33] * QSCALE); o.y = cvtpk(s[2 * 33] * QSCALE, s[3 * 33] * QSCALE); o.z = cvtpk(s[4 * 33] * QSCALE, s[5 * 33] * QSCALE); o.w = cvtpk(s[6 * 33] * QSCALE, s[7 * 33] * QSCALE);
                        *(u32x4*)(WT + (size_t)drow * 256 + k0 + 8 * c) = o; }
                    LDS_WAIT(); asm volatile("" ::: "memory");
                }
                continue; } r -= 2 * I_UQ;
            if (r < 2 * I_UKV) { const int j = r / I_UKV, q = r % I_UKV, kb = q / 64, nb = q % 64; const int n0 = 32 * nb, head = n0 >> 7, r0 = n0 & 127;
                if (r0 < 64) transpose_item(w_ukv + (size_t)j * 128 * 2048, 2048, 64 * kb, n0, WUK + (size_t)j * 1024 * 128, 128, head * 64 + r0, 1.f, scr, lane);
                else transpose_item(w_ukv + (size_t)j * 128 * 2048, 2048, 64 * kb, n0, WUV + (size_t)j * 1024 * 128, 128, head * 64 + r0 - 64, 1.f, scr, lane);
                continue; } r -= 2 * I_UKV;
            if (r < 2 * I_O) { const int j = r / I_O, q = r % I_O, kb = q / 32, nb = q % 32;
                transpose_item(w_o + (size_t)j * 1024 * 1024, 1024, 64 * kb, 32 * nb, WO + (size_t)j * 1024 * 1024, 1024, 32 * nb, 1.f, scr, lane); continue; } r -= 2 * I_O;
            { const int jg = r / I_P, q = r % I_P, kb = q / 8, nb = q % 8;
                transpose_item(pool_w + (size_t)jg * 65536, 256, 64 * kb, 32 * nb, WP + (size_t)jg * 65536, 256, 32 * nb, 1.f, scr, lane); }
        }
        SEAM(0);
    }

    for (int l = 0; l < DEPTH; ++l) {
        const int pb = 1 + PPL * l, j = l >> 1;
        tid = opaque(threadIdx.x); lane = tid & 63; wave = __builtin_amdgcn_readfirstlane(tid >> 6); gw = vcu * NWAVES + wave; scr = (LAS float*)(lds + RING_OFF + wave * SCR_WAVE);
        const bool mla = (l & 1) == 0;
#define MOE_WEIGHT_CONV() do { \
            constexpr int I13 = 64 * 16 * 4, I2 = 64 * 4 * 16; \
            for (int it = gw; it < 2 * I13 + I2; it += NGW) { int r = it; \
                if (r < 2 * I13) { const int which = r / I13, q = r % I13, e = q >> 6, kb = (q >> 2) & 15, nb = q & 3; const int n0 = 64 * nb; \
                    const float* W = (which ? w3 : w1) + ((size_t)l * 64 + e) * 1024 * 256; \
                    transpose_item64(W, 256, 64 * kb, n0, W13 + (size_t)e * 512 * 1024, 1024, (n0 >> 7) * 256 + (n0 & 127) + which * 128, scr, lane); } \
                else { r -= 2 * I13; const int e = r >> 6, kb = (r >> 4) & 3, nb = r & 15; \
                    transpose_item64(w2 + ((size_t)l * 64 + e) * 256 * 1024, 1024, 64 * kb, 64 * nb, W2T + (size_t)e * 1024 * 256, 256, 64 * nb, scr, lane); } } } while (0)

        if (mla) {
            if (PHON(0) && IN(pb + 0)) {
                for (int rep = 0; rep < NREP(0); ++rep) {
                pg8::Gemm g{2048, 1024, 1024}; pg8::DenseOrder S; S.init(NTOK, 512, G, bx, XHL, (size_t)256 * 2048 * 2, 0, WIN + (size_t)j * 512 * 1024, (size_t)256 * 1024 * 2);
                pg8::EpiF32 E{LATB, 512};
                pg8::gemm_phase<pg8::EpiF32, pg8::DenseOrder, true>(lds + RING_OFF, g, S, E);
                MOE_WEIGHT_CONV();
                }
                SEAM(pb + 0);
            }
            if (PHON(1) && IN(pb + 1)) {
                const float* gq = q_norm + j * 256; const float* gk = kv_norm + j * 128;
                const f32x4 gqv = *(const f32x4*)(gq + 4 * lane); const f32x4 gkv = *(const f32x4*)(gk + 4 * (lane & 31));
                for (int m = gw; m < NTOK; m += NGW) {
                    const float* lr = LATB + (size_t)m * 512;
                    const f32x4 a = *(const f32x4*)(lr + 4 * lane), c = *(const f32x4*)(lr + 256 + 4 * lane);
                    const float sq = wave_sum(a.x * a.x + a.y * a.y + a.z * a.z + a.w * a.w);
                    const float sk = wave_sum(lane < 32 ? (c.x * c.x + c.y * c.y + c.z * c.z + c.w * c.w) : 0.f);
                    const float rq = 1.0f / sqrtf(sq * (1.f / 256.f) + RMS_EPS), rk = 1.0f / sqrtf(sk * (1.f / 128.f) + RMS_EPS);
                    { u32x2 o; o.x = cvtpk(a.x * rq * gqv.x, a.y * rq * gqv.y); o.y = cvtpk(a.z * rq * gqv.z, a.w * rq * gqv.w); *((u32x2*)(CQ + (size_t)m * 256) + lane) = o; }
                    if (lane < 32) { u32x2 o; o.x = cvtpk(c.x * rk * gkv.x, c.y * rk * gkv.y); o.y = cvtpk(c.z * rk * gkv.z, c.w * rk * gkv.w); *((u32x2*)(CKV + (size_t)m * 128) + lane) = o; }
                    f32x4 p; p.x = __shfl_xor(c.x, 4); p.y = __shfl_xor(c.y, 4); p.z = __shfl_xor(c.z, 4); p.w = __shfl_xor(c.w, 4);
                    if (lane >= 32 && lane < 40) {
                        const f32x4 cv = *(const f32x4*)(COS + (size_t)m * 16 + 4 * (lane & 3)), sv = *(const f32x4*)(SIN + (size_t)m * 16 + 4 * (lane & 3));
                        f32x4 y; if (lane < 36) y = c * cv - p * sv; else y = c * cv + p * sv;
                        u32x2 o; o.x = cvtpk(y.x, y.y); o.y = cvtpk(y.z, y.w); *((u32x2*)(KR + (size_t)m * 32) + (lane - 32)) = o;
                    }
                }
                SEAM(pb + 1);
            }
            if (PHON(2) && IN(pb + 2)) {
                for (int rep = 0; rep < NREP(2); ++rep) {
                { pg8::Gemm g{256, 256, 256}; pg8::DenseOrder S; S.init(NTOK, 1536, G, bx, CQ, (size_t)256 * 256 * 2, 0, WUQ + (size_t)j * 1536 * 256, (size_t)256 * 256 * 2);
                  pg8::EpiQ E{QB, COS, SIN};
                  pg8::gemm_phase<pg8::EpiQ, pg8::DenseOrder, true>(lds + RING_OFF, g, S, E); }
                { pg8::Gemm g{128, 128, 128}; pg8::DenseOrder S; S.init(NTOK, 1024, G, bx, CKV, (size_t)256 * 128 * 2, 0, WUK + (size_t)j * 1024 * 128, (size_t)256 * 128 * 2);
                  pg8::EpiBf16 E{KN, 1024};
                  pg8::gemm_phase<pg8::EpiBf16, pg8::DenseOrder, true>(lds + RING_OFF, g, S, E); }
                { pg8::Gemm g{128, 128, 128}; pg8::DenseOrder S; S.init(1024, NTOK, G, bx, WUV + (size_t)j * 1024 * 128, (size_t)256 * 128 * 2, 0, CKV, (size_t)256 * 128 * 2);
                  pg8::EpiBf16 E{VT, (size_t)NTOK};
                  pg8::gemm_phase<pg8::EpiBf16, pg8::DenseOrder, true>(lds + RING_OFF, g, S, E); }
                }
                SEAM(pb + 2);
            }
            if (PHON(3) && IN(pb + 3)) {
                for (int rep = 0; rep < NREP(3); ++rep)
                for (int i = 0;; ++i) {
                    const int L = i * G + vcu; if (L >= 2048) break;
                    const int sl = L & 255, rnd = L >> 8, s = sl & 7, bh = (sl >> 3) + 32 * (rnd >> 2), k = rnd & 3;
                    const int qb = (k == 0) ? s : (k == 1) ? 15 - s : (k == 2) ? 16 + s : 31 - s;
                    att::attn_unit(bh >> 4, bh & 15, qb, QB, KN, KR, VT, OB, lds + RING_OFF);
                }
                SEAM(pb + 3);
            }
            if (PHON(4) && IN(pb + 4)) {
                for (int rep = 0; rep < NREP(4); ++rep) {
                pg8::Gemm g{1024, 1024, 1024}; pg8::DenseOrder S; S.init(NTOK, 1024, G, bx, OB, (size_t)256 * 1024 * 2, 0, WO + (size_t)j * 1024 * 1024, (size_t)256 * 1024 * 2);
                pg8::EpiBf16 E{FB, 1024};
                pg8::gemm_phase<pg8::EpiBf16, pg8::DenseOrder, true>(lds + RING_OFF, g, S, E);
                }
                SEAM(pb + 4);
            }
        } else {
            if (PHON(13) && IN(pb + 0)) {
                for (int rep = 0; rep < NREP(13); ++rep) {
                for (int it = gw; it < 4 * (NTOK / 64); it += NGW) {
                    const int grp = it & 3, chunk = it >> 2, t0 = chunk * 64, s0 = t0 & (SEQ - 1), win = 2 << grp;
                    const bf16_t* xb = XHL + (size_t)grp * 256 + 4 * lane;
                    f32x4 S4 = {0.f, 0.f, 0.f, 0.f};
                    for (int jj = 1; jj < win; ++jj) { if (s0 - jj >= 0) { const bf16_t* p = xb + (size_t)(t0 - jj) * 2048; S4 += join4(*(const u32x2*)p, *(const u32x2*)(p + 1024)); } }
                    for (int tt = 0; tt < 64; ++tt) {
                        const int t = t0 + tt, s = s0 + tt; const bf16_t* p = xb + (size_t)t * 2048;
                        const f32x4 xv = join4(*(const u32x2*)p, *(const u32x2*)(p + 1024));
                        S4 += xv;
                        const float rc = 1.0f / (float)((s + 1 < win) ? s + 1 : win);
                        const f32x4 pv = S4 * rc - xv;
                        u32x2 o; o.x = cvtpk(pv.x, pv.y); o.y = cvtpk(pv.z, pv.w); *(u32x2*)(POOLED + (size_t)t * 1024 + grp * 256 + 4 * lane) = o;
                        if (s - win + 1 >= 0) { const bf16_t* pp = xb + (size_t)(t - win + 1) * 2048; S4 -= join4(*(const u32x2*)pp, *(const u32x2*)(pp + 1024)); }
                    }
                }
                MOE_WEIGHT_CONV();
                }
                SEAM(pb + 0);
            }
            if (PHON(14) && IN(pb + 1)) {
                for (int rep = 0; rep < NREP(14); ++rep) {
                pg8::Gemm g{1024, 256, 256}; pg8::DenseOrder S; S.init(NTOK, 1024, G, bx, POOLED, (size_t)256 * 1024 * 2, (size_t)256 * 2, WP + (size_t)j * 4 * 65536, (size_t)65536 * 2);
                pg8::EpiPool E{FB, pool_b + j * 1024, pool_scale + j * 1024};
                pg8::gemm_phase<pg8::EpiPool, pg8::DenseOrder, true>(lds + RING_OFF, g, S, E);
                }
                SEAM(pb + 1);
            }
        }
        if (PHON(5) && IN(pb + 5)) {
                for (int rep = 0; rep < NREP(5); ++rep) {
            f32x4 gv[4], bv[4];
#pragma unroll
            for (int jj = 0; jj < 4; ++jj) { gv[jj] = *(const f32x4*)(ln_g + (size_t)(l * 2 + 0) * 1024 + 4 * lane + 256 * jj); bv[jj] = *(const f32x4*)(ln_b + (size_t)(l * 2 + 0) * 1024 + 4 * lane + 256 * jj); }
            for (int m = gw; m < NTOK; m += NGW) {
                const u32x2* xh = (const u32x2*)(XHL + (size_t)m * 2048) + lane; const u32x2* fr2 = (const u32x2*)(FB + (size_t)m * 1024) + lane; f32x4 v[4]; float s = 0.f;
#pragma unroll
                for (int jj = 0; jj < 4; ++jj) { v[jj] = join4(xh[64 * jj], xh[256 + 64 * jj]) * DN_ALPHA + bf4(fr2[64 * jj]); s += (v[jj].x + v[jj].y) + (v[jj].z + v[jj].w); }
                const float mean = wave_sum(s) * (1.f / 1024.f); float s2 = 0.f;
#pragma unroll
                for (int jj = 0; jj < 4; ++jj) { v[jj] = v[jj] - mean; s2 += (v[jj].x * v[jj].x + v[jj].y * v[jj].y) + (v[jj].z * v[jj].z + v[jj].w * v[jj].w); }
                const float rstd = 1.0f / sqrtf(wave_sum(s2) * (1.f / 1024.f) + LN_EPS);
                u32x2* oh = (u32x2*)(XHL + (size_t)m * 2048) + lane;
#pragma unroll
                for (int jj = 0; jj < 4; ++jj) { const f32x4 y = v[jj] * rstd * gv[jj] + bv[jj]; u32x2 h, lo2; split4(y, h, lo2); oh[64 * jj] = h; oh[256 + 64 * jj] = lo2; }
            }
            }
                SEAM(pb + 5);
        }
        if (PHON(6) && IN(pb + 6)) {
                for (int rep = 0; rep < NREP(6); ++rep) {
            pg8::Gemm g{2048, 1024, 1024}; pg8::DenseOrder S; S.init(NTOK, 512, G, bx, XHL, (size_t)256 * 2048 * 2, (size_t)1024 * 2, WR + (size_t)l * 2 * 256 * 1024, (size_t)256 * 1024 * 2);
            pg8::EpiRouter E{LG};
            pg8::gemm_phase<pg8::EpiRouter, pg8::DenseOrder, true>(lds + RING_OFF, g, S, E);
            }
                SEAM(pb + 6);
        }
        if (PHON(7) && IN(pb + 7)) {
                for (int rep = 0; rep < NREP(7); ++rep) {
            LAS int* hist = (LAS int*)(lds + RING_OFF);
            const float* bg = b_grp + l * 8; const float* be = b_exp + l * 64;
            for (int c = bx; c < 256; c += G) {
                if (tid < 64) hist[tid] = 0;
                __syncthreads();
                if (tid < 128) {
                    const int t = c * 128 + tid; const float* lg = LG + (size_t)t * LGP;
                    const float* lg2 = lg + (size_t)NTOK * LGP;
                    const f32x4 g0 = *(const f32x4*)lg + *(const f32x4*)lg2, g1 = *(const f32x4*)(lg + 4) + *(const f32x4*)(lg2 + 4);
                    float gl[8] = {g0.x + bg[0], g0.y + bg[1], g0.z + bg[2], g0.w + bg[3], g1.x + bg[4], g1.y + bg[5], g1.z + bg[6], g1.w + bg[7]};
                    int gs = 0; float gm = gl[0];
#pragma unroll
                    for (int i = 1; i < 8; ++i) if (gl[i] > gm) { gm = gl[i]; gs = i; }
                    float se = 0.f;
#pragma unroll
                    for (int i = 0; i < 8; ++i) se += __expf(gl[i] - gm);
                    const float ggate = 1.0f / se;
                    const f32x4 e0 = *(const f32x4*)(lg + 8 + gs * 8) + *(const f32x4*)(lg2 + 8 + gs * 8), e1 = *(const f32x4*)(lg + 12 + gs * 8) + *(const f32x4*)(lg2 + 12 + gs * 8);
                    const f32x4 b0 = *(const f32x4*)(be + gs * 8), b1 = *(const f32x4*)(be + gs * 8 + 4);
                    float el[8] = {e0.x + b0.x, e0.y + b0.y, e0.z + b0.z, e0.w + b0.w, e1.x + b1.x, e1.y + b1.y, e1.z + b1.z, e1.w + b1.w};
                    int i1 = 0; float m1 = el[0];
#pragma unroll
                    for (int i = 1; i < 8; ++i) if (el[i] > m1) { m1 = el[i]; i1 = i; }
                    int i2 = -1; float m2 = -INFINITY;
#pragma unroll
                    for (int i = 0; i < 8; ++i) if (i != i1 && el[i] > m2) { m2 = el[i]; i2 = i; }
                    const float x2 = __expf(m2 - m1), rs = 1.0f / (1.0f + x2);
                    const int ex1 = gs * 8 + i1, ex2 = gs * 8 + i2;
                    const int p1 = __hip_atomic_fetch_add(&hist[ex1], 1, __ATOMIC_RELAXED, __HIP_MEMORY_SCOPE_WORKGROUP), p2 = __hip_atomic_fetch_add(&hist[ex2], 1, __ATOMIC_RELAXED, __HIP_MEMORY_SCOPE_WORKGROUP);
                    AE[2 * t] = ex1; AE[2 * t + 1] = ex2; APOS[2 * t] = p1; APOS[2 * t + 1] = p2; AG[2 * t] = ggate * rs; AG[2 * t + 1] = ggate * x2 * rs;
                }
                __syncthreads();
                if (tid < 64) CNT[c * 64 + tid] = hist[tid];
                __syncthreads();
            }
            }
                SEAM(pb + 7);
        }
        if (PHON(8) && IN(pb + 8)) {
                for (int rep = 0; rep < NREP(8); ++rep) {
            LAS int* part = (LAS int*)(lds + RING_OFF); LAS int* pstart = part + 512; LAS int* tot = pstart + 64; LAS int* base = tot + 64; LAS int* misc = base + 64;
            { const int e = tid & 63, p = tid >> 6; int s = 0; for (int c = 32 * p; c < 32 * p + 32; ++c) s += CNT[c * 64 + e]; part[p * 64 + e] = s; }
            __syncthreads();
            if (tid < 64) { int s = 0; for (int p = 0; p < 8; ++p) s += part[p * 64 + tid]; tot[tid] = s; }
            __syncthreads();
            if (tid == 0) { int a = 0; for (int e = 0; e < 64; ++e) { pstart[e] = a; a += (tot[e] + 255) & ~255; } misc[0] = a >> 8; }
            __syncthreads();
            if (bx == 0) {
                const int ntl = misc[0];
                for (int i = tid; i < MAX_TILES; i += NWAVES * 64) { int ee = 0; for (int e = 0; e < 64; ++e) if (pstart[e] <= i * 256) ee = e; TILE[i] = (i < ntl) ? ee : 0; }
                if (tid == 0) TILE[MAX_TILES] = ntl;
            }
            for (int e = bx; e < 64; e += G) { const int r0 = pstart[e] + tot[e], r1 = pstart[e] + ((tot[e] + 255) & ~255); for (int r = r0 + tid; r < r1; r += NWAVES * 64) { RSLOT[r] = -1; RGATE[r] = 0.f; } }
            for (int c = bx; c < 256; c += G) {
                __syncthreads();
                { const int e = tid & 63, p = tid >> 6; int s = 0; for (int cc = 32 * p; cc < 32 * p + 32 && cc < c; ++cc) s += CNT[cc * 64 + e]; part[p * 64 + e] = s; }
                __syncthreads();
                if (tid < 64) { int s = pstart[tid]; for (int p = 0; p < 8; ++p) s += part[p * 64 + tid]; base[tid] = s; }
                __syncthreads();
                for (int i = 0; i < 32; ++i) {
                    const int ga = c * 256 + wave * 32 + i, t = ga >> 1;
                    const int e = AE[ga], dest = base[e] + APOS[ga];
                    const u32x4* src = (const u32x4*)(XHL + (size_t)t * 2048); u32x4* dst = (u32x4*)(XS + (size_t)dest * 1024);
                    const u32x4 v0 = src[lane], v1 = src[64 + lane]; dst[lane] = v0; dst[64 + lane] = v1;
                    if (lane == 0) { RSLOT[dest] = ga; RGATE[dest] = AG[ga]; }
                }
            }
            }
                SEAM(pb + 8);
        }
        if (PHON(9) && IN(pb + 9)) {
                for (int rep = 0; rep < NREP(9); ++rep) {
            const int ntl = TILE[MAX_TILES];
            pg8::Gemm g{1024, 1024, 1024}; pg8::MoeOrder S; S.init(TILE, ntl, 2, G, bx, XS, (size_t)256 * 1024 * 2, W13, (size_t)512 * 1024 * 2, (size_t)256 * 1024 * 2);
            pg8::EpiSwiglu E{HS};
            pg8::gemm_phase<pg8::EpiSwiglu, pg8::MoeOrder, true>(lds + RING_OFF, g, S, E);
            }
                SEAM(pb + 9);
        }
        if (PHON(10) && IN(pb + 10)) {
                for (int rep = 0; rep < NREP(10); ++rep) {
            const int ntl = TILE[MAX_TILES];
            pg8::Gemm g{256, 256, 256}; pg8::MoeOrder S; S.init(TILE, ntl, 4, G, bx, HS, (size_t)256 * 256 * 2, W2T, (size_t)1024 * 256 * 2, (size_t)256 * 256 * 2);
            pg8::EpiMoeOut E{YB, RSLOT, RGATE};
            pg8::gemm_phase<pg8::EpiMoeOut, pg8::MoeOrder, true>(lds + RING_OFF, g, S, E);
            }
                SEAM(pb + 10);
        }
        if (PHON(11) && IN(pb + 11)) {
            f32x4 gv[4], bv[4];
#pragma unroll
            for (int jj = 0; jj < 4; ++jj) { gv[jj] = *(const f32x4*)(ln_g + (size_t)(l * 2 + 1) * 1024 + 4 * lane + 256 * jj); bv[jj] = *(const f32x4*)(ln_b + (size_t)(l * 2 + 1) * 1024 + 4 * lane + 256 * jj); }
            const bool lastl = (l == DEPTH - 1);
            for (int m = gw; m < NTOK; m += NGW) {
                u32x2* xh = (u32x2*)(XHL + (size_t)m * 2048) + lane;
                const u32x2* y0 = (const u32x2*)(YB + (size_t)(2 * m) * 1024) + lane; const u32x2* y1 = (const u32x2*)(YB + (size_t)(2 * m + 1) * 1024) + lane;
                f32x4 v[4]; float s = 0.f;
#pragma unroll
                for (int jj = 0; jj < 4; ++jj) { v[jj] = join4(xh[64 * jj], xh[256 + 64 * jj]) * DN_ALPHA + (bf4(y0[64 * jj]) + bf4(y1[64 * jj])); s += (v[jj].x + v[jj].y) + (v[jj].z + v[jj].w); }
                const float mean = wave_sum(s) * (1.f / 1024.f); float s2 = 0.f;
#pragma unroll
                for (int jj = 0; jj < 4; ++jj) { v[jj] = v[jj] - mean; s2 += (v[jj].x * v[jj].x + v[jj].y * v[jj].y) + (v[jj].z * v[jj].z + v[jj].w * v[jj].w); }
                const float rstd = 1.0f / sqrtf(wave_sum(s2) * (1.f / 1024.f) + LN_EPS);
                if (lastl) { f32x4* orow = (f32x4*)(kargs()->out + (size_t)m * 1024) + lane;
#pragma unroll
                    for (int jj = 0; jj < 4; ++jj) orow[64 * jj] = v[jj] * rstd * gv[jj] + bv[jj];
                } else {
#pragma unroll
                    for (int jj = 0; jj < 4; ++jj) { const f32x4 y = v[jj] * rstd * gv[jj] + bv[jj]; u32x2 h, lo2; split4(y, h, lo2); xh[64 * jj] = h; xh[256 + 64 * jj] = lo2; }
                }
            }
            SEAM(pb + 11);
        }
    }
#undef IN
#undef SEAM
}
#undef ws
#undef in_x
#undef in_pos
#undef ln_g
#undef ln_b
#undef w_in
#undef q_norm
#undef w_uq
#undef kv_norm
#undef w_ukv
#undef w_o
#undef pool_w
#undef pool_b
#undef pool_scale
#undef w_grp
#undef b_grp
#undef w_exp
#undef b_exp
#undef w1
#undef w3
#undef w2
#undef COS
#undef SIN
#undef CNT
#undef TILE
#undef AE
#undef APOS
#undef AG
#undef RSLOT
#undef RGATE
#undef WIN
#undef WUQ
#undef WUK
#undef WUV
#undef WO
#undef WP
#undef WR
#undef W13
#undef W2T
#undef FB
#undef XHL
#undef LATB
#undef CQ
#undef CKV
#undef KR
#undef QB
#undef KN
#undef VT
#undef OB
#undef POOLED
#undef LG
#undef XS
#undef HS
#undef YB

static bool phase_exists(int p) {
    if (p == 0) return true;
    const int l = (p - 1) / PPL, k = (p - 1) % PPL;
    if (k >= 5) return true;
    return (l & 1) == 0 ? true : (k < 2);
}
extern "C" void kernel_launch(void* const* d_in, const int* in_sizes, int n_in, void* d_out, int out_size, void* d_ws, size_t ws_size, hipStream_t stream) {
    static int grid = 0;
    if (grid == 0) {
        if (n_in != 20 || in_sizes[0] != NTOK * D_MODEL || out_size != NTOK * D_MODEL || ws_size < WS_END) { fprintf(stderr, "kernel_launch: unexpected shapes / workspace (%zu < %zu)\n", ws_size, (size_t)WS_END); grid = -1; return; }
        int dev = 0, cus = 0, per_cu = 0;
        if (hipGetDevice(&dev) != hipSuccess || hipDeviceGetAttribute(&cus, hipDeviceAttributeMultiprocessorCount, dev) != hipSuccess) { grid = -1; return; }
        if (hipFuncSetAttribute((const void*)mk_fwd, hipFuncAttributeMaxDynamicSharedMemorySize, LDS_BYTES) != hipSuccess) { fprintf(stderr, "kernel_launch: hipFuncSetAttribute failed\n"); grid = -1; return; }
        if (hipOccupancyMaxActiveBlocksPerMultiprocessor(&per_cu, (const void*)mk_fwd, NWAVES * 64, LDS_BYTES) != hipSuccess || per_cu < 1) fprintf(stderr, "kernel_launch: occupancy query reports %d\n", per_cu);
        (void)hipGetLastError();
        grid = cus;
    }
    if (grid < 0) return;
    if (hipMemsetAsync((char*)d_ws + WS_CTL, 0, CTL_ZERO_BYTES, stream) != hipSuccess) return;
    Args a{};
    for (int i = 0; i < 20; ++i) a.in[i] = d_in[i];
    a.out = (float*)d_out; a.ws = (unsigned char*)d_ws;
#if MK_ONE_LAUNCH
    a.ph_lo = 0; a.ph_hi = NPHASE;
    hipLaunchKernelGGL(mk_fwd, dim3(grid), dim3(NWAVES * 64), LDS_BYTES, stream, a);
#else
    for (int p = 0; p < NPHASE; ++p) {
        if (!phase_exists(p)) continue;
        a.ph_lo = p; a.ph_hi = p + 1;
        hipLaunchKernelGGL(mk_fwd, dim3(grid), dim3(NWAVES * 64), LDS_BYTES, stream, a);
    }
#endif
}
```

```cpp
#include <hip/hip_runtime.h>
#include <cstdio>
#include <cstdint>

#ifndef MK_ONE_LAUNCH
#define MK_ONE_LAUNCH 1
#endif

#define LAS __attribute__((address_space(3)))
#define GAS __attribute__((address_space(1)))

constexpr int D_MODEL = 1024, BATCH = 4, SEQ = 8192, DEPTH = 4, NTOK = BATCH * SEQ;
constexpr int N_HEADS = 16, QK_NOPE = 64, QK_ROPE = 32, V_HEAD = 64, Q_LORA = 256, KV_LORA = 128, LAT = Q_LORA + KV_LORA + QK_ROPE;
constexpr int QPITCH = N_HEADS * (QK_NOPE + QK_ROPE);
constexpr int N_GROUPS = 8, EPG = 8, N_EXPERTS = 64, D_EXPERT = 256;
constexpr int MAX_TILES = 320;
constexpr float DN_ALPHA = 1.681792830507429f;
constexpr float LN_EPS = 1e-5f, RMS_EPS = 1e-6f;
constexpr float QSCALE = 0.14724444602590306f;
constexpr int LGP = 80;

constexpr size_t MiB = 1u << 20;
constexpr size_t WS_CTL = 0, CTL_ZERO_BYTES = 1 * MiB;
constexpr size_t WS_COS = 1 * MiB, WS_SIN = 3 * MiB;
constexpr size_t WS_CNT = 5 * MiB;
constexpr size_t WS_TILE = 5 * MiB + 65536;
constexpr size_t WS_AE = 5 * MiB + 131072, WS_APOS = WS_AE + 262144, WS_AG = WS_APOS + 262144;
constexpr size_t WS_RSLOT = 6 * MiB, WS_RGATE = 6 * MiB + 512 * 1024;
constexpr size_t WS_WIN = 8 * MiB;
constexpr size_t WS_WUQ = 10 * MiB;
constexpr size_t WS_WUK = 12 * MiB;
constexpr size_t WS_WUV = 13 * MiB;
constexpr size_t WS_WO = 14 * MiB;
constexpr size_t WS_WP = 18 * MiB;
constexpr size_t WS_WR = 19 * MiB;
constexpr size_t WS_W13 = 24 * MiB;
constexpr size_t WS_W2T = 88 * MiB;
constexpr size_t WS_FB = 120 * MiB;
constexpr size_t WS_XHL = 248 * MiB;
constexpr size_t WS_R1 = 376 * MiB;
constexpr size_t WS_LAT = WS_R1;
constexpr size_t WS_CQ = WS_R1 + 64 * MiB;
constexpr size_t WS_CKV = WS_R1 + 80 * MiB;
constexpr size_t WS_KR = WS_R1 + 88 * MiB;
constexpr size_t WS_Q = WS_R1 + 92 * MiB;
constexpr size_t WS_KN = WS_R1 + 188 * MiB;
constexpr size_t WS_VT = WS_R1 + 252 * MiB;
constexpr size_t WS_O = WS_R1 + 316 * MiB;
constexpr size_t WS_POOLED = WS_R1;
constexpr size_t WS_LG = WS_R1;
constexpr size_t WS_LIST = WS_R1 + 20 * MiB;
constexpr size_t WS_LGATE = WS_R1 + 36 * MiB;
constexpr size_t WS_HS = WS_R1 + 180 * MiB;
constexpr size_t WS_Y = WS_R1 + 220 * MiB;
constexpr size_t WS_END = WS_R1 + 384 * MiB;
static_assert(WS_O + 64 * MiB <= WS_END && WS_Y + 128 * MiB <= WS_END, "ws map");

constexpr int CW_TMO = 0, CW_CODE = 1, CW_BAR = 4096, CW_GCNT = 16384;

constexpr int RING_OFF = 0, RING_BYTES = 131072, SCR_WAVE = 17408;
constexpr int LDSCTL_OFF = 8 * SCR_WAVE, MISC_OFF = LDSCTL_OFF + 320, TINFO_OFF = LDSCTL_OFF + 1024;
constexpr int LDS_BYTES = 147456;

typedef unsigned short bf16_t;
typedef short bf16x8 __attribute__((ext_vector_type(8)));
typedef float f32x4 __attribute__((ext_vector_type(4)));
typedef float f32x16 __attribute__((ext_vector_type(16)));
typedef unsigned u32x4 __attribute__((ext_vector_type(4)));
typedef unsigned u32x2 __attribute__((ext_vector_type(2)));
typedef float f32x2_t __attribute__((ext_vector_type(2)));
typedef __bf16 bf16x2_t __attribute__((ext_vector_type(2)));
#define RLX_AGENT __ATOMIC_RELAXED, __HIP_MEMORY_SCOPE_AGENT
#define LDS_WAIT() asm volatile("s_waitcnt lgkmcnt(0)" ::: "memory")
#define VM_WAIT() asm volatile("s_waitcnt vmcnt(0)" ::: "memory")

__device__ __forceinline__ unsigned cvtpk(float lo, float hi) { f32x2_t v = {lo, hi}; bf16x2_t b = __builtin_convertvector(v, bf16x2_t); return __builtin_bit_cast(unsigned, b); }
__device__ __forceinline__ int opaque(int x) { asm volatile("" : "+v"(x)); return x; }
__device__ __forceinline__ int opaque_s(int x) { asm volatile("" : "+s"(x)); return x; }
__device__ __forceinline__ float bflo(unsigned u) { return __uint_as_float(u << 16); }
__device__ __forceinline__ float bfhi(unsigned u) { return __uint_as_float(u & 0xffff0000u); }
__device__ __forceinline__ float wave_sum(float v) {
#pragma unroll
    for (int o = 1; o < 64; o <<= 1) v += __shfl_xor(v, o);
    return v;
}
__device__ __forceinline__ void split4(const f32x4 v, u32x2& h, u32x2& l) {
    h.x = cvtpk(v.x, v.y); h.y = cvtpk(v.z, v.w);
    l.x = cvtpk(v.x - bflo(h.x), v.y - bfhi(h.x)); l.y = cvtpk(v.z - bflo(h.y), v.w - bfhi(h.y));
}
__device__ __forceinline__ f32x4 join4(const u32x2 h, const u32x2 l) {
    return (f32x4){bflo(h.x) + bflo(l.x), bfhi(h.x) + bfhi(l.x), bflo(h.y) + bflo(l.y), bfhi(h.y) + bfhi(l.y)};
}
__device__ __forceinline__ f32x4 bf4(const u32x2 h) { return (f32x4){bflo(h.x), bfhi(h.x), bflo(h.y), bfhi(h.y)}; }

namespace pg8 {
constexpr int BM = 256, BK = 64, HALF = 128, HTB = HALF * BK * 2, STAGE_BYTES = 8 * HTB, NXCD = 8, WGM = 8;
__host__ __device__ __forceinline__ int lds_byte(int r, int c) { const int st = (r >> 4) * 2 + (c >> 5), rr = r & 15, cc = c & 31, ob = rr * 64 + cc * 2; return st * 1024 + (ob ^ (((ob >> 9) & 1) << 5)); }
__host__ __device__ __forceinline__ void stage_rc(int b, int& R, int& C) { const int st = b / 1024, sb = b % 1024, swz = sb ^ (((sb >> 9) & 1) << 5); R = (st >> 1) * 16 + swz / 64; C = (st & 1) * 32 + (swz % 64) / 2; }
__host__ __device__ __forceinline__ int perm32(int rho) { const int n = rho >> 4, i = rho & 15; return 8 * (i >> 2) + 4 * n + (i & 3); }

struct Unit { int pm, pn; };
struct Gemm { int lda, ldb, K; };

struct DenseOrder {
    int nM, nN, nwg, G, c;
    const char* A; const char* B; size_t a_pm, a_pn, b_pn;
    __device__ __forceinline__ void init(int M, int N, int G_, int c_, const void* A_, size_t a_pm_, size_t a_pn_, const void* B_, size_t b_pn_) {
        nM = M / BM; nN = N / BM; nwg = nM * nN; G = G_; c = c_; A = (const char*)A_; B = (const char*)B_; a_pm = a_pm_; a_pn = a_pn_; b_pn = b_pn_; }
    __device__ __forceinline__ bool next(int i, Unit& u) const {
        const long L = (long)i * G + c; if (L >= nwg) return false;
        int wgid = (int)L; { const int q = nwg / NXCD, r = nwg % NXCD, xcd = wgid % NXCD, off = wgid / NXCD; wgid = (xcd < r ? xcd * (q + 1) : r * (q + 1) + (xcd - r) * q) + off; }
        const int nig = WGM * nN, gid = wgid / nig, fm = gid * WGM, gsz = (nM - fm) < WGM ? (nM - fm) : WGM;
        u.pm = fm + ((wgid % nig) % gsz); u.pn = (wgid % nig) / gsz; return true;
    }
    __device__ __forceinline__ const char* a_base(const Unit& u) const { return A + (size_t)u.pm * a_pm + (size_t)u.pn * a_pn; }
    __device__ __forceinline__ unsigned a_voff(const Unit&, int R, int C, int lda) const { return (unsigned)(R * lda + C) * 2u; }
    __device__ __forceinline__ const char* b_base(const Unit& u) const { return B + (size_t)u.pn * b_pn; }
};
constexpr int TI_CNT = 320, LIST_CAP = 65536;
struct MoeOrder {
    const LAS int* tinfo; int ntiles, nN, nwg, G, c;
    const char* A; const char* W; size_t a_tile, w_e, w_pn;
    __device__ __forceinline__ void init(const LAS int* ti, int ntiles_, int nN_, int G_, int c_, const void* A_, size_t a_tile_, const void* W_, size_t w_e_, size_t w_pn_) {
        tinfo = ti; ntiles = ntiles_; nN = nN_; nwg = ntiles_ * nN_; G = G_; c = c_; A = (const char*)A_; a_tile = a_tile_; W = (const char*)W_; w_e = w_e_; w_pn = w_pn_; }
    __device__ __forceinline__ bool next(int i, Unit& u) const {
        const long L = (long)i * G + c; if (L >= nwg) return false;
        int wgid = (int)L; { const int q = nwg / NXCD, r = nwg % NXCD, xcd = wgid % NXCD, off = wgid / NXCD; wgid = (xcd < r ? xcd * (q + 1) : r * (q + 1) + (xcd - r) * q) + off; }
        u.pm = wgid / nN; u.pn = wgid % nN; return true;
    }
    __device__ __forceinline__ const char* a_base(const Unit& u) const { return A + (size_t)u.pm * a_tile; }
    __device__ __forceinline__ const char* b_base(const Unit& u) const { const int e = __builtin_amdgcn_readfirstlane(tinfo[u.pm]) & 255; return W + (size_t)e * w_e + (size_t)u.pn * w_pn; }
    __device__ __forceinline__ unsigned a_voff(const Unit&, int R, int C, int lda) const { return (unsigned)(R * lda + C) * 2u; }
};
struct GatherOrder {
    const LAS int* tinfo; int ntiles, nN, nwg, G, c;
    const char* A; const int* list; const char* W; size_t w_e, w_pn;
    __device__ __forceinline__ void init(const LAS int* ti, int ntiles_, int nN_, int G_, int c_, const void* A_, const int* list_, const void* W_, size_t w_e_, size_t w_pn_) {
        tinfo = ti; ntiles = ntiles_; nN = nN_; nwg = ntiles_ * nN_; G = G_; c = c_; A = (const char*)A_; list = list_; W = (const char*)W_; w_e = w_e_; w_pn = w_pn_; }
    __device__ __forceinline__ bool next(int i, Unit& u) const {
        const long L = (long)i * G + c; if (L >= nwg) return false;
        int wgid = (int)L; { const int q = nwg / NXCD, r = nwg % NXCD, xcd = wgid % NXCD, off = wgid / NXCD; wgid = (xcd < r ? xcd * (q + 1) : r * (q + 1) + (xcd - r) * q) + off; }
        u.pm = wgid / nN; u.pn = wgid % nN; return true;
    }
    __device__ __forceinline__ const char* a_base(const Unit&) const { return A; }
    __device__ __forceinline__ const char* b_base(const Unit& u) const { const int e = __builtin_amdgcn_readfirstlane(tinfo[u.pm]) & 255; return W + (size_t)e * w_e + (size_t)u.pn * w_pn; }
    __device__ __forceinline__ unsigned a_voff(const Unit& u, int R, int C, int lda) const {
        const int ti = tinfo[u.pm], e = ti & 255, r = (ti >> 8) * 256 + R; const int n = tinfo[TI_CNT + e];
        const int ga = (r < n) ? list[(size_t)e * LIST_CAP + r] : 0;
        return (unsigned)(ga >> 1) * (unsigned)(lda * 2) + (unsigned)C * 2u; }
};

#define ACC_T const f32x4 (&acc)[2][2][4][2]
struct EpiBf16 {
    static constexpr bool PERM = true;
    bf16_t* O; size_t ldc;
    __device__ __forceinline__ void operator()(ACC_T, const Unit& u, int wr, int wc, int fr, int fq) const {
        const int row0 = u.pm * BM + wr * 64 + fr, col0 = u.pn * BM + wc * 32 + 8 * fq;
#pragma unroll
        for (int ai = 0; ai < 2; ++ai)
#pragma unroll
            for (int m = 0; m < 4; ++m) { bf16_t* rowp = O + (size_t)(row0 + ai * HALF + m * 16) * ldc + col0;
#pragma unroll
                for (int bj = 0; bj < 2; ++bj) { const f32x4 v0 = acc[ai][bj][m][0], v1 = acc[ai][bj][m][1];
                    u32x4 w; w.x = cvtpk(v0[0], v0[1]); w.y = cvtpk(v0[2], v0[3]); w.z = cvtpk(v1[0], v1[1]); w.w = cvtpk(v1[2], v1[3]);
                    *(u32x4*)(rowp + bj * HALF) = w; } }
    }
};
struct EpiF32 {
    static constexpr bool PERM = false;
    float* O; size_t ldc;
    __device__ __forceinline__ void operator()(ACC_T, const Unit& u, int wr, int wc, int fr, int fq) const {
        const int row0 = u.pm * BM + wr * 64 + fr, col0 = u.pn * BM + wc * 32 + 4 * fq;
#pragma unroll
        for (int ai = 0; ai < 2; ++ai)
#pragma unroll
            for (int m = 0; m < 4; ++m) { float* rowp = O + (size_t)(row0 + ai * HALF + m * 16) * ldc + col0;
#pragma unroll
                for (int bj = 0; bj < 2; ++bj)
#pragma unroll
                    for (int n = 0; n < 2; ++n) *(f32x4*)(rowp + bj * HALF + n * 16) = acc[ai][bj][m][n]; }
    }
};
struct EpiQ {
    static constexpr bool PERM = true;
    bf16_t* Q; const float* cs; const float* sn;
    __device__ __forceinline__ void operator()(ACC_T, const Unit& u, int wr, int wc, int fr, int fq) const {
        const int row0 = u.pm * BM + wr * 64 + fr;
        if (u.pn < 4) {
#pragma unroll
            for (int ai = 0; ai < 2; ++ai)
#pragma unroll
                for (int m = 0; m < 4; ++m) { const int row = row0 + ai * HALF + m * 16;
#pragma unroll
                    for (int bj = 0; bj < 2; ++bj) { const int col = u.pn * BM + bj * HALF + wc * 32 + 8 * fq; const f32x4 v0 = acc[ai][bj][m][0], v1 = acc[ai][bj][m][1];
                        u32x4 w; w.x = cvtpk(v0[0], v0[1]); w.y = cvtpk(v0[2], v0[3]); w.z = cvtpk(v1[0], v1[1]); w.w = cvtpk(v1[2], v1[3]);
                        *(u32x4*)(Q + (size_t)row * QPITCH + (col >> 6) * 96 + (col & 63)) = w; } }
        } else {
            const int head = (u.pn - 4) * 8 + 2 * wc + (fq >> 1), i0 = 8 * (fq & 1);
#pragma unroll
            for (int ai = 0; ai < 2; ++ai)
#pragma unroll
                for (int m = 0; m < 4; ++m) { const int row = row0 + ai * HALF + m * 16;
                    const f32x4 c0 = *(const f32x4*)(cs + (size_t)row * 16 + i0), c1 = *(const f32x4*)(cs + (size_t)row * 16 + i0 + 4);
                    const f32x4 s0 = *(const f32x4*)(sn + (size_t)row * 16 + i0), s1 = *(const f32x4*)(sn + (size_t)row * 16 + i0 + 4);
                    const f32x4 a0 = acc[ai][0][m][0], a1 = acc[ai][0][m][1], b0 = acc[ai][1][m][0], b1 = acc[ai][1][m][1];
                    const f32x4 y10 = a0 * c0 - b0 * s0, y11 = a1 * c1 - b1 * s1, y20 = b0 * c0 + a0 * s0, y21 = b1 * c1 + a1 * s1;
                    u32x4 w1, w2; w1.x = cvtpk(y10[0], y10[1]); w1.y = cvtpk(y10[2], y10[3]); w1.z = cvtpk(y11[0], y11[1]); w1.w = cvtpk(y11[2], y11[3]);
                    w2.x = cvtpk(y20[0], y20[1]); w2.y = cvtpk(y20[2], y20[3]); w2.z = cvtpk(y21[0], y21[1]); w2.w = cvtpk(y21[2], y21[3]);
                    bf16_t* qp = Q + (size_t)row * QPITCH + head * 96 + 64 + i0;
                    *(u32x4*)qp = w1; *(u32x4*)(qp + 16) = w2; asm volatile("" ::: "memory"); }
        }
    }
};
struct EpiPool {
    static constexpr bool PERM = true;
    bf16_t* F; const float* bias; const float* scale;
    __device__ __forceinline__ void operator()(ACC_T, const Unit& u, int wr, int wc, int fr, int fq) const {
        const int row0 = u.pm * BM + wr * 64 + fr, col0 = u.pn * BM + wc * 32 + 8 * fq;
#pragma unroll
        for (int bj = 0; bj < 2; ++bj) { const int c = col0 + bj * HALF;
            const f32x4 b0 = *(const f32x4*)(bias + c), b1 = *(const f32x4*)(bias + c + 4), s0 = *(const f32x4*)(scale + c), s1 = *(const f32x4*)(scale + c + 4);
#pragma unroll
            for (int ai = 0; ai < 2; ++ai)
#pragma unroll
                for (int m = 0; m < 4; ++m) { const f32x4 v0 = (acc[ai][bj][m][0] + b0) * s0, v1 = (acc[ai][bj][m][1] + b1) * s1;
                    u32x4 w; w.x = cvtpk(v0[0], v0[1]); w.y = cvtpk(v0[2], v0[3]); w.z = cvtpk(v1[0], v1[1]); w.w = cvtpk(v1[2], v1[3]);
                    *(u32x4*)(F + (size_t)(row0 + ai * HALF + m * 16) * 1024 + c) = w; } }
    }
};
struct EpiRouter {
    static constexpr bool PERM = false;
    float* LG;
    __device__ __forceinline__ void operator()(ACC_T, const Unit& u, int wr, int wc, int fr, int fq) const {
        const int row0 = u.pm * BM + wr * 64 + fr;
#pragma unroll
        for (int ai = 0; ai < 2; ++ai)
#pragma unroll
            for (int m = 0; m < 4; ++m) { float* lr = LG + ((size_t)u.pn * NTOK + (size_t)(row0 + ai * HALF + m * 16)) * LGP;
#pragma unroll
                for (int n = 0; n < 2; ++n) { const int j = wc * 32 + 16 * n + 4 * fq; if (j < 72) *(f32x4*)(lr + j) = acc[ai][0][m][n] + acc[ai][1][m][n]; } }
    }
};
struct EpiSwiglu {
    static constexpr bool PERM = true;
    bf16_t* H;
    __device__ __forceinline__ void operator()(ACC_T, const Unit& u, int wr, int wc, int fr, int fq) const {
        const int row0 = u.pm * BM + wr * 64 + fr, col0 = u.pn * HALF + wc * 32 + 8 * fq;
#pragma unroll
        for (int ai = 0; ai < 2; ++ai)
#pragma unroll
            for (int m = 0; m < 4; ++m) { float h[8];
#pragma unroll
                for (int n = 0; n < 2; ++n)
#pragma unroll
                    for (int e = 0; e < 4; ++e) { const float a = acc[ai][0][m][n][e], b = acc[ai][1][m][n][e];
                        h[n * 4 + e] = a * __builtin_amdgcn_rcpf(1.0f + __builtin_amdgcn_exp2f(-1.4426950408889634f * a)) * b; }
                u32x4 w; w.x = cvtpk(h[0], h[1]); w.y = cvtpk(h[2], h[3]); w.z = cvtpk(h[4], h[5]); w.w = cvtpk(h[6], h[7]);
                *(u32x4*)(H + (size_t)(row0 + ai * HALF + m * 16) * D_EXPERT + col0) = w; }
    }
};
struct EpiMoeOut {
    static constexpr bool PERM = true;
    bf16_t* Y; const LAS int* tinfo; const int* list; const float* lgate;
    __device__ __forceinline__ void operator()(ACC_T, const Unit& u, int wr, int wc, int fr, int fq) const {
        const int ti = tinfo[u.pm], e = ti & 255, n = tinfo[TI_CNT + e], r0 = (ti >> 8) * 256 + wr * 64 + fr, col0 = u.pn * BM + wc * 32 + 8 * fq;
#pragma unroll
        for (int ai = 0; ai < 2; ++ai)
#pragma unroll
            for (int m = 0; m < 4; ++m) { const int r = r0 + ai * HALF + m * 16;
                if (r < n) { const size_t li = (size_t)e * LIST_CAP + r; const int ga = list[li]; const float g = lgate[li]; bf16_t* yp = Y + (size_t)ga * D_MODEL + col0;
#pragma unroll
                    for (int bj = 0; bj < 2; ++bj) { const f32x4 v0 = acc[ai][bj][m][0] * g, v1 = acc[ai][bj][m][1] * g;
                        u32x4 w; w.x = cvtpk(v0[0], v0[1]); w.y = cvtpk(v0[2], v0[3]); w.z = cvtpk(v1[0], v1[1]); w.w = cvtpk(v1[2], v1[3]);
                        *(u32x4*)(yp + bj * HALF) = w; } }
                if (m & 1) asm volatile("" ::: "memory"); }
    }
};
#undef ACC_T

template <class Epi, class Sched, bool ALIGN_EPI>
__device__ __forceinline__ void gemm_phase(LAS unsigned char* lds, const Gemm g, const Sched& S, const Epi& E) {
    const int tid = opaque(threadIdx.x), wid = __builtin_amdgcn_readfirstlane(tid >> 6), lane = tid & 63, wr = wid >> 2, wc = wid & 3, fr = lane & 15, fq = lane >> 4;
    const int K = opaque_s(g.K), nt = K / BK;
    unsigned voffB[2]; int Rr[2], Cc[2];
#pragma unroll
    for (int i = 0; i < 2; ++i) { int R, C; stage_rc(tid * 16 + i * 8192, R, C); const int Rb = Epi::PERM ? ((R & ~31) + perm32(R & 31)) : R;
        Rr[i] = R; Cc[i] = C; voffB[i] = (unsigned)(Rb * g.ldb + C) * 2u; }
    const size_t kstep = (size_t)(BK * 2);
    const size_t hstepB = (size_t)HALF * g.ldb * 2;
    const unsigned ldsw = (unsigned)wid * 1024u;
    const int aoff = lds_byte(wr * 64 + fr, fq * 8), boff = lds_byte(wc * 32 + fr, fq * 8);
#define PG8_SA(b, h) (((b) * 2 + (h)) * HTB)
#define PG8_SB(b, h) ((4 + (b) * 2 + (h)) * HTB)
#define PG8_STAGE(bufoff, gbase, voff) do { _Pragma("unroll") for (int _i = 0; _i < 2; ++_i) \
        __builtin_amdgcn_global_load_lds((const unsigned*)((const char*)(gbase) + (voff)[_i]), (LAS unsigned*)(lds + (bufoff) + ldsw + _i * 8192), 16, 0, 0); } while (0)
#define PG8_LDA(dst, b, h) do { _Pragma("unroll") for (int m = 0; m < 4; ++m) _Pragma("unroll") for (int k = 0; k < 2; ++k) dst[m][k] = *(const LAS bf16x8*)(lds + PG8_SA(b, h) + aoff + m * 2048 + k * 1024); } while (0)
#define PG8_LDB(dst, b, h) do { _Pragma("unroll") for (int n = 0; n < 2; ++n) _Pragma("unroll") for (int k = 0; k < 2; ++k) dst[n][k] = *(const LAS bf16x8*)(lds + PG8_SB(b, h) + boff + n * 2048 + k * 1024); } while (0)
#define PG8_MMA(ai, bj, At, Bt) do { __builtin_amdgcn_s_setprio(1); _Pragma("unroll") for (int m = 0; m < 4; ++m) _Pragma("unroll") for (int n = 0; n < 2; ++n) _Pragma("unroll") for (int k = 0; k < 2; ++k) \
        acc[ai][bj][m][n] = __builtin_amdgcn_mfma_f32_16x16x32_bf16(Bt[n][k], At[m][k], acc[ai][bj][m][n], 0, 0, 0); __builtin_amdgcn_s_setprio(0); } while (0)
#define PG8_WAIT_V(n) asm volatile("s_waitcnt vmcnt(" #n ")" ::: "memory")
#define PG8_WAIT_L(n) asm volatile("s_waitcnt lgkmcnt(" #n ")" ::: "memory")
#define PG8_BAR __builtin_amdgcn_s_barrier()
#define PG8_SCHED __builtin_amdgcn_sched_barrier(0)
    Unit cur, nxt; int ui = 0;
    if (!S.next(0, cur)) return;
    f32x4 acc[2][2][4][2];
#pragma unroll
    for (int a = 0; a < 2; ++a)
#pragma unroll
        for (int b = 0; b < 2; ++b)
#pragma unroll
            for (int m = 0; m < 4; ++m)
#pragma unroll
                for (int n = 0; n < 2; ++n) acc[a][b][m][n] = (f32x4){0.f, 0.f, 0.f, 0.f};
    bf16x8 At[4][2], B0[2][2], B1[2][2];
    const char* cA = S.a_base(cur); const char* cB = S.b_base(cur);
    unsigned vA[2][2], vN[2][2];
#pragma unroll
    for (int h = 0; h < 2; ++h)
#pragma unroll
        for (int i = 0; i < 2; ++i) { vA[h][i] = S.a_voff(cur, Rr[i] + h * HALF, Cc[i], g.lda); vN[h][i] = vA[h][i]; }
    PG8_STAGE(PG8_SB(0, 0), cB, voffB); PG8_STAGE(PG8_SB(0, 1), cB + hstepB, voffB); PG8_STAGE(PG8_SA(0, 0), cA, vA[0]); PG8_STAGE(PG8_SA(0, 1), cA, vA[1]);
    if (wr == 1) PG8_BAR;
    PG8_WAIT_V(2); PG8_BAR;
    PG8_STAGE(PG8_SB(1, 0), cB + kstep, voffB); PG8_STAGE(PG8_SA(1, 0), cA + kstep, vA[0]); PG8_STAGE(PG8_SB(1, 1), cB + hstepB + kstep, voffB);
    PG8_WAIT_V(6); PG8_BAR;
    for (;;) {
        const bool has_next = S.next(ui + 1, nxt);
        const char* nA = has_next ? S.a_base(nxt) : cA; const char* nB = has_next ? S.b_base(nxt) : cB;
        if (has_next) {
#pragma unroll
            for (int h = 0; h < 2; ++h)
#pragma unroll
                for (int i = 0; i < 2; ++i) vN[h][i] = S.a_voff(nxt, Rr[i] + h * HALF, Cc[i], g.lda);
        }
#pragma nounroll
        for (int t = 0; t < nt; t += 2) {
            const bool last = (t == nt - 2);
            const char* a1 = cA + (size_t)(t + 1) * kstep;
            const char* a2 = last ? nA : cA + (size_t)(t + 2) * kstep; const char* b2 = last ? nB : cB + (size_t)(t + 2) * kstep;
            const char* a3 = a2 + kstep; const char* b3 = b2 + kstep;
            unsigned w0[2], w1[2];
#pragma unroll
            for (int i = 0; i < 2; ++i) { w0[i] = last ? vN[0][i] : vA[0][i]; w1[i] = last ? vN[1][i] : vA[1][i]; }
            PG8_LDB(B0, 0, 0); PG8_LDB(B1, 0, 1); PG8_SCHED; PG8_LDA(At, 0, 0); PG8_STAGE(PG8_SA(1, 1), a1, vA[1]);
            PG8_WAIT_V(8); PG8_WAIT_L(0); PG8_BAR; PG8_MMA(0, 0, At, B0); PG8_MMA(0, 1, At, B1); PG8_BAR; PG8_SCHED;
            PG8_LDA(At, 0, 1); PG8_STAGE(PG8_SB(0, 0), b2, voffB); PG8_STAGE(PG8_SB(0, 1), b2 + hstepB, voffB); PG8_STAGE(PG8_SA(0, 0), a2, w0);
            PG8_WAIT_V(8); PG8_WAIT_L(0); PG8_BAR; PG8_MMA(1, 0, At, B0); PG8_MMA(1, 1, At, B1); PG8_BAR; PG8_SCHED;
            PG8_LDB(B0, 1, 0); PG8_LDB(B1, 1, 1); PG8_SCHED; PG8_LDA(At, 1, 0); PG8_STAGE(PG8_SA(0, 1), a2, w1);
            PG8_WAIT_V(8); PG8_WAIT_L(0); PG8_BAR; PG8_MMA(0, 0, At, B0); PG8_MMA(0, 1, At, B1); PG8_BAR; PG8_SCHED;
            PG8_LDA(At, 1, 1); PG8_STAGE(PG8_SB(1, 0), b3, voffB); PG8_STAGE(PG8_SB(1, 1), b3 + hstepB, voffB); PG8_STAGE(PG8_SA(1, 0), a3, w0);
            PG8_WAIT_V(8); PG8_WAIT_L(0); PG8_BAR; PG8_MMA(1, 0, At, B0); PG8_MMA(1, 1, At, B1); PG8_BAR; PG8_SCHED;
        }
        if constexpr (ALIGN_EPI) { if (wr == 0) PG8_BAR; }
        E(acc, cur, wr, wc, fr, fq);
        if (!has_next) break;
#pragma unroll
        for (int a = 0; a < 2; ++a)
#pragma unroll
            for (int b = 0; b < 2; ++b)
#pragma unroll
                for (int m = 0; m < 4; ++m)
#pragma unroll
                    for (int n = 0; n < 2; ++n) acc[a][b][m][n] = (f32x4){0.f, 0.f, 0.f, 0.f};
        cur = nxt; cA = nA; cB = nB; ++ui;
#pragma unroll
        for (int h = 0; h < 2; ++h)
#pragma unroll
            for (int i = 0; i < 2; ++i) vA[h][i] = vN[h][i];
        if constexpr (ALIGN_EPI) { if (wr == 1) PG8_BAR; }
    }
    PG8_WAIT_V(0);
    if constexpr (!ALIGN_EPI) { if (wr == 0) PG8_BAR; }
    PG8_BAR;
#undef PG8_SA
#undef PG8_SB
#undef PG8_STAGE
#undef PG8_LDA
#undef PG8_LDB
#undef PG8_MMA
#undef PG8_WAIT_V
#undef PG8_WAIT_L
#undef PG8_BAR
#undef PG8_SCHED
}
}

namespace att {
constexpr int KSLOT = 12288, VSLOT = 8192, LDS_K = 0, LDS_V = 3 * KSLOT, LDS_BYTES = LDS_V + 3 * VSLOT;
constexpr float THR = 6.0f;
__device__ __forceinline__ void attn_unit(int b, int h, int qb, const bf16_t* __restrict__ Q, const bf16_t* __restrict__ KN, const bf16_t* __restrict__ KR, const bf16_t* __restrict__ VT, bf16_t* __restrict__ O, LAS unsigned char* lds) {
    const int tid = opaque(threadIdx.x), lane = tid & 63, r32 = lane & 31, hi = lane >> 5;
    const int w = __builtin_amdgcn_readfirstlane(tid >> 6);
    const size_t tok0 = (size_t)b * SEQ;
    const int q0 = qb * 256, NT = 4 * (qb + 1);
    const bf16_t* ksrc = KN + (tok0 + lane) * 1024 + h * 64 + 8 * w;
    const bf16_t* rsrc = KR + (tok0 + lane) * 32 + 8 * (w & 3);
    const bf16_t* vsrc = VT + (size_t)(h * 64 + lane) * NTOK + tok0 + 8 * w;
#define ATT_ISSUE(t, slot) do { \
        __builtin_amdgcn_global_load_lds((const unsigned*)(ksrc + (size_t)(t) * 65536), (LAS unsigned*)(lds + LDS_K + (slot) * KSLOT + w * 1024), 16, 0, 0); \
        if (w < 4) __builtin_amdgcn_global_load_lds((const unsigned*)(rsrc + (size_t)(t) * 2048), (LAS unsigned*)(lds + LDS_K + (slot) * KSLOT + (8 + w) * 1024), 16, 0, 0); \
        __builtin_amdgcn_global_load_lds((const unsigned*)(vsrc + (size_t)(t) * 64), (LAS unsigned*)(lds + LDS_V + (slot) * VSLOT + w * 1024), 16, 0, 0); } while (0)
    ATT_ISSUE(0, 0); ATT_ISSUE(1, 1);
    bf16x8 qr[6];
    { const bf16_t* qp = Q + (tok0 + q0 + w * 32 + r32) * QPITCH + h * 96 + hi * 8;
#pragma unroll
      for (int d0 = 0; d0 < 6; ++d0) qr[d0] = *(const bf16x8*)(qp + d0 * 16); }
    const int kvp = (r32 & 19) | ((r32 & 4) << 1) | ((r32 & 8) >> 1);
    const int kfoff = hi * 1024 + kvp * 16, vfoff = hi * 1024 + r32 * 16;
    float mhat = 0.f, lsum = 0.f;
    f32x16 o0 = {}, o1 = {}, negm = {};
    const int qrel = w * 32 + r32;
    int slot = 0;
    for (int t = 0; t < NT; ++t) {
        if (t == 0 || t + 1 >= NT) asm volatile("s_waitcnt vmcnt(0)" ::: "memory");
        else if (w < 4) asm volatile("s_waitcnt vmcnt(3)" ::: "memory");
        else asm volatile("s_waitcnt vmcnt(2)" ::: "memory");
        __builtin_amdgcn_s_barrier();
        asm volatile("" ::: "memory");
        if (t + 2 < NT) { const int s2 = (slot == 0) ? 2 : slot - 1; ATT_ISSUE(t + 2, s2); }
        const int jb = t - (NT - 4);
        const bool active = (jb < 0) || (jb <= (w >> 1));
        if (active) {
            const LAS unsigned char* kb = lds + LDS_K + slot * KSLOT + kfoff;
            const LAS unsigned char* vb = lds + LDS_V + slot * VSLOT + vfoff;
            f32x16 p0 = negm, p1 = negm;
#pragma unroll
            for (int d0 = 0; d0 < 6; ++d0) {
                const bf16x8 k0 = *(const LAS bf16x8*)(kb + d0 * 2048), k1 = *(const LAS bf16x8*)(kb + d0 * 2048 + 512);
                p0 = __builtin_amdgcn_mfma_f32_32x32x16_bf16(k0, qr[d0], p0, 0, 0, 0);
                p1 = __builtin_amdgcn_mfma_f32_32x32x16_bf16(k1, qr[d0], p1, 0, 0, 0);
            }
            if (jb >= 0) {
                const int kb0 = 64 * jb + 8 * hi;
#pragma unroll
                for (int r = 0; r < 16; ++r) { const int key = kb0 + (r & 3) + 4 * ((r >> 2) & 1) + 16 * (r >> 3);
                    if (key > qrel) p0[r] = -INFINITY; if (key + 32 > qrel) p1[r] = -INFINITY; }
            }
            float rm = fmaxf(p0[0], p1[0]);
#pragma unroll
            for (int r = 1; r < 16; ++r) rm = fmaxf(rm, fmaxf(p0[r], p1[r]));
            { auto rr = __builtin_amdgcn_permlane32_swap(__float_as_uint(rm), __float_as_uint(rm), false, false); rm = fmaxf(__uint_as_float(rr[0]), __uint_as_float(rr[1])); }
            if (t == 0) {
                mhat = rm;
#pragma unroll
                for (int r = 0; r < 16; ++r) { p0[r] -= rm; p1[r] -= rm; negm[r] = -mhat; }
            } else if (__any(rm > THR)) {
                const float dl = fmaxf(rm, 0.f); mhat += dl;
                const float f = __builtin_amdgcn_exp2f(-dl); lsum *= f;
#pragma unroll
                for (int r = 0; r < 16; ++r) { p0[r] -= dl; p1[r] -= dl; o0[r] *= f; o1[r] *= f; negm[r] = -mhat; }
            }
            float sacc = 0.f;
#pragma unroll
            for (int r = 0; r < 16; ++r) { p0[r] = __builtin_amdgcn_exp2f(p0[r]); p1[r] = __builtin_amdgcn_exp2f(p1[r]); sacc += p0[r] + p1[r]; }
            lsum += sacc;
            u32x4 pw[4];
#pragma unroll
            for (int i = 0; i < 2; ++i) {
                pw[i] = (u32x4){cvtpk(p0[8 * i], p0[8 * i + 1]), cvtpk(p0[8 * i + 2], p0[8 * i + 3]), cvtpk(p0[8 * i + 4], p0[8 * i + 5]), cvtpk(p0[8 * i + 6], p0[8 * i + 7])};
                pw[2 + i] = (u32x4){cvtpk(p1[8 * i], p1[8 * i + 1]), cvtpk(p1[8 * i + 2], p1[8 * i + 3]), cvtpk(p1[8 * i + 4], p1[8 * i + 5]), cvtpk(p1[8 * i + 6], p1[8 * i + 7])};
            }
#pragma unroll
            for (int kc2 = 0; kc2 < 4; ++kc2) {
                const bf16x8 v0 = *(const LAS bf16x8*)(vb + kc2 * 2048), v1 = *(const LAS bf16x8*)(vb + kc2 * 2048 + 512);
                const bf16x8 pf = __builtin_bit_cast(bf16x8, pw[kc2]);
                o0 = __builtin_amdgcn_mfma_f32_32x32x16_bf16(v0, pf, o0, 0, 0, 0);
                o1 = __builtin_amdgcn_mfma_f32_32x32x16_bf16(v1, pf, o1, 0, 0, 0);
            }
        }
        slot = (slot == 2) ? 0 : slot + 1;
    }
    { auto rr = __builtin_amdgcn_permlane32_swap(__float_as_uint(lsum), __float_as_uint(lsum), false, false); lsum = __uint_as_float(rr[0]) + __uint_as_float(rr[1]); }
    const float inv = 1.0f / lsum;
    bf16_t* op = O + (tok0 + q0 + w * 32 + r32) * 1024 + h * 64 + 4 * hi;
#pragma unroll
    for (int g = 0; g < 4; ++g) {
        u32x2 a, c; a.x = cvtpk(o0[4 * g] * inv, o0[4 * g + 1] * inv); a.y = cvtpk(o0[4 * g + 2] * inv, o0[4 * g + 3] * inv);
        c.x = cvtpk(o1[4 * g] * inv, o1[4 * g + 1] * inv); c.y = cvtpk(o1[4 * g + 2] * inv, o1[4 * g + 3] * inv);
        *(u32x2*)(op + 8 * g) = a; *(u32x2*)(op + 32 + 8 * g) = c;
    }
    asm volatile("s_waitcnt lgkmcnt(0)" ::: "memory");
    __builtin_amdgcn_s_barrier();
#undef ATT_ISSUE
}
}

#define XB_TMO      128
#define XB_XCNT(j)  (256  + 64 * (j))
#define XB_XSUB(j)  (1280 + 64 * (j))
#define XB_XGEN(j)  (2304 + 64 * (j))
#define XB_TOP      3328
#define XB_TOPGEN   3392
#define XCD_BAR_WORDS 3456
#define XB_SPIN_CAP (1u << 18)
__device__ __forceinline__ unsigned xb_ld(unsigned* p)              { return __hip_atomic_load(p, __ATOMIC_RELAXED, __HIP_MEMORY_SCOPE_AGENT); }
__device__ __forceinline__ unsigned xb_add(unsigned* p, unsigned v) { return __hip_atomic_fetch_add(p, v, __ATOMIC_RELAXED, __HIP_MEMORY_SCOPE_AGENT); }
__device__ __forceinline__ unsigned xb_xcc_id() { return (unsigned)__builtin_amdgcn_s_getreg((3 << 11) | 20) & 0xFu; }
#define XB_SPIN(cond, bar) do { unsigned _sp = 0; while (cond) { __builtin_amdgcn_s_sleep(1); \
    if ((++_sp & 255u) == 0u) { if (xb_ld(&(bar)[XB_TMO])) break; if (_sp > XB_SPIN_CAP) { atomicAdd(&(bar)[XB_TMO], 1u); break; } } } } while (0)
struct XcdBarrier { unsigned* bar; unsigned x; volatile LAS unsigned* st; };
__device__ __forceinline__ XcdBarrier xcd_barrier_post(unsigned* bar, volatile LAS unsigned* st) {
    XcdBarrier b; b.bar = bar; b.x = xb_xcc_id(); b.st = st;
    if (threadIdx.x == 0) (void)xb_add(&bar[XB_XCNT(b.x)], 1u);
    return b;
}
__device__ __forceinline__ void xcd_barrier_complete(unsigned* bar, unsigned x, unsigned& nloc, unsigned& nx) {
    const unsigned G = gridDim.x * gridDim.y * gridDim.z;
    unsigned sum, cnt, mine, sp = 0u;
    for (;;) {
        sum = 0u; cnt = 0u; mine = 0u;
#pragma unroll
        for (unsigned j = 0; j < 16; ++j) { const unsigned c = xb_ld(&bar[XB_XCNT(j)]); sum += c; cnt += (c > 0u) ? 1u : 0u; mine = (j == x) ? c : mine; }
        if (sum == G) break;
        __builtin_amdgcn_s_sleep(1);
        if ((++sp & 255u) == 0u) { if (xb_ld(&bar[XB_TMO])) break; if (sp > XB_SPIN_CAP) { atomicAdd(&bar[XB_TMO], 1u); break; } }
    }
    nloc = mine > 0u ? mine : 1u; nx = cnt > 0u ? cnt : 1u;
}
__device__ __forceinline__ void xcd_barrier(const XcdBarrier& b) {
    asm volatile("s_waitcnt vmcnt(0)" ::: "memory");
    __syncthreads();
    if (threadIdx.x == 0) {
        unsigned* bar = b.bar;
        __builtin_amdgcn_s_waitcnt(0);
        unsigned nloc = b.st[0], nx = b.st[1];
        if (nloc == 0u) { xcd_barrier_complete(bar, b.x, nloc, nx); b.st[0] = nloc; b.st[1] = nx; }
        const unsigned old = xb_add(&bar[XB_XSUB(b.x)], 1u);
        const unsigned gen = old / nloc;
        if (old + 1u == (gen + 1u) * nloc) {
            __builtin_amdgcn_fence(__ATOMIC_RELEASE, "agent");
            asm volatile("s_waitcnt vmcnt(0)" ::: "memory");
            const unsigned og = xb_add(&bar[XB_TOP], 1u);
            const unsigned tg = og / nx;
            if (og + 1u == (tg + 1u) * nx) xb_add(&bar[XB_TOPGEN], 1u);
            else XB_SPIN(xb_ld(&bar[XB_TOPGEN]) == tg, bar);
            __builtin_amdgcn_fence(__ATOMIC_ACQUIRE, "agent");
            xb_add(&bar[XB_XGEN(b.x)], 1u);
            asm volatile("s_waitcnt vmcnt(0)" ::: "memory");
        } else {
            XB_SPIN(xb_ld(&bar[XB_XGEN(b.x)]) == gen, bar);
            __builtin_amdgcn_fence(__ATOMIC_ACQUIRE, "agent");
            asm volatile("s_waitcnt vmcnt(0)" ::: "memory");
        }
    }
    __syncthreads();
}

struct Args { const void* in[20]; float* out; unsigned char* ws; int ph_lo, ph_hi; };
typedef const __attribute__((address_space(4))) Args* KArgs;
__device__ __forceinline__ KArgs kargs() { KArgs p = (KArgs)__builtin_amdgcn_kernarg_segment_ptr(); asm volatile("" : "+s"(p)); return p; }
constexpr int NWAVES = 8;
constexpr int PPL = 12;
constexpr int NPHASE = 1 + DEPTH * PPL;

__constant__ double c_invf[16] = {1.0, 0.5623413251903491, 0.31622776601683794, 0.1778279410038923, 0.1, 0.05623413251903491, 0.03162277660168379, 0.01778279410038923,
                                  0.01, 0.005623413251903491, 0.0031622776601683794, 0.0017782794100389228, 0.001, 0.0005623413251903491, 0.00031622776601683794, 0.00017782794100389227};

__device__ __forceinline__ void transpose_item(const float* __restrict__ W, int ldw, int k0, int n0, bf16_t* __restrict__ WT, int ldt, int drow0, float mul, LAS float* scr, int lane) {
#pragma unroll 8
    for (int i = 0; i < 32; ++i) { const int kk = 2 * i + (lane >> 5); scr[kk * 33 + (lane & 31)] = W[(size_t)(k0 + kk) * ldw + n0 + (lane & 31)]; }
    LDS_WAIT(); asm volatile("" ::: "memory");
    const int c = lane & 7;
#pragma unroll
    for (int j = 0; j < 4; ++j) { const int n = (lane >> 3) + 8 * j; const LAS float* s = scr + (8 * c) * 33 + n;
        u32x4 o; o.x = cvtpk(s[0 * 33] * mul, s[1 * 33] * mul); o.y = cvtpk(s[2 * 33] * mul, s[3 * 33] * mul); o.z = cvtpk(s[4 * 33] * mul, s[5 * 33] * mul); o.w = cvtpk(s[6 * 33] * mul, s[7 * 33] * mul);
        *(u32x4*)(WT + (size_t)(drow0 + n) * ldt + k0 + 8 * c) = o; }
    LDS_WAIT(); asm volatile("" ::: "memory");
}

__device__ __forceinline__ void transpose_item64(const float* __restrict__ W, int ldw, int k0, int n0, bf16_t* __restrict__ WT, int ldt, int drow0, LAS float* scr, int lane) {
    f32x4 v[16];
    const float* src = W + (size_t)(k0 + (lane >> 4)) * ldw + n0 + 4 * (lane & 15);
#pragma unroll
    for (int i = 0; i < 16; ++i) v[i] = *(const f32x4*)(src + (size_t)(4 * i) * ldw);
#pragma unroll
    for (int i = 0; i < 16; ++i) *(LAS f32x4*)(scr + (4 * i + (lane >> 4)) * 68 + 4 * (lane & 15)) = v[i];
    LDS_WAIT(); asm volatile("" ::: "memory");
    bf16_t* dst = WT + (size_t)(drow0 + lane) * ldt + k0;
#pragma unroll
    for (int c = 0; c < 8; ++c) { const LAS float* sp = scr + (8 * c) * 68 + lane;
        u32x4 o; o.x = cvtpk(sp[0], sp[68]); o.y = cvtpk(sp[2 * 68], sp[3 * 68]); o.z = cvtpk(sp[4 * 68], sp[5 * 68]); o.w = cvtpk(sp[6 * 68], sp[7 * 68]);
        *(u32x4*)(dst + 8 * c) = o; }
    LDS_WAIT(); asm volatile("" ::: "memory");
}

__device__ __forceinline__ void sincos_d(double a, float& s, float& c) {
    const double TWO_PI_HI = 6.283185307179586, TWO_PI_LO = 2.4492935982947064e-16, INV_2PI = 0.15915494309189535;
    const double n = __builtin_rint(a * INV_2PI);
    double r = __builtin_fma(-n, TWO_PI_HI, a); r = __builtin_fma(-n, TWO_PI_LO, r);
    const double HALF_PI = 1.5707963267948966, HALF_PI_LO = 6.123233995736766e-17;
    const double qd = __builtin_rint(r * 0.6366197723675814);
    double y = __builtin_fma(-qd, HALF_PI, r); y = __builtin_fma(-qd, HALF_PI_LO, y);
    const int q = ((int)qd) & 3;
    const double y2 = y * y;
    double sp = -7.647163731819816e-13; sp = sp * y2 + 1.6059043836821613e-10; sp = sp * y2 - 2.505210838544172e-08; sp = sp * y2 + 2.7557319223985893e-06; sp = sp * y2 - 0.0001984126984126984;
    sp = sp * y2 + 0.008333333333333333; sp = sp * y2 - 0.16666666666666666; sp = y + y * y2 * sp;
    double cp = 4.779477332387385e-14; cp = cp * y2 - 1.1470745597729725e-11; cp = cp * y2 + 2.08767569878681e-09; cp = cp * y2 - 2.755731922398589e-07; cp = cp * y2 + 2.48015873015873e-05;
    cp = cp * y2 - 0.001388888888888889; cp = cp * y2 + 0.041666666666666664; cp = cp * y2 - 0.5; cp = 1.0 + y2 * cp;
    double ss, cc;
    if (q == 0) { ss = sp; cc = cp; } else if (q == 1) { ss = cp; cc = -sp; } else if (q == 2) { ss = -sp; cc = -cp; } else { ss = -cp; cc = sp; }
    s = (float)ss; c = (float)cc;
}

__global__ void __launch_bounds__(NWAVES * 64, 2) mk_fwd(Args args_unused) {
    extern __shared__ __attribute__((aligned(16))) unsigned char lds_raw[];
    LAS unsigned char* lds = (LAS unsigned char*)lds_raw;
    volatile LAS unsigned* MISC = (volatile LAS unsigned*)(lds + MISC_OFF);
    int tid = threadIdx.x, lane = tid & 63, wave = __builtin_amdgcn_readfirstlane(tid >> 6);
    const int G = gridDim.x, bx = blockIdx.x;
    const int vcu = (G % 8 == 0) ? (bx % 8) * (G / 8) + bx / 8 : bx;
    int gw = vcu * NWAVES + wave; const int NGW = G * NWAVES;
#define ws (kargs()->ws)
    unsigned* ctl = (unsigned*)(ws + WS_CTL);
    for (int u = tid; u < (LDS_BYTES - LDSCTL_OFF) / 4; u += NWAVES * 64) ((LAS unsigned*)(lds + LDSCTL_OFF))[u] = 0u;
    __syncthreads();
    XcdBarrier bar; bar.bar = ctl + CW_BAR; bar.x = 0; bar.st = nullptr;
#if MK_ONE_LAUNCH
    bar = xcd_barrier_post(ctl + CW_BAR, MISC + 8);
#endif
    const int lo = kargs()->ph_lo, hi = kargs()->ph_hi;
#ifndef MK_REP_MASK
#define MK_REP_MASK 0u
#endif
#define NREP(b) (1 + (int)((MK_REP_MASK >> (b)) & 1u))
#ifndef MK_PH_MASK
#define MK_PH_MASK 0xffffffffu
#endif
#define PHON(b) ((MK_PH_MASK >> (b)) & 1u)
#define IN(k) (lo <= (k) && (k) < hi)
#if MK_ONE_LAUNCH
#define SEAM(k) do { if ((k) + 1 < hi) xcd_barrier(bar); } while (0)
#else
#define SEAM(k) do { } while (0)
#endif
#define in_x ((const float*)kargs()->in[0])
#define in_pos ((const int*)kargs()->in[1])
#define ln_g ((const float*)kargs()->in[2])
#define ln_b ((const float*)kargs()->in[3])
#define w_in ((const float*)kargs()->in[4])
#define q_norm ((const float*)kargs()->in[5])
#define w_uq ((const float*)kargs()->in[6])
#define kv_norm ((const float*)kargs()->in[7])
#define w_ukv ((const float*)kargs()->in[8])
#define w_o ((const float*)kargs()->in[9])
#define pool_w ((const float*)kargs()->in[10])
#define pool_b ((const float*)kargs()->in[11])
#define pool_scale ((const float*)kargs()->in[12])
#define w_grp ((const float*)kargs()->in[13])
#define b_grp ((const float*)kargs()->in[14])
#define w_exp ((const float*)kargs()->in[15])
#define b_exp ((const float*)kargs()->in[16])
#define w1 ((const float*)kargs()->in[17])
#define w3 ((const float*)kargs()->in[18])
#define w2 ((const float*)kargs()->in[19])
#define COS ((float*)(ws + WS_COS))
#define SIN ((float*)(ws + WS_SIN))
#define CNT ((int*)(ws + WS_CNT))
#define TILE ((int*)(ws + WS_TILE))
#define AE ((int*)(ws + WS_AE))
#define APOS ((int*)(ws + WS_APOS))
#define AG ((float*)(ws + WS_AG))
#define RSLOT ((int*)(ws + WS_RSLOT))
#define RGATE ((float*)(ws + WS_RGATE))
#define WIN ((bf16_t*)(ws + WS_WIN))
#define WUQ ((bf16_t*)(ws + WS_WUQ))
#define WUK ((bf16_t*)(ws + WS_WUK))
#define WUV ((bf16_t*)(ws + WS_WUV))
#define WO ((bf16_t*)(ws + WS_WO))
#define WP ((bf16_t*)(ws + WS_WP))
#define WR ((bf16_t*)(ws + WS_WR))
#define W13 ((bf16_t*)(ws + WS_W13))
#define W2T ((bf16_t*)(ws + WS_W2T))
#define FB ((bf16_t*)(ws + WS_FB))
#define XHL ((bf16_t*)(ws + WS_XHL))
#define LATB ((float*)(ws + WS_LAT))
#define CQ ((bf16_t*)(ws + WS_CQ))
#define CKV ((bf16_t*)(ws + WS_CKV))
#define KR ((bf16_t*)(ws + WS_KR))
#define QB ((bf16_t*)(ws + WS_Q))
#define KN ((bf16_t*)(ws + WS_KN))
#define VT ((bf16_t*)(ws + WS_VT))
#define OB ((bf16_t*)(ws + WS_O))
#define POOLED ((bf16_t*)(ws + WS_POOLED))
#define LG ((float*)(ws + WS_LG))
#define ROWLIST ((int*)(ws + WS_LIST))
#define LGATE ((float*)(ws + WS_LGATE))
#define HS ((bf16_t*)(ws + WS_HS))
#define YB ((bf16_t*)(ws + WS_Y))
    LAS float* scr = (LAS float*)(lds + RING_OFF + wave * SCR_WAVE);

    if (PHON(12) && IN(0)) {
        for (int m = gw; m < NTOK; m += NGW) {
            const f32x4* xr = (const f32x4*)(in_x + (size_t)m * D_MODEL) + lane; u32x2* oh = (u32x2*)(XHL + (size_t)m * 2048) + lane;
#pragma unroll
            for (int j = 0; j < 4; ++j) { u32x2 h, l; split4(xr[64 * j], h, l); oh[64 * j] = h; oh[256 + 64 * j] = l; }
        }
        for (int idx = gw * 64 + lane; idx < NTOK * 16; idx += NGW * 64) { float s, c; sincos_d((double)in_pos[idx >> 4] * c_invf[idx & 15], s, c); COS[idx] = c; SIN[idx] = s; }
        for (int idx = gw * 64 + lane; idx < DEPTH * 2 * 256 * 1024; idx += NGW * 64) {
            const int l = idx >> 19, ks = (idx >> 18) & 1, row = (idx >> 10) & 255, k = idx & 1023;
            const int j = row < 72 ? row : ((row >= 128 && row < 200) ? row - 128 : -1);
            float v = 0.f;
            if (j >= 0 && !(ks == 1 && row >= 128)) { const float wv = (j < 8) ? w_grp[((size_t)l * 1024 + k) * 8 + j] : w_exp[((size_t)l * 1024 + k) * 64 + (j - 8)];
                const float whi = bflo(cvtpk(wv, 0.f)); v = (row < 72) ? whi : (wv - whi); }
            WR[idx] = (bf16_t)(cvtpk(v, 0.f) & 0xffffu);
        }
        for (int idx = gw * 64 + lane; idx < 2 * 96 * 1024 / 8; idx += NGW * 64) { const int j = idx / (96 * 128), r = idx % (96 * 128); *(u32x4*)(WIN + ((size_t)j * 512 + 416) * 1024 + (size_t)r * 8) = (u32x4){0u, 0u, 0u, 0u}; }
        constexpr int I_IN = 16 * 13, I_UQ = 4 * 48, I_UKV = 2 * 64, I_O = 16 * 32, I_P = 4 * 8;
        constexpr int NIT = 2 * (I_IN + I_UQ + I_UKV + I_O) + 8 * I_P;
        for (int it = gw; it < NIT; it += NGW) {
            int r = it;
            if (r < 2 * I_IN) { const int j = r / I_IN, q = r % I_IN, kb = q / 13, nb = q % 13;
                transpose_item(w_in + (size_t)j * 1024 * LAT, LAT, 64 * kb, 32 * nb, WIN + (size_t)j * 512 * 1024, 1024, 32 * nb, 1.f, scr, lane); continue; } r -= 2 * I_IN;
            if (r < 2 * I_UQ) { const int j = r / I_UQ, q = r % I_UQ, kb = q / 48, nb = q % 48; const int n0 = 32 * nb, head = n0 / 96, r0 = n0 % 96;
                if (r0 < 64) transpose_item(w_uq + (size_t)j * 256 * QPITCH, QPITCH, 64 * kb, n0, WUQ + (size_t)j * 1536 * 256, 256, head * 64 + r0, QSCALE, scr, lane);
                else {
                    const float* W = w_uq + (size_t)j * 256 * QPITCH; bf16_t* WT = WUQ + (size_t)j * 1536 * 256; const int k0 = 64 * kb;
#pragma unroll 8
                    for (int i = 0; i < 32; ++i) { const int kk = 2 * i + (lane >> 5); scr[kk * 33 + (lane & 31)] = W[(size_t)(k0 + kk) * QPITCH + n0 + (lane & 31)]; }
                    LDS_WAIT(); asm volatile("" ::: "memory");
                    const int c = lane & 7;
#pragma unroll
                    for (int jj = 0; jj < 4; ++jj) { const int n = (lane >> 3) + 8 * jj; const LAS float* s = scr + (8 * c) * 33 + n;
                        const int drow = 1024 + (head >> 3) * 256 + (head & 7) * 16 + (n < 16 ? n : 128 + n - 16);
                        u32x4 o; o.x = cvtpk(s[0 * 33] * QSCALE, s[1 * 33] * QSCALE); o.y = cvtpk(s[2 * 33] * QSCALE, s[3 * 33] * QSCALE); o.z = cvtpk(s[4 * 33] * QSCALE, s[5 * 33] * QSCALE); o.w = cvtpk(s[6 * 33] * QSCALE, s[7 * 33] * QSCALE);
                        *(u32x4*)(WT + (size_t)drow * 256 + k0 + 8 * c) = o; }
                    LDS_WAIT(); asm volatile("" ::: "memory");
                }
                continue; } r -= 2 * I_UQ;
            if (r < 2 * I_UKV) { const int j = r / I_UKV, q = r % I_UKV, kb = q / 64, nb = q % 64; const int n0 = 32 * nb, head = n0 >> 7, r0 = n0 & 127;
                if (r0 < 64) transpose_item(w_ukv + (size_t)j * 128 * 2048, 2048, 64 * kb, n0, WUK + (size_t)j * 1024 * 128, 128, head * 64 + r0, 1.f, scr, lane);
                else transpose_item(w_ukv + (size_t)j * 128 * 2048, 2048, 64 * kb, n0, WUV + (size_t)j * 1024 * 128, 128, head * 64 + r0 - 64, 1.f, scr, lane);
                continue; } r -= 2 * I_UKV;
            if (r < 2 * I_O) { const int j = r / I_O, q = r % I_O, kb = q / 32, nb = q % 32;
                transpose_item(w_o + (size_t)j * 1024 * 1024, 1024, 64 * kb, 32 * nb, WO + (size_t)j * 1024 * 1024, 1024, 32 * nb, 1.f, scr, lane); continue; } r -= 2 * I_O;
            { const int jg = r / I_P, q = r % I_P, kb = q / 8, nb = q % 8;
                transpose_item(pool_w + (size_t)jg * 65536, 256, 64 * kb, 32 * nb, WP + (size_t)jg * 65536, 256, 32 * nb, 1.f, scr, lane); }
        }
        SEAM(0);
    }

    for (int l = 0; l < DEPTH; ++l) {
        const int pb = 1 + PPL * l, j = l >> 1;
        tid = opaque(threadIdx.x); lane = tid & 63; wave = __builtin_amdgcn_readfirstlane(tid >> 6); gw = vcu * NWAVES + wave; scr = (LAS float*)(lds + RING_OFF + wave * SCR_WAVE);
        const bool mla = (l & 1) == 0;
#define MOE_WEIGHT_CONV() do { \
            constexpr int I13 = 64 * 16 * 4, I2 = 64 * 4 * 16; \
            for (int it = gw; it < 2 * I13 + I2; it += NGW) { int r = it; \
                if (r < 2 * I13) { const int which = r / I13, q = r % I13, e = q >> 6, kb = (q >> 2) & 15, nb = q & 3; const int n0 = 64 * nb; \
                    const float* W = (which ? w3 : w1) + ((size_t)l * 64 + e) * 1024 * 256; \
                    transpose_item64(W, 256, 64 * kb, n0, W13 + (size_t)e * 512 * 1024, 1024, (n0 >> 7) * 256 + (n0 & 127) + which * 128, scr, lane); } \
                else { r -= 2 * I13; const int e = r >> 6, kb = (r >> 4) & 3, nb = r & 15; \
                    transpose_item64(w2 + ((size_t)l * 64 + e) * 256 * 1024, 1024, 64 * kb, 64 * nb, W2T + (size_t)e * 1024 * 256, 256, 64 * nb, scr, lane); } } } while (0)

        if (mla) {
            if (PHON(0) && IN(pb + 0)) {
                for (int rep = 0; rep < NREP(0); ++rep) {
                pg8::Gemm g{2048, 1024, 1024}; pg8::DenseOrder S; S.init(NTOK, 512, G, bx, XHL, (size_t)256 * 2048 * 2, 0, WIN + (size_t)j * 512 * 1024, (size_t)256 * 1024 * 2);
                pg8::EpiF32 E{LATB, 512};
                pg8::gemm_phase<pg8::EpiF32, pg8::DenseOrder, true>(lds + RING_OFF, g, S, E);
                MOE_WEIGHT_CONV();
                }
                SEAM(pb + 0);
            }
            if (PHON(1) && IN(pb + 1)) {
                const float* gq = q_norm + j * 256; const float* gk = kv_norm + j * 128;
                const f32x4 gqv = *(const f32x4*)(gq + 4 * lane); const f32x4 gkv = *(const f32x4*)(gk + 4 * (lane & 31));
                for (int m = gw; m < NTOK; m += NGW) {
                    const float* lr = LATB + (size_t)m * 512;
                    const f32x4 a = *(const f32x4*)(lr + 4 * lane), c = *(const f32x4*)(lr + 256 + 4 * lane);
                    const float sq = wave_sum(a.x * a.x + a.y * a.y + a.z * a.z + a.w * a.w);
                    const float sk = wave_sum(lane < 32 ? (c.x * c.x + c.y * c.y + c.z * c.z + c.w * c.w) : 0.f);
                    const float rq = 1.0f / sqrtf(sq * (1.f / 256.f) + RMS_EPS), rk = 1.0f / sqrtf(sk * (1.f / 128.f) + RMS_EPS);
                    { u32x2 o; o.x = cvtpk(a.x * rq * gqv.x, a.y * rq * gqv.y); o.y = cvtpk(a.z * rq * gqv.z, a.w * rq * gqv.w); *((u32x2*)(CQ + (size_t)m * 256) + lane) = o; }
                    if (lane < 32) { u32x2 o; o.x = cvtpk(c.x * rk * gkv.x, c.y * rk * gkv.y); o.y = cvtpk(c.z * rk * gkv.z, c.w * rk * gkv.w); *((u32x2*)(CKV + (size_t)m * 128) + lane) = o; }
                    f32x4 p; p.x = __shfl_xor(c.x, 4); p.y = __shfl_xor(c.y, 4); p.z = __shfl_xor(c.z, 4); p.w = __shfl_xor(c.w, 4);
                    if (lane >= 32 && lane < 40) {
                        const f32x4 cv = *(const f32x4*)(COS + (size_t)m * 16 + 4 * (lane & 3)), sv = *(const f32x4*)(SIN + (size_t)m * 16 + 4 * (lane & 3));
                        f32x4 y; if (lane < 36) y = c * cv - p * sv; else y = c * cv + p * sv;
                        u32x2 o; o.x = cvtpk(y.x, y.y); o.y = cvtpk(y.z, y.w); *((u32x2*)(KR + (size_t)m * 32) + (lane - 32)) = o;
                    }
                }
                SEAM(pb + 1);
            }
            if (PHON(2) && IN(pb + 2)) {
                for (int rep = 0; rep < NREP(2); ++rep) {
                { pg8::Gemm g{256, 256, 256}; pg8::DenseOrder S; S.init(NTOK, 1536, G, bx, CQ, (size_t)256 * 256 * 2, 0, WUQ + (size_t)j * 1536 * 256, (size_t)256 * 256 * 2);
                  pg8::EpiQ E{QB, COS, SIN};
                  pg8::gemm_phase<pg8::EpiQ, pg8::DenseOrder, true>(lds + RING_OFF, g, S, E); }
                { pg8::Gemm g{128, 128, 128}; pg8::DenseOrder S; S.init(NTOK, 1024, G, bx, CKV, (size_t)256 * 128 * 2, 0, WUK + (size_t)j * 1024 * 128, (size_t)256 * 128 * 2);
                  pg8::EpiBf16 E{KN, 1024};
                  pg8::gemm_phase<pg8::EpiBf16, pg8::DenseOrder, true>(lds + RING_OFF, g, S, E); }
                { pg8::Gemm g{128, 128, 128}; pg8::DenseOrder S; S.init(1024, NTOK, G, bx, WUV + (size_t)j * 1024 * 128, (size_t)256 * 128 * 2, 0, CKV, (size_t)256 * 128 * 2);
                  pg8::EpiBf16 E{VT, (size_t)NTOK};
                  pg8::gemm_phase<pg8::EpiBf16, pg8::DenseOrder, true>(lds + RING_OFF, g, S, E); }
                }
                SEAM(pb + 2);
            }
            if (PHON(3) && IN(pb + 3)) {
                for (int rep = 0; rep < NREP(3); ++rep)
                for (int i = 0;; ++i) {
                    const int L = i * G + vcu; if (L >= 2048) break;
                    const int sl = L & 255, rnd = L >> 8, s = sl & 7, bh = (sl >> 3) + 32 * (rnd >> 2), k = rnd & 3;
                    const int qb = (k == 0) ? s : (k == 1) ? 15 - s : (k == 2) ? 16 + s : 31 - s;
                    att::attn_unit(bh >> 4, bh & 15, qb, QB, KN, KR, VT, OB, lds + RING_OFF);
                }
                SEAM(pb + 3);
            }
            if (PHON(4) && IN(pb + 4)) {
                for (int rep = 0; rep < NREP(4); ++rep) {
                pg8::Gemm g{1024, 1024, 1024}; pg8::DenseOrder S; S.init(NTOK, 1024, G, bx, OB, (size_t)256 * 1024 * 2, 0, WO + (size_t)j * 1024 * 1024, (size_t)256 * 1024 * 2);
                pg8::EpiBf16 E{FB, 1024};
                pg8::gemm_phase<pg8::EpiBf16, pg8::DenseOrder, true>(lds + RING_OFF, g, S, E);
                }
                SEAM(pb + 4);
            }
        } else {
            if (PHON(13) && IN(pb + 0)) {
                for (int rep = 0; rep < NREP(13); ++rep) {
                for (int it = gw; it < 4 * (NTOK / 64); it += NGW) {
                    const int grp = it & 3, chunk = it >> 2, t0 = chunk * 64, s0 = t0 & (SEQ - 1), win = 2 << grp;
                    const bf16_t* xb = XHL + (size_t)grp * 256 + 4 * lane;
                    f32x4 S4 = {0.f, 0.f, 0.f, 0.f};
                    for (int jj = 1; jj < win; ++jj) { if (s0 - jj >= 0) { const bf16_t* p = xb + (size_t)(t0 - jj) * 2048; S4 += join4(*(const u32x2*)p, *(const u32x2*)(p + 1024)); } }
                    for (int tt = 0; tt < 64; ++tt) {
                        const int t = t0 + tt, s = s0 + tt; const bf16_t* p = xb + (size_t)t * 2048;
                        const f32x4 xv = join4(*(const u32x2*)p, *(const u32x2*)(p + 1024));
                        S4 += xv;
                        const float rc = 1.0f / (float)((s + 1 < win) ? s + 1 : win);
                        const f32x4 pv = S4 * rc - xv;
                        u32x2 o; o.x = cvtpk(pv.x, pv.y); o.y = cvtpk(pv.z, pv.w); *(u32x2*)(POOLED + (size_t)t * 1024 + grp * 256 + 4 * lane) = o;
                        if (s - win + 1 >= 0) { const bf16_t* pp = xb + (size_t)(t - win + 1) * 2048; S4 -= join4(*(const u32x2*)pp, *(const u32x2*)(pp + 1024)); }
                    }
                }
                MOE_WEIGHT_CONV();
                }
                SEAM(pb + 0);
            }
            if (PHON(14) && IN(pb + 1)) {
                for (int rep = 0; rep < NREP(14); ++rep) {
                pg8::Gemm g{1024, 256, 256}; pg8::DenseOrder S; S.init(NTOK, 1024, G, bx, POOLED, (size_t)256 * 1024 * 2, (size_t)256 * 2, WP + (size_t)j * 4 * 65536, (size_t)65536 * 2);
                pg8::EpiPool E{FB, pool_b + j * 1024, pool_scale + j * 1024};
                pg8::gemm_phase<pg8::EpiPool, pg8::DenseOrder, true>(lds + RING_OFF, g, S, E);
                }
                SEAM(pb + 1);
            }
        }
        if (PHON(5) && IN(pb + 5)) {
                for (int rep = 0; rep < NREP(5); ++rep) {
            f32x4 gv[4], bv[4];
#pragma unroll
            for (int jj = 0; jj < 4; ++jj) { gv[jj] = *(const f32x4*)(ln_g + (size_t)(l * 2 + 0) * 1024 + 4 * lane + 256 * jj); bv[jj] = *(const f32x4*)(ln_b + (size_t)(l * 2 + 0) * 1024 + 4 * lane + 256 * jj); }
            for (int m = gw; m < NTOK; m += NGW) {
                const u32x2* xh = (const u32x2*)(XHL + (size_t)m * 2048) + lane; const u32x2* fr2 = (const u32x2*)(FB + (size_t)m * 1024) + lane; f32x4 v[4]; float s = 0.f;
#pragma unroll
                for (int jj = 0; jj < 4; ++jj) { v[jj] = join4(xh[64 * jj], xh[256 + 64 * jj]) * DN_ALPHA + bf4(fr2[64 * jj]); s += (v[jj].x + v[jj].y) + (v[jj].z + v[jj].w); }
                const float mean = wave_sum(s) * (1.f / 1024.f); float s2 = 0.f;
#pragma unroll
                for (int jj = 0; jj < 4; ++jj) { v[jj] = v[jj] - mean; s2 += (v[jj].x * v[jj].x + v[jj].y * v[jj].y) + (v[jj].z * v[jj].z + v[jj].w * v[jj].w); }
                const float rstd = 1.0f / sqrtf(wave_sum(s2) * (1.f / 1024.f) + LN_EPS);
                u32x2* oh = (u32x2*)(XHL + (size_t)m * 2048) + lane;
#pragma unroll
                for (int jj = 0; jj < 4; ++jj) { const f32x4 y = v[jj] * rstd * gv[jj] + bv[jj]; u32x2 h, lo2; split4(y, h, lo2); oh[64 * jj] = h; oh[256 + 64 * jj] = lo2; }
            }
            }
                SEAM(pb + 5);
        }
        if (PHON(6) && IN(pb + 6)) {
                for (int rep = 0; rep < NREP(6); ++rep) {
            pg8::Gemm g{2048, 1024, 1024}; pg8::DenseOrder S; S.init(NTOK, 512, G, bx, XHL, (size_t)256 * 2048 * 2, (size_t)1024 * 2, WR + (size_t)l * 2 * 256 * 1024, (size_t)256 * 1024 * 2);
            pg8::EpiRouter E{LG};
            pg8::gemm_phase<pg8::EpiRouter, pg8::DenseOrder, true>(lds + RING_OFF, g, S, E);
            }
                SEAM(pb + 6);
        }
        if (PHON(7) && IN(pb + 7)) {
            for (int rep = 0; rep < NREP(7); ++rep) {
            LAS int* hist = (LAS int*)(lds + RING_OFF); LAS int* cbase = hist + 64;
            const float* bg = b_grp + l * 8; const float* be = b_exp + l * 64;
            unsigned* gcnt = ctl + CW_GCNT + 64 * l;
            for (int c = bx; c < 256; c += G) {
                if (tid < 64) hist[tid] = 0;
                __syncthreads();
                int ex1 = 0, ex2 = 0, p1 = 0, p2 = 0; float ga1 = 0.f, ga2 = 0.f;
                const int t = c * 128 + tid;
                if (tid < 128) {
                    const float* lg = LG + (size_t)t * LGP;
                    const float* lg2 = lg + (size_t)NTOK * LGP;
                    const f32x4 g0 = *(const f32x4*)lg + *(const f32x4*)lg2, g1 = *(const f32x4*)(lg + 4) + *(const f32x4*)(lg2 + 4);
                    float gl[8] = {g0.x + bg[0], g0.y + bg[1], g0.z + bg[2], g0.w + bg[3], g1.x + bg[4], g1.y + bg[5], g1.z + bg[6], g1.w + bg[7]};
                    int gs = 0; float gm = gl[0];
#pragma unroll
                    for (int i = 1; i < 8; ++i) if (gl[i] > gm) { gm = gl[i]; gs = i; }
                    float se = 0.f;
#pragma unroll
                    for (int i = 0; i < 8; ++i) se += __expf(gl[i] - gm);
                    const float ggate = 1.0f / se;
                    const f32x4 e0 = *(const f32x4*)(lg + 8 + gs * 8) + *(const f32x4*)(lg2 + 8 + gs * 8), e1 = *(const f32x4*)(lg + 12 + gs * 8) + *(const f32x4*)(lg2 + 12 + gs * 8);
                    const f32x4 b0 = *(const f32x4*)(be + gs * 8), b1 = *(const f32x4*)(be + gs * 8 + 4);
                    float el[8] = {e0.x + b0.x, e0.y + b0.y, e0.z + b0.z, e0.w + b0.w, e1.x + b1.x, e1.y + b1.y, e1.z + b1.z, e1.w + b1.w};
                    int i1 = 0; float m1 = el[0];
#pragma unroll
                    for (int i = 1; i < 8; ++i) if (el[i] > m1) { m1 = el[i]; i1 = i; }
                    int i2 = -1; float m2 = -INFINITY;
#pragma unroll
                    for (int i = 0; i < 8; ++i) if (i != i1 && el[i] > m2) { m2 = el[i]; i2 = i; }
                    const float x2 = __expf(m2 - m1), rs = 1.0f / (1.0f + x2);
                    ex1 = gs * 8 + i1; ex2 = gs * 8 + i2; ga1 = ggate * rs; ga2 = ggate * x2 * rs;
                    p1 = __hip_atomic_fetch_add(&hist[ex1], 1, __ATOMIC_RELAXED, __HIP_MEMORY_SCOPE_WORKGROUP); p2 = __hip_atomic_fetch_add(&hist[ex2], 1, __ATOMIC_RELAXED, __HIP_MEMORY_SCOPE_WORKGROUP);
                }
                __syncthreads();
                if (tid < 64) { const int n = hist[tid]; cbase[tid] = n ? (int)__hip_atomic_fetch_add(gcnt + tid, (unsigned)n, __ATOMIC_RELAXED, __HIP_MEMORY_SCOPE_AGENT) : 0; }
                __syncthreads();
                if (tid < 128) {
                    const size_t i1 = (size_t)ex1 * pg8::LIST_CAP + cbase[ex1] + p1, i2 = (size_t)ex2 * pg8::LIST_CAP + cbase[ex2] + p2;
                    ROWLIST[i1] = 2 * t; LGATE[i1] = ga1; ROWLIST[i2] = 2 * t + 1; LGATE[i2] = ga2;
                }
                __syncthreads();
            }
            }
            SEAM(pb + 7);
        }
#define MOE_TILE_TABLE() \
            LAS int* tinfo = (LAS int*)(lds + TINFO_OFF); \
            __syncthreads(); \
            if (tid < 64) tinfo[pg8::TI_CNT + tid] = (int)__hip_atomic_load(ctl + CW_GCNT + 64 * l + tid, __ATOMIC_RELAXED, __HIP_MEMORY_SCOPE_AGENT); \
            __syncthreads(); \
            if (tid == 0) { int tt = 0; for (int e = 0; e < 64; ++e) { const int n = (tinfo[pg8::TI_CNT + e] + 255) >> 8; for (int i = 0; i < n && tt < MAX_TILES; ++i) tinfo[tt++] = e | (i << 8); } tinfo[pg8::TI_CNT + 64] = tt; } \
            __syncthreads(); \
            const int ntl = tinfo[pg8::TI_CNT + 64];
        if (PHON(9) && IN(pb + 9)) {
            for (int rep = 0; rep < NREP(9); ++rep) {
            MOE_TILE_TABLE();
            pg8::Gemm g{2048, 1024, 1024}; pg8::GatherOrder S; S.init(tinfo, ntl, 2, G, bx, XHL, ROWLIST, W13, (size_t)512 * 1024 * 2, (size_t)256 * 1024 * 2);
            pg8::EpiSwiglu E{HS};
            pg8::gemm_phase<pg8::EpiSwiglu, pg8::GatherOrder, true>(lds + RING_OFF, g, S, E);
            }
            SEAM(pb + 9);
        }
        if (PHON(10) && IN(pb + 10)) {
            for (int rep = 0; rep < NREP(10); ++rep) {
            MOE_TILE_TABLE();
            pg8::Gemm g{256, 256, 256}; pg8::MoeOrder S; S.init(tinfo, ntl, 4, G, bx, HS, (size_t)256 * 256 * 2, W2T, (size_t)1024 * 256 * 2, (size_t)256 * 256 * 2);
            pg8::EpiMoeOut E{YB, tinfo, ROWLIST, LGATE};
            pg8::gemm_phase<pg8::EpiMoeOut, pg8::MoeOrder, true>(lds + RING_OFF, g, S, E);
            }
            SEAM(pb + 10);
        }
        if (PHON(11) && IN(pb + 11)) {
            f32x4 gv[4], bv[4];
#pragma unroll
            for (int jj = 0; jj < 4; ++jj) { gv[jj] = *(const f32x4*)(ln_g + (size_t)(l * 2 + 1) * 1024 + 4 * lane + 256 * jj); bv[jj] = *(const f32x4*)(ln_b + (size_t)(l * 2 + 1) * 1024 + 4 * lane + 256 * jj); }
            const bool lastl = (l == DEPTH - 1);
            for (int m = gw; m < NTOK; m += NGW) {
                u32x2* xh = (u32x2*)(XHL + (size_t)m * 2048) + lane;
                const u32x2* y0 = (const u32x2*)(YB + (size_t)(2 * m) * 1024) + lane; const u32x2* y1 = (const u32x2*)(YB + (size_t)(2 * m + 1) * 1024) + lane;
                f32x4 v[4]; float s = 0.f;
#pragma unroll
                for (int jj = 0; jj < 4; ++jj) { v[jj] = join4(xh[64 * jj], xh[256 + 64 * jj]) * DN_ALPHA + (bf4(y0[64 * jj]) + bf4(y1[64 * jj])); s += (v[jj].x + v[jj].y) + (v[jj].z + v[jj].w); }
                const float mean = wave_sum(s) * (1.f / 1024.f); float s2 = 0.f;
#pragma unroll
                for (int jj = 0; jj < 4; ++jj) { v[jj] = v[jj] - mean; s2 += (v[jj].x * v[jj].x + v[jj].y * v[jj].y) + (v[jj].z * v[jj].z + v[jj].w * v[jj].w); }
                const float rstd = 1.0f / sqrtf(wave_sum(s2) * (1.f / 1024.f) + LN_EPS);
                if (lastl) { f32x4* orow = (f32x4*)(kargs()->out + (size_t)m * 1024) + lane;
#pragma unroll
                    for (int jj = 0; jj < 4; ++jj) orow[64 * jj] = v[jj] * rstd * gv[jj] + bv[jj];
                } else {
#pragma unroll
                    for (int jj = 0; jj < 4; ++jj) { const f32x4 y = v[jj] * rstd * gv[jj] + bv[jj]; u32x2 h, lo2; split4(y, h, lo2); xh[64 * jj] = h; xh[256 + 64 * jj] = lo2; }
                }
            }
            SEAM(pb + 11);
        }
    }
#undef IN
#undef SEAM
}
#undef ws
#undef in_x
#undef in_pos
#undef ln_g
#undef ln_b
#undef w_in
#undef q_norm
#undef w_uq
#undef kv_norm
#undef w_ukv
#undef w_o
#undef pool_w
#undef pool_b
#undef pool_scale
#undef w_grp
#undef b_grp
#undef w_exp
#undef b_exp
#undef w1
#undef w3
#undef w2
#undef COS
#undef SIN
#undef CNT
#undef TILE
#undef AE
#undef APOS
#undef AG
#undef RSLOT
#undef RGATE
#undef WIN
#undef WUQ
#undef WUK
#undef WUV
#undef WO
#undef WP
#undef WR
#undef W13
#undef W2T
#undef FB
#undef XHL
#undef LATB
#undef CQ
#undef CKV
#undef KR
#undef QB
#undef KN
#undef VT
#undef OB
#undef POOLED
#undef LG
#undef ROWLIST
#undef LGATE
#undef HS
#undef YB

static bool phase_exists(int p) {
    if (p == 0) return true;
    const int l = (p - 1) / PPL, k = (p - 1) % PPL;
    if (k == 8) return false;
    if (k >= 5) return true;
    return (l & 1) == 0 ? true : (k < 2);
}
extern "C" void kernel_launch(void* const* d_in, const int* in_sizes, int n_in, void* d_out, int out_size, void* d_ws, size_t ws_size, hipStream_t stream) {
    static int grid = 0;
    if (grid == 0) {
        if (n_in != 20 || in_sizes[0] != NTOK * D_MODEL || out_size != NTOK * D_MODEL || ws_size < WS_END) { fprintf(stderr, "kernel_launch: unexpected shapes / workspace (%zu < %zu)\n", ws_size, (size_t)WS_END); grid = -1; return; }
        int dev = 0, cus = 0, per_cu = 0;
        if (hipGetDevice(&dev) != hipSuccess || hipDeviceGetAttribute(&cus, hipDeviceAttributeMultiprocessorCount, dev) != hipSuccess) { grid = -1; return; }
        if (hipFuncSetAttribute((const void*)mk_fwd, hipFuncAttributeMaxDynamicSharedMemorySize, LDS_BYTES) != hipSuccess) { fprintf(stderr, "kernel_launch: hipFuncSetAttribute failed\n"); grid = -1; return; }
        if (hipOccupancyMaxActiveBlocksPerMultiprocessor(&per_cu, (const void*)mk_fwd, NWAVES * 64, LDS_BYTES) != hipSuccess || per_cu < 1) fprintf(stderr, "kernel_launch: occupancy query reports %d\n", per_cu);
        (void)hipGetLastError();
        grid = cus;
    }
    if (grid < 0) return;
    if (hipMemsetAsync((char*)d_ws + WS_CTL, 0, CTL_ZERO_BYTES, stream) != hipSuccess) return;
    Args a{};
    for (int i = 0; i < 20; ++i) a.in[i] = d_in[i];
    a.out = (float*)d_out; a.ws = (unsigned char*)d_ws;
#if MK_ONE_LAUNCH
    a.ph_lo = 0; a.ph_hi = NPHASE;
    hipLaunchKernelGGL(mk_fwd, dim3(grid), dim3(NWAVES * 64), LDS_BYTES, stream, a);
#else
    for (int p = 0; p < NPHASE; ++p) {
        if (!phase_exists(p)) continue;
        a.ph_lo = p; a.ph_hi = p + 1;
        hipLaunchKernelGGL(mk_fwd, dim3(grid), dim3(NWAVES * 64), LDS_BYTES, stream, a);
    }
#endif
}
```

```cpp
#include <hip/hip_runtime.h>
#include <cstdio>
#include <cstdint>

#ifndef MK_ONE_LAUNCH
#define MK_ONE_LAUNCH 1
#endif

#define LAS __attribute__((address_space(3)))
#define GAS __attribute__((address_space(1)))

constexpr int D_MODEL = 1024, BATCH = 4, SEQ = 8192, DEPTH = 4, NTOK = BATCH * SEQ;
constexpr int N_HEADS = 16, QK_NOPE = 64, QK_ROPE = 32, V_HEAD = 64, Q_LORA = 256, KV_LORA = 128, LAT = Q_LORA + KV_LORA + QK_ROPE;
constexpr int QPITCH = N_HEADS * (QK_NOPE + QK_ROPE);
constexpr int N_GROUPS = 8, EPG = 8, N_EXPERTS = 64, D_EXPERT = 256;
constexpr int MAX_TILES = 320;
constexpr float DN_ALPHA = 1.681792830507429f;
constexpr float LN_EPS = 1e-5f, RMS_EPS = 1e-6f;
constexpr float QSCALE = 0.14724444602590306f;
constexpr int LGP = 80;

constexpr size_t MiB = 1u << 20;
constexpr size_t WS_CTL = 0, CTL_ZERO_BYTES = 1 * MiB;
constexpr size_t WS_COS = 1 * MiB, WS_SIN = 3 * MiB;
constexpr size_t WS_CNT = 5 * MiB;
constexpr size_t WS_TILE = 5 * MiB + 65536;
constexpr size_t WS_AE = 5 * MiB + 131072, WS_APOS = WS_AE + 262144, WS_AG = WS_APOS + 262144;
constexpr size_t WS_RSLOT = 6 * MiB, WS_RGATE = 6 * MiB + 512 * 1024;
constexpr size_t WS_WIN = 8 * MiB;
constexpr size_t WS_WUQ = 10 * MiB;
constexpr size_t WS_WUK = 12 * MiB;
constexpr size_t WS_WUV = 13 * MiB;
constexpr size_t WS_WO = 14 * MiB;
constexpr size_t WS_WP = 18 * MiB;
constexpr size_t WS_WR = 19 * MiB;
constexpr size_t WS_W13 = 24 * MiB;
constexpr size_t WS_W2T = 88 * MiB;
constexpr size_t WS_FB = 120 * MiB;
constexpr size_t WS_XHL = 248 * MiB;
constexpr size_t WS_R1 = 376 * MiB;
constexpr size_t WS_LAT = WS_R1;
constexpr size_t WS_CQ = WS_R1 + 64 * MiB;
constexpr size_t WS_CKV = WS_R1 + 80 * MiB;
constexpr size_t WS_KR = WS_R1 + 88 * MiB;
constexpr size_t WS_Q = WS_R1 + 92 * MiB;
constexpr size_t WS_KN = WS_R1 + 188 * MiB;
constexpr size_t WS_VT = WS_R1 + 252 * MiB;
constexpr size_t WS_O = WS_R1 + 316 * MiB;
constexpr size_t WS_POOLED = WS_R1;
constexpr size_t WS_LG = WS_R1;
constexpr size_t WS_LIST = WS_R1 + 20 * MiB;
constexpr size_t WS_LGATE = WS_R1 + 36 * MiB;
constexpr size_t WS_HS = WS_R1 + 180 * MiB;
constexpr size_t WS_Y = WS_R1 + 220 * MiB;
constexpr size_t WS_END = WS_R1 + 384 * MiB;
static_assert(WS_O + 64 * MiB <= WS_END && WS_Y + 128 * MiB <= WS_END, "ws map");

constexpr int CW_TMO = 0, CW_CODE = 1, CW_BAR = 4096, CW_GCNT = 16384;

constexpr int RING_OFF = 0, RING_BYTES = 131072, SCR_WAVE = 17408;
constexpr int LDSCTL_OFF = 8 * SCR_WAVE, MISC_OFF = LDSCTL_OFF + 320, TINFO_OFF = LDSCTL_OFF + 1024;
constexpr int LDS_BYTES = 147456;

typedef unsigned short bf16_t;
typedef short bf16x8 __attribute__((ext_vector_type(8)));
typedef float f32x4 __attribute__((ext_vector_type(4)));
typedef float f32x16 __attribute__((ext_vector_type(16)));
typedef unsigned u32x4 __attribute__((ext_vector_type(4)));
typedef unsigned u32x2 __attribute__((ext_vector_type(2)));
typedef float f32x2_t __attribute__((ext_vector_type(2)));
typedef __bf16 bf16x2_t __attribute__((ext_vector_type(2)));
#define RLX_AGENT __ATOMIC_RELAXED, __HIP_MEMORY_SCOPE_AGENT
#define LDS_WAIT() asm volatile("s_waitcnt lgkmcnt(0)" ::: "memory")
#define VM_WAIT() asm volatile("s_waitcnt vmcnt(0)" ::: "memory")

__device__ __forceinline__ unsigned cvtpk(float lo, float hi) { f32x2_t v = {lo, hi}; bf16x2_t b = __builtin_convertvector(v, bf16x2_t); return __builtin_bit_cast(unsigned, b); }
__device__ __forceinline__ int opaque(int x) { asm volatile("" : "+v"(x)); return x; }
__device__ __forceinline__ int opaque_s(int x) { asm volatile("" : "+s"(x)); return x; }
__device__ __forceinline__ float bflo(unsigned u) { return __uint_as_float(u << 16); }
__device__ __forceinline__ float bfhi(unsigned u) { return __uint_as_float(u & 0xffff0000u); }
__device__ __forceinline__ float wave_sum(float v) {
#pragma unroll
    for (int o = 1; o < 64; o <<= 1) v += __shfl_xor(v, o);
    return v;
}
__device__ __forceinline__ void split4(const f32x4 v, u32x2& h, u32x2& l) {
    h.x = cvtpk(v.x, v.y); h.y = cvtpk(v.z, v.w);
    l.x = cvtpk(v.x - bflo(h.x), v.y - bfhi(h.x)); l.y = cvtpk(v.z - bflo(h.y), v.w - bfhi(h.y));
}
__device__ __forceinline__ f32x4 join4(const u32x2 h, const u32x2 l) {
    return (f32x4){bflo(h.x) + bflo(l.x), bfhi(h.x) + bfhi(l.x), bflo(h.y) + bflo(l.y), bfhi(h.y) + bfhi(l.y)};
}
struct F8 { f32x4 a, b; };
__device__ __forceinline__ F8 bf8(const u32x4 w) { F8 r; r.a = (f32x4){bflo(w.x), bfhi(w.x), bflo(w.y), bfhi(w.y)}; r.b = (f32x4){bflo(w.z), bfhi(w.z), bflo(w.w), bfhi(w.w)}; return r; }
__device__ __forceinline__ u32x4 pk8(const f32x4 a, const f32x4 b) { u32x4 w; w.x = cvtpk(a.x, a.y); w.y = cvtpk(a.z, a.w); w.z = cvtpk(b.x, b.y); w.w = cvtpk(b.z, b.w); return w; }
__device__ __forceinline__ f32x4 bf4(const u32x2 h) { return (f32x4){bflo(h.x), bfhi(h.x), bflo(h.y), bfhi(h.y)}; }

namespace pg8 {
constexpr int BM = 256, BK = 64, HALF = 128, HTB = HALF * BK * 2, STAGE_BYTES = 8 * HTB, NXCD = 8, WGM = 8;
__host__ __device__ __forceinline__ int lds_byte(int r, int c) { const int st = (r >> 4) * 2 + (c >> 5), rr = r & 15, cc = c & 31, ob = rr * 64 + cc * 2; return st * 1024 + (ob ^ (((ob >> 9) & 1) << 5)); }
__host__ __device__ __forceinline__ void stage_rc(int b, int& R, int& C) { const int st = b / 1024, sb = b % 1024, swz = sb ^ (((sb >> 9) & 1) << 5); R = (st >> 1) * 16 + swz / 64; C = (st & 1) * 32 + (swz % 64) / 2; }
__host__ __device__ __forceinline__ int perm32(int rho) { const int n = rho >> 4, i = rho & 15; return 8 * (i >> 2) + 4 * n + (i & 3); }

struct Unit { int pm, pn; };
struct Gemm { int lda, ldb, K; };

struct DenseOrder {
    int nM, nN, nwg, G, c;
    const char* A; const char* B; size_t a_pm, a_pn, b_pn;
    __device__ __forceinline__ void init(int M, int N, int G_, int c_, const void* A_, size_t a_pm_, size_t a_pn_, const void* B_, size_t b_pn_) {
        nM = M / BM; nN = N / BM; nwg = nM * nN; G = G_; c = c_; A = (const char*)A_; B = (const char*)B_; a_pm = a_pm_; a_pn = a_pn_; b_pn = b_pn_; }
    __device__ __forceinline__ bool next(int i, Unit& u) const {
        const long L = (long)i * G + c; if (L >= nwg) return false;
        int wgid = (int)L; { const int q = nwg / NXCD, r = nwg % NXCD, xcd = wgid % NXCD, off = wgid / NXCD; wgid = (xcd < r ? xcd * (q + 1) : r * (q + 1) + (xcd - r) * q) + off; }
        const int nig = WGM * nN, gid = wgid / nig, fm = gid * WGM, gsz = (nM - fm) < WGM ? (nM - fm) : WGM;
        u.pm = fm + ((wgid % nig) % gsz); u.pn = (wgid % nig) / gsz; return true;
    }
    __device__ __forceinline__ const char* a_base(const Unit& u) const { return A + (size_t)u.pm * a_pm + (size_t)u.pn * a_pn; }
    __device__ __forceinline__ unsigned a_voff(const Unit&, int R, int C, int lda) const { return (unsigned)(R * lda + C) * 2u; }
    __device__ __forceinline__ const char* b_base(const Unit& u) const { return B + (size_t)u.pn * b_pn; }
};
constexpr int TI_CNT = 320, LIST_CAP = 65536;
struct MoeOrder {
    const LAS int* tinfo; int ntiles, nN, nwg, G, c;
    const char* A; const char* W; size_t a_tile, w_e, w_pn;
    __device__ __forceinline__ void init(const LAS int* ti, int ntiles_, int nN_, int G_, int c_, const void* A_, size_t a_tile_, const void* W_, size_t w_e_, size_t w_pn_) {
        tinfo = ti; ntiles = ntiles_; nN = nN_; nwg = ntiles_ * nN_; G = G_; c = c_; A = (const char*)A_; a_tile = a_tile_; W = (const char*)W_; w_e = w_e_; w_pn = w_pn_; }
    __device__ __forceinline__ bool next(int i, Unit& u) const {
        const long L = (long)i * G + c; if (L >= nwg) return false;
        int wgid = (int)L; { const int q = nwg / NXCD, r = nwg % NXCD, xcd = wgid % NXCD, off = wgid / NXCD; wgid = (xcd < r ? xcd * (q + 1) : r * (q + 1) + (xcd - r) * q) + off; }
        u.pm = wgid / nN; u.pn = wgid % nN; return true;
    }
    __device__ __forceinline__ const char* a_base(const Unit& u) const { return A + (size_t)u.pm * a_tile; }
    __device__ __forceinline__ const char* b_base(const Unit& u) const { const int e = __builtin_amdgcn_readfirstlane(tinfo[u.pm]) & 255; return W + (size_t)e * w_e + (size_t)u.pn * w_pn; }
    __device__ __forceinline__ unsigned a_voff(const Unit&, int R, int C, int lda) const { return (unsigned)(R * lda + C) * 2u; }
};
struct GatherOrder {
    const LAS int* tinfo; int ntiles, nN, nwg, G, c;
    const char* A; const int* list; const char* W; size_t w_e, w_pn;
    __device__ __forceinline__ void init(const LAS int* ti, int ntiles_, int nN_, int G_, int c_, const void* A_, const int* list_, const void* W_, size_t w_e_, size_t w_pn_) {
        tinfo = ti; ntiles = ntiles_; nN = nN_; nwg = ntiles_ * nN_; G = G_; c = c_; A = (const char*)A_; list = list_; W = (const char*)W_; w_e = w_e_; w_pn = w_pn_; }
    __device__ __forceinline__ bool next(int i, Unit& u) const {
        const long L = (long)i * G + c; if (L >= nwg) return false;
        int wgid = (int)L; { const int q = nwg / NXCD, r = nwg % NXCD, xcd = wgid % NXCD, off = wgid / NXCD; wgid = (xcd < r ? xcd * (q + 1) : r * (q + 1) + (xcd - r) * q) + off; }
        u.pm = wgid / nN; u.pn = wgid % nN; return true;
    }
    __device__ __forceinline__ const char* a_base(const Unit&) const { return A; }
    __device__ __forceinline__ const char* b_base(const Unit& u) const { const int e = __builtin_amdgcn_readfirstlane(tinfo[u.pm]) & 255; return W + (size_t)e * w_e + (size_t)u.pn * w_pn; }
    __device__ __forceinline__ unsigned a_voff(const Unit& u, int R, int C, int lda) const {
        const int ti = tinfo[u.pm], e = ti & 255, r = (ti >> 8) * 256 + R; const int n = tinfo[TI_CNT + e];
        const int ga = (r < n) ? list[(size_t)e * LIST_CAP + r] : 0;
        return (unsigned)(ga >> 1) * (unsigned)(lda * 2) + (unsigned)C * 2u; }
};

#define ACC_T const f32x4 (&acc)[2][2][4][2]
struct EpiBf16 {
    static constexpr bool PERM = true;
    bf16_t* O; size_t ldc;
    __device__ __forceinline__ void operator()(ACC_T, const Unit& u, int wr, int wc, int fr, int fq) const {
        const int row0 = u.pm * BM + wr * 64 + fr, col0 = u.pn * BM + wc * 32 + 8 * fq;
#pragma unroll
        for (int ai = 0; ai < 2; ++ai)
#pragma unroll
            for (int m = 0; m < 4; ++m) { bf16_t* rowp = O + (size_t)(row0 + ai * HALF + m * 16) * ldc + col0;
#pragma unroll
                for (int bj = 0; bj < 2; ++bj) { const f32x4 v0 = acc[ai][bj][m][0], v1 = acc[ai][bj][m][1];
                    u32x4 w; w.x = cvtpk(v0[0], v0[1]); w.y = cvtpk(v0[2], v0[3]); w.z = cvtpk(v1[0], v1[1]); w.w = cvtpk(v1[2], v1[3]);
                    *(u32x4*)(rowp + bj * HALF) = w; } }
    }
};
struct EpiF32 {
    static constexpr bool PERM = false;
    float* O; size_t ldc;
    __device__ __forceinline__ void operator()(ACC_T, const Unit& u, int wr, int wc, int fr, int fq) const {
        const int row0 = u.pm * BM + wr * 64 + fr, col0 = u.pn * BM + wc * 32 + 4 * fq;
#pragma unroll
        for (int ai = 0; ai < 2; ++ai)
#pragma unroll
            for (int m = 0; m < 4; ++m) { float* rowp = O + (size_t)(row0 + ai * HALF + m * 16) * ldc + col0;
#pragma unroll
                for (int bj = 0; bj < 2; ++bj)
#pragma unroll
                    for (int n = 0; n < 2; ++n) *(f32x4*)(rowp + bj * HALF + n * 16) = acc[ai][bj][m][n]; }
    }
};
struct EpiQ {
    static constexpr bool PERM = true;
    bf16_t* Q; const float* cs; const float* sn;
    __device__ __forceinline__ void operator()(ACC_T, const Unit& u, int wr, int wc, int fr, int fq) const {
        const int row0 = u.pm * BM + wr * 64 + fr;
        if (u.pn < 4) {
#pragma unroll
            for (int ai = 0; ai < 2; ++ai)
#pragma unroll
                for (int m = 0; m < 4; ++m) { const int row = row0 + ai * HALF + m * 16;
#pragma unroll
                    for (int bj = 0; bj < 2; ++bj) { const int col = u.pn * BM + bj * HALF + wc * 32 + 8 * fq; const f32x4 v0 = acc[ai][bj][m][0], v1 = acc[ai][bj][m][1];
                        u32x4 w; w.x = cvtpk(v0[0], v0[1]); w.y = cvtpk(v0[2], v0[3]); w.z = cvtpk(v1[0], v1[1]); w.w = cvtpk(v1[2], v1[3]);
                        *(u32x4*)(Q + (size_t)row * QPITCH + (col >> 6) * 96 + (col & 63)) = w; } }
        } else {
            const int head = (u.pn - 4) * 8 + 2 * wc + (fq >> 1), i0 = 8 * (fq & 1);
#pragma unroll
            for (int ai = 0; ai < 2; ++ai)
#pragma unroll
                for (int m = 0; m < 4; ++m) { const int row = row0 + ai * HALF + m * 16;
                    const f32x4 c0 = *(const f32x4*)(cs + (size_t)row * 16 + i0), c1 = *(const f32x4*)(cs + (size_t)row * 16 + i0 + 4);
                    const f32x4 s0 = *(const f32x4*)(sn + (size_t)row * 16 + i0), s1 = *(const f32x4*)(sn + (size_t)row * 16 + i0 + 4);
                    const f32x4 a0 = acc[ai][0][m][0], a1 = acc[ai][0][m][1], b0 = acc[ai][1][m][0], b1 = acc[ai][1][m][1];
                    const f32x4 y10 = a0 * c0 - b0 * s0, y11 = a1 * c1 - b1 * s1, y20 = b0 * c0 + a0 * s0, y21 = b1 * c1 + a1 * s1;
                    u32x4 w1, w2; w1.x = cvtpk(y10[0], y10[1]); w1.y = cvtpk(y10[2], y10[3]); w1.z = cvtpk(y11[0], y11[1]); w1.w = cvtpk(y11[2], y11[3]);
                    w2.x = cvtpk(y20[0], y20[1]); w2.y = cvtpk(y20[2], y20[3]); w2.z = cvtpk(y21[0], y21[1]); w2.w = cvtpk(y21[2], y21[3]);
                    bf16_t* qp = Q + (size_t)row * QPITCH + head * 96 + 64 + i0;
                    *(u32x4*)qp = w1; *(u32x4*)(qp + 16) = w2; asm volatile("" ::: "memory"); }
        }
    }
};
struct EpiPool {
    static constexpr bool PERM = true;
    bf16_t* F; const float* bias; const float* scale;
    __device__ __forceinline__ void operator()(ACC_T, const Unit& u, int wr, int wc, int fr, int fq) const {
        const int row0 = u.pm * BM + wr * 64 + fr, col0 = u.pn * BM + wc * 32 + 8 * fq;
#pragma unroll
        for (int bj = 0; bj < 2; ++bj) { const int c = col0 + bj * HALF;
            const f32x4 b0 = *(const f32x4*)(bias + c), b1 = *(const f32x4*)(bias + c + 4), s0 = *(const f32x4*)(scale + c), s1 = *(const f32x4*)(scale + c + 4);
#pragma unroll
            for (int ai = 0; ai < 2; ++ai)
#pragma unroll
                for (int m = 0; m < 4; ++m) { const f32x4 v0 = (acc[ai][bj][m][0] + b0) * s0, v1 = (acc[ai][bj][m][1] + b1) * s1;
                    u32x4 w; w.x = cvtpk(v0[0], v0[1]); w.y = cvtpk(v0[2], v0[3]); w.z = cvtpk(v1[0], v1[1]); w.w = cvtpk(v1[2], v1[3]);
                    *(u32x4*)(F + (size_t)(row0 + ai * HALF + m * 16) * 1024 + c) = w; } }
    }
};
struct EpiRouter {
    static constexpr bool PERM = false;
    float* LG;
    __device__ __forceinline__ void operator()(ACC_T, const Unit& u, int wr, int wc, int fr, int fq) const {
        const int row0 = u.pm * BM + wr * 64 + fr;
#pragma unroll
        for (int ai = 0; ai < 2; ++ai)
#pragma unroll
            for (int m = 0; m < 4; ++m) { float* lr = LG + ((size_t)u.pn * NTOK + (size_t)(row0 + ai * HALF + m * 16)) * LGP;
#pragma unroll
                for (int n = 0; n < 2; ++n) { const int j = wc * 32 + 16 * n + 4 * fq; if (j < 72) *(f32x4*)(lr + j) = acc[ai][0][m][n] + acc[ai][1][m][n]; } }
    }
};
struct EpiSwiglu {
    static constexpr bool PERM = true;
    bf16_t* H;
    __device__ __forceinline__ void operator()(ACC_T, const Unit& u, int wr, int wc, int fr, int fq) const {
        const int row0 = u.pm * BM + wr * 64 + fr, col0 = u.pn * HALF + wc * 32 + 8 * fq;
#pragma unroll
        for (int ai = 0; ai < 2; ++ai)
#pragma unroll
            for (int m = 0; m < 4; ++m) { float h[8];
#pragma unroll
                for (int n = 0; n < 2; ++n)
#pragma unroll
                    for (int e = 0; e < 4; ++e) { const float a = acc[ai][0][m][n][e], b = acc[ai][1][m][n][e];
                        h[n * 4 + e] = a * __builtin_amdgcn_rcpf(1.0f + __builtin_amdgcn_exp2f(-1.4426950408889634f * a)) * b; }
                u32x4 w; w.x = cvtpk(h[0], h[1]); w.y = cvtpk(h[2], h[3]); w.z = cvtpk(h[4], h[5]); w.w = cvtpk(h[6], h[7]);
                *(u32x4*)(H + (size_t)(row0 + ai * HALF + m * 16) * D_EXPERT + col0) = w; }
    }
};
struct EpiMoeOut {
    static constexpr bool PERM = true;
    bf16_t* Y; const LAS int* tinfo; const int* list; const float* lgate;
    __device__ __forceinline__ void operator()(ACC_T, const Unit& u, int wr, int wc, int fr, int fq) const {
        const int ti = tinfo[u.pm], e = ti & 255, n = tinfo[TI_CNT + e], r0 = (ti >> 8) * 256 + wr * 64 + fr, col0 = u.pn * BM + wc * 32 + 8 * fq;
#pragma unroll
        for (int ai = 0; ai < 2; ++ai)
#pragma unroll
            for (int m = 0; m < 4; ++m) { const int r = r0 + ai * HALF + m * 16;
                if (r < n) { const size_t li = (size_t)e * LIST_CAP + r; const int ga = list[li]; const float g = lgate[li]; bf16_t* yp = Y + (size_t)ga * D_MODEL + col0;
#pragma unroll
                    for (int bj = 0; bj < 2; ++bj) { const f32x4 v0 = acc[ai][bj][m][0] * g, v1 = acc[ai][bj][m][1] * g;
                        u32x4 w; w.x = cvtpk(v0[0], v0[1]); w.y = cvtpk(v0[2], v0[3]); w.z = cvtpk(v1[0], v1[1]); w.w = cvtpk(v1[2], v1[3]);
                        *(u32x4*)(yp + bj * HALF) = w; } }
                if (m & 1) asm volatile("" ::: "memory"); }
    }
};
#undef ACC_T

template <class Epi, class Sched, bool ALIGN_EPI>
__device__ __forceinline__ void gemm_phase(LAS unsigned char* lds, const Gemm g, const Sched& S, const Epi& E) {
    const int tid = opaque(threadIdx.x), wid = __builtin_amdgcn_readfirstlane(tid >> 6), lane = tid & 63, wr = wid >> 2, wc = wid & 3, fr = lane & 15, fq = lane >> 4;
    const int K = opaque_s(g.K), nt = K / BK;
    unsigned voffB[2]; int Rr[2], Cc[2];
#pragma unroll
    for (int i = 0; i < 2; ++i) { int R, C; stage_rc(tid * 16 + i * 8192, R, C); const int Rb = Epi::PERM ? ((R & ~31) + perm32(R & 31)) : R;
        Rr[i] = R; Cc[i] = C; voffB[i] = (unsigned)(Rb * g.ldb + C) * 2u; }
    const size_t kstep = (size_t)(BK * 2);
    const size_t hstepB = (size_t)HALF * g.ldb * 2;
    const unsigned ldsw = (unsigned)wid * 1024u;
    const int aoff = lds_byte(wr * 64 + fr, fq * 8), boff = lds_byte(wc * 32 + fr, fq * 8);
#define PG8_SA(b, h) (((b) * 2 + (h)) * HTB)
#define PG8_SB(b, h) ((4 + (b) * 2 + (h)) * HTB)
#define PG8_STAGE(bufoff, gbase, voff) do { _Pragma("unroll") for (int _i = 0; _i < 2; ++_i) \
        __builtin_amdgcn_global_load_lds((const unsigned*)((const char*)(gbase) + (voff)[_i]), (LAS unsigned*)(lds + (bufoff) + ldsw + _i * 8192), 16, 0, 0); } while (0)
#define PG8_LDA(dst, b, h) do { _Pragma("unroll") for (int m = 0; m < 4; ++m) _Pragma("unroll") for (int k = 0; k < 2; ++k) dst[m][k] = *(const LAS bf16x8*)(lds + PG8_SA(b, h) + aoff + m * 2048 + k * 1024); } while (0)
#define PG8_LDB(dst, b, h) do { _Pragma("unroll") for (int n = 0; n < 2; ++n) _Pragma("unroll") for (int k = 0; k < 2; ++k) dst[n][k] = *(const LAS bf16x8*)(lds + PG8_SB(b, h) + boff + n * 2048 + k * 1024); } while (0)
#define PG8_MMA(ai, bj, At, Bt) do { __builtin_amdgcn_s_setprio(1); _Pragma("unroll") for (int m = 0; m < 4; ++m) _Pragma("unroll") for (int n = 0; n < 2; ++n) _Pragma("unroll") for (int k = 0; k < 2; ++k) \
        acc[ai][bj][m][n] = __builtin_amdgcn_mfma_f32_16x16x32_bf16(Bt[n][k], At[m][k], acc[ai][bj][m][n], 0, 0, 0); __builtin_amdgcn_s_setprio(0); } while (0)
#define PG8_WAIT_V(n) asm volatile("s_waitcnt vmcnt(" #n ")" ::: "memory")
#define PG8_WAIT_L(n) asm volatile("s_waitcnt lgkmcnt(" #n ")" ::: "memory")
#define PG8_BAR __builtin_amdgcn_s_barrier()
#define PG8_SCHED __builtin_amdgcn_sched_barrier(0)
    Unit cur, nxt; int ui = 0;
    if (!S.next(0, cur)) return;
    f32x4 acc[2][2][4][2];
#pragma unroll
    for (int a = 0; a < 2; ++a)
#pragma unroll
        for (int b = 0; b < 2; ++b)
#pragma unroll
            for (int m = 0; m < 4; ++m)
#pragma unroll
                for (int n = 0; n < 2; ++n) acc[a][b][m][n] = (f32x4){0.f, 0.f, 0.f, 0.f};
    bf16x8 At[4][2], B0[2][2], B1[2][2];
    const char* cA = S.a_base(cur); const char* cB = S.b_base(cur);
    unsigned vA[2][2], vN[2][2];
#pragma unroll
    for (int h = 0; h < 2; ++h)
#pragma unroll
        for (int i = 0; i < 2; ++i) { vA[h][i] = S.a_voff(cur, Rr[i] + h * HALF, Cc[i], g.lda); vN[h][i] = vA[h][i]; }
    PG8_STAGE(PG8_SB(0, 0), cB, voffB); PG8_STAGE(PG8_SB(0, 1), cB + hstepB, voffB); PG8_STAGE(PG8_SA(0, 0), cA, vA[0]); PG8_STAGE(PG8_SA(0, 1), cA, vA[1]);
    if (wr == 1) PG8_BAR;
    PG8_WAIT_V(2); PG8_BAR;
    PG8_STAGE(PG8_SB(1, 0), cB + kstep, voffB); PG8_STAGE(PG8_SA(1, 0), cA + kstep, vA[0]); PG8_STAGE(PG8_SB(1, 1), cB + hstepB + kstep, voffB);
    PG8_WAIT_V(6); PG8_BAR;
    for (;;) {
        const bool has_next = S.next(ui + 1, nxt);
        const char* nA = has_next ? S.a_base(nxt) : cA; const char* nB = has_next ? S.b_base(nxt) : cB;
        if (has_next) {
#pragma unroll
            for (int h = 0; h < 2; ++h)
#pragma unroll
                for (int i = 0; i < 2; ++i) vN[h][i] = S.a_voff(nxt, Rr[i] + h * HALF, Cc[i], g.lda);
        }
#pragma nounroll
        for (int t = 0; t < nt; t += 2) {
            const bool last = (t == nt - 2);
            const char* a1 = cA + (size_t)(t + 1) * kstep;
            const char* a2 = last ? nA : cA + (size_t)(t + 2) * kstep; const char* b2 = last ? nB : cB + (size_t)(t + 2) * kstep;
            const char* a3 = a2 + kstep; const char* b3 = b2 + kstep;
            unsigned w0[2], w1[2];
#pragma unroll
            for (int i = 0; i < 2; ++i) { w0[i] = last ? vN[0][i] : vA[0][i]; w1[i] = last ? vN[1][i] : vA[1][i]; }
            PG8_LDB(B0, 0, 0); PG8_LDB(B1, 0, 1); PG8_SCHED; PG8_LDA(At, 0, 0); PG8_STAGE(PG8_SA(1, 1), a1, vA[1]);
            PG8_WAIT_V(8); PG8_WAIT_L(0); PG8_BAR; PG8_MMA(0, 0, At, B0); PG8_MMA(0, 1, At, B1); PG8_BAR; PG8_SCHED;
            PG8_LDA(At, 0, 1); PG8_STAGE(PG8_SB(0, 0), b2, voffB); PG8_STAGE(PG8_SB(0, 1), b2 + hstepB, voffB); PG8_STAGE(PG8_SA(0, 0), a2, w0);
            PG8_WAIT_V(8); PG8_WAIT_L(0); PG8_BAR; PG8_MMA(1, 0, At, B0); PG8_MMA(1, 1, At, B1); PG8_BAR; PG8_SCHED;
            PG8_LDB(B0, 1, 0); PG8_LDB(B1, 1, 1); PG8_SCHED; PG8_LDA(At, 1, 0); PG8_STAGE(PG8_SA(0, 1), a2, w1);
            PG8_WAIT_V(8); PG8_WAIT_L(0); PG8_BAR; PG8_MMA(0, 0, At, B0); PG8_MMA(0, 1, At, B1); PG8_BAR; PG8_SCHED;
            PG8_LDA(At, 1, 1); PG8_STAGE(PG8_SB(1, 0), b3, voffB); PG8_STAGE(PG8_SB(1, 1), b3 + hstepB, voffB); PG8_STAGE(PG8_SA(1, 0), a3, w0);
            PG8_WAIT_V(8); PG8_WAIT_L(0); PG8_BAR; PG8_MMA(1, 0, At, B0); PG8_MMA(1, 1, At, B1); PG8_BAR; PG8_SCHED;
        }
        if constexpr (ALIGN_EPI) { if (wr == 0) PG8_BAR; }
        E(acc, cur, wr, wc, fr, fq);
        if (!has_next) break;
#pragma unroll
        for (int a = 0; a < 2; ++a)
#pragma unroll
            for (int b = 0; b < 2; ++b)
#pragma unroll
                for (int m = 0; m < 4; ++m)
#pragma unroll
                    for (int n = 0; n < 2; ++n) acc[a][b][m][n] = (f32x4){0.f, 0.f, 0.f, 0.f};
        cur = nxt; cA = nA; cB = nB; ++ui;
#pragma unroll
        for (int h = 0; h < 2; ++h)
#pragma unroll
            for (int i = 0; i < 2; ++i) vA[h][i] = vN[h][i];
        if constexpr (ALIGN_EPI) { if (wr == 1) PG8_BAR; }
    }
    PG8_WAIT_V(0);
    if constexpr (!ALIGN_EPI) { if (wr == 0) PG8_BAR; }
    PG8_BAR;
#undef PG8_SA
#undef PG8_SB
#undef PG8_STAGE
#undef PG8_LDA
#undef PG8_LDB
#undef PG8_MMA
#undef PG8_WAIT_V
#undef PG8_WAIT_L
#undef PG8_BAR
#undef PG8_SCHED
}
}

namespace att {
constexpr int KSLOT = 12288, VSLOT = 8192, LDS_K = 0, LDS_V = 3 * KSLOT, LDS_BYTES = LDS_V + 3 * VSLOT;
constexpr float THR = 6.0f;
__device__ __forceinline__ void attn_unit(int b, int h, int qb, const bf16_t* __restrict__ Q, const bf16_t* __restrict__ KN, const bf16_t* __restrict__ KR, const bf16_t* __restrict__ VT, bf16_t* __restrict__ O, LAS unsigned char* lds) {
    const int tid = opaque(threadIdx.x), lane = tid & 63, r32 = lane & 31, hi = lane >> 5;
    const int w = __builtin_amdgcn_readfirstlane(tid >> 6);
    const size_t tok0 = (size_t)b * SEQ;
    const int q0 = qb * 256, NT = 4 * (qb + 1);
    const bf16_t* ksrc = KN + (tok0 + lane) * 1024 + h * 64 + 8 * w;
    const bf16_t* rsrc = KR + (tok0 + lane) * 32 + 8 * (w & 3);
    const bf16_t* vsrc = VT + (size_t)(h * 64 + lane) * NTOK + tok0 + 8 * w;
#define ATT_ISSUE(t, slot) do { \
        __builtin_amdgcn_global_load_lds((const unsigned*)(ksrc + (size_t)(t) * 65536), (LAS unsigned*)(lds + LDS_K + (slot) * KSLOT + w * 1024), 16, 0, 0); \
        if (w < 4) __builtin_amdgcn_global_load_lds((const unsigned*)(rsrc + (size_t)(t) * 2048), (LAS unsigned*)(lds + LDS_K + (slot) * KSLOT + (8 + w) * 1024), 16, 0, 0); \
        __builtin_amdgcn_global_load_lds((const unsigned*)(vsrc + (size_t)(t) * 64), (LAS unsigned*)(lds + LDS_V + (slot) * VSLOT + w * 1024), 16, 0, 0); } while (0)
    ATT_ISSUE(0, 0); ATT_ISSUE(1, 1);
    bf16x8 qr[6];
    { const bf16_t* qp = Q + (tok0 + q0 + w * 32 + r32) * QPITCH + h * 96 + hi * 8;
#pragma unroll
      for (int d0 = 0; d0 < 6; ++d0) qr[d0] = *(const bf16x8*)(qp + d0 * 16); }
    const int kvp = (r32 & 19) | ((r32 & 4) << 1) | ((r32 & 8) >> 1);
    const int kfoff = hi * 1024 + kvp * 16, vfoff = hi * 1024 + r32 * 16;
    float mhat = 0.f, lsum = 0.f;
    f32x16 o0 = {}, o1 = {}, negm = {};
    const int qrel = w * 32 + r32;
    int slot = 0;
    for (int t = 0; t < NT; ++t) {
        if (t == 0 || t + 1 >= NT) asm volatile("s_waitcnt vmcnt(0)" ::: "memory");
        else if (w < 4) asm volatile("s_waitcnt vmcnt(3)" ::: "memory");
        else asm volatile("s_waitcnt vmcnt(2)" ::: "memory");
        __builtin_amdgcn_s_barrier();
        asm volatile("" ::: "memory");
        if (t + 2 < NT) { const int s2 = (slot == 0) ? 2 : slot - 1; ATT_ISSUE(t + 2, s2); }
        const int jb = t - (NT - 4);
        const bool active = (jb < 0) || (jb <= (w >> 1));
        if (active) {
            const LAS unsigned char* kb = lds + LDS_K + slot * KSLOT + kfoff;
            const LAS unsigned char* vb = lds + LDS_V + slot * VSLOT + vfoff;
            f32x16 p0 = negm, p1 = negm;
#pragma unroll
            for (int d0 = 0; d0 < 6; ++d0) {
                const bf16x8 k0 = *(const LAS bf16x8*)(kb + d0 * 2048), k1 = *(const LAS bf16x8*)(kb + d0 * 2048 + 512);
                p0 = __builtin_amdgcn_mfma_f32_32x32x16_bf16(k0, qr[d0], p0, 0, 0, 0);
                p1 = __builtin_amdgcn_mfma_f32_32x32x16_bf16(k1, qr[d0], p1, 0, 0, 0);
            }
            if (jb >= 0) {
                const int kb0 = 64 * jb + 8 * hi;
#pragma unroll
                for (int r = 0; r < 16; ++r) { const int key = kb0 + (r & 3) + 4 * ((r >> 2) & 1) + 16 * (r >> 3);
                    if (key > qrel) p0[r] = -INFINITY; if (key + 32 > qrel) p1[r] = -INFINITY; }
            }
            float rm = fmaxf(p0[0], p1[0]);
#pragma unroll
            for (int r = 1; r < 16; ++r) rm = fmaxf(rm, fmaxf(p0[r], p1[r]));
            { auto rr = __builtin_amdgcn_permlane32_swap(__float_as_uint(rm), __float_as_uint(rm), false, false); rm = fmaxf(__uint_as_float(rr[0]), __uint_as_float(rr[1])); }
            if (t == 0) {
                mhat = rm;
#pragma unroll
                for (int r = 0; r < 16; ++r) { p0[r] -= rm; p1[r] -= rm; negm[r] = -mhat; }
            } else if (__any(rm > THR)) {
                const float dl = fmaxf(rm, 0.f); mhat += dl;
                const float f = __builtin_amdgcn_exp2f(-dl); lsum *= f;
#pragma unroll
                for (int r = 0; r < 16; ++r) { p0[r] -= dl; p1[r] -= dl; o0[r] *= f; o1[r] *= f; negm[r] = -mhat; }
            }
            float sacc = 0.f;
#pragma unroll
            for (int r = 0; r < 16; ++r) { p0[r] = __builtin_amdgcn_exp2f(p0[r]); p1[r] = __builtin_amdgcn_exp2f(p1[r]); sacc += p0[r] + p1[r]; }
            lsum += sacc;
            u32x4 pw[4];
#pragma unroll
            for (int i = 0; i < 2; ++i) {
                pw[i] = (u32x4){cvtpk(p0[8 * i], p0[8 * i + 1]), cvtpk(p0[8 * i + 2], p0[8 * i + 3]), cvtpk(p0[8 * i + 4], p0[8 * i + 5]), cvtpk(p0[8 * i + 6], p0[8 * i + 7])};
                pw[2 + i] = (u32x4){cvtpk(p1[8 * i], p1[8 * i + 1]), cvtpk(p1[8 * i + 2], p1[8 * i + 3]), cvtpk(p1[8 * i + 4], p1[8 * i + 5]), cvtpk(p1[8 * i + 6], p1[8 * i + 7])};
            }
#pragma unroll
            for (int kc2 = 0; kc2 < 4; ++kc2) {
                const bf16x8 v0 = *(const LAS bf16x8*)(vb + kc2 * 2048), v1 = *(const LAS bf16x8*)(vb + kc2 * 2048 + 512);
                const bf16x8 pf = __builtin_bit_cast(bf16x8, pw[kc2]);
                o0 = __builtin_amdgcn_mfma_f32_32x32x16_bf16(v0, pf, o0, 0, 0, 0);
                o1 = __builtin_amdgcn_mfma_f32_32x32x16_bf16(v1, pf, o1, 0, 0, 0);
            }
        }
        slot = (slot == 2) ? 0 : slot + 1;
    }
    { auto rr = __builtin_amdgcn_permlane32_swap(__float_as_uint(lsum), __float_as_uint(lsum), false, false); lsum = __uint_as_float(rr[0]) + __uint_as_float(rr[1]); }
    const float inv = 1.0f / lsum;
    bf16_t* op = O + (tok0 + q0 + w * 32 + r32) * 1024 + h * 64 + 4 * hi;
#pragma unroll
    for (int g = 0; g < 4; ++g) {
        u32x2 a, c; a.x = cvtpk(o0[4 * g] * inv, o0[4 * g + 1] * inv); a.y = cvtpk(o0[4 * g + 2] * inv, o0[4 * g + 3] * inv);
        c.x = cvtpk(o1[4 * g] * inv, o1[4 * g + 1] * inv); c.y = cvtpk(o1[4 * g + 2] * inv, o1[4 * g + 3] * inv);
        *(u32x2*)(op + 8 * g) = a; *(u32x2*)(op + 32 + 8 * g) = c;
    }
    asm volatile("s_waitcnt lgkmcnt(0)" ::: "memory");
    __builtin_amdgcn_s_barrier();
#undef ATT_ISSUE
}
}

#define XB_TMO      128
#define XB_XCNT(j)  (256  + 64 * (j))
#define XB_XSUB(j)  (1280 + 64 * (j))
#define XB_XGEN(j)  (2304 + 64 * (j))
#define XB_TOP      3328
#define XB_TOPGEN   3392
#define XCD_BAR_WORDS 3456
#define XB_SPIN_CAP (1u << 18)
__device__ __forceinline__ unsigned xb_ld(unsigned* p)              { return __hip_atomic_load(p, __ATOMIC_RELAXED, __HIP_MEMORY_SCOPE_AGENT); }
__device__ __forceinline__ unsigned xb_add(unsigned* p, unsigned v) { return __hip_atomic_fetch_add(p, v, __ATOMIC_RELAXED, __HIP_MEMORY_SCOPE_AGENT); }
__device__ __forceinline__ unsigned xb_xcc_id() { return (unsigned)__builtin_amdgcn_s_getreg((3 << 11) | 20) & 0xFu; }
#define XB_SPIN(cond, bar) do { unsigned _sp = 0; while (cond) { __builtin_amdgcn_s_sleep(1); \
    if ((++_sp & 255u) == 0u) { if (xb_ld(&(bar)[XB_TMO])) break; if (_sp > XB_SPIN_CAP) { atomicAdd(&(bar)[XB_TMO], 1u); break; } } } } while (0)
struct XcdBarrier { unsigned* bar; unsigned x; volatile LAS unsigned* st; };
__device__ __forceinline__ XcdBarrier xcd_barrier_post(unsigned* bar, volatile LAS unsigned* st) {
    XcdBarrier b; b.bar = bar; b.x = xb_xcc_id(); b.st = st;
    if (threadIdx.x == 0) (void)xb_add(&bar[XB_XCNT(b.x)], 1u);
    return b;
}
__device__ __forceinline__ void xcd_barrier_complete(unsigned* bar, unsigned x, unsigned& nloc, unsigned& nx) {
    const unsigned G = gridDim.x * gridDim.y * gridDim.z;
    unsigned sum, cnt, mine, sp = 0u;
    for (;;) {
        sum = 0u; cnt = 0u; mine = 0u;
#pragma unroll
        for (unsigned j = 0; j < 16; ++j) { const unsigned c = xb_ld(&bar[XB_XCNT(j)]); sum += c; cnt += (c > 0u) ? 1u : 0u; mine = (j == x) ? c : mine; }
        if (sum == G) break;
        __builtin_amdgcn_s_sleep(1);
        if ((++sp & 255u) == 0u) { if (xb_ld(&bar[XB_TMO])) break; if (sp > XB_SPIN_CAP) { atomicAdd(&bar[XB_TMO], 1u); break; } }
    }
    nloc = mine > 0u ? mine : 1u; nx = cnt > 0u ? cnt : 1u;
}
__device__ __forceinline__ void xcd_barrier(const XcdBarrier& b) {
    asm volatile("s_waitcnt vmcnt(0)" ::: "memory");
    __syncthreads();
    if (threadIdx.x == 0) {
        unsigned* bar = b.bar;
        __builtin_amdgcn_s_waitcnt(0);
        unsigned nloc = b.st[0], nx = b.st[1];
        if (nloc == 0u) { xcd_barrier_complete(bar, b.x, nloc, nx); b.st[0] = nloc; b.st[1] = nx; }
        const unsigned old = xb_add(&bar[XB_XSUB(b.x)], 1u);
        const unsigned gen = old / nloc;
        if (old + 1u == (gen + 1u) * nloc) {
            __builtin_amdgcn_fence(__ATOMIC_RELEASE, "agent");
            asm volatile("s_waitcnt vmcnt(0)" ::: "memory");
            const unsigned og = xb_add(&bar[XB_TOP], 1u);
            const unsigned tg = og / nx;
            if (og + 1u == (tg + 1u) * nx) xb_add(&bar[XB_TOPGEN], 1u);
            else XB_SPIN(xb_ld(&bar[XB_TOPGEN]) == tg, bar);
            __builtin_amdgcn_fence(__ATOMIC_ACQUIRE, "agent");
            xb_add(&bar[XB_XGEN(b.x)], 1u);
            asm volatile("s_waitcnt vmcnt(0)" ::: "memory");
        } else {
            XB_SPIN(xb_ld(&bar[XB_XGEN(b.x)]) == gen, bar);
            __builtin_amdgcn_fence(__ATOMIC_ACQUIRE, "agent");
            asm volatile("s_waitcnt vmcnt(0)" ::: "memory");
        }
    }
    __syncthreads();
}

struct Args { const void* in[20]; float* out; unsigned char* ws; int ph_lo, ph_hi; };
typedef const __attribute__((address_space(4))) Args* KArgs;
__device__ __forceinline__ KArgs kargs() { KArgs p = (KArgs)__builtin_amdgcn_kernarg_segment_ptr(); asm volatile("" : "+s"(p)); return p; }
constexpr int NWAVES = 8;
constexpr int PPL = 12;
constexpr int NPHASE = 1 + DEPTH * PPL;

__constant__ double c_invf[16] = {1.0, 0.5623413251903491, 0.31622776601683794, 0.1778279410038923, 0.1, 0.05623413251903491, 0.03162277660168379, 0.01778279410038923,
                                  0.01, 0.005623413251903491, 0.0031622776601683794, 0.0017782794100389228, 0.001, 0.0005623413251903491, 0.00031622776601683794, 0.00017782794100389227};

__device__ __forceinline__ void transpose_item(const float* __restrict__ W, int ldw, int k0, int n0, bf16_t* __restrict__ WT, int ldt, int drow0, float mul, LAS float* scr, int lane) {
#pragma unroll 8
    for (int i = 0; i < 32; ++i) { const int kk = 2 * i + (lane >> 5); scr[kk * 33 + (lane & 31)] = W[(size_t)(k0 + kk) * ldw + n0 + (lane & 31)]; }
    LDS_WAIT(); asm volatile("" ::: "memory");
    const int c = lane & 7;
#pragma unroll
    for (int j = 0; j < 4; ++j) { const int n = (lane >> 3) + 8 * j; const LAS float* s = scr + (8 * c) * 33 + n;
        u32x4 o; o.x = cvtpk(s[0 * 33] * mul, s[1 * 33] * mul); o.y = cvtpk(s[2 * 33] * mul, s[3 * 33] * mul); o.z = cvtpk(s[4 * 33] * mul, s[5 * 33] * mul); o.w = cvtpk(s[6 * 33] * mul, s[7 * 33] * mul);
        *(u32x4*)(WT + (size_t)(drow0 + n) * ldt + k0 + 8 * c) = o; }
    LDS_WAIT(); asm volatile("" ::: "memory");
}

__device__ __forceinline__ void transpose_item64(const float* __restrict__ W, int ldw, int k0, int n0, bf16_t* __restrict__ WT, int ldt, int drow0, LAS float* scr, int lane) {
    f32x4 v[16];
    const float* src = W + (size_t)(k0 + (lane >> 4)) * ldw + n0 + 4 * (lane & 15);
#pragma unroll
    for (int i = 0; i < 16; ++i) v[i] = *(const f32x4*)(src + (size_t)(4 * i) * ldw);
#pragma unroll
    for (int i = 0; i < 16; ++i) *(LAS f32x4*)(scr + (4 * i + (lane >> 4)) * 68 + 4 * (lane & 15)) = v[i];
    LDS_WAIT(); asm volatile("" ::: "memory");
    bf16_t* dst = WT + (size_t)(drow0 + lane) * ldt + k0;
#pragma unroll
    for (int c = 0; c < 8; ++c) { const LAS float* sp = scr + (8 * c) * 68 + lane;
        u32x4 o; o.x = cvtpk(sp[0], sp[68]); o.y = cvtpk(sp[2 * 68], sp[3 * 68]); o.z = cvtpk(sp[4 * 68], sp[5 * 68]); o.w = cvtpk(sp[6 * 68], sp[7 * 68]);
        *(u32x4*)(dst + 8 * c) = o; }
    LDS_WAIT(); asm volatile("" ::: "memory");
}

__device__ __forceinline__ void sincos_d(double a, float& s, float& c) {
    const double TWO_PI_HI = 6.283185307179586, TWO_PI_LO = 2.4492935982947064e-16, INV_2PI = 0.15915494309189535;
    const double n = __builtin_rint(a * INV_2PI);
    double r = __builtin_fma(-n, TWO_PI_HI, a); r = __builtin_fma(-n, TWO_PI_LO, r);
    const double HALF_PI = 1.5707963267948966, HALF_PI_LO = 6.123233995736766e-17;
    const double qd = __builtin_rint(r * 0.6366197723675814);
    double y = __builtin_fma(-qd, HALF_PI, r); y = __builtin_fma(-qd, HALF_PI_LO, y);
    const int q = ((int)qd) & 3;
    const double y2 = y * y;
    double sp = -7.647163731819816e-13; sp = sp * y2 + 1.6059043836821613e-10; sp = sp * y2 - 2.505210838544172e-08; sp = sp * y2 + 2.7557319223985893e-06; sp = sp * y2 - 0.0001984126984126984;
    sp = sp * y2 + 0.008333333333333333; sp = sp * y2 - 0.16666666666666666; sp = y + y * y2 * sp;
    double cp = 4.779477332387385e-14; cp = cp * y2 - 1.1470745597729725e-11; cp = cp * y2 + 2.08767569878681e-09; cp = cp * y2 - 2.755731922398589e-07; cp = cp * y2 + 2.48015873015873e-05;
    cp = cp * y2 - 0.001388888888888889; cp = cp * y2 + 0.041666666666666664; cp = cp * y2 - 0.5; cp = 1.0 + y2 * cp;
    double ss, cc;
    if (q == 0) { ss = sp; cc = cp; } else if (q == 1) { ss = cp; cc = -sp; } else if (q == 2) { ss = -sp; cc = -cp; } else { ss = -cp; cc = sp; }
    s = (float)ss; c = (float)cc;
}

__global__ void __launch_bounds__(NWAVES * 64, 2) mk_fwd(Args args_unused) {
    extern __shared__ __attribute__((aligned(16))) unsigned char lds_raw[];
    LAS unsigned char* lds = (LAS unsigned char*)lds_raw;
    volatile LAS unsigned* MISC = (volatile LAS unsigned*)(lds + MISC_OFF);
    int tid = threadIdx.x, lane = tid & 63, wave = __builtin_amdgcn_readfirstlane(tid >> 6);
    const int G = gridDim.x, bx = blockIdx.x;
    const int vcu = (G % 8 == 0) ? (bx % 8) * (G / 8) + bx / 8 : bx;
    int gw = vcu * NWAVES + wave; const int NGW = G * NWAVES;
#define ws (kargs()->ws)
    unsigned* ctl = (unsigned*)(ws + WS_CTL);
    for (int u = tid; u < (LDS_BYTES - LDSCTL_OFF) / 4; u += NWAVES * 64) ((LAS unsigned*)(lds + LDSCTL_OFF))[u] = 0u;
    __syncthreads();
    XcdBarrier bar; bar.bar = ctl + CW_BAR; bar.x = 0; bar.st = nullptr;
#if MK_ONE_LAUNCH
    bar = xcd_barrier_post(ctl + CW_BAR, MISC + 8);
#endif
    const int lo = kargs()->ph_lo, hi = kargs()->ph_hi;
#ifndef MK_REP_MASK
#define MK_REP_MASK 0u
#endif
#define NREP(b) (1 + (int)((MK_REP_MASK >> (b)) & 1u))
#ifndef MK_PH_MASK
#define MK_PH_MASK 0xffffffffu
#endif
#define PHON(b) ((MK_PH_MASK >> (b)) & 1u)
#define IN(k) (lo <= (k) && (k) < hi)
#if MK_ONE_LAUNCH
#define SEAM(k) do { if ((k) + 1 < hi) xcd_barrier(bar); } while (0)
#else
#define SEAM(k) do { } while (0)
#endif
#define in_x ((const float*)kargs()->in[0])
#define in_pos ((const int*)kargs()->in[1])
#define ln_g ((const float*)kargs()->in[2])
#define ln_b ((const float*)kargs()->in[3])
#define w_in ((const float*)kargs()->in[4])
#define q_norm ((const float*)kargs()->in[5])
#define w_uq ((const float*)kargs()->in[6])
#define kv_norm ((const float*)kargs()->in[7])
#define w_ukv ((const float*)kargs()->in[8])
#define w_o ((const float*)kargs()->in[9])
#define pool_w ((const float*)kargs()->in[10])
#define pool_b ((const float*)kargs()->in[11])
#define pool_scale ((const float*)kargs()->in[12])
#define w_grp ((const float*)kargs()->in[13])
#define b_grp ((const float*)kargs()->in[14])
#define w_exp ((const float*)kargs()->in[15])
#define b_exp ((const float*)kargs()->in[16])
#define w1 ((const float*)kargs()->in[17])
#define w3 ((const float*)kargs()->in[18])
#define w2 ((const float*)kargs()->in[19])
#define COS ((float*)(ws + WS_COS))
#define SIN ((float*)(ws + WS_SIN))
#define CNT ((int*)(ws + WS_CNT))
#define TILE ((int*)(ws + WS_TILE))
#define AE ((int*)(ws + WS_AE))
#define APOS ((int*)(ws + WS_APOS))
#define AG ((float*)(ws + WS_AG))
#define RSLOT ((int*)(ws + WS_RSLOT))
#define RGATE ((float*)(ws + WS_RGATE))
#define WIN ((bf16_t*)(ws + WS_WIN))
#define WUQ ((bf16_t*)(ws + WS_WUQ))
#define WUK ((bf16_t*)(ws + WS_WUK))
#define WUV ((bf16_t*)(ws + WS_WUV))
#define WO ((bf16_t*)(ws + WS_WO))
#define WP ((bf16_t*)(ws + WS_WP))
#define WR ((bf16_t*)(ws + WS_WR))
#define W13 ((bf16_t*)(ws + WS_W13))
#define W2T ((bf16_t*)(ws + WS_W2T))
#define FB ((bf16_t*)(ws + WS_FB))
#define XHL ((bf16_t*)(ws + WS_XHL))
#define LATB ((float*)(ws + WS_LAT))
#define CQ ((bf16_t*)(ws + WS_CQ))
#define CKV ((bf16_t*)(ws + WS_CKV))
#define KR ((bf16_t*)(ws + WS_KR))
#define QB ((bf16_t*)(ws + WS_Q))
#define KN ((bf16_t*)(ws + WS_KN))
#define VT ((bf16_t*)(ws + WS_VT))
#define OB ((bf16_t*)(ws + WS_O))
#define POOLED ((bf16_t*)(ws + WS_POOLED))
#define LG ((float*)(ws + WS_LG))
#define ROWLIST ((int*)(ws + WS_LIST))
#define LGATE ((float*)(ws + WS_LGATE))
#define HS ((bf16_t*)(ws + WS_HS))
#define YB ((bf16_t*)(ws + WS_Y))
    LAS float* scr = (LAS float*)(lds + RING_OFF + wave * SCR_WAVE);

    if (PHON(12) && IN(0)) {
        for (int m = gw; m < NTOK; m += NGW) {
            const f32x4* xr = (const f32x4*)(in_x + (size_t)m * D_MODEL) + 2 * lane; u32x4* oh = (u32x4*)(XHL + (size_t)m * 2048) + lane;
#pragma unroll
            for (int j = 0; j < 2; ++j) oh[64 * j] = pk8(xr[128 * j], xr[128 * j + 1]);
        }
        for (int idx = gw * 64 + lane; idx < NTOK * 16; idx += NGW * 64) { float s, c; sincos_d((double)in_pos[idx >> 4] * c_invf[idx & 15], s, c); COS[idx] = c; SIN[idx] = s; }
        for (int idx = gw * 64 + lane; idx < DEPTH * 2 * 256 * 1024; idx += NGW * 64) {
            const int l = idx >> 19, ks = (idx >> 18) & 1, row = (idx >> 10) & 255, k = idx & 1023;
            const int j = row < 72 ? row : ((row >= 128 && row < 200) ? row - 128 : -1);
            float v = 0.f;
            if (j >= 0 && !(ks == 1 && row >= 128)) { const float wv = (j < 8) ? w_grp[((size_t)l * 1024 + k) * 8 + j] : w_exp[((size_t)l * 1024 + k) * 64 + (j - 8)];
                const float whi = bflo(cvtpk(wv, 0.f)); v = (row < 72) ? whi : (wv - whi); }
            WR[idx] = (bf16_t)(cvtpk(v, 0.f) & 0xffffu);
        }
        for (int idx = gw * 64 + lane; idx < 2 * 96 * 1024 / 8; idx += NGW * 64) { const int j = idx / (96 * 128), r = idx % (96 * 128); *(u32x4*)(WIN + ((size_t)j * 512 + 416) * 1024 + (size_t)r * 8) = (u32x4){0u, 0u, 0u, 0u}; }
        constexpr int I_IN = 16 * 13, I_UQ = 4 * 48, I_UKV = 2 * 64, I_O = 16 * 32, I_P = 4 * 8;
        constexpr int NIT = 2 * (I_IN + I_UQ + I_UKV + I_O) + 8 * I_P;
        for (int it = gw; it < NIT; it += NGW) {
            int r = it;
            if (r < 2 * I_IN) { const int j = r / I_IN, q = r % I_IN, kb = q / 13, nb = q % 13;
                transpose_item(w_in + (size_t)j * 1024 * LAT, LAT, 64 * kb, 32 * nb, WIN + (size_t)j * 512 * 1024, 1024, 32 * nb, 1.f, scr, lane); continue; } r -= 2 * I_IN;
            if (r < 2 * I_UQ) { const int j = r / I_UQ, q = r % I_UQ, kb = q / 48, nb = q % 48; const int n0 = 32 * nb, head = n0 / 96, r0 = n0 % 96;
                if (r0 < 64) transpose_item(w_uq + (size_t)j * 256 * QPITCH, QPITCH, 64 * kb, n0, WUQ + (size_t)j * 1536 * 256, 256, head * 64 + r0, QSCALE, scr, lane);
                else {
                    const float* W = w_uq + (size_t)j * 256 * QPITCH; bf16_t* WT = WUQ + (size_t)j * 1536 * 256; const int k0 = 64 * kb;
#pragma unroll 8
                    for (int i = 0; i < 32; ++i) { const int kk = 2 * i + (lane >> 5); scr[kk * 33 + (lane & 31)] = W[(size_t)(k0 + kk) * QPITCH + n0 + (lane & 31)]; }
                    LDS_WAIT(); asm volatile("" ::: "memory");
                    const int c = lane & 7;
#pragma unroll
                    for (int jj = 0; jj < 4; ++jj) { const int n = (lane >> 3) + 8 * jj; const LAS float* s = scr + (8 * c) * 33 + n;
                        const int drow = 1024 + (head >> 3) * 256 + (head & 7) * 16 + (n < 16 ? n : 128 + n - 16);
                        u32x4 o; o.x = cvtpk(s[0 * 33] * QSCALE, s[1 * 33] * QSCALE); o.y = cvtpk(s[2 * 33] * QSCALE, s[3 * 33] * QSCALE); o.z = cvtpk(s[4 * 33] * QSCALE, s[5 * 33] * QSCALE); o.w = cvtpk(s[6 * 33] * QSCALE, s[7 * 33] * QSCALE);
                        *(u32x4*)(WT + (size_t)drow * 256 + k0 + 8 * c) = o; }
                    LDS_WAIT(); asm volatile("" ::: "memory");
                }
                continue; } r -= 2 * I_UQ;
            if (r < 2 * I_UKV) { const int j = r / I_UKV, q = r % I_UKV, kb = q / 64, nb = q % 64; const int n0 = 32 * nb, head = n0 >> 7, r0 = n0 & 127;
                if (r0 < 64) transpose_item(w_ukv + (size_t)j * 128 * 2048, 2048, 64 * kb, n0, WUK + (size_t)j * 1024 * 128, 128, head * 64 + r0, 1.f, scr, lane);
                else transpose_item(w_ukv + (size_t)j * 128 * 2048, 2048, 64 * kb, n0, WUV + (size_t)j * 1024 * 128, 128, head * 64 + r0 - 64, 1.f, scr, lane);
                continue; } r -= 2 * I_UKV;
            if (r < 2 * I_O) { const int j = r / I_O, q = r % I_O, kb = q / 32, nb = q % 32;
                transpose_item(w_o + (size_t)j * 1024 * 1024, 1024, 64 * kb, 32 * nb, WO + (size_t)j * 1024 * 1024, 1024, 32 * nb, 1.f, scr, lane); continue; } r -= 2 * I_O;
            { const int jg = r / I_P, q = r % I_P, kb = q / 8, nb = q % 8;
                transpose_item(pool_w + (size_t)jg * 65536, 256, 64 * kb, 32 * nb, WP + (size_t)jg * 65536, 256, 32 * nb, 1.f, scr, lane); }
        }
        SEAM(0);
    }

    for (int l = 0; l < DEPTH; ++l) {
        const int pb = 1 + PPL * l, j = l >> 1;
        tid = opaque(threadIdx.x); lane = tid & 63; wave = __builtin_amdgcn_readfirstlane(tid >> 6); gw = vcu * NWAVES + wave; scr = (LAS float*)(lds + RING_OFF + wave * SCR_WAVE);
        const bool mla = (l & 1) == 0;
#define MOE_WEIGHT_CONV() do { \
            constexpr int I13 = 64 * 16 * 4, I2 = 64 * 4 * 16; \
            for (int it = gw; it < 2 * I13 + I2; it += NGW) { int r = it; \
                if (r < 2 * I13) { const int which = r / I13, q = r % I13, e = q >> 6, kb = (q >> 2) & 15, nb = q & 3; const int n0 = 64 * nb; \
                    const float* W = (which ? w3 : w1) + ((size_t)l * 64 + e) * 1024 * 256; \
                    transpose_item64(W, 256, 64 * kb, n0, W13 + (size_t)e * 512 * 1024, 1024, (n0 >> 7) * 256 + (n0 & 127) + which * 128, scr, lane); } \
                else { r -= 2 * I13; const int e = r >> 6, kb = (r >> 4) & 3, nb = r & 15; \
                    transpose_item64(w2 + ((size_t)l * 64 + e) * 256 * 1024, 1024, 64 * kb, 64 * nb, W2T + (size_t)e * 1024 * 256, 256, 64 * nb, scr, lane); } } } while (0)

        if (mla) {
            if (PHON(0) && IN(pb + 0)) {
                for (int rep = 0; rep < NREP(0); ++rep) { if (rep) __syncthreads();
                pg8::Gemm g{2048, 1024, 1024}; pg8::DenseOrder S; S.init(NTOK, 512, G, bx, XHL, (size_t)256 * 2048 * 2, 0, WIN + (size_t)j * 512 * 1024, (size_t)256 * 1024 * 2);
                pg8::EpiF32 E{LATB, 512};
                pg8::gemm_phase<pg8::EpiF32, pg8::DenseOrder, true>(lds + RING_OFF, g, S, E);
                MOE_WEIGHT_CONV();
                }
                SEAM(pb + 0);
            }
            if (PHON(1) && IN(pb + 1)) {
                const float* gq = q_norm + j * 256; const float* gk = kv_norm + j * 128;
                const f32x4 gqv = *(const f32x4*)(gq + 4 * lane); const f32x4 gkv = *(const f32x4*)(gk + 4 * (lane & 31));
                for (int m = gw; m < NTOK; m += NGW) {
                    const float* lr = LATB + (size_t)m * 512;
                    const f32x4 a = *(const f32x4*)(lr + 4 * lane), c = *(const f32x4*)(lr + 256 + 4 * lane);
                    const float sq = wave_sum(a.x * a.x + a.y * a.y + a.z * a.z + a.w * a.w);
                    const float sk = wave_sum(lane < 32 ? (c.x * c.x + c.y * c.y + c.z * c.z + c.w * c.w) : 0.f);
                    const float rq = 1.0f / sqrtf(sq * (1.f / 256.f) + RMS_EPS), rk = 1.0f / sqrtf(sk * (1.f / 128.f) + RMS_EPS);
                    { u32x2 o; o.x = cvtpk(a.x * rq * gqv.x, a.y * rq * gqv.y); o.y = cvtpk(a.z * rq * gqv.z, a.w * rq * gqv.w); *((u32x2*)(CQ + (size_t)m * 256) + lane) = o; }
                    if (lane < 32) { u32x2 o; o.x = cvtpk(c.x * rk * gkv.x, c.y * rk * gkv.y); o.y = cvtpk(c.z * rk * gkv.z, c.w * rk * gkv.w); *((u32x2*)(CKV + (size_t)m * 128) + lane) = o; }
                    f32x4 p; p.x = __shfl_xor(c.x, 4); p.y = __shfl_xor(c.y, 4); p.z = __shfl_xor(c.z, 4); p.w = __shfl_xor(c.w, 4);
                    if (lane >= 32 && lane < 40) {
                        const f32x4 cv = *(const f32x4*)(COS + (size_t)m * 16 + 4 * (lane & 3)), sv = *(const f32x4*)(SIN + (size_t)m * 16 + 4 * (lane & 3));
                        f32x4 y; if (lane < 36) y = c * cv - p * sv; else y = c * cv + p * sv;
                        u32x2 o; o.x = cvtpk(y.x, y.y); o.y = cvtpk(y.z, y.w); *((u32x2*)(KR + (size_t)m * 32) + (lane - 32)) = o;
                    }
                }
                SEAM(pb + 1);
            }
            if (PHON(2) && IN(pb + 2)) {
                for (int rep = 0; rep < NREP(2); ++rep) {
                { pg8::Gemm g{256, 256, 256}; pg8::DenseOrder S; S.init(NTOK, 1536, G, bx, CQ, (size_t)256 * 256 * 2, 0, WUQ + (size_t)j * 1536 * 256, (size_t)256 * 256 * 2);
                  pg8::EpiQ E{QB, COS, SIN};
                  pg8::gemm_phase<pg8::EpiQ, pg8::DenseOrder, true>(lds + RING_OFF, g, S, E); }
                { pg8::Gemm g{128, 128, 128}; pg8::DenseOrder S; S.init(NTOK, 1024, G, bx, CKV, (size_t)256 * 128 * 2, 0, WUK + (size_t)j * 1024 * 128, (size_t)256 * 128 * 2);
                  pg8::EpiBf16 E{KN, 1024};
                  pg8::gemm_phase<pg8::EpiBf16, pg8::DenseOrder, true>(lds + RING_OFF, g, S, E); }
                { pg8::Gemm g{128, 128, 128}; pg8::DenseOrder S; S.init(1024, NTOK, G, bx, WUV + (size_t)j * 1024 * 128, (size_t)256 * 128 * 2, 0, CKV, (size_t)256 * 128 * 2);
                  pg8::EpiBf16 E{VT, (size_t)NTOK};
                  pg8::gemm_phase<pg8::EpiBf16, pg8::DenseOrder, true>(lds + RING_OFF, g, S, E); }
                }
                SEAM(pb + 2);
            }
            if (PHON(3) && IN(pb + 3)) {
                for (int rep = 0; rep < NREP(3); ++rep)
                for (int i = 0;; ++i) {
                    const int L = i * G + vcu; if (L >= 2048) break;
                    const int sl = L & 255, rnd = L >> 8, s = sl & 7, bh = (sl >> 3) + 32 * (rnd >> 2), k = rnd & 3;
                    const int qb = (k == 0) ? s : (k == 1) ? 15 - s : (k == 2) ? 16 + s : 31 - s;
                    att::attn_unit(bh >> 4, bh & 15, qb, QB, KN, KR, VT, OB, lds + RING_OFF);
                }
                SEAM(pb + 3);
            }
            if (PHON(4) && IN(pb + 4)) {
                for (int rep = 0; rep < NREP(4); ++rep) {
                pg8::Gemm g{1024, 1024, 1024}; pg8::DenseOrder S; S.init(NTOK, 1024, G, bx, OB, (size_t)256 * 1024 * 2, 0, WO + (size_t)j * 1024 * 1024, (size_t)256 * 1024 * 2);
                pg8::EpiBf16 E{FB, 1024};
                pg8::gemm_phase<pg8::EpiBf16, pg8::DenseOrder, true>(lds + RING_OFF, g, S, E);
                }
                SEAM(pb + 4);
            }
        } else {
            if (PHON(13) && IN(pb + 0)) {
                for (int rep = 0; rep < NREP(13); ++rep) {
                for (int it = gw; it < 2 * (NTOK / 32); it += NGW) {
                    const int q = it & 1, t0 = (it >> 1) * 32, s0 = t0 & (SEQ - 1), grp = 2 * q + (lane >> 5), win = 2 << grp;
                    const bf16_t* xb = XHL + grp * 256 + 8 * (lane & 31);
                    bf16_t* pout = POOLED + grp * 256 + 8 * (lane & 31);
                    f32x4 Sa = {0.f, 0.f, 0.f, 0.f}, Sb = {0.f, 0.f, 0.f, 0.f};
#pragma unroll
                    for (int jj = 1; jj < 16; ++jj) { if (jj < win && s0 - jj >= 0) { const F8 r = bf8(*(const u32x4*)(xb + (size_t)(t0 - jj) * 2048)); Sa += r.a; Sb += r.b; } }
                    for (int tb = 0; tb < 32; tb += 8) {
                        u32x4 xn[8], xe[8];
#pragma unroll
                        for (int i = 0; i < 8; ++i) { const int t = t0 + tb + i; xn[i] = *(const u32x4*)(xb + (size_t)t * 2048);
                            xe[i] = (s0 + tb + i - win + 1 >= 0) ? *(const u32x4*)(xb + (size_t)(t - win + 1) * 2048) : (u32x4){0u, 0u, 0u, 0u}; }
#pragma unroll
                        for (int i = 0; i < 8; ++i) { const int sI = s0 + tb + i; const F8 xv = bf8(xn[i]), ev = bf8(xe[i]);
                            Sa += xv.a; Sb += xv.b;
                            const float rc = 1.0f / (float)((sI + 1 < win) ? sI + 1 : win);
                            *(u32x4*)(pout + (size_t)(t0 + tb + i) * 1024) = pk8(Sa * rc - xv.a, Sb * rc - xv.b);
                            Sa -= ev.a; Sb -= ev.b; }
                    }
                }
                MOE_WEIGHT_CONV();
                }
                SEAM(pb + 0);
            }
            if (PHON(14) && IN(pb + 1)) {
                for (int rep = 0; rep < NREP(14); ++rep) {
                pg8::Gemm g{1024, 256, 256}; pg8::DenseOrder S; S.init(NTOK, 1024, G, bx, POOLED, (size_t)256 * 1024 * 2, (size_t)256 * 2, WP + (size_t)j * 4 * 65536, (size_t)65536 * 2);
                pg8::EpiPool E{FB, pool_b + j * 1024, pool_scale + j * 1024};
                pg8::gemm_phase<pg8::EpiPool, pg8::DenseOrder, true>(lds + RING_OFF, g, S, E);
                }
                SEAM(pb + 1);
            }
        }
        if (PHON(5) && IN(pb + 5)) {
                for (int rep = 0; rep < NREP(5); ++rep) {
            f32x4 gv[4], bv[4];
#pragma unroll
            for (int jj = 0; jj < 4; ++jj) { const int c = 8 * lane + 512 * (jj >> 1) + 4 * (jj & 1); gv[jj] = *(const f32x4*)(ln_g + (size_t)(l * 2 + 0) * 1024 + c); bv[jj] = *(const f32x4*)(ln_b + (size_t)(l * 2 + 0) * 1024 + c); }
            for (int m = gw; m < NTOK; m += NGW) {
                u32x4* xh = (u32x4*)(XHL + (size_t)m * 2048) + lane; const u32x4* fr2 = (const u32x4*)(FB + (size_t)m * 1024) + lane;
                const F8 x0 = bf8(xh[0]), x1 = bf8(xh[64]), f0 = bf8(fr2[0]), f1 = bf8(fr2[64]);
                f32x4 v[4] = {x0.a * DN_ALPHA + f0.a, x0.b * DN_ALPHA + f0.b, x1.a * DN_ALPHA + f1.a, x1.b * DN_ALPHA + f1.b}; float s = 0.f;
#pragma unroll
                for (int jj = 0; jj < 4; ++jj) s += (v[jj].x + v[jj].y) + (v[jj].z + v[jj].w);
                const float mean = wave_sum(s) * (1.f / 1024.f); float s2 = 0.f;
#pragma unroll
                for (int jj = 0; jj < 4; ++jj) { v[jj] = v[jj] - mean; s2 += (v[jj].x * v[jj].x + v[jj].y * v[jj].y) + (v[jj].z * v[jj].z + v[jj].w * v[jj].w); }
                const float rstd = 1.0f / sqrtf(wave_sum(s2) * (1.f / 1024.f) + LN_EPS);
#pragma unroll
                for (int jj = 0; jj < 4; ++jj) v[jj] = v[jj] * rstd * gv[jj] + bv[jj];
#pragma unroll
                for (int j = 0; j < 2; ++j) { const u32x4 h = pk8(v[2 * j], v[2 * j + 1]); const F8 hf = bf8(h);
                    xh[64 * j] = h; xh[128 + 64 * j] = pk8(v[2 * j] - hf.a, v[2 * j + 1] - hf.b); }
            }
            }
                SEAM(pb + 5);
        }
        if (PHON(6) && IN(pb + 6)) {
                for (int rep = 0; rep < NREP(6); ++rep) {
            pg8::Gemm g{2048, 1024, 1024}; pg8::DenseOrder S; S.init(NTOK, 512, G, bx, XHL, (size_t)256 * 2048 * 2, (size_t)1024 * 2, WR + (size_t)l * 2 * 256 * 1024, (size_t)256 * 1024 * 2);
            pg8::EpiRouter E{LG};
            pg8::gemm_phase<pg8::EpiRouter, pg8::DenseOrder, true>(lds + RING_OFF, g, S, E);
            }
                SEAM(pb + 6);
        }
        if (PHON(7) && IN(pb + 7)) {
            for (int rep = 0; rep < NREP(7); ++rep) {
            LAS int* hist = (LAS int*)(lds + RING_OFF); LAS int* cbase = hist + 64;
            const float* bg = b_grp + l * 8; const float* be = b_exp + l * 64;
            unsigned* gcnt = ctl + CW_GCNT + 64 * l;
            for (int c = bx; c < 256; c += G) {
                if (tid < 64) hist[tid] = 0;
                __syncthreads();
                int ex1 = 0, ex2 = 0, p1 = 0, p2 = 0; float ga1 = 0.f, ga2 = 0.f;
                const int t = c * 128 + tid;
                if (tid < 128) {
                    const float* lg = LG + (size_t)t * LGP;
                    const float* lg2 = lg + (size_t)NTOK * LGP;
                    const f32x4 g0 = *(const f32x4*)lg + *(const f32x4*)lg2, g1 = *(const f32x4*)(lg + 4) + *(const f32x4*)(lg2 + 4);
                    float gl[8] = {g0.x + bg[0], g0.y + bg[1], g0.z + bg[2], g0.w + bg[3], g1.x + bg[4], g1.y + bg[5], g1.z + bg[6], g1.w + bg[7]};
                    int gs = 0; float gm = gl[0];
#pragma unroll
                    for (int i = 1; i < 8; ++i) if (gl[i] > gm) { gm = gl[i]; gs = i; }
                    float se = 0.f;
#pragma unroll
                    for (int i = 0; i < 8; ++i) se += __expf(gl[i] - gm);
                    const float ggate = 1.0f / se;
                    const f32x4 e0 = *(const f32x4*)(lg + 8 + gs * 8) + *(const f32x4*)(lg2 + 8 + gs * 8), e1 = *(const f32x4*)(lg + 12 + gs * 8) + *(const f32x4*)(lg2 + 12 + gs * 8);
                    const f32x4 b0 = *(const f32x4*)(be + gs * 8), b1 = *(const f32x4*)(be + gs * 8 + 4);
                    float el[8] = {e0.x + b0.x, e0.y + b0.y, e0.z + b0.z, e0.w + b0.w, e1.x + b1.x, e1.y + b1.y, e1.z + b1.z, e1.w + b1.w};
                    int i1 = 0; float m1 = el[0];
#pragma unroll
                    for (int i = 1; i < 8; ++i) if (el[i] > m1) { m1 = el[i]; i1 = i; }
                    int i2 = -1; float m2 = -INFINITY;
#pragma unroll
                    for (int i = 0; i < 8; ++i) if (i != i1 && el[i] > m2) { m2 = el[i]; i2 = i; }
                    const float x2 = __expf(m2 - m1), rs = 1.0f / (1.0f + x2);
                    ex1 = gs * 8 + i1; ex2 = gs * 8 + i2; ga1 = ggate * rs; ga2 = ggate * x2 * rs;
                    p1 = __hip_atomic_fetch_add(&hist[ex1], 1, __ATOMIC_RELAXED, __HIP_MEMORY_SCOPE_WORKGROUP); p2 = __hip_atomic_fetch_add(&hist[ex2], 1, __ATOMIC_RELAXED, __HIP_MEMORY_SCOPE_WORKGROUP);
                }
                __syncthreads();
                if (tid < 64) { const int n = hist[tid]; cbase[tid] = n ? (int)__hip_atomic_fetch_add(gcnt + tid, (unsigned)n, __ATOMIC_RELAXED, __HIP_MEMORY_SCOPE_AGENT) : 0; }
                __syncthreads();
                if (tid < 128) {
                    const size_t i1 = (size_t)ex1 * pg8::LIST_CAP + cbase[ex1] + p1, i2 = (size_t)ex2 * pg8::LIST_CAP + cbase[ex2] + p2;
                    ROWLIST[i1] = 2 * t; LGATE[i1] = ga1; ROWLIST[i2] = 2 * t + 1; LGATE[i2] = ga2;
                }
                __syncthreads();
            }
            }
            SEAM(pb + 7);
        }
#define MOE_TILE_TABLE() \
            LAS int* tinfo = (LAS int*)(lds + TINFO_OFF); \
            __syncthreads(); \
            if (tid < 64) tinfo[pg8::TI_CNT + tid] = (int)__hip_atomic_load(ctl + CW_GCNT + 64 * l + tid, __ATOMIC_RELAXED, __HIP_MEMORY_SCOPE_AGENT); \
            __syncthreads(); \
            if (tid == 0) { int tt = 0; for (int e = 0; e < 64; ++e) { const int n = (tinfo[pg8::TI_CNT + e] + 255) >> 8; for (int i = 0; i < n && tt < MAX_TILES; ++i) tinfo[tt++] = e | (i << 8); } tinfo[pg8::TI_CNT + 64] = tt; } \
            __syncthreads(); \
            const int ntl = tinfo[pg8::TI_CNT + 64];
        if (PHON(9) && IN(pb + 9)) {
            for (int rep = 0; rep < NREP(9); ++rep) {
            MOE_TILE_TABLE();
            pg8::Gemm g{2048, 1024, 1024}; pg8::GatherOrder S; S.init(tinfo, ntl, 2, G, bx, XHL, ROWLIST, W13, (size_t)512 * 1024 * 2, (size_t)256 * 1024 * 2);
            pg8::EpiSwiglu E{HS};
            pg8::gemm_phase<pg8::EpiSwiglu, pg8::GatherOrder, true>(lds + RING_OFF, g, S, E);
            }
            SEAM(pb + 9);
        }
        if (PHON(10) && IN(pb + 10)) {
            for (int rep = 0; rep < NREP(10); ++rep) {
            MOE_TILE_TABLE();
            pg8::Gemm g{256, 256, 256}; pg8::MoeOrder S; S.init(tinfo, ntl, 4, G, bx, HS, (size_t)256 * 256 * 2, W2T, (size_t)1024 * 256 * 2, (size_t)256 * 256 * 2);
            pg8::EpiMoeOut E{YB, tinfo, ROWLIST, LGATE};
            pg8::gemm_phase<pg8::EpiMoeOut, pg8::MoeOrder, true>(lds + RING_OFF, g, S, E);
            }
            SEAM(pb + 10);
        }
        if (PHON(11) && IN(pb + 11)) {
            f32x4 gv[4], bv[4];
#pragma unroll
            for (int jj = 0; jj < 4; ++jj) { const int c = 8 * lane + 512 * (jj >> 1) + 4 * (jj & 1); gv[jj] = *(const f32x4*)(ln_g + (size_t)(l * 2 + 1) * 1024 + c); bv[jj] = *(const f32x4*)(ln_b + (size_t)(l * 2 + 1) * 1024 + c); }
            const bool lastl = (l == DEPTH - 1);
            for (int m = gw; m < NTOK; m += NGW) {
                u32x4* xh = (u32x4*)(XHL + (size_t)m * 2048) + lane;
                const u32x4* y0 = (const u32x4*)(YB + (size_t)(2 * m) * 1024) + lane; const u32x4* y1 = (const u32x4*)(YB + (size_t)(2 * m + 1) * 1024) + lane;
                const F8 x0 = bf8(xh[0]), x1 = bf8(xh[64]), a0 = bf8(y0[0]), a1 = bf8(y0[64]), c0 = bf8(y1[0]), c1 = bf8(y1[64]);
                f32x4 v[4] = {x0.a * DN_ALPHA + (a0.a + c0.a), x0.b * DN_ALPHA + (a0.b + c0.b), x1.a * DN_ALPHA + (a1.a + c1.a), x1.b * DN_ALPHA + (a1.b + c1.b)}; float s = 0.f;
#pragma unroll
                for (int jj = 0; jj < 4; ++jj) s += (v[jj].x + v[jj].y) + (v[jj].z + v[jj].w);
                const float mean = wave_sum(s) * (1.f / 1024.f); float s2 = 0.f;
#pragma unroll
                for (int jj = 0; jj < 4; ++jj) { v[jj] = v[jj] - mean; s2 += (v[jj].x * v[jj].x + v[jj].y * v[jj].y) + (v[jj].z * v[jj].z + v[jj].w * v[jj].w); }
                const float rstd = 1.0f / sqrtf(wave_sum(s2) * (1.f / 1024.f) + LN_EPS);
#pragma unroll
                for (int jj = 0; jj < 4; ++jj) v[jj] = v[jj] * rstd * gv[jj] + bv[jj];
                if (lastl) { f32x4* orow = (f32x4*)(kargs()->out + (size_t)m * 1024) + 2 * lane;
                    orow[0] = v[0]; orow[1] = v[1]; orow[128] = v[2]; orow[129] = v[3];
                } else { xh[0] = pk8(v[0], v[1]); xh[64] = pk8(v[2], v[3]); }
            }
            SEAM(pb + 11);
        }
    }
#undef IN
#undef SEAM
}
#undef ws
#undef in_x
#undef in_pos
#undef ln_g
#undef ln_b
#undef w_in
#undef q_norm
#undef w_uq
#undef kv_norm
#undef w_ukv
#undef w_o
#undef pool_w
#undef pool_b
#undef pool_scale
#undef w_grp
#undef b_grp
#undef w_exp
#undef b_exp
#undef w1
#undef w3
#undef w2
#undef COS
#undef SIN
#undef CNT
#undef TILE
#undef AE
#undef APOS
#undef AG
#undef RSLOT
#undef RGATE
#undef WIN
#undef WUQ
#undef WUK
#undef WUV
#undef WO
#undef WP
#undef WR
#undef W13
#undef W2T
#undef FB
#undef XHL
#undef LATB
#undef CQ
#undef CKV
#undef KR
#undef QB
#undef KN
#undef VT
#undef OB
#undef POOLED
#undef LG
#undef ROWLIST
#undef LGATE
#undef HS
#undef YB

static bool phase_exists(int p) {
    if (p == 0) return true;
    const int l = (p - 1) / PPL, k = (p - 1) % PPL;
    if (k == 8) return false;
    if (k >= 5) return true;
    return (l & 1) == 0 ? true : (k < 2);
}
extern "C" void kernel_launch(void* const* d_in, const int* in_sizes, int n_in, void* d_out, int out_size, void* d_ws, size_t ws_size, hipStream_t stream) {
    static int grid = 0;
    if (grid == 0) {
        if (n_in != 20 || in_sizes[0] != NTOK * D_MODEL || out_size != NTOK * D_MODEL || ws_size < WS_END) { fprintf(stderr, "kernel_launch: unexpected shapes / workspace (%zu < %zu)\n", ws_size, (size_t)WS_END); grid = -1; return; }
        int dev = 0, cus = 0, per_cu = 0;
        if (hipGetDevice(&dev) != hipSuccess || hipDeviceGetAttribute(&cus, hipDeviceAttributeMultiprocessorCount, dev) != hipSuccess) { grid = -1; return; }
        if (hipFuncSetAttribute((const void*)mk_fwd, hipFuncAttributeMaxDynamicSharedMemorySize, LDS_BYTES) != hipSuccess) { fprintf(stderr, "kernel_launch: hipFuncSetAttribute failed\n"); grid = -1; return; }
        if (hipOccupancyMaxActiveBlocksPerMultiprocessor(&per_cu, (const void*)mk_fwd, NWAVES * 64, LDS_BYTES) != hipSuccess || per_cu < 1) fprintf(stderr, "kernel_launch: occupancy query reports %d\n", per_cu);
        (void)hipGetLastError();
        grid = cus;
    }
    if (grid < 0) return;
    if (hipMemsetAsync((char*)d_ws + WS_CTL, 0, CTL_ZERO_BYTES, stream) != hipSuccess) return;
    Args a{};
    for (int i = 0; i < 20; ++i) a.in[i] = d_in[i];
    a.out = (float*)d_out; a.ws = (unsigned char*)d_ws;
#if MK_ONE_LAUNCH
    a.ph_lo = 0; a.ph_hi = NPHASE;
    hipLaunchKernelGGL(mk_fwd, dim3(grid), dim3(NWAVES * 64), LDS_BYTES, stream, a);
#else
    for (int p = 0; p < NPHASE; ++p) {
        if (!phase_exists(p)) continue;
        a.ph_lo = p; a.ph_hi = p + 1;
        hipLaunchKernelGGL(mk_fwd, dim3(grid), dim3(NWAVES * 64), LDS_BYTES, stream, a);
    }
#endif
}
```

```cpp
#include <hip/hip_runtime.h>
#include <cstdio>
#include <cstdint>

#ifndef MK_ONE_LAUNCH
#define MK_ONE_LAUNCH 1
#endif

#define LAS __attribute__((address_space(3)))
#define GAS __attribute__((address_space(1)))

constexpr int D_MODEL = 1024, BATCH = 4, SEQ = 8192, DEPTH = 4, NTOK = BATCH * SEQ;
constexpr int N_HEADS = 16, QK_NOPE = 64, QK_ROPE = 32, V_HEAD = 64, Q_LORA = 256, KV_LORA = 128, LAT = Q_LORA + KV_LORA + QK_ROPE;
constexpr int QPITCH = N_HEADS * (QK_NOPE + QK_ROPE);
constexpr int N_GROUPS = 8, EPG = 8, N_EXPERTS = 64, D_EXPERT = 256;
constexpr int MAX_TILES = 320;
constexpr float DN_ALPHA = 1.681792830507429f;
constexpr float LN_EPS = 1e-5f, RMS_EPS = 1e-6f;
constexpr float QSCALE = 0.14724444602590306f;
constexpr int LGP = 80;

constexpr size_t MiB = 1u << 20;
constexpr size_t WS_CTL = 0, CTL_ZERO_BYTES = 1 * MiB;
constexpr size_t WS_COS = 1 * MiB, WS_SIN = 3 * MiB;
constexpr size_t WS_CNT = 5 * MiB;
constexpr size_t WS_TILE = 5 * MiB + 65536;
constexpr size_t WS_AE = 5 * MiB + 131072, WS_APOS = WS_AE + 262144, WS_AG = WS_APOS + 262144;
constexpr size_t WS_RSLOT = 6 * MiB, WS_RGATE = 6 * MiB + 512 * 1024;
constexpr size_t WS_WIN = 8 * MiB;
constexpr size_t WS_WUQ = 10 * MiB;
constexpr size_t WS_WUK = 12 * MiB;
constexpr size_t WS_WUV = 13 * MiB;
constexpr size_t WS_WO = 14 * MiB;
constexpr size_t WS_WP = 18 * MiB;
constexpr size_t WS_WR = 19 * MiB;
constexpr size_t WS_W13 = 24 * MiB;
constexpr size_t WS_W2T = 88 * MiB;
constexpr size_t WS_FB = 120 * MiB;
constexpr size_t WS_XHL = 248 * MiB;
constexpr size_t WS_R1 = 376 * MiB;
constexpr size_t WS_LAT = WS_R1;
constexpr size_t WS_CQ = WS_R1 + 64 * MiB;
constexpr size_t WS_CKV = WS_R1 + 80 * MiB;
constexpr size_t WS_KR = WS_R1 + 88 * MiB;
constexpr size_t WS_Q = WS_R1 + 92 * MiB;
constexpr size_t WS_KN = WS_R1 + 188 * MiB;
constexpr size_t WS_VT = WS_R1 + 252 * MiB;
constexpr size_t WS_O = WS_R1 + 316 * MiB;
constexpr size_t WS_POOLED = WS_R1;
constexpr size_t WS_LG = WS_R1;
constexpr size_t WS_LIST = WS_R1 + 20 * MiB;
constexpr size_t WS_LGATE = WS_R1 + 36 * MiB;
constexpr size_t WS_HS = WS_R1 + 180 * MiB;
constexpr size_t WS_Y = WS_R1 + 220 * MiB;
constexpr size_t WS_END = WS_R1 + 384 * MiB;
static_assert(WS_O + 64 * MiB <= WS_END && WS_Y + 128 * MiB <= WS_END, "ws map");

constexpr int CW_TMO = 0, CW_CODE = 1, CW_BAR = 4096, CW_GCNT = 16384;

constexpr int RING_OFF = 0, RING_BYTES = 131072, SCR_WAVE = 17408;
constexpr int LDSCTL_OFF = 8 * SCR_WAVE, MISC_OFF = LDSCTL_OFF + 320, TINFO_OFF = LDSCTL_OFF + 1024;
constexpr int LDS_BYTES = 147456;

typedef unsigned short bf16_t;
typedef short bf16x8 __attribute__((ext_vector_type(8)));
typedef float f32x4 __attribute__((ext_vector_type(4)));
typedef float f32x16 __attribute__((ext_vector_type(16)));
typedef unsigned u32x4 __attribute__((ext_vector_type(4)));
typedef unsigned u32x2 __attribute__((ext_vector_type(2)));
typedef float f32x2_t __attribute__((ext_vector_type(2)));
typedef __bf16 bf16x2_t __attribute__((ext_vector_type(2)));
#define RLX_AGENT __ATOMIC_RELAXED, __HIP_MEMORY_SCOPE_AGENT
#define LDS_WAIT() asm volatile("s_waitcnt lgkmcnt(0)" ::: "memory")
#define VM_WAIT() asm volatile("s_waitcnt vmcnt(0)" ::: "memory")

__device__ __forceinline__ unsigned cvtpk(float lo, float hi) { f32x2_t v = {lo, hi}; bf16x2_t b = __builtin_convertvector(v, bf16x2_t); return __builtin_bit_cast(unsigned, b); }
__device__ __forceinline__ int opaque(int x) { asm volatile("" : "+v"(x)); return x; }
__device__ __forceinline__ int opaque_s(int x) { asm volatile("" : "+s"(x)); return x; }
__device__ __forceinline__ float bflo(unsigned u) { return __uint_as_float(u << 16); }
__device__ __forceinline__ float bfhi(unsigned u) { return __uint_as_float(u & 0xffff0000u); }
__device__ __forceinline__ float wave_sum(float v) {
#pragma unroll
    for (int o = 1; o < 64; o <<= 1) v += __shfl_xor(v, o);
    return v;
}
__device__ __forceinline__ void split4(const f32x4 v, u32x2& h, u32x2& l) {
    h.x = cvtpk(v.x, v.y); h.y = cvtpk(v.z, v.w);
    l.x = cvtpk(v.x - bflo(h.x), v.y - bfhi(h.x)); l.y = cvtpk(v.z - bflo(h.y), v.w - bfhi(h.y));
}
__device__ __forceinline__ f32x4 join4(const u32x2 h, const u32x2 l) {
    return (f32x4){bflo(h.x) + bflo(l.x), bfhi(h.x) + bfhi(l.x), bflo(h.y) + bflo(l.y), bfhi(h.y) + bfhi(l.y)};
}
struct F8 { f32x4 a, b; };
__device__ __forceinline__ F8 bf8(const u32x4 w) { F8 r; r.a = (f32x4){bflo(w.x), bfhi(w.x), bflo(w.y), bfhi(w.y)}; r.b = (f32x4){bflo(w.z), bfhi(w.z), bflo(w.w), bfhi(w.w)}; return r; }
__device__ __forceinline__ u32x4 pk8(const f32x4 a, const f32x4 b) { u32x4 w; w.x = cvtpk(a.x, a.y); w.y = cvtpk(a.z, a.w); w.z = cvtpk(b.x, b.y); w.w = cvtpk(b.z, b.w); return w; }
__device__ __forceinline__ f32x4 bf4(const u32x2 h) { return (f32x4){bflo(h.x), bfhi(h.x), bflo(h.y), bfhi(h.y)}; }

namespace pg8 {
constexpr int BM = 256, BK = 64, HALF = 128, HTB = HALF * BK * 2, STAGE_BYTES = 8 * HTB, NXCD = 8, WGM = 8;
__host__ __device__ __forceinline__ int lds_byte(int r, int c) { const int st = (r >> 4) * 2 + (c >> 5), rr = r & 15, cc = c & 31, ob = rr * 64 + cc * 2; return st * 1024 + (ob ^ (((ob >> 9) & 1) << 5)); }
__host__ __device__ __forceinline__ void stage_rc(int b, int& R, int& C) { const int st = b / 1024, sb = b % 1024, swz = sb ^ (((sb >> 9) & 1) << 5); R = (st >> 1) * 16 + swz / 64; C = (st & 1) * 32 + (swz % 64) / 2; }
__host__ __device__ __forceinline__ int perm32(int rho) { const int n = rho >> 4, i = rho & 15; return 8 * (i >> 2) + 4 * n + (i & 3); }

struct Unit { int pm, pn; };
struct Gemm { int lda, ldb, K; };

struct DenseOrder {
    int nM, nN, nwg, G, c;
    const char* A; const char* B; size_t a_pm, a_pn, b_pn;
    __device__ __forceinline__ void init(int M, int N, int G_, int c_, const void* A_, size_t a_pm_, size_t a_pn_, const void* B_, size_t b_pn_) {
        nM = M / BM; nN = N / BM; nwg = nM * nN; G = G_; c = c_; A = (const char*)A_; B = (const char*)B_; a_pm = a_pm_; a_pn = a_pn_; b_pn = b_pn_; }
    __device__ __forceinline__ bool next(int i, Unit& u) const {
        const long L = (long)i * G + c; if (L >= nwg) return false;
        int wgid = (int)L; { const int q = nwg / NXCD, r = nwg % NXCD, xcd = wgid % NXCD, off = wgid / NXCD; wgid = (xcd < r ? xcd * (q + 1) : r * (q + 1) + (xcd - r) * q) + off; }
        const int nig = WGM * nN, gid = wgid / nig, fm = gid * WGM, gsz = (nM - fm) < WGM ? (nM - fm) : WGM;
        u.pm = fm + ((wgid % nig) % gsz); u.pn = (wgid % nig) / gsz; return true;
    }
    __device__ __forceinline__ const char* a_base(const Unit& u) const { return A + (size_t)u.pm * a_pm + (size_t)u.pn * a_pn; }
    __device__ __forceinline__ unsigned a_voff(const Unit&, int R, int C, int lda) const { return (unsigned)(R * lda + C) * 2u; }
    __device__ __forceinline__ const char* b_base(const Unit& u) const { return B + (size_t)u.pn * b_pn; }
};
constexpr int TI_CNT = 320, LIST_CAP = 65536;
struct MoeOrder {
    const LAS int* tinfo; int ntiles, nN, nwg, G, c;
    const char* A; const char* W; size_t a_tile, w_e, w_pn;
    __device__ __forceinline__ void init(const LAS int* ti, int ntiles_, int nN_, int G_, int c_, const void* A_, size_t a_tile_, const void* W_, size_t w_e_, size_t w_pn_) {
        tinfo = ti; ntiles = ntiles_; nN = nN_; nwg = ntiles_ * nN_; G = G_; c = c_; A = (const char*)A_; a_tile = a_tile_; W = (const char*)W_; w_e = w_e_; w_pn = w_pn_; }
    __device__ __forceinline__ bool next(int i, Unit& u) const {
        const long L = (long)i * G + c; if (L >= nwg) return false;
        int wgid = (int)L; { const int q = nwg / NXCD, r = nwg % NXCD, xcd = wgid % NXCD, off = wgid / NXCD; wgid = (xcd < r ? xcd * (q + 1) : r * (q + 1) + (xcd - r) * q) + off; }
        u.pm = wgid / nN; u.pn = wgid % nN; return true;
    }
    __device__ __forceinline__ const char* a_base(const Unit& u) const { return A + (size_t)u.pm * a_tile; }
    __device__ __forceinline__ const char* b_base(const Unit& u) const { const int e = __builtin_amdgcn_readfirstlane(tinfo[u.pm]) & 255; return W + (size_t)e * w_e + (size_t)u.pn * w_pn; }
    __device__ __forceinline__ unsigned a_voff(const Unit&, int R, int C, int lda) const { return (unsigned)(R * lda + C) * 2u; }
};
struct GatherOrder {
    const LAS int* tinfo; int ntiles, nN, nwg, G, c;
    const char* A; const int* list; const char* W; size_t w_e, w_pn;
    __device__ __forceinline__ void init(const LAS int* ti, int ntiles_, int nN_, int G_, int c_, const void* A_, const int* list_, const void* W_, size_t w_e_, size_t w_pn_) {
        tinfo = ti; ntiles = ntiles_; nN = nN_; nwg = ntiles_ * nN_; G = G_; c = c_; A = (const char*)A_; list = list_; W = (const char*)W_; w_e = w_e_; w_pn = w_pn_; }
    __device__ __forceinline__ bool next(int i, Unit& u) const {
        const long L = (long)i * G + c; if (L >= nwg) return false;
        int wgid = (int)L; { const int q = nwg / NXCD, r = nwg % NXCD, xcd = wgid % NXCD, off = wgid / NXCD; wgid = (xcd < r ? xcd * (q + 1) : r * (q + 1) + (xcd - r) * q) + off; }
        u.pm = wgid / nN; u.pn = wgid % nN; return true;
    }
    __device__ __forceinline__ const char* a_base(const Unit&) const { return A; }
    __device__ __forceinline__ const char* b_base(const Unit& u) const { const int e = __builtin_amdgcn_readfirstlane(tinfo[u.pm]) & 255; return W + (size_t)e * w_e + (size_t)u.pn * w_pn; }
    __device__ __forceinline__ unsigned a_voff(const Unit& u, int R, int C, int lda) const {
        const int ti = tinfo[u.pm], e = ti & 255, r = (ti >> 8) * 256 + R; const int n = tinfo[TI_CNT + e];
        const int ga = (r < n) ? list[(size_t)e * LIST_CAP + r] : 0;
        return (unsigned)(ga >> 1) * (unsigned)(lda * 2) + (unsigned)C * 2u; }
};

#define ACC_T const f32x4 (&acc)[2][2][4][2]
struct EpiBf16 {
    static constexpr bool PERM = true;
    bf16_t* O; size_t ldc;
    __device__ __forceinline__ void operator()(ACC_T, const Unit& u, int wr, int wc, int fr, int fq) const {
        const int row0 = u.pm * BM + wr * 64 + fr, col0 = u.pn * BM + wc * 32 + 8 * fq;
#pragma unroll
        for (int ai = 0; ai < 2; ++ai)
#pragma unroll
            for (int m = 0; m < 4; ++m) { bf16_t* rowp = O + (size_t)(row0 + ai * HALF + m * 16) * ldc + col0;
#pragma unroll
                for (int bj = 0; bj < 2; ++bj) { const f32x4 v0 = acc[ai][bj][m][0], v1 = acc[ai][bj][m][1];
                    u32x4 w; w.x = cvtpk(v0[0], v0[1]); w.y = cvtpk(v0[2], v0[3]); w.z = cvtpk(v1[0], v1[1]); w.w = cvtpk(v1[2], v1[3]);
                    *(u32x4*)(rowp + bj * HALF) = w; } }
    }
};
struct EpiF32 {
    static constexpr bool PERM = false;
    float* O; size_t ldc;
    __device__ __forceinline__ void operator()(ACC_T, const Unit& u, int wr, int wc, int fr, int fq) const {
        const int row0 = u.pm * BM + wr * 64 + fr, col0 = u.pn * BM + wc * 32 + 4 * fq;
#pragma unroll
        for (int ai = 0; ai < 2; ++ai)
#pragma unroll
            for (int m = 0; m < 4; ++m) { float* rowp = O + (size_t)(row0 + ai * HALF + m * 16) * ldc + col0;
#pragma unroll
                for (int bj = 0; bj < 2; ++bj)
#pragma unroll
                    for (int n = 0; n < 2; ++n) *(f32x4*)(rowp + bj * HALF + n * 16) = acc[ai][bj][m][n]; }
    }
};
struct EpiQ {
    static constexpr bool PERM = true;
    bf16_t* Q; const float* cs; const float* sn;
    __device__ __forceinline__ void operator()(ACC_T, const Unit& u, int wr, int wc, int fr, int fq) const {
        const int row0 = u.pm * BM + wr * 64 + fr;
        if (u.pn < 4) {
#pragma unroll
            for (int ai = 0; ai < 2; ++ai)
#pragma unroll
                for (int m = 0; m < 4; ++m) { const int row = row0 + ai * HALF + m * 16;
#pragma unroll
                    for (int bj = 0; bj < 2; ++bj) { const int col = u.pn * BM + bj * HALF + wc * 32 + 8 * fq; const f32x4 v0 = acc[ai][bj][m][0], v1 = acc[ai][bj][m][1];
                        u32x4 w; w.x = cvtpk(v0[0], v0[1]); w.y = cvtpk(v0[2], v0[3]); w.z = cvtpk(v1[0], v1[1]); w.w = cvtpk(v1[2], v1[3]);
                        *(u32x4*)(Q + (size_t)row * QPITCH + (col >> 6) * 96 + (col & 63)) = w; } }
        } else {
            const int head = (u.pn - 4) * 8 + 2 * wc + (fq >> 1), i0 = 8 * (fq & 1);
#pragma unroll
            for (int ai = 0; ai < 2; ++ai)
#pragma unroll
                for (int m = 0; m < 4; ++m) { const int row = row0 + ai * HALF + m * 16;
                    const f32x4 c0 = *(const f32x4*)(cs + (size_t)row * 16 + i0), c1 = *(const f32x4*)(cs + (size_t)row * 16 + i0 + 4);
                    const f32x4 s0 = *(const f32x4*)(sn + (size_t)row * 16 + i0), s1 = *(const f32x4*)(sn + (size_t)row * 16 + i0 + 4);
                    const f32x4 a0 = acc[ai][0][m][0], a1 = acc[ai][0][m][1], b0 = acc[ai][1][m][0], b1 = acc[ai][1][m][1];
                    const f32x4 y10 = a0 * c0 - b0 * s0, y11 = a1 * c1 - b1 * s1, y20 = b0 * c0 + a0 * s0, y21 = b1 * c1 + a1 * s1;
                    u32x4 w1, w2; w1.x = cvtpk(y10[0], y10[1]); w1.y = cvtpk(y10[2], y10[3]); w1.z = cvtpk(y11[0], y11[1]); w1.w = cvtpk(y11[2], y11[3]);
                    w2.x = cvtpk(y20[0], y20[1]); w2.y = cvtpk(y20[2], y20[3]); w2.z = cvtpk(y21[0], y21[1]); w2.w = cvtpk(y21[2], y21[3]);
                    bf16_t* qp = Q + (size_t)row * QPITCH + head * 96 + 64 + i0;
                    *(u32x4*)qp = w1; *(u32x4*)(qp + 16) = w2; asm volatile("" ::: "memory"); }
        }
    }
};
struct EpiPool {
    static constexpr bool PERM = true;
    bf16_t* F; const float* bias; const float* scale;
    __device__ __forceinline__ void operator()(ACC_T, const Unit& u, int wr, int wc, int fr, int fq) const {
        const int row0 = u.pm * BM + wr * 64 + fr, col0 = u.pn * BM + wc * 32 + 8 * fq;
#pragma unroll
        for (int bj = 0; bj < 2; ++bj) { const int c = col0 + bj * HALF;
            const f32x4 b0 = *(const f32x4*)(bias + c), b1 = *(const f32x4*)(bias + c + 4), s0 = *(const f32x4*)(scale + c), s1 = *(const f32x4*)(scale + c + 4);
#pragma unroll
            for (int ai = 0; ai < 2; ++ai)
#pragma unroll
                for (int m = 0; m < 4; ++m) { const f32x4 v0 = (acc[ai][bj][m][0] + b0) * s0, v1 = (acc[ai][bj][m][1] + b1) * s1;
                    u32x4 w; w.x = cvtpk(v0[0], v0[1]); w.y = cvtpk(v0[2], v0[3]); w.z = cvtpk(v1[0], v1[1]); w.w = cvtpk(v1[2], v1[3]);
                    *(u32x4*)(F + (size_t)(row0 + ai * HALF + m * 16) * 1024 + c) = w; } }
    }
};
struct EpiRouter {
    static constexpr bool PERM = false;
    float* LG;
    __device__ __forceinline__ void operator()(ACC_T, const Unit& u, int wr, int wc, int fr, int fq) const {
        const int row0 = u.pm * BM + wr * 64 + fr;
#pragma unroll
        for (int ai = 0; ai < 2; ++ai)
#pragma unroll
            for (int m = 0; m < 4; ++m) { float* lr = LG + ((size_t)u.pn * NTOK + (size_t)(row0 + ai * HALF + m * 16)) * LGP;
#pragma unroll
                for (int n = 0; n < 2; ++n) { const int j = wc * 32 + 16 * n + 4 * fq; if (j < 72) *(f32x4*)(lr + j) = acc[ai][0][m][n] + acc[ai][1][m][n]; } }
    }
};
struct EpiSwiglu {
    static constexpr bool PERM = true;
    bf16_t* H;
    __device__ __forceinline__ void operator()(ACC_T, const Unit& u, int wr, int wc, int fr, int fq) const {
        const int row0 = u.pm * BM + wr * 64 + fr, col0 = u.pn * HALF + wc * 32 + 8 * fq;
#pragma unroll
        for (int ai = 0; ai < 2; ++ai)
#pragma unroll
            for (int m = 0; m < 4; ++m) { float h[8];
#pragma unroll
                for (int n = 0; n < 2; ++n)
#pragma unroll
                    for (int e = 0; e < 4; ++e) { const float a = acc[ai][0][m][n][e], b = acc[ai][1][m][n][e];
                        h[n * 4 + e] = a * __builtin_amdgcn_rcpf(1.0f + __builtin_amdgcn_exp2f(-1.4426950408889634f * a)) * b; }
                u32x4 w; w.x = cvtpk(h[0], h[1]); w.y = cvtpk(h[2], h[3]); w.z = cvtpk(h[4], h[5]); w.w = cvtpk(h[6], h[7]);
                *(u32x4*)(H + (size_t)(row0 + ai * HALF + m * 16) * D_EXPERT + col0) = w; }
    }
};
struct EpiMoeOut {
    static constexpr bool PERM = true;
    bf16_t* Y; const LAS int* tinfo; const int* list; const float* lgate;
    __device__ __forceinline__ void operator()(ACC_T, const Unit& u, int wr, int wc, int fr, int fq) const {
        const int ti = tinfo[u.pm], e = ti & 255, n = tinfo[TI_CNT + e], r0 = (ti >> 8) * 256 + wr * 64 + fr, col0 = u.pn * BM + wc * 32 + 8 * fq;
#pragma unroll
        for (int ai = 0; ai < 2; ++ai)
#pragma unroll
            for (int m = 0; m < 4; ++m) { const int r = r0 + ai * HALF + m * 16;
                if (r < n) { const size_t li = (size_t)e * LIST_CAP + r; const int ga = list[li]; const float g = lgate[li]; bf16_t* yp = Y + (size_t)ga * D_MODEL + col0;
#pragma unroll
                    for (int bj = 0; bj < 2; ++bj) { const f32x4 v0 = acc[ai][bj][m][0] * g, v1 = acc[ai][bj][m][1] * g;
                        u32x4 w; w.x = cvtpk(v0[0], v0[1]); w.y = cvtpk(v0[2], v0[3]); w.z = cvtpk(v1[0], v1[1]); w.w = cvtpk(v1[2], v1[3]);
                        *(u32x4*)(yp + bj * HALF) = w; } }
                if (m & 1) asm volatile("" ::: "memory"); }
    }
};
#undef ACC_T

template <class Epi, class Sched, bool ALIGN_EPI>
__device__ __forceinline__ void gemm_phase(LAS unsigned char* lds, const Gemm g, const Sched& S, const Epi& E) {
    const int tid = opaque(threadIdx.x), wid = __builtin_amdgcn_readfirstlane(tid >> 6), lane = tid & 63, wr = wid >> 2, wc = wid & 3, fr = lane & 15, fq = lane >> 4;
    const int K = opaque_s(g.K), nt = K / BK;
    unsigned voffB[2]; int Rr[2], Cc[2];
#pragma unroll
    for (int i = 0; i < 2; ++i) { int R, C; stage_rc(tid * 16 + i * 8192, R, C); const int Rb = Epi::PERM ? ((R & ~31) + perm32(R & 31)) : R;
        Rr[i] = R; Cc[i] = C; voffB[i] = (unsigned)(Rb * g.ldb + C) * 2u; }
    const size_t kstep = (size_t)(BK * 2);
    const size_t hstepB = (size_t)HALF * g.ldb * 2;
    const unsigned ldsw = (unsigned)wid * 1024u;
    const int aoff = lds_byte(wr * 64 + fr, fq * 8), boff = lds_byte(wc * 32 + fr, fq * 8);
#define PG8_SA(b, h) (((b) * 2 + (h)) * HTB)
#define PG8_SB(b, h) ((4 + (b) * 2 + (h)) * HTB)
#define PG8_STAGE(bufoff, gbase, voff) do { _Pragma("unroll") for (int _i = 0; _i < 2; ++_i) \
        __builtin_amdgcn_global_load_lds((const unsigned*)((const char*)(gbase) + (voff)[_i]), (LAS unsigned*)(lds + (bufoff) + ldsw + _i * 8192), 16, 0, 0); } while (0)
#define PG8_LDA(dst, b, h) do { _Pragma("unroll") for (int m = 0; m < 4; ++m) _Pragma("unroll") for (int k = 0; k < 2; ++k) dst[m][k] = *(const LAS bf16x8*)(lds + PG8_SA(b, h) + aoff + m * 2048 + k * 1024); } while (0)
#define PG8_LDB(dst, b, h) do { _Pragma("unroll") for (int n = 0; n < 2; ++n) _Pragma("unroll") for (int k = 0; k < 2; ++k) dst[n][k] = *(const LAS bf16x8*)(lds + PG8_SB(b, h) + boff + n * 2048 + k * 1024); } while (0)
#define PG8_MMA(ai, bj, At, Bt) do { __builtin_amdgcn_s_setprio(1); _Pragma("unroll") for (int m = 0; m < 4; ++m) _Pragma("unroll") for (int n = 0; n < 2; ++n) _Pragma("unroll") for (int k = 0; k < 2; ++k) \
        acc[ai][bj][m][n] = __builtin_amdgcn_mfma_f32_16x16x32_bf16(Bt[n][k], At[m][k], acc[ai][bj][m][n], 0, 0, 0); __builtin_amdgcn_s_setprio(0); } while (0)
#define PG8_WAIT_V(n) asm volatile("s_waitcnt vmcnt(" #n ")" ::: "memory")
#define PG8_WAIT_L(n) asm volatile("s_waitcnt lgkmcnt(" #n ")" ::: "memory")
#define PG8_BAR __builtin_amdgcn_s_barrier()
#define PG8_SCHED __builtin_amdgcn_sched_barrier(0)
    Unit cur, nxt; int ui = 0;
    if (!S.next(0, cur)) return;
    f32x4 acc[2][2][4][2];
#pragma unroll
    for (int a = 0; a < 2; ++a)
#pragma unroll
        for (int b = 0; b < 2; ++b)
#pragma unroll
            for (int m = 0; m < 4; ++m)
#pragma unroll
                for (int n = 0; n < 2; ++n) acc[a][b][m][n] = (f32x4){0.f, 0.f, 0.f, 0.f};
    bf16x8 At[4][2], B0[2][2], B1[2][2];
    const char* cA = S.a_base(cur); const char* cB = S.b_base(cur);
    unsigned vA[2][2], vN[2][2];
#pragma unroll
    for (int h = 0; h < 2; ++h)
#pragma unroll
        for (int i = 0; i < 2; ++i) { vA[h][i] = S.a_voff(cur, Rr[i] + h * HALF, Cc[i], g.lda); vN[h][i] = vA[h][i]; }
    PG8_STAGE(PG8_SB(0, 0), cB, voffB); PG8_STAGE(PG8_SB(0, 1), cB + hstepB, voffB); PG8_STAGE(PG8_SA(0, 0), cA, vA[0]); PG8_STAGE(PG8_SA(0, 1), cA, vA[1]);
    if (wr == 1) PG8_BAR;
    PG8_WAIT_V(2); PG8_BAR;
    PG8_STAGE(PG8_SB(1, 0), cB + kstep, voffB); PG8_STAGE(PG8_SA(1, 0), cA + kstep, vA[0]); PG8_STAGE(PG8_SB(1, 1), cB + hstepB + kstep, voffB);
    PG8_WAIT_V(6); PG8_BAR;
    for (;;) {
        const bool has_next = S.next(ui + 1, nxt);
        const char* nA = has_next ? S.a_base(nxt) : cA; const char* nB = has_next ? S.b_base(nxt) : cB;
        if (has_next) {
#pragma unroll
            for (int h = 0; h < 2; ++h)
#pragma unroll
                for (int i = 0; i < 2; ++i) vN[h][i] = S.a_voff(nxt, Rr[i] + h * HALF, Cc[i], g.lda);
        }
#pragma nounroll
        for (int t = 0; t < nt; t += 2) {
            const bool last = (t == nt - 2);
            const char* a1 = cA + (size_t)(t + 1) * kstep;
            const char* a2 = last ? nA : cA + (size_t)(t + 2) * kstep; const char* b2 = last ? nB : cB + (size_t)(t + 2) * kstep;
            const char* a3 = a2 + kstep; const char* b3 = b2 + kstep;
            unsigned w0[2], w1[2];
#pragma unroll
            for (int i = 0; i < 2; ++i) { w0[i] = last ? vN[0][i] : vA[0][i]; w1[i] = last ? vN[1][i] : vA[1][i]; }
            PG8_LDB(B0, 0, 0); PG8_LDB(B1, 0, 1); PG8_SCHED; PG8_LDA(At, 0, 0); PG8_STAGE(PG8_SA(1, 1), a1, vA[1]);
            PG8_WAIT_V(8); PG8_WAIT_L(0); PG8_BAR; PG8_MMA(0, 0, At, B0); PG8_MMA(0, 1, At, B1); PG8_BAR; PG8_SCHED;
            PG8_LDA(At, 0, 1); PG8_STAGE(PG8_SB(0, 0), b2, voffB); PG8_STAGE(PG8_SB(0, 1), b2 + hstepB, voffB); PG8_STAGE(PG8_SA(0, 0), a2, w0);
            PG8_WAIT_V(8); PG8_WAIT_L(0); PG8_BAR; PG8_MMA(1, 0, At, B0); PG8_MMA(1, 1, At, B1); PG8_BAR; PG8_SCHED;
            PG8_LDB(B0, 1, 0); PG8_LDB(B1, 1, 1); PG8_SCHED; PG8_LDA(At, 1, 0); PG8_STAGE(PG8_SA(0, 1), a2, w1);
            PG8_WAIT_V(8); PG8_WAIT_L(0); PG8_BAR; PG8_MMA(0, 0, At, B0); PG8_MMA(0, 1, At, B1); PG8_BAR; PG8_SCHED;
            PG8_LDA(At, 1, 1); PG8_STAGE(PG8_SB(1, 0), b3, voffB); PG8_STAGE(PG8_SB(1, 1), b3 + hstepB, voffB); PG8_STAGE(PG8_SA(1, 0), a3, w0);
            PG8_WAIT_V(8); PG8_WAIT_L(0); PG8_BAR; PG8_MMA(1, 0, At, B0); PG8_MMA(1, 1, At, B1); PG8_BAR; PG8_SCHED;
        }
        if constexpr (ALIGN_EPI) { if (wr == 0) PG8_BAR; }
        E(acc, cur, wr, wc, fr, fq);
        if (!has_next) break;
#pragma unroll
        for (int a = 0; a < 2; ++a)
#pragma unroll
            for (int b = 0; b < 2; ++b)
#pragma unroll
                for (int m = 0; m < 4; ++m)
#pragma unroll
                    for (int n = 0; n < 2; ++n) acc[a][b][m][n] = (f32x4){0.f, 0.f, 0.f, 0.f};
        cur = nxt; cA = nA; cB = nB; ++ui;
#pragma unroll
        for (int h = 0; h < 2; ++h)
#pragma unroll
            for (int i = 0; i < 2; ++i) vA[h][i] = vN[h][i];
        if constexpr (ALIGN_EPI) { if (wr == 1) PG8_BAR; }
    }
    PG8_WAIT_V(0);
    if constexpr (!ALIGN_EPI) { if (wr == 0) PG8_BAR; }
    PG8_BAR;
#undef PG8_SA
#undef PG8_SB
#undef PG8_STAGE
#undef PG8_LDA
#undef PG8_LDB
#undef PG8_MMA
#undef PG8_WAIT_V
#undef PG8_WAIT_L
#undef PG8_BAR
#undef PG8_SCHED
}
}

namespace att {
constexpr int KSLOT = 12288, VSLOT = 8192, LDS_K = 0, LDS_V = 3 * KSLOT, LDS_BYTES = LDS_V + 3 * VSLOT;
constexpr float THR = 6.0f;
__device__ __forceinline__ int nx3(int s) { return s == 2 ? 0 : s + 1; }
__device__ __forceinline__ int pv3(int s) { return s == 0 ? 2 : s - 1; }
__device__ __forceinline__ void glds16(const void* g, LAS unsigned char* l) { __builtin_amdgcn_global_load_lds((const unsigned*)g, (LAS unsigned*)l, 16, 0, 0); }

template <bool FIRST, bool GEN>
__device__ __forceinline__ void att_step(f32x16& c0, f32x16& c1, f32x16& n0, f32x16& n1, f32x16& o0, f32x16& o1, f32x16& negm, float& mhat, float& lsum, u32x4 (&pw)[4], const bf16x8 (&qr)[6],
                                         const LAS unsigned char* kb_next, const LAS unsigned char* vb_prev, bool act_prev, bool act_cur, bool act_nxt, int jb, int qrel, int hi) {
    if (!FIRST && (!GEN || act_prev)) {
#pragma unroll
        for (int kc2 = 0; kc2 < 4; ++kc2) {
            const bf16x8 v0 = *(const LAS bf16x8*)(vb_prev + kc2 * 2048), v1 = *(const LAS bf16x8*)(vb_prev + kc2 * 2048 + 512);
            const bf16x8 pf = __builtin_bit_cast(bf16x8, pw[kc2]);
            o0 = __builtin_amdgcn_mfma_f32_32x32x16_bf16(v0, pf, o0, 0, 0, 0);
            o1 = __builtin_amdgcn_mfma_f32_32x32x16_bf16(v1, pf, o1, 0, 0, 0);
        }
    }
    if (!GEN || act_cur) {
        if ((GEN || FIRST) && jb >= 0) {
            const int kb0 = 64 * jb + 8 * hi;
#pragma unroll
            for (int r = 0; r < 16; ++r) { const int key = kb0 + (r & 3) + 4 * ((r >> 2) & 1) + 16 * (r >> 3);
                if (key > qrel) c0[r] = -INFINITY; if (key + 32 > qrel) c1[r] = -INFINITY; }
        }
        float ra = fmaxf(fmaxf(c0[0], c0[1]), c1[0]), rb = fmaxf(fmaxf(c0[2], c0[3]), c1[1]);
        ra = fmaxf(fmaxf(ra, c1[2]), c1[3]);
#pragma unroll
        for (int r = 4; r < 16; r += 4) { ra = fmaxf(fmaxf(ra, c0[r]), c0[r + 1]); rb = fmaxf(fmaxf(rb, c0[r + 2]), c0[r + 3]); ra = fmaxf(fmaxf(ra, c1[r]), c1[r + 1]); rb = fmaxf(fmaxf(rb, c1[r + 2]), c1[r + 3]); }
        float rm = fmaxf(ra, rb);
        { auto rr = __builtin_amdgcn_permlane32_swap(__float_as_uint(rm), __float_as_uint(rm), false, false); rm = fmaxf(__uint_as_float(rr[0]), __uint_as_float(rr[1])); }
        if (FIRST) {
            mhat = rm;
#pragma unroll
            for (int r = 0; r < 16; ++r) { c0[r] -= rm; c1[r] -= rm; negm[r] = -rm; }
        } else if (__any(rm > THR)) {
            const float dl = fmaxf(rm, 0.f); mhat += dl;
            const float f = __builtin_amdgcn_exp2f(-dl); lsum *= f;
#pragma unroll
            for (int r = 0; r < 16; ++r) { c0[r] -= dl; c1[r] -= dl; o0[r] *= f; o1[r] *= f; negm[r] = -mhat; }
        }
    }
    if (!GEN || act_nxt) {
        n0 = negm; n1 = negm;
#pragma unroll
        for (int d0 = 0; d0 < 6; ++d0) {
            const bf16x8 k0 = *(const LAS bf16x8*)(kb_next + d0 * 2048), k1 = *(const LAS bf16x8*)(kb_next + d0 * 2048 + 512);
            n0 = __builtin_amdgcn_mfma_f32_32x32x16_bf16(k0, qr[d0], n0, 0, 0, 0);
            n1 = __builtin_amdgcn_mfma_f32_32x32x16_bf16(k1, qr[d0], n1, 0, 0, 0);
        }
    }
    if (!GEN || act_cur) {
        float sa = 0.f, sb = 0.f;
#pragma unroll
        for (int r = 0; r < 16; ++r) { c0[r] = __builtin_amdgcn_exp2f(c0[r]); c1[r] = __builtin_amdgcn_exp2f(c1[r]); sa += c0[r]; sb += c1[r]; }
        lsum += sa + sb;
#pragma unroll
        for (int i = 0; i < 2; ++i) {
            pw[i] = (u32x4){cvtpk(c0[8 * i], c0[8 * i + 1]), cvtpk(c0[8 * i + 2], c0[8 * i + 3]), cvtpk(c0[8 * i + 4], c0[8 * i + 5]), cvtpk(c0[8 * i + 6], c0[8 * i + 7])};
            pw[2 + i] = (u32x4){cvtpk(c1[8 * i], c1[8 * i + 1]), cvtpk(c1[8 * i + 2], c1[8 * i + 3]), cvtpk(c1[8 * i + 4], c1[8 * i + 5]), cvtpk(c1[8 * i + 6], c1[8 * i + 7])};
        }
    }
}

__device__ __forceinline__ void attn_unit(int b, int h, int qb, const bf16_t* __restrict__ Q, const bf16_t* __restrict__ KN, const bf16_t* __restrict__ KR, const bf16_t* __restrict__ VT, bf16_t* __restrict__ O, LAS unsigned char* lds) {
    const int tid = opaque(threadIdx.x), lane = tid & 63, r32 = lane & 31, hi = lane >> 5;
    const int w = __builtin_amdgcn_readfirstlane(tid >> 6);
    const size_t tok0 = (size_t)b * SEQ;
    const int q0 = qb * 256, NT = 4 * (qb + 1);
    const bf16_t* ksrc = KN + (tok0 + lane) * 1024 + h * 64 + 8 * w;
    const bf16_t* rsrc = KR + (tok0 + lane) * 32 + 8 * (w & 3);
    const bf16_t* vsrc = VT + (size_t)(h * 64 + lane) * NTOK + tok0 + 8 * w;
#define ATT_ISSUE_K(t, slot) do { glds16(ksrc + (size_t)(t) * 65536, lds + LDS_K + (slot) * KSLOT + w * 1024); \
        if (w < 4) glds16(rsrc + (size_t)(t) * 2048, lds + LDS_K + (slot) * KSLOT + (8 + w) * 1024); } while (0)
#define ATT_ISSUE_V(t, slot) glds16(vsrc + (size_t)(t) * 64, lds + LDS_V + (slot) * VSLOT + w * 1024)
    ATT_ISSUE_K(0, 0); ATT_ISSUE_K(1, 1); ATT_ISSUE_K(2, 2); ATT_ISSUE_V(0, 0);
    bf16x8 qr[6];
    { const bf16_t* qp = Q + (tok0 + q0 + w * 32 + r32) * QPITCH + h * 96 + hi * 8;
#pragma unroll
      for (int d0 = 0; d0 < 6; ++d0) qr[d0] = *(const bf16x8*)(qp + d0 * 16); }
    const int kvp = (r32 & 19) | ((r32 & 4) << 1) | ((r32 & 8) >> 1);
    const LAS unsigned char* kf = lds + LDS_K + hi * 1024 + kvp * 16;
    const LAS unsigned char* vf = lds + LDS_V + hi * 1024 + r32 * 16;
    float mhat = 0.f, lsum = 0.f;
    f32x16 o0 = {}, o1 = {}, negm = {}, sA0 = {}, sA1 = {}, sB0, sB1;
    u32x4 pw[4] = {};
    const int qrel = w * 32 + r32, wb = w >> 1;
    asm volatile("s_waitcnt vmcnt(0)" ::: "memory");
    __builtin_amdgcn_s_barrier();
    asm volatile("" ::: "memory");
#pragma unroll
    for (int d0 = 0; d0 < 6; ++d0) {
        const bf16x8 k0 = *(const LAS bf16x8*)(kf + d0 * 2048), k1 = *(const LAS bf16x8*)(kf + d0 * 2048 + 512);
        sA0 = __builtin_amdgcn_mfma_f32_32x32x16_bf16(k0, qr[d0], sA0, 0, 0, 0);
        sA1 = __builtin_amdgcn_mfma_f32_32x32x16_bf16(k1, qr[d0], sA1, 0, 0, 0);
    }
    int st = 0;
#define ATT_SYNC(t) do { \
        if ((t) == 0 || (t) + 2 >= NT) asm volatile("s_waitcnt vmcnt(0)" ::: "memory"); \
        else if (w < 4) asm volatile("s_waitcnt vmcnt(3)" ::: "memory"); \
        else asm volatile("s_waitcnt vmcnt(2)" ::: "memory"); \
        __builtin_amdgcn_s_barrier(); asm volatile("" ::: "memory"); \
        if ((t) + 3 < NT) ATT_ISSUE_K((t) + 3, st); \
        if ((t) + 1 < NT) ATT_ISSUE_V((t) + 1, nx3(st)); } while (0)
#define ATT_ACT(tt) (((tt) - (NT - 4)) < 0 || ((tt) - (NT - 4)) <= wb)
#define ATT_STEP(FIRST, GEN, C0, C1, N0, N1, t) do { ATT_SYNC(t); \
        att_step<FIRST, GEN>(C0, C1, N0, N1, o0, o1, negm, mhat, lsum, pw, qr, kf + nx3(st) * KSLOT, vf + pv3(st) * VSLOT, \
                             (t) > 0 && ATT_ACT((t) - 1), ATT_ACT(t), (t) + 1 < NT && ATT_ACT((t) + 1), (t) - (NT - 4), qrel, hi); \
        st = nx3(st); } while (0)
    ATT_STEP(true, true, sA0, sA1, sB0, sB1, 0);
    int t = 1;
    const int ts = (NT > 4) ? NT - 5 : 1;
    for (; t + 1 < ts; t += 2) {
        ATT_STEP(false, false, sB0, sB1, sA0, sA1, t);
        ATT_STEP(false, false, sA0, sA1, sB0, sB1, t + 1);
    }
    if (NT > 4) { ATT_STEP(false, true, sB0, sB1, sA0, sA1, NT - 5); ATT_STEP(false, true, sA0, sA1, sB0, sB1, NT - 4); }
    ATT_STEP(false, true, sB0, sB1, sA0, sA1, NT - 3);
    ATT_STEP(false, true, sA0, sA1, sB0, sB1, NT - 2);
    ATT_STEP(false, true, sB0, sB1, sA0, sA1, NT - 1);
    if (ATT_ACT(NT - 1)) {
        const LAS unsigned char* vb = vf + pv3(st) * VSLOT;
#pragma unroll
        for (int kc2 = 0; kc2 < 4; ++kc2) {
            const bf16x8 v0 = *(const LAS bf16x8*)(vb + kc2 * 2048), v1 = *(const LAS bf16x8*)(vb + kc2 * 2048 + 512);
            const bf16x8 pf = __builtin_bit_cast(bf16x8, pw[kc2]);
            o0 = __builtin_amdgcn_mfma_f32_32x32x16_bf16(v0, pf, o0, 0, 0, 0);
            o1 = __builtin_amdgcn_mfma_f32_32x32x16_bf16(v1, pf, o1, 0, 0, 0);
        }
    }
    { auto rr = __builtin_amdgcn_permlane32_swap(__float_as_uint(lsum), __float_as_uint(lsum), false, false); lsum = __uint_as_float(rr[0]) + __uint_as_float(rr[1]); }
    const float inv = 1.0f / lsum;
    bf16_t* op = O + (tok0 + q0 + w * 32 + r32) * 1024 + h * 64 + 4 * hi;
#pragma unroll
    for (int g = 0; g < 4; ++g) {
        u32x2 a, c; a.x = cvtpk(o0[4 * g] * inv, o0[4 * g + 1] * inv); a.y = cvtpk(o0[4 * g + 2] * inv, o0[4 * g + 3] * inv);
        c.x = cvtpk(o1[4 * g] * inv, o1[4 * g + 1] * inv); c.y = cvtpk(o1[4 * g + 2] * inv, o1[4 * g + 3] * inv);
        *(u32x2*)(op + 8 * g) = a; *(u32x2*)(op + 32 + 8 * g) = c;
    }
    asm volatile("s_waitcnt lgkmcnt(0)" ::: "memory");
    __builtin_amdgcn_s_barrier();
#undef ATT_ISSUE_K
#undef ATT_ISSUE_V
#undef ATT_SYNC
#undef ATT_ACT
#undef ATT_STEP
}
}

#define XB_TMO      128
#define XB_XCNT(j)  (256  + 64 * (j))
#define XB_XSUB(j)  (1280 + 64 * (j))
#define XB_XGEN(j)  (2304 + 64 * (j))
#define XB_TOP      3328
#define XB_TOPGEN   3392
#define XCD_BAR_WORDS 3456
#define XB_SPIN_CAP (1u << 18)
__device__ __forceinline__ unsigned xb_ld(unsigned* p)              { return __hip_atomic_load(p, __ATOMIC_RELAXED, __HIP_MEMORY_SCOPE_AGENT); }
__device__ __forceinline__ unsigned xb_add(unsigned* p, unsigned v) { return __hip_atomic_fetch_add(p, v, __ATOMIC_RELAXED, __HIP_MEMORY_SCOPE_AGENT); }
__device__ __forceinline__ unsigned xb_xcc_id() { return (unsigned)__builtin_amdgcn_s_getreg((3 << 11) | 20) & 0xFu; }
#define XB_SPIN(cond, bar) do { unsigned _sp = 0; while (cond) { __builtin_amdgcn_s_sleep(1); \
    if ((++_sp & 255u) == 0u) { if (xb_ld(&(bar)[XB_TMO])) break; if (_sp > XB_SPIN_CAP) { atomicAdd(&(bar)[XB_TMO], 1u); break; } } } } while (0)
struct XcdBarrier { unsigned* bar; unsigned x; volatile LAS unsigned* st; };
__device__ __forceinline__ XcdBarrier xcd_barrier_post(unsigned* bar, volatile LAS unsigned* st) {
    XcdBarrier b; b.bar = bar; b.x = xb_xcc_id(); b.st = st;
    if (threadIdx.x == 0) (void)xb_add(&bar[XB_XCNT(b.x)], 1u);
    return b;
}
__device__ __forceinline__ void xcd_barrier_complete(unsigned* bar, unsigned x, unsigned& nloc, unsigned& nx) {
    const unsigned G = gridDim.x * gridDim.y * gridDim.z;
    unsigned sum, cnt, mine, sp = 0u;
    for (;;) {
        sum = 0u; cnt = 0u; mine = 0u;
#pragma unroll
        for (unsigned j = 0; j < 16; ++j) { const unsigned c = xb_ld(&bar[XB_XCNT(j)]); sum += c; cnt += (c > 0u) ? 1u : 0u; mine = (j == x) ? c : mine; }
        if (sum == G) break;
        __builtin_amdgcn_s_sleep(1);
        if ((++sp & 255u) == 0u) { if (xb_ld(&bar[XB_TMO])) break; if (sp > XB_SPIN_CAP) { atomicAdd(&bar[XB_TMO], 1u); break; } }
    }
    nloc = mine > 0u ? mine : 1u; nx = cnt > 0u ? cnt : 1u;
}
__device__ __forceinline__ void xcd_barrier(const XcdBarrier& b) {
    asm volatile("s_waitcnt vmcnt(0)" ::: "memory");
    __syncthreads();
    if (threadIdx.x == 0) {
        unsigned* bar = b.bar;
        __builtin_amdgcn_s_waitcnt(0);
        unsigned nloc = b.st[0], nx = b.st[1];
        if (nloc == 0u) { xcd_barrier_complete(bar, b.x, nloc, nx); b.st[0] = nloc; b.st[1] = nx; }
        const unsigned old = xb_add(&bar[XB_XSUB(b.x)], 1u);
        const unsigned gen = old / nloc;
        if (old + 1u == (gen + 1u) * nloc) {
            __builtin_amdgcn_fence(__ATOMIC_RELEASE, "agent");
            asm volatile("s_waitcnt vmcnt(0)" ::: "memory");
            const unsigned og = xb_add(&bar[XB_TOP], 1u);
            const unsigned tg = og / nx;
            if (og + 1u == (tg + 1u) * nx) xb_add(&bar[XB_TOPGEN], 1u);
            else XB_SPIN(xb_ld(&bar[XB_TOPGEN]) == tg, bar);
            __builtin_amdgcn_fence(__ATOMIC_ACQUIRE, "agent");
            xb_add(&bar[XB_XGEN(b.x)], 1u);
            asm volatile("s_waitcnt vmcnt(0)" ::: "memory");
        } else {
            XB_SPIN(xb_ld(&bar[XB_XGEN(b.x)]) == gen, bar);
            __builtin_amdgcn_fence(__ATOMIC_ACQUIRE, "agent");
            asm volatile("s_waitcnt vmcnt(0)" ::: "memory");
        }
    }
    __syncthreads();
}

struct Args { const void* in[20]; float* out; unsigned char* ws; int ph_lo, ph_hi; };
typedef const __attribute__((address_space(4))) Args* KArgs;
__device__ __forceinline__ KArgs kargs() { KArgs p = (KArgs)__builtin_amdgcn_kernarg_segment_ptr(); asm volatile("" : "+s"(p)); return p; }
constexpr int NWAVES = 8;
constexpr int PPL = 12;
constexpr int NPHASE = 1 + DEPTH * PPL;

__constant__ double c_invf[16] = {1.0, 0.5623413251903491, 0.31622776601683794, 0.1778279410038923, 0.1, 0.05623413251903491, 0.03162277660168379, 0.01778279410038923,
                                  0.01, 0.005623413251903491, 0.0031622776601683794, 0.0017782794100389228, 0.001, 0.0005623413251903491, 0.00031622776601683794, 0.00017782794100389227};

__device__ __forceinline__ void transpose_item(const float* __restrict__ W, int ldw, int k0, int n0, bf16_t* __restrict__ WT, int ldt, int drow0, float mul, LAS float* scr, int lane) {
#pragma unroll 8
    for (int i = 0; i < 32; ++i) { const int kk = 2 * i + (lane >> 5); scr[kk * 33 + (lane & 31)] = W[(size_t)(k0 + kk) * ldw + n0 + (lane & 31)]; }
    LDS_WAIT(); asm volatile("" ::: "memory");
    const int c = lane & 7;
#pragma unroll
    for (int j = 0; j < 4; ++j) { const int n = (lane >> 3) + 8 * j; const LAS float* s = scr + (8 * c) * 33 + n;
        u32x4 o; o.x = cvtpk(s[0 * 33] * mul, s[1 * 33] * mul); o.y = cvtpk(s[2 * 33] * mul, s[3 * 33] * mul); o.z = cvtpk(s[4 * 33] * mul, s[5 * 33] * mul); o.w = cvtpk(s[6 * 33] * mul, s[7 * 33] * mul);
        *(u32x4*)(WT + (size_t)(drow0 + n) * ldt + k0 + 8 * c) = o; }
    LDS_WAIT(); asm volatile("" ::: "memory");
}

__device__ __forceinline__ void transpose_item64(const float* __restrict__ W, int ldw, int k0, int n0, bf16_t* __restrict__ WT, int ldt, int drow0, LAS float* scr, int lane) {
    f32x4 v[16];
    const float* src = W + (size_t)(k0 + (lane >> 4)) * ldw + n0 + 4 * (lane & 15);
#pragma unroll
    for (int i = 0; i < 16; ++i) v[i] = *(const f32x4*)(src + (size_t)(4 * i) * ldw);
#pragma unroll
    for (int i = 0; i < 16; ++i) *(LAS f32x4*)(scr + (4 * i + (lane >> 4)) * 68 + 4 * (lane & 15)) = v[i];
    LDS_WAIT(); asm volatile("" ::: "memory");
    bf16_t* dst = WT + (size_t)(drow0 + lane) * ldt + k0;
#pragma unroll
    for (int c = 0; c < 8; ++c) { const LAS float* sp = scr + (8 * c) * 68 + lane;
        u32x4 o; o.x = cvtpk(sp[0], sp[68]); o.y = cvtpk(sp[2 * 68], sp[3 * 68]); o.z = cvtpk(sp[4 * 68], sp[5 * 68]); o.w = cvtpk(sp[6 * 68], sp[7 * 68]);
        *(u32x4*)(dst + 8 * c) = o; }
    LDS_WAIT(); asm volatile("" ::: "memory");
}

__device__ __forceinline__ void sincos_d(double a, float& s, float& c) {
    const double TWO_PI_HI = 6.283185307179586, TWO_PI_LO = 2.4492935982947064e-16, INV_2PI = 0.15915494309189535;
    const double n = __builtin_rint(a * INV_2PI);
    double r = __builtin_fma(-n, TWO_PI_HI, a); r = __builtin_fma(-n, TWO_PI_LO, r);
    const double HALF_PI = 1.5707963267948966, HALF_PI_LO = 6.123233995736766e-17;
    const double qd = __builtin_rint(r * 0.6366197723675814);
    double y = __builtin_fma(-qd, HALF_PI, r); y = __builtin_fma(-qd, HALF_PI_LO, y);
    const int q = ((int)qd) & 3;
    const double y2 = y * y;
    double sp = -7.647163731819816e-13; sp = sp * y2 + 1.6059043836821613e-10; sp = sp * y2 - 2.505210838544172e-08; sp = sp * y2 + 2.7557319223985893e-06; sp = sp * y2 - 0.0001984126984126984;
    sp = sp * y2 + 0.008333333333333333; sp = sp * y2 - 0.16666666666666666; sp = y + y * y2 * sp;
    double cp = 4.779477332387385e-14; cp = cp * y2 - 1.1470745597729725e-11; cp = cp * y2 + 2.08767569878681e-09; cp = cp * y2 - 2.755731922398589e-07; cp = cp * y2 + 2.48015873015873e-05;
    cp = cp * y2 - 0.001388888888888889; cp = cp * y2 + 0.041666666666666664; cp = cp * y2 - 0.5; cp = 1.0 + y2 * cp;
    double ss, cc;
    if (q == 0) { ss = sp; cc = cp; } else if (q == 1) { ss = cp; cc = -sp; } else if (q == 2) { ss = -sp; cc = -cp; } else { ss = -cp; cc = sp; }
    s = (float)ss; c = (float)cc;
}

__global__ void __launch_bounds__(NWAVES * 64, 2) mk_fwd(Args args_unused) {
    extern __shared__ __attribute__((aligned(16))) unsigned char lds_raw[];
    LAS unsigned char* lds = (LAS unsigned char*)lds_raw;
    volatile LAS unsigned* MISC = (volatile LAS unsigned*)(lds + MISC_OFF);
    int tid = threadIdx.x, lane = tid & 63, wave = __builtin_amdgcn_readfirstlane(tid >> 6);
    const int G = gridDim.x, bx = blockIdx.x;
    const int vcu = (G % 8 == 0) ? (bx % 8) * (G / 8) + bx / 8 : bx;
    int gw = vcu * NWAVES + wave; const int NGW = G * NWAVES;
#define ws (kargs()->ws)
    unsigned* ctl = (unsigned*)(ws + WS_CTL);
    for (int u = tid; u < (LDS_BYTES - LDSCTL_OFF) / 4; u += NWAVES * 64) ((LAS unsigned*)(lds + LDSCTL_OFF))[u] = 0u;
    __syncthreads();
    XcdBarrier bar; bar.bar = ctl + CW_BAR; bar.x = 0; bar.st = nullptr;
#if MK_ONE_LAUNCH
    bar = xcd_barrier_post(ctl + CW_BAR, MISC + 8);
#endif
    const int lo = kargs()->ph_lo, hi = kargs()->ph_hi;
#ifndef MK_REP_MASK
#define MK_REP_MASK 0u
#endif
#define NREP(b) (1 + (int)((MK_REP_MASK >> (b)) & 1u))
#ifndef MK_PH_MASK
#define MK_PH_MASK 0xffffffffu
#endif
#define PHON(b) ((MK_PH_MASK >> (b)) & 1u)
#define IN(k) (lo <= (k) && (k) < hi)
#if MK_ONE_LAUNCH
#define SEAM(k) do { if ((k) + 1 < hi) xcd_barrier(bar); } while (0)
#else
#define SEAM(k) do { } while (0)
#endif
#define in_x ((const float*)kargs()->in[0])
#define in_pos ((const int*)kargs()->in[1])
#define ln_g ((const float*)kargs()->in[2])
#define ln_b ((const float*)kargs()->in[3])
#define w_in ((const float*)kargs()->in[4])
#define q_norm ((const float*)kargs()->in[5])
#define w_uq ((const float*)kargs()->in[6])
#define kv_norm ((const float*)kargs()->in[7])
#define w_ukv ((const float*)kargs()->in[8])
#define w_o ((const float*)kargs()->in[9])
#define pool_w ((const float*)kargs()->in[10])
#define pool_b ((const float*)kargs()->in[11])
#define pool_scale ((const float*)kargs()->in[12])
#define w_grp ((const float*)kargs()->in[13])
#define b_grp ((const float*)kargs()->in[14])
#define w_exp ((const float*)kargs()->in[15])
#define b_exp ((const float*)kargs()->in[16])
#define w1 ((const float*)kargs()->in[17])
#define w3 ((const float*)kargs()->in[18])
#define w2 ((const float*)kargs()->in[19])
#define COS ((float*)(ws + WS_COS))
#define SIN ((float*)(ws + WS_SIN))
#define CNT ((int*)(ws + WS_CNT))
#define TILE ((int*)(ws + WS_TILE))
#define AE ((int*)(ws + WS_AE))
#define APOS ((int*)(ws + WS_APOS))
#define AG ((float*)(ws + WS_AG))
#define RSLOT ((int*)(ws + WS_RSLOT))
#define RGATE ((float*)(ws + WS_RGATE))
#define WIN ((bf16_t*)(ws + WS_WIN))
#define WUQ ((bf16_t*)(ws + WS_WUQ))
#define WUK ((bf16_t*)(ws + WS_WUK))
#define WUV ((bf16_t*)(ws + WS_WUV))
#define WO ((bf16_t*)(ws + WS_WO))
#define WP ((bf16_t*)(ws + WS_WP))
#define WR ((bf16_t*)(ws + WS_WR))
#define W13 ((bf16_t*)(ws + WS_W13))
#define W2T ((bf16_t*)(ws + WS_W2T))
#define FB ((bf16_t*)(ws + WS_FB))
#define XHL ((bf16_t*)(ws + WS_XHL))
#define LATB ((float*)(ws + WS_LAT))
#define CQ ((bf16_t*)(ws + WS_CQ))
#define CKV ((bf16_t*)(ws + WS_CKV))
#define KR ((bf16_t*)(ws + WS_KR))
#define QB ((bf16_t*)(ws + WS_Q))
#define KN ((bf16_t*)(ws + WS_KN))
#define VT ((bf16_t*)(ws + WS_VT))
#define OB ((bf16_t*)(ws + WS_O))
#define POOLED ((bf16_t*)(ws + WS_POOLED))
#define LG ((float*)(ws + WS_LG))
#define ROWLIST ((int*)(ws + WS_LIST))
#define LGATE ((float*)(ws + WS_LGATE))
#define HS ((bf16_t*)(ws + WS_HS))
#define YB ((bf16_t*)(ws + WS_Y))
    LAS float* scr = (LAS float*)(lds + RING_OFF + wave * SCR_WAVE);

    if (PHON(12) && IN(0)) {
        for (int m = gw; m < NTOK; m += NGW) {
            const f32x4* xr = (const f32x4*)(in_x + (size_t)m * D_MODEL) + 2 * lane; u32x4* oh = (u32x4*)(XHL + (size_t)m * 2048) + lane;
#pragma unroll
            for (int j = 0; j < 2; ++j) oh[64 * j] = pk8(xr[128 * j], xr[128 * j + 1]);
        }
        for (int idx = gw * 64 + lane; idx < NTOK * 16; idx += NGW * 64) { float s, c; sincos_d((double)in_pos[idx >> 4] * c_invf[idx & 15], s, c); COS[idx] = c; SIN[idx] = s; }
        for (int idx = gw * 64 + lane; idx < DEPTH * 2 * 256 * 1024; idx += NGW * 64) {
            const int l = idx >> 19, ks = (idx >> 18) & 1, row = (idx >> 10) & 255, k = idx & 1023;
            const int j = row < 72 ? row : ((row >= 128 && row < 200) ? row - 128 : -1);
            float v = 0.f;
            if (j >= 0 && !(ks == 1 && row >= 128)) { const float wv = (j < 8) ? w_grp[((size_t)l * 1024 + k) * 8 + j] : w_exp[((size_t)l * 1024 + k) * 64 + (j - 8)];
                const float whi = bflo(cvtpk(wv, 0.f)); v = (row < 72) ? whi : (wv - whi); }
            WR[idx] = (bf16_t)(cvtpk(v, 0.f) & 0xffffu);
        }
        for (int idx = gw * 64 + lane; idx < 2 * 96 * 1024 / 8; idx += NGW * 64) { const int j = idx / (96 * 128), r = idx % (96 * 128); *(u32x4*)(WIN + ((size_t)j * 512 + 416) * 1024 + (size_t)r * 8) = (u32x4){0u, 0u, 0u, 0u}; }
        constexpr int I_IN = 16 * 13, I_UQ = 4 * 48, I_UKV = 2 * 64, I_O = 16 * 32, I_P = 4 * 8;
        constexpr int NIT = 2 * (I_IN + I_UQ + I_UKV + I_O) + 8 * I_P;
        for (int it = gw; it < NIT; it += NGW) {
            int r = it;
            if (r < 2 * I_IN) { const int j = r / I_IN, q = r % I_IN, kb = q / 13, nb = q % 13;
                transpose_item(w_in + (size_t)j * 1024 * LAT, LAT, 64 * kb, 32 * nb, WIN + (size_t)j * 512 * 1024, 1024, 32 * nb, 1.f, scr, lane); continue; } r -= 2 * I_IN;
            if (r < 2 * I_UQ) { const int j = r / I_UQ, q = r % I_UQ, kb = q / 48, nb = q % 48; const int n0 = 32 * nb, head = n0 / 96, r0 = n0 % 96;
                if (r0 < 64) transpose_item(w_uq + (size_t)j * 256 * QPITCH, QPITCH, 64 * kb, n0, WUQ + (size_t)j * 1536 * 256, 256, head * 64 + r0, QSCALE, scr, lane);
                else {
                    const float* W = w_uq + (size_t)j * 256 * QPITCH; bf16_t* WT = WUQ + (size_t)j * 1536 * 256; const int k0 = 64 * kb;
#pragma unroll 8
                    for (int i = 0; i < 32; ++i) { const int kk = 2 * i + (lane >> 5); scr[kk * 33 + (lane & 31)] = W[(size_t)(k0 + kk) * QPITCH + n0 + (lane & 31)]; }
                    LDS_WAIT(); asm volatile("" ::: "memory");
                    const int c = lane & 7;
#pragma unroll
                    for (int jj = 0; jj < 4; ++jj) { const int n = (lane >> 3) + 8 * jj; const LAS float* s = scr + (8 * c) * 33 + n;
                        const int drow = 1024 + (head >> 3) * 256 + (head & 7) * 16 + (n < 16 ? n : 128 + n - 16);
                        u32x4 o; o.x = cvtpk(s[0 * 33] * QSCALE, s[1 * 33] * QSCALE); o.y = cvtpk(s[2 * 33] * QSCALE, s[3 * 33] * QSCALE); o.z = cvtpk(s[4 * 33] * QSCALE, s[5 * 33] * QSCALE); o.w = cvtpk(s[6 * 33] * QSCALE, s[7 * 33] * QSCALE);
                        *(u32x4*)(WT + (size_t)drow * 256 + k0 + 8 * c) = o; }
                    LDS_WAIT(); asm volatile("" ::: "memory");
                }
                continue; } r -= 2 * I_UQ;
            if (r < 2 * I_UKV) { const int j = r / I_UKV, q = r % I_UKV, kb = q / 64, nb = q % 64; const int n0 = 32 * nb, head = n0 >> 7, r0 = n0 & 127;
                if (r0 < 64) transpose_item(w_ukv + (size_t)j * 128 * 2048, 2048, 64 * kb, n0, WUK + (size_t)j * 1024 * 128, 128, head * 64 + r0, 1.f, scr, lane);
                else transpose_item(w_ukv + (size_t)j * 128 * 2048, 2048, 64 * kb, n0, WUV + (size_t)j * 1024 * 128, 128, head * 64 + r0 - 64, 1.f, scr, lane);
                continue; } r -= 2 * I_UKV;
            if (r < 2 * I_O) { const int j = r / I_O, q = r % I_O, kb = q / 32, nb = q % 32;
                transpose_item(w_o + (size_t)j * 1024 * 1024, 1024, 64 * kb, 32 * nb, WO + (size_t)j * 1024 * 1024, 1024, 32 * nb, 1.f, scr, lane); continue; } r -= 2 * I_O;
            { const int jg = r / I_P, q = r % I_P, kb = q / 8, nb = q % 8;
                transpose_item(pool_w + (size_t)jg * 65536, 256, 64 * kb, 32 * nb, WP + (size_t)jg * 65536, 256, 32 * nb, 1.f, scr, lane); }
        }
        SEAM(0);
    }

    for (int l = 0; l < DEPTH; ++l) {
        const int pb = 1 + PPL * l, j = l >> 1;
        tid = opaque(threadIdx.x); lane = tid & 63; wave = __builtin_amdgcn_readfirstlane(tid >> 6); gw = vcu * NWAVES + wave; scr = (LAS float*)(lds + RING_OFF + wave * SCR_WAVE);
        const bool mla = (l & 1) == 0;
#define MOE_WEIGHT_CONV() do { \
            constexpr int I13 = 64 * 16 * 4, I2 = 64 * 4 * 16; \
            for (int it = gw; it < 2 * I13 + I2; it += NGW) { int r = it; \
                if (r < 2 * I13) { const int which = r / I13, q = r % I13, e = q >> 6, kb = (q >> 2) & 15, nb = q & 3; const int n0 = 64 * nb; \
                    const float* W = (which ? w3 : w1) + ((size_t)l * 64 + e) * 1024 * 256; \
                    transpose_item64(W, 256, 64 * kb, n0, W13 + (size_t)e * 512 * 1024, 1024, (n0 >> 7) * 256 + (n0 & 127) + which * 128, scr, lane); } \
                else { r -= 2 * I13; const int e = r >> 6, kb = (r >> 4) & 3, nb = r & 15; \
                    transpose_item64(w2 + ((size_t)l * 64 + e) * 256 * 1024, 1024, 64 * kb, 64 * nb, W2T + (size_t)e * 1024 * 256, 256, 64 * nb, scr, lane); } } } while (0)

        if (mla) {
            if (PHON(0) && IN(pb + 0)) {
                for (int rep = 0; rep < NREP(0); ++rep) { if (rep) __syncthreads();
                pg8::Gemm g{2048, 1024, 1024}; pg8::DenseOrder S; S.init(NTOK, 512, G, bx, XHL, (size_t)256 * 2048 * 2, 0, WIN + (size_t)j * 512 * 1024, (size_t)256 * 1024 * 2);
                pg8::EpiF32 E{LATB, 512};
                pg8::gemm_phase<pg8::EpiF32, pg8::DenseOrder, true>(lds + RING_OFF, g, S, E);
                MOE_WEIGHT_CONV();
                }
                SEAM(pb + 0);
            }
            if (PHON(1) && IN(pb + 1)) {
                const float* gq = q_norm + j * 256; const float* gk = kv_norm + j * 128;
                const f32x4 gqv = *(const f32x4*)(gq + 4 * lane); const f32x4 gkv = *(const f32x4*)(gk + 4 * (lane & 31));
                for (int m = gw; m < NTOK; m += NGW) {
                    const float* lr = LATB + (size_t)m * 512;
                    const f32x4 a = *(const f32x4*)(lr + 4 * lane), c = *(const f32x4*)(lr + 256 + 4 * lane);
                    const float sq = wave_sum(a.x * a.x + a.y * a.y + a.z * a.z + a.w * a.w);
                    const float sk = wave_sum(lane < 32 ? (c.x * c.x + c.y * c.y + c.z * c.z + c.w * c.w) : 0.f);
                    const float rq = 1.0f / sqrtf(sq * (1.f / 256.f) + RMS_EPS), rk = 1.0f / sqrtf(sk * (1.f / 128.f) + RMS_EPS);
                    { u32x2 o; o.x = cvtpk(a.x * rq * gqv.x, a.y * rq * gqv.y); o.y = cvtpk(a.z * rq * gqv.z, a.w * rq * gqv.w); *((u32x2*)(CQ + (size_t)m * 256) + lane) = o; }
                    if (lane < 32) { u32x2 o; o.x = cvtpk(c.x * rk * gkv.x, c.y * rk * gkv.y); o.y = cvtpk(c.z * rk * gkv.z, c.w * rk * gkv.w); *((u32x2*)(CKV + (size_t)m * 128) + lane) = o; }
                    f32x4 p; p.x = __shfl_xor(c.x, 4); p.y = __shfl_xor(c.y, 4); p.z = __shfl_xor(c.z, 4); p.w = __shfl_xor(c.w, 4);
                    if (lane >= 32 && lane < 40) {
                        const f32x4 cv = *(const f32x4*)(COS + (size_t)m * 16 + 4 * (lane & 3)), sv = *(const f32x4*)(SIN + (size_t)m * 16 + 4 * (lane & 3));
                        f32x4 y; if (lane < 36) y = c * cv - p * sv; else y = c * cv + p * sv;
                        u32x2 o; o.x = cvtpk(y.x, y.y); o.y = cvtpk(y.z, y.w); *((u32x2*)(KR + (size_t)m * 32) + (lane - 32)) = o;
                    }
                }
                SEAM(pb + 1);
            }
            if (PHON(2) && IN(pb + 2)) {
                for (int rep = 0; rep < NREP(2); ++rep) {
                { pg8::Gemm g{256, 256, 256}; pg8::DenseOrder S; S.init(NTOK, 1536, G, bx, CQ, (size_t)256 * 256 * 2, 0, WUQ + (size_t)j * 1536 * 256, (size_t)256 * 256 * 2);
                  pg8::EpiQ E{QB, COS, SIN};
                  pg8::gemm_phase<pg8::EpiQ, pg8::DenseOrder, true>(lds + RING_OFF, g, S, E); }
                { pg8::Gemm g{128, 128, 128}; pg8::DenseOrder S; S.init(NTOK, 1024, G, bx, CKV, (size_t)256 * 128 * 2, 0, WUK + (size_t)j * 1024 * 128, (size_t)256 * 128 * 2);
                  pg8::EpiBf16 E{KN, 1024};
                  pg8::gemm_phase<pg8::EpiBf16, pg8::DenseOrder, true>(lds + RING_OFF, g, S, E); }
                { pg8::Gemm g{128, 128, 128}; pg8::DenseOrder S; S.init(1024, NTOK, G, bx, WUV + (size_t)j * 1024 * 128, (size_t)256 * 128 * 2, 0, CKV, (size_t)256 * 128 * 2);
                  pg8::EpiBf16 E{VT, (size_t)NTOK};
                  pg8::gemm_phase<pg8::EpiBf16, pg8::DenseOrder, true>(lds + RING_OFF, g, S, E); }
                }
                SEAM(pb + 2);
            }
            if (PHON(3) && IN(pb + 3)) {
                for (int rep = 0; rep < NREP(3); ++rep)
                for (int i = 0;; ++i) {
                    const int L = i * G + vcu; if (L >= 2048) break;
                    const int sl = L & 255, rnd = L >> 8, s = sl & 7, bh = (sl >> 3) + 32 * (rnd >> 2), k = rnd & 3;
                    const int qb = (k == 0) ? s : (k == 1) ? 15 - s : (k == 2) ? 16 + s : 31 - s;
                    att::attn_unit(bh >> 4, bh & 15, qb, QB, KN, KR, VT, OB, lds + RING_OFF);
                }
                SEAM(pb + 3);
            }
            if (PHON(4) && IN(pb + 4)) {
                for (int rep = 0; rep < NREP(4); ++rep) {
                pg8::Gemm g{1024, 1024, 1024}; pg8::DenseOrder S; S.init(NTOK, 1024, G, bx, OB, (size_t)256 * 1024 * 2, 0, WO + (size_t)j * 1024 * 1024, (size_t)256 * 1024 * 2);
                pg8::EpiBf16 E{FB, 1024};
                pg8::gemm_phase<pg8::EpiBf16, pg8::DenseOrder, true>(lds + RING_OFF, g, S, E);
                }
                SEAM(pb + 4);
            }
        } else {
            if (PHON(13) && IN(pb + 0)) {
                for (int rep = 0; rep < NREP(13); ++rep) {
                for (int it = gw; it < 2 * (NTOK / 32); it += NGW) {
                    const int q = it & 1, t0 = (it >> 1) * 32, s0 = t0 & (SEQ - 1), grp = 2 * q + (lane >> 5), win = 2 << grp;
                    const bf16_t* xb = XHL + grp * 256 + 8 * (lane & 31);
                    bf16_t* pout = POOLED + grp * 256 + 8 * (lane & 31);
                    f32x4 Sa = {0.f, 0.f, 0.f, 0.f}, Sb = {0.f, 0.f, 0.f, 0.f};
#pragma unroll
                    for (int jj = 1; jj < 16; ++jj) { if (jj < win && s0 - jj >= 0) { const F8 r = bf8(*(const u32x4*)(xb + (size_t)(t0 - jj) * 2048)); Sa += r.a; Sb += r.b; } }
                    for (int tb = 0; tb < 32; tb += 8) {
                        u32x4 xn[8], xe[8];
#pragma unroll
                        for (int i = 0; i < 8; ++i) { const int t = t0 + tb + i; xn[i] = *(const u32x4*)(xb + (size_t)t * 2048);
                            xe[i] = (s0 + tb + i - win + 1 >= 0) ? *(const u32x4*)(xb + (size_t)(t - win + 1) * 2048) : (u32x4){0u, 0u, 0u, 0u}; }
#pragma unroll
                        for (int i = 0; i < 8; ++i) { const int sI = s0 + tb + i; const F8 xv = bf8(xn[i]), ev = bf8(xe[i]);
                            Sa += xv.a; Sb += xv.b;
                            const float rc = 1.0f / (float)((sI + 1 < win) ? sI + 1 : win);
                            *(u32x4*)(pout + (size_t)(t0 + tb + i) * 1024) = pk8(Sa * rc - xv.a, Sb * rc - xv.b);
                            Sa -= ev.a; Sb -= ev.b; }
                    }
                }
                MOE_WEIGHT_CONV();
                }
                SEAM(pb + 0);
            }
            if (PHON(14) && IN(pb + 1)) {
                for (int rep = 0; rep < NREP(14); ++rep) {
                pg8::Gemm g{1024, 256, 256}; pg8::DenseOrder S; S.init(NTOK, 1024, G, bx, POOLED, (size_t)256 * 1024 * 2, (size_t)256 * 2, WP + (size_t)j * 4 * 65536, (size_t)65536 * 2);
                pg8::EpiPool E{FB, pool_b + j * 1024, pool_scale + j * 1024};
                pg8::gemm_phase<pg8::EpiPool, pg8::DenseOrder, true>(lds + RING_OFF, g, S, E);
                }
                SEAM(pb + 1);
            }
        }
        if (PHON(5) && IN(pb + 5)) {
                for (int rep = 0; rep < NREP(5); ++rep) {
            f32x4 gv[4], bv[4];
#pragma unroll
            for (int jj = 0; jj < 4; ++jj) { const int c = 8 * lane + 512 * (jj >> 1) + 4 * (jj & 1); gv[jj] = *(const f32x4*)(ln_g + (size_t)(l * 2 + 0) * 1024 + c); bv[jj] = *(const f32x4*)(ln_b + (size_t)(l * 2 + 0) * 1024 + c); }
            for (int m = gw; m < NTOK; m += NGW) {
                u32x4* xh = (u32x4*)(XHL + (size_t)m * 2048) + lane; const u32x4* fr2 = (const u32x4*)(FB + (size_t)m * 1024) + lane;
                const F8 x0 = bf8(xh[0]), x1 = bf8(xh[64]), f0 = bf8(fr2[0]), f1 = bf8(fr2[64]);
                f32x4 v[4] = {x0.a * DN_ALPHA + f0.a, x0.b * DN_ALPHA + f0.b, x1.a * DN_ALPHA + f1.a, x1.b * DN_ALPHA + f1.b}; float s = 0.f;
#pragma unroll
                for (int jj = 0; jj < 4; ++jj) s += (v[jj].x + v[jj].y) + (v[jj].z + v[jj].w);
                const float mean = wave_sum(s) * (1.f / 1024.f); float s2 = 0.f;
#pragma unroll
                for (int jj = 0; jj < 4; ++jj) { v[jj] = v[jj] - mean; s2 += (v[jj].x * v[jj].x + v[jj].y * v[jj].y) + (v[jj].z * v[jj].z + v[jj].w * v[jj].w); }
                const float rstd = 1.0f / sqrtf(wave_sum(s2) * (1.f / 1024.f) + LN_EPS);
#pragma unroll
                for (int jj = 0; jj < 4; ++jj) v[jj] = v[jj] * rstd * gv[jj] + bv[jj];
#pragma unroll
                for (int j = 0; j < 2; ++j) { const u32x4 h = pk8(v[2 * j], v[2 * j + 1]); const F8 hf = bf8(h);
                    xh[64 * j] = h; xh[128 + 64 * j] = pk8(v[2 * j] - hf.a, v[2 * j + 1] - hf.b); }
            }
            }
                SEAM(pb + 5);
        }
        if (PHON(6) && IN(pb + 6)) {
                for (int rep = 0; rep < NREP(6); ++rep) {
            pg8::Gemm g{2048, 1024, 1024}; pg8::DenseOrder S; S.init(NTOK, 512, G, bx, XHL, (size_t)256 * 2048 * 2, (size_t)1024 * 2, WR + (size_t)l * 2 * 256 * 1024, (size_t)256 * 1024 * 2);
            pg8::EpiRouter E{LG};
            pg8::gemm_phase<pg8::EpiRouter, pg8::DenseOrder, true>(lds + RING_OFF, g, S, E);
            }
                SEAM(pb + 6);
        }
        if (PHON(7) && IN(pb + 7)) {
            for (int rep = 0; rep < NREP(7); ++rep) {
            LAS int* hist = (LAS int*)(lds + RING_OFF); LAS int* cbase = hist + 64;
            const float* bg = b_grp + l * 8; const float* be = b_exp + l * 64;
            unsigned* gcnt = ctl + CW_GCNT + 64 * l;
            for (int c = bx; c < 256; c += G) {
                if (tid < 64) hist[tid] = 0;
                __syncthreads();
                int ex1 = 0, ex2 = 0, p1 = 0, p2 = 0; float ga1 = 0.f, ga2 = 0.f;
                const int t = c * 128 + tid;
                if (tid < 128) {
                    const float* lg = LG + (size_t)t * LGP;
                    const float* lg2 = lg + (size_t)NTOK * LGP;
                    const f32x4 g0 = *(const f32x4*)lg + *(const f32x4*)lg2, g1 = *(const f32x4*)(lg + 4) + *(const f32x4*)(lg2 + 4);
                    float gl[8] = {g0.x + bg[0], g0.y + bg[1], g0.z + bg[2], g0.w + bg[3], g1.x + bg[4], g1.y + bg[5], g1.z + bg[6], g1.w + bg[7]};
                    int gs = 0; float gm = gl[0];
#pragma unroll
                    for (int i = 1; i < 8; ++i) if (gl[i] > gm) { gm = gl[i]; gs = i; }
                    float se = 0.f;
#pragma unroll
                    for (int i = 0; i < 8; ++i) se += __expf(gl[i] - gm);
                    const float ggate = 1.0f / se;
                    const f32x4 e0 = *(const f32x4*)(lg + 8 + gs * 8) + *(const f32x4*)(lg2 + 8 + gs * 8), e1 = *(const f32x4*)(lg + 12 + gs * 8) + *(const f32x4*)(lg2 + 12 + gs * 8);
                    const f32x4 b0 = *(const f32x4*)(be + gs * 8), b1 = *(const f32x4*)(be + gs * 8 + 4);
                    float el[8] = {e0.x + b0.x, e0.y + b0.y, e0.z + b0.z, e0.w + b0.w, e1.x + b1.x, e1.y + b1.y, e1.z + b1.z, e1.w + b1.w};
                    int i1 = 0; float m1 = el[0];
#pragma unroll
                    for (int i = 1; i < 8; ++i) if (el[i] > m1) { m1 = el[i]; i1 = i; }
                    int i2 = -1; float m2 = -INFINITY;
#pragma unroll
                    for (int i = 0; i < 8; ++i) if (i != i1 && el[i] > m2) { m2 = el[i]; i2 = i; }
                    const float x2 = __expf(m2 - m1), rs = 1.0f / (1.0f + x2);
                    ex1 = gs * 8 + i1; ex2 = gs * 8 + i2; ga1 = ggate * rs; ga2 = ggate * x2 * rs;
                    p1 = __hip_atomic_fetch_add(&hist[ex1], 1, __ATOMIC_RELAXED, __HIP_MEMORY_SCOPE_WORKGROUP); p2 = __hip_atomic_fetch_add(&hist[ex2], 1, __ATOMIC_RELAXED, __HIP_MEMORY_SCOPE_WORKGROUP);
                }
                __syncthreads();
                if (tid < 64) { const int n = hist[tid]; cbase[tid] = n ? (int)__hip_atomic_fetch_add(gcnt + tid, (unsigned)n, __ATOMIC_RELAXED, __HIP_MEMORY_SCOPE_AGENT) : 0; }
                __syncthreads();
                if (tid < 128) {
                    const size_t i1 = (size_t)ex1 * pg8::LIST_CAP + cbase[ex1] + p1, i2 = (size_t)ex2 * pg8::LIST_CAP + cbase[ex2] + p2;
                    ROWLIST[i1] = 2 * t; LGATE[i1] = ga1; ROWLIST[i2] = 2 * t + 1; LGATE[i2] = ga2;
                }
                __syncthreads();
            }
            }
            SEAM(pb + 7);
        }
#define MOE_TILE_TABLE() \
            LAS int* tinfo = (LAS int*)(lds + TINFO_OFF); \
            __syncthreads(); \
            if (tid < 64) tinfo[pg8::TI_CNT + tid] = (int)__hip_atomic_load(ctl + CW_GCNT + 64 * l + tid, __ATOMIC_RELAXED, __HIP_MEMORY_SCOPE_AGENT); \
            __syncthreads(); \
            if (tid == 0) { int tt = 0; for (int e = 0; e < 64; ++e) { const int n = (tinfo[pg8::TI_CNT + e] + 255) >> 8; for (int i = 0; i < n && tt < MAX_TILES; ++i) tinfo[tt++] = e | (i << 8); } tinfo[pg8::TI_CNT + 64] = tt; } \
            __syncthreads(); \
            const int ntl = tinfo[pg8::TI_CNT + 64];
        if (PHON(9) && IN(pb + 9)) {
            for (int rep = 0; rep < NREP(9); ++rep) {
            MOE_TILE_TABLE();
            pg8::Gemm g{2048, 1024, 1024}; pg8::GatherOrder S; S.init(tinfo, ntl, 2, G, bx, XHL, ROWLIST, W13, (size_t)512 * 1024 * 2, (size_t)256 * 1024 * 2);
            pg8::EpiSwiglu E{HS};
            pg8::gemm_phase<pg8::EpiSwiglu, pg8::GatherOrder, true>(lds + RING_OFF, g, S, E);
            }
            SEAM(pb + 9);
        }
        if (PHON(10) && IN(pb + 10)) {
            for (int rep = 0; rep < NREP(10); ++rep) {
            MOE_TILE_TABLE();
            pg8::Gemm g{256, 256, 256}; pg8::MoeOrder S; S.init(tinfo, ntl, 4, G, bx, HS, (size_t)256 * 256 * 2, W2T, (size_t)1024 * 256 * 2, (size_t)256 * 256 * 2);
            pg8::EpiMoeOut E{YB, tinfo, ROWLIST, LGATE};
            pg8::gemm_phase<pg8::EpiMoeOut, pg8::MoeOrder, true>(lds + RING_OFF, g, S, E);
            }
            SEAM(pb + 10);
        }
        if (PHON(11) && IN(pb + 11)) {
            f32x4 gv[4], bv[4];
#pragma unroll
            for (int jj = 0; jj < 4; ++jj) { const int c = 8 * lane + 512 * (jj >> 1) + 4 * (jj & 1); gv[jj] = *(const f32x4*)(ln_g + (size_t)(l * 2 + 1) * 1024 + c); bv[jj] = *(const f32x4*)(ln_b + (size_t)(l * 2 + 1) * 1024 + c); }
            const bool lastl = (l == DEPTH - 1);
            for (int m = gw; m < NTOK; m += NGW) {
                u32x4* xh = (u32x4*)(XHL + (size_t)m * 2048) + lane;
                const u32x4* y0 = (const u32x4*)(YB + (size_t)(2 * m) * 1024) + lane; const u32x4* y1 = (const u32x4*)(YB + (size_t)(2 * m + 1) * 1024) + lane;
                const F8 x0 = bf8(xh[0]), x1 = bf8(xh[64]), a0 = bf8(y0[0]), a1 = bf8(y0[64]), c0 = bf8(y1[0]), c1 = bf8(y1[64]);
                f32x4 v[4] = {x0.a * DN_ALPHA + (a0.a + c0.a), x0.b * DN_ALPHA + (a0.b + c0.b), x1.a * DN_ALPHA + (a1.a + c1.a), x1.b * DN_ALPHA + (a1.b + c1.b)}; float s = 0.f;
#pragma unroll
                for (int jj = 0; jj < 4; ++jj) s += (v[jj].x + v[jj].y) + (v[jj].z + v[jj].w);
                const float mean = wave_sum(s) * (1.f / 1024.f); float s2 = 0.f;
#pragma unroll
                for (int jj = 0; jj < 4; ++jj) { v[jj] = v[jj] - mean; s2 += (v[jj].x * v[jj].x + v[jj].y * v[jj].y) + (v[jj].z * v[jj].z + v[jj].w * v[jj].w); }
                const float rstd = 1.0f / sqrtf(wave_sum(s2) * (1.f / 1024.f) + LN_EPS);
#pragma unroll
                for (int jj = 0; jj < 4; ++jj) v[jj] = v[jj] * rstd * gv[jj] + bv[jj];
                if (lastl) { f32x4* orow = (f32x4*)(kargs()->out + (size_t)m * 1024) + 2 * lane;
                    orow[0] = v[0]; orow[1] = v[1]; orow[128] = v[2]; orow[129] = v[3];
                } else { xh[0] = pk8(v[0], v[1]); xh[64] = pk8(v[2], v[3]); }
            }
            SEAM(pb + 11);
        }
    }
#undef IN
#undef SEAM
}
#undef ws
#undef in_x
#undef in_pos
#undef ln_g
#undef ln_b
#undef w_in
#undef q_norm
#undef w_uq
#undef kv_norm
#undef w_ukv
#undef w_o
#undef pool_w
#undef pool_b
#undef pool_scale
#undef w_grp
#undef b_grp
#undef w_exp
#undef b_exp
#undef w1
#undef w3
#undef w2
#undef COS
#undef SIN
#undef CNT
#undef TILE
#undef AE
#undef APOS
#undef AG
#undef RSLOT
#undef RGATE
#undef WIN
#undef WUQ
#undef WUK
#undef WUV
#undef WO
#undef WP
#undef WR
#undef W13
#undef W2T
#undef FB
#undef XHL
#undef LATB
#undef CQ
#undef CKV
#undef KR
#undef QB
#undef KN
#undef VT
#undef OB
#undef POOLED
#undef LG
#undef ROWLIST
#undef LGATE
#undef HS
#undef YB

static bool phase_exists(int p) {
    if (p == 0) return true;
    const int l = (p - 1) / PPL, k = (p - 1) % PPL;
    if (k == 8) return false;
    if (k >= 5) return true;
    return (l & 1) == 0 ? true : (k < 2);
}
extern "C" void kernel_launch(void* const* d_in, const int* in_sizes, int n_in, void* d_out, int out_size, void* d_ws, size_t ws_size, hipStream_t stream) {
    static int grid = 0;
    if (grid == 0) {
        if (n_in != 20 || in_sizes[0] != NTOK * D_MODEL || out_size != NTOK * D_MODEL || ws_size < WS_END) { fprintf(stderr, "kernel_launch: unexpected shapes / workspace (%zu < %zu)\n", ws_size, (size_t)WS_END); grid = -1; return; }
        int dev = 0, cus = 0, per_cu = 0;
        if (hipGetDevice(&dev) != hipSuccess || hipDeviceGetAttribute(&cus, hipDeviceAttributeMultiprocessorCount, dev) != hipSuccess) { grid = -1; return; }
        if (hipFuncSetAttribute((const void*)mk_fwd, hipFuncAttributeMaxDynamicSharedMemorySize, LDS_BYTES) != hipSuccess) { fprintf(stderr, "kernel_launch: hipFuncSetAttribute failed\n"); grid = -1; return; }
        if (hipOccupancyMaxActiveBlocksPerMultiprocessor(&per_cu, (const void*)mk_fwd, NWAVES * 64, LDS_BYTES) != hipSuccess || per_cu < 1) fprintf(stderr, "kernel_launch: occupancy query reports %d\n", per_cu);
        (void)hipGetLastError();
        grid = cus;
    }
    if (grid < 0) return;
    if (hipMemsetAsync((char*)d_ws + WS_CTL, 0, CTL_ZERO_BYTES, stream) != hipSuccess) return;
    Args a{};
    for (int i = 0; i < 20; ++i) a.in[i] = d_in[i];
    a.out = (float*)d_out; a.ws = (unsigned char*)d_ws;
#if MK_ONE_LAUNCH
    a.ph_lo = 0; a.ph_hi = NPHASE;
    hipLaunchKernelGGL(mk_fwd, dim3(grid), dim3(NWAVES * 64), LDS_BYTES, stream, a);
#else
    for (int p = 0; p < NPHASE; ++p) {
        if (!phase_exists(p)) continue;
        a.ph_lo = p; a.ph_hi = p + 1;
        hipLaunchKernelGGL(mk_fwd, dim3(grid), dim3(NWAVES * 64), LDS_BYTES, stream, a);
    }
#endif
}
```

```cpp
#include <hip/hip_runtime.h>
#include <cstdio>
#include <cstdint>

#ifndef MK_ONE_LAUNCH
#define MK_ONE_LAUNCH 1
#endif

#define LAS __attribute__((address_space(3)))
#define GAS __attribute__((address_space(1)))

constexpr int D_MODEL = 1024, BATCH = 4, SEQ = 8192, DEPTH = 4, NTOK = BATCH * SEQ;
constexpr int N_HEADS = 16, QK_NOPE = 64, QK_ROPE = 32, V_HEAD = 64, Q_LORA = 256, KV_LORA = 128, LAT = Q_LORA + KV_LORA + QK_ROPE;
constexpr int QPITCH = N_HEADS * (QK_NOPE + QK_ROPE);
constexpr int N_GROUPS = 8, EPG = 8, N_EXPERTS = 64, D_EXPERT = 256;
constexpr int MAX_TILES = 320;
constexpr float DN_ALPHA = 1.681792830507429f;
constexpr float LN_EPS = 1e-5f, RMS_EPS = 1e-6f;
constexpr float QSCALE = 0.14724444602590306f;
constexpr int LGP = 80;

constexpr size_t MiB = 1u << 20;
constexpr size_t WS_CTL = 0, CTL_ZERO_BYTES = 1 * MiB;
constexpr size_t WS_COS = 1 * MiB, WS_SIN = 3 * MiB;
constexpr size_t WS_CNT = 5 * MiB;
constexpr size_t WS_TILE = 5 * MiB + 65536;
constexpr size_t WS_AE = 5 * MiB + 131072, WS_APOS = WS_AE + 262144, WS_AG = WS_APOS + 262144;
constexpr size_t WS_RSLOT = 6 * MiB, WS_RGATE = 6 * MiB + 512 * 1024;
constexpr size_t WS_WIN = 8 * MiB;
constexpr size_t WS_WUQ = 10 * MiB;
constexpr size_t WS_WUK = 12 * MiB;
constexpr size_t WS_WUV = 13 * MiB;
constexpr size_t WS_WO = 14 * MiB;
constexpr size_t WS_WP = 18 * MiB;
constexpr size_t WS_WR = 19 * MiB;
constexpr size_t WS_W13 = 24 * MiB;
constexpr size_t WS_W2T = 88 * MiB;
constexpr size_t WS_W13B = 184 * MiB;
constexpr size_t WS_W2TB = 760 * MiB;
constexpr size_t WS_FB = 120 * MiB;
constexpr size_t WS_XHL = 248 * MiB;
constexpr size_t WS_R1 = 376 * MiB;
constexpr size_t WS_LAT = WS_R1;
constexpr size_t WS_CQ = WS_R1 + 64 * MiB;
constexpr size_t WS_CKV = WS_R1 + 80 * MiB;
constexpr size_t WS_KR = WS_R1 + 88 * MiB;
constexpr size_t WS_Q = WS_R1 + 92 * MiB;
constexpr size_t WS_KN = WS_R1 + 188 * MiB;
constexpr size_t WS_VT = WS_R1 + 252 * MiB;
constexpr size_t WS_O = WS_R1 + 316 * MiB;
constexpr size_t WS_POOLED = WS_R1;
constexpr size_t WS_LG = WS_R1;
constexpr size_t WS_LIST = WS_R1 + 20 * MiB;
constexpr size_t WS_LGATE = WS_R1 + 36 * MiB;
constexpr size_t WS_HS = WS_R1 + 180 * MiB;
constexpr size_t WS_Y = WS_R1 + 220 * MiB;
constexpr size_t WS_END = 792 * MiB;
static_assert(WS_O + 64 * MiB <= WS_END && WS_Y + 128 * MiB <= WS_END, "ws map");

constexpr int CW_TMO = 0, CW_CODE = 1, CW_BAR = 4096, CW_GCNT = 16384;

constexpr int RING_OFF = 0, RING_BYTES = 131072, SCR_WAVE = 17408;
constexpr int LDSCTL_OFF = 8 * SCR_WAVE, MISC_OFF = LDSCTL_OFF + 320, TINFO_OFF = LDSCTL_OFF + 1024;
constexpr int LDS_BYTES = 147456;

typedef unsigned short bf16_t;
typedef short bf16x8 __attribute__((ext_vector_type(8)));
typedef float f32x4 __attribute__((ext_vector_type(4)));
typedef float f32x16 __attribute__((ext_vector_type(16)));
typedef unsigned u32x4 __attribute__((ext_vector_type(4)));
typedef unsigned u32x2 __attribute__((ext_vector_type(2)));
typedef float f32x2_t __attribute__((ext_vector_type(2)));
typedef __bf16 bf16x2_t __attribute__((ext_vector_type(2)));
#define RLX_AGENT __ATOMIC_RELAXED, __HIP_MEMORY_SCOPE_AGENT
#define LDS_WAIT() asm volatile("s_waitcnt lgkmcnt(0)" ::: "memory")
#define VM_WAIT() asm volatile("s_waitcnt vmcnt(0)" ::: "memory")

__device__ __forceinline__ unsigned cvtpk(float lo, float hi) { f32x2_t v = {lo, hi}; bf16x2_t b = __builtin_convertvector(v, bf16x2_t); return __builtin_bit_cast(unsigned, b); }
__device__ __forceinline__ int opaque(int x) { asm volatile("" : "+v"(x)); return x; }
__device__ __forceinline__ int opaque_s(int x) { asm volatile("" : "+s"(x)); return x; }
__device__ __forceinline__ float bflo(unsigned u) { return __uint_as_float(u << 16); }
__device__ __forceinline__ float bfhi(unsigned u) { return __uint_as_float(u & 0xffff0000u); }
__device__ __forceinline__ float wave_sum(float v) {
#pragma unroll
    for (int o = 1; o < 64; o <<= 1) v += __shfl_xor(v, o);
    return v;
}
__device__ __forceinline__ void split4(const f32x4 v, u32x2& h, u32x2& l) {
    h.x = cvtpk(v.x, v.y); h.y = cvtpk(v.z, v.w);
    l.x = cvtpk(v.x - bflo(h.x), v.y - bfhi(h.x)); l.y = cvtpk(v.z - bflo(h.y), v.w - bfhi(h.y));
}
__device__ __forceinline__ f32x4 join4(const u32x2 h, const u32x2 l) {
    return (f32x4){bflo(h.x) + bflo(l.x), bfhi(h.x) + bfhi(l.x), bflo(h.y) + bflo(l.y), bfhi(h.y) + bfhi(l.y)};
}
struct F8 { f32x4 a, b; };
__device__ __forceinline__ F8 bf8(const u32x4 w) { F8 r; r.a = (f32x4){bflo(w.x), bfhi(w.x), bflo(w.y), bfhi(w.y)}; r.b = (f32x4){bflo(w.z), bfhi(w.z), bflo(w.w), bfhi(w.w)}; return r; }
__device__ __forceinline__ u32x4 pk8(const f32x4 a, const f32x4 b) { u32x4 w; w.x = cvtpk(a.x, a.y); w.y = cvtpk(a.z, a.w); w.z = cvtpk(b.x, b.y); w.w = cvtpk(b.z, b.w); return w; }
__device__ __forceinline__ f32x4 bf4(const u32x2 h) { return (f32x4){bflo(h.x), bfhi(h.x), bflo(h.y), bfhi(h.y)}; }

namespace pg8 {
constexpr int BM = 256, BK = 64, HALF = 128, HTB = HALF * BK * 2, STAGE_BYTES = 8 * HTB, NXCD = 8, WGM = 8;
__host__ __device__ __forceinline__ int lds_byte(int r, int c) { const int st = (r >> 4) * 2 + (c >> 5), rr = r & 15, cc = c & 31, ob = rr * 64 + cc * 2; return st * 1024 + (ob ^ (((ob >> 9) & 1) << 5)); }
__host__ __device__ __forceinline__ void stage_rc(int b, int& R, int& C) { const int st = b / 1024, sb = b % 1024, swz = sb ^ (((sb >> 9) & 1) << 5); R = (st >> 1) * 16 + swz / 64; C = (st & 1) * 32 + (swz % 64) / 2; }
__host__ __device__ __forceinline__ int perm32(int rho) { const int n = rho >> 4, i = rho & 15; return 8 * (i >> 2) + 4 * n + (i & 3); }

struct Unit { int pm, pn; };
struct Gemm { int lda, ldb, K; };

struct DenseOrder {
    int nM, nN, nwg, G, c;
    const char* A; const char* B; size_t a_pm, a_pn, b_pn;
    __device__ __forceinline__ void init(int M, int N, int G_, int c_, const void* A_, size_t a_pm_, size_t a_pn_, const void* B_, size_t b_pn_) {
        nM = M / BM; nN = N / BM; nwg = nM * nN; G = G_; c = c_; A = (const char*)A_; B = (const char*)B_; a_pm = a_pm_; a_pn = a_pn_; b_pn = b_pn_; }
    __device__ __forceinline__ bool next(int i, Unit& u) const {
        const long L = (long)i * G + c; if (L >= nwg) return false;
        int wgid = (int)L; { const int q = nwg / NXCD, r = nwg % NXCD, xcd = wgid % NXCD, off = wgid / NXCD; wgid = (xcd < r ? xcd * (q + 1) : r * (q + 1) + (xcd - r) * q) + off; }
        const int nig = WGM * nN, gid = wgid / nig, fm = gid * WGM, gsz = (nM - fm) < WGM ? (nM - fm) : WGM;
        u.pm = fm + ((wgid % nig) % gsz); u.pn = (wgid % nig) / gsz; return true;
    }
    __device__ __forceinline__ const char* a_base(const Unit& u) const { return A + (size_t)u.pm * a_pm + (size_t)u.pn * a_pn; }
    __device__ __forceinline__ unsigned a_voff(const Unit&, int R, int C, int lda) const { return (unsigned)(R * lda + C) * 2u; }
    __device__ __forceinline__ const char* b_base(const Unit& u) const { return B + (size_t)u.pn * b_pn; }
};
constexpr int TI_CNT = 320, LIST_CAP = 65536;
struct MoeOrder {
    const LAS int* tinfo; int ntiles, nN, nwg, G, c;
    const char* A; const char* W; size_t a_tile, w_e, w_pn;
    __device__ __forceinline__ void init(const LAS int* ti, int ntiles_, int nN_, int G_, int c_, const void* A_, size_t a_tile_, const void* W_, size_t w_e_, size_t w_pn_) {
        tinfo = ti; ntiles = ntiles_; nN = nN_; nwg = ntiles_ * nN_; G = G_; c = c_; A = (const char*)A_; a_tile = a_tile_; W = (const char*)W_; w_e = w_e_; w_pn = w_pn_; }
    __device__ __forceinline__ bool next(int i, Unit& u) const {
        const long L = (long)i * G + c; if (L >= nwg) return false;
        int wgid = (int)L; { const int q = nwg / NXCD, r = nwg % NXCD, xcd = wgid % NXCD, off = wgid / NXCD; wgid = (xcd < r ? xcd * (q + 1) : r * (q + 1) + (xcd - r) * q) + off; }
        u.pm = wgid / nN; u.pn = wgid % nN; return true;
    }
    __device__ __forceinline__ const char* a_base(const Unit& u) const { return A + (size_t)u.pm * a_tile; }
    __device__ __forceinline__ const char* b_base(const Unit& u) const { const int e = __builtin_amdgcn_readfirstlane(tinfo[u.pm]) & 255; return W + (size_t)e * w_e + (size_t)u.pn * w_pn; }
    __device__ __forceinline__ unsigned a_voff(const Unit&, int R, int C, int lda) const { return (unsigned)(R * lda + C) * 2u; }
};
struct GatherOrder {
    const LAS int* tinfo; int ntiles, nN, nwg, G, c;
    const char* A; const int* list; const char* W; size_t w_e, w_pn;
    __device__ __forceinline__ void init(const LAS int* ti, int ntiles_, int nN_, int G_, int c_, const void* A_, const int* list_, const void* W_, size_t w_e_, size_t w_pn_) {
        tinfo = ti; ntiles = ntiles_; nN = nN_; nwg = ntiles_ * nN_; G = G_; c = c_; A = (const char*)A_; list = list_; W = (const char*)W_; w_e = w_e_; w_pn = w_pn_; }
    __device__ __forceinline__ bool next(int i, Unit& u) const {
        const long L = (long)i * G + c; if (L >= nwg) return false;
        int wgid = (int)L; { const int q = nwg / NXCD, r = nwg % NXCD, xcd = wgid % NXCD, off = wgid / NXCD; wgid = (xcd < r ? xcd * (q + 1) : r * (q + 1) + (xcd - r) * q) + off; }
        u.pm = wgid / nN; u.pn = wgid % nN; return true;
    }
    __device__ __forceinline__ const char* a_base(const Unit&) const { return A; }
    __device__ __forceinline__ const char* b_base(const Unit& u) const { const int e = __builtin_amdgcn_readfirstlane(tinfo[u.pm]) & 255; return W + (size_t)e * w_e + (size_t)u.pn * w_pn; }
    __device__ __forceinline__ unsigned a_voff(const Unit& u, int R, int C, int lda) const {
        const int ti = tinfo[u.pm], e = ti & 255, r = (ti >> 8) * 256 + R; const int n = tinfo[TI_CNT + e];
        const int ga = (r < n) ? list[(size_t)e * LIST_CAP + r] : 0;
        return (unsigned)(ga >> 1) * (unsigned)(lda * 2) + (unsigned)C * 2u; }
};

#define ACC_T const f32x4 (&acc)[2][2][4][2]
struct EpiBf16 {
    static constexpr bool PERM = true;
    bf16_t* O; size_t ldc;
    __device__ __forceinline__ void operator()(ACC_T, const Unit& u, int wr, int wc, int fr, int fq) const {
        const int row0 = u.pm * BM + wr * 64 + fr, col0 = u.pn * BM + wc * 32 + 8 * fq;
#pragma unroll
        for (int ai = 0; ai < 2; ++ai)
#pragma unroll
            for (int m = 0; m < 4; ++m) { bf16_t* rowp = O + (size_t)(row0 + ai * HALF + m * 16) * ldc + col0;
#pragma unroll
                for (int bj = 0; bj < 2; ++bj) { const f32x4 v0 = acc[ai][bj][m][0], v1 = acc[ai][bj][m][1];
                    u32x4 w; w.x = cvtpk(v0[0], v0[1]); w.y = cvtpk(v0[2], v0[3]); w.z = cvtpk(v1[0], v1[1]); w.w = cvtpk(v1[2], v1[3]);
                    *(u32x4*)(rowp + bj * HALF) = w; } }
    }
};
struct EpiF32 {
    static constexpr bool PERM = false;
    float* O; size_t ldc;
    __device__ __forceinline__ void operator()(ACC_T, const Unit& u, int wr, int wc, int fr, int fq) const {
        const int row0 = u.pm * BM + wr * 64 + fr, col0 = u.pn * BM + wc * 32 + 4 * fq;
#pragma unroll
        for (int ai = 0; ai < 2; ++ai)
#pragma unroll
            for (int m = 0; m < 4; ++m) { float* rowp = O + (size_t)(row0 + ai * HALF + m * 16) * ldc + col0;
#pragma unroll
                for (int bj = 0; bj < 2; ++bj)
#pragma unroll
                    for (int n = 0; n < 2; ++n) *(f32x4*)(rowp + bj * HALF + n * 16) = acc[ai][bj][m][n]; }
    }
};
struct EpiQ {
    static constexpr bool PERM = true;
    bf16_t* Q; const float* cs; const float* sn;
    __device__ __forceinline__ void operator()(ACC_T, const Unit& u, int wr, int wc, int fr, int fq) const {
        const int row0 = u.pm * BM + wr * 64 + fr;
        if (u.pn < 4) {
#pragma unroll
            for (int ai = 0; ai < 2; ++ai)
#pragma unroll
                for (int m = 0; m < 4; ++m) { const int row = row0 + ai * HALF + m * 16;
#pragma unroll
                    for (int bj = 0; bj < 2; ++bj) { const int col = u.pn * BM + bj * HALF + wc * 32 + 8 * fq; const f32x4 v0 = acc[ai][bj][m][0], v1 = acc[ai][bj][m][1];
                        u32x4 w; w.x = cvtpk(v0[0], v0[1]); w.y = cvtpk(v0[2], v0[3]); w.z = cvtpk(v1[0], v1[1]); w.w = cvtpk(v1[2], v1[3]);
                        *(u32x4*)(Q + (size_t)row * QPITCH + (col >> 6) * 96 + (col & 63)) = w; } }
        } else {
            const int head = (u.pn - 4) * 8 + 2 * wc + (fq >> 1), i0 = 8 * (fq & 1);
#pragma unroll
            for (int ai = 0; ai < 2; ++ai)
#pragma unroll
                for (int m = 0; m < 4; ++m) { const int row = row0 + ai * HALF + m * 16;
                    const f32x4 c0 = *(const f32x4*)(cs + (size_t)row * 16 + i0), c1 = *(const f32x4*)(cs + (size_t)row * 16 + i0 + 4);
                    const f32x4 s0 = *(const f32x4*)(sn + (size_t)row * 16 + i0), s1 = *(const f32x4*)(sn + (size_t)row * 16 + i0 + 4);
                    const f32x4 a0 = acc[ai][0][m][0], a1 = acc[ai][0][m][1], b0 = acc[ai][1][m][0], b1 = acc[ai][1][m][1];
                    const f32x4 y10 = a0 * c0 - b0 * s0, y11 = a1 * c1 - b1 * s1, y20 = b0 * c0 + a0 * s0, y21 = b1 * c1 + a1 * s1;
                    u32x4 w1, w2; w1.x = cvtpk(y10[0], y10[1]); w1.y = cvtpk(y10[2], y10[3]); w1.z = cvtpk(y11[0], y11[1]); w1.w = cvtpk(y11[2], y11[3]);
                    w2.x = cvtpk(y20[0], y20[1]); w2.y = cvtpk(y20[2], y20[3]); w2.z = cvtpk(y21[0], y21[1]); w2.w = cvtpk(y21[2], y21[3]);
                    bf16_t* qp = Q + (size_t)row * QPITCH + head * 96 + 64 + i0;
                    *(u32x4*)qp = w1; *(u32x4*)(qp + 16) = w2; asm volatile("" ::: "memory"); }
        }
    }
};
struct EpiPool {
    static constexpr bool PERM = true;
    bf16_t* F; const float* bias; const float* scale;
    __device__ __forceinline__ void operator()(ACC_T, const Unit& u, int wr, int wc, int fr, int fq) const {
        const int row0 = u.pm * BM + wr * 64 + fr, col0 = u.pn * BM + wc * 32 + 8 * fq;
#pragma unroll
        for (int bj = 0; bj < 2; ++bj) { const int c = col0 + bj * HALF;
            const f32x4 b0 = *(const f32x4*)(bias + c), b1 = *(const f32x4*)(bias + c + 4), s0 = *(const f32x4*)(scale + c), s1 = *(const f32x4*)(scale + c + 4);
#pragma unroll
            for (int ai = 0; ai < 2; ++ai)
#pragma unroll
                for (int m = 0; m < 4; ++m) { const f32x4 v0 = (acc[ai][bj][m][0] + b0) * s0, v1 = (acc[ai][bj][m][1] + b1) * s1;
                    u32x4 w; w.x = cvtpk(v0[0], v0[1]); w.y = cvtpk(v0[2], v0[3]); w.z = cvtpk(v1[0], v1[1]); w.w = cvtpk(v1[2], v1[3]);
                    *(u32x4*)(F + (size_t)(row0 + ai * HALF + m * 16) * 1024 + c) = w; } }
    }
};
struct EpiRouter {
    static constexpr bool PERM = false;
    float* LG;
    __device__ __forceinline__ void operator()(ACC_T, const Unit& u, int wr, int wc, int fr, int fq) const {
        const int row0 = u.pm * BM + wr * 64 + fr;
#pragma unroll
        for (int ai = 0; ai < 2; ++ai)
#pragma unroll
            for (int m = 0; m < 4; ++m) { float* lr = LG + ((size_t)u.pn * NTOK + (size_t)(row0 + ai * HALF + m * 16)) * LGP;
#pragma unroll
                for (int n = 0; n < 2; ++n) { const int j = wc * 32 + 16 * n + 4 * fq; if (j < 72) *(f32x4*)(lr + j) = acc[ai][0][m][n] + acc[ai][1][m][n]; } }
    }
};
struct EpiSwiglu {
    static constexpr bool PERM = true;
    bf16_t* H;
    __device__ __forceinline__ void operator()(ACC_T, const Unit& u, int wr, int wc, int fr, int fq) const {
        const int row0 = u.pm * BM + wr * 64 + fr, col0 = u.pn * HALF + wc * 32 + 8 * fq;
#pragma unroll
        for (int ai = 0; ai < 2; ++ai)
#pragma unroll
            for (int m = 0; m < 4; ++m) { float h[8];
#pragma unroll
                for (int n = 0; n < 2; ++n)
#pragma unroll
                    for (int e = 0; e < 4; ++e) { const float a = acc[ai][0][m][n][e], b = acc[ai][1][m][n][e];
                        h[n * 4 + e] = a * __builtin_amdgcn_rcpf(1.0f + __builtin_amdgcn_exp2f(-1.4426950408889634f * a)) * b; }
                u32x4 w; w.x = cvtpk(h[0], h[1]); w.y = cvtpk(h[2], h[3]); w.z = cvtpk(h[4], h[5]); w.w = cvtpk(h[6], h[7]);
                *(u32x4*)(H + (size_t)(row0 + ai * HALF + m * 16) * D_EXPERT + col0) = w; }
    }
};
struct EpiMoeOut {
    static constexpr bool PERM = true;
    bf16_t* Y; const LAS int* tinfo; const int* list; const float* lgate;
    __device__ __forceinline__ void operator()(ACC_T, const Unit& u, int wr, int wc, int fr, int fq) const {
        const int ti = tinfo[u.pm], e = ti & 255, n = tinfo[TI_CNT + e], r0 = (ti >> 8) * 256 + wr * 64 + fr, col0 = u.pn * BM + wc * 32 + 8 * fq;
#pragma unroll
        for (int ai = 0; ai < 2; ++ai)
#pragma unroll
            for (int m = 0; m < 4; ++m) { const int r = r0 + ai * HALF + m * 16;
                if (r < n) { const size_t li = (size_t)e * LIST_CAP + r; const int ga = list[li]; const float g = lgate[li]; bf16_t* yp = Y + (size_t)ga * D_MODEL + col0;
#pragma unroll
                    for (int bj = 0; bj < 2; ++bj) { const f32x4 v0 = acc[ai][bj][m][0] * g, v1 = acc[ai][bj][m][1] * g;
                        u32x4 w; w.x = cvtpk(v0[0], v0[1]); w.y = cvtpk(v0[2], v0[3]); w.z = cvtpk(v1[0], v1[1]); w.w = cvtpk(v1[2], v1[3]);
                        *(u32x4*)(yp + bj * HALF) = w; } }
                if (m & 1) asm volatile("" ::: "memory"); }
    }
};
#undef ACC_T

template <class Epi, class Sched, bool ALIGN_EPI>
__device__ __forceinline__ void gemm_phase(LAS unsigned char* lds, const Gemm g, const Sched& S, const Epi& E) {
    const int tid = opaque(threadIdx.x), wid = __builtin_amdgcn_readfirstlane(tid >> 6), lane = tid & 63, wr = wid >> 2, wc = wid & 3, fr = lane & 15, fq = lane >> 4;
    const int K = opaque_s(g.K), nt = K / BK;
    unsigned voffB[2]; int Rr[2], Cc[2];
#pragma unroll
    for (int i = 0; i < 2; ++i) { int R, C; stage_rc(tid * 16 + i * 8192, R, C); const int Rb = Epi::PERM ? ((R & ~31) + perm32(R & 31)) : R;
        Rr[i] = R; Cc[i] = C; voffB[i] = (unsigned)(Rb * g.ldb + C) * 2u; }
    const size_t kstep = (size_t)(BK * 2);
    const size_t hstepB = (size_t)HALF * g.ldb * 2;
    const unsigned ldsw = (unsigned)wid * 1024u;
    const int aoff = lds_byte(wr * 64 + fr, fq * 8), boff = lds_byte(wc * 32 + fr, fq * 8);
#define PG8_SA(b, h) (((b) * 2 + (h)) * HTB)
#define PG8_SB(b, h) ((4 + (b) * 2 + (h)) * HTB)
#define PG8_STAGE(bufoff, gbase, voff) do { _Pragma("unroll") for (int _i = 0; _i < 2; ++_i) \
        __builtin_amdgcn_global_load_lds((const unsigned*)((const char*)(gbase) + (voff)[_i]), (LAS unsigned*)(lds + (bufoff) + ldsw + _i * 8192), 16, 0, 0); } while (0)
#define PG8_LDA(dst, b, h) do { _Pragma("unroll") for (int m = 0; m < 4; ++m) _Pragma("unroll") for (int k = 0; k < 2; ++k) dst[m][k] = *(const LAS bf16x8*)(lds + PG8_SA(b, h) + aoff + m * 2048 + k * 1024); } while (0)
#define PG8_LDB(dst, b, h) do { _Pragma("unroll") for (int n = 0; n < 2; ++n) _Pragma("unroll") for (int k = 0; k < 2; ++k) dst[n][k] = *(const LAS bf16x8*)(lds + PG8_SB(b, h) + boff + n * 2048 + k * 1024); } while (0)
#define PG8_MMA(ai, bj, At, Bt) do { __builtin_amdgcn_s_setprio(1); _Pragma("unroll") for (int m = 0; m < 4; ++m) _Pragma("unroll") for (int n = 0; n < 2; ++n) _Pragma("unroll") for (int k = 0; k < 2; ++k) \
        acc[ai][bj][m][n] = __builtin_amdgcn_mfma_f32_16x16x32_bf16(Bt[n][k], At[m][k], acc[ai][bj][m][n], 0, 0, 0); __builtin_amdgcn_s_setprio(0); } while (0)
#define PG8_WAIT_V(n) asm volatile("s_waitcnt vmcnt(" #n ")" ::: "memory")
#define PG8_WAIT_L(n) asm volatile("s_waitcnt lgkmcnt(" #n ")" ::: "memory")
#define PG8_BAR __builtin_amdgcn_s_barrier()
#define PG8_SCHED __builtin_amdgcn_sched_barrier(0)
    Unit cur, nxt; int ui = 0;
    if (!S.next(0, cur)) return;
    f32x4 acc[2][2][4][2];
#pragma unroll
    for (int a = 0; a < 2; ++a)
#pragma unroll
        for (int b = 0; b < 2; ++b)
#pragma unroll
            for (int m = 0; m < 4; ++m)
#pragma unroll
                for (int n = 0; n < 2; ++n) acc[a][b][m][n] = (f32x4){0.f, 0.f, 0.f, 0.f};
    bf16x8 At[4][2], B0[2][2], B1[2][2];
    const char* cA = S.a_base(cur); const char* cB = S.b_base(cur);
    unsigned vA[2][2], vN[2][2];
#pragma unroll
    for (int h = 0; h < 2; ++h)
#pragma unroll
        for (int i = 0; i < 2; ++i) { vA[h][i] = S.a_voff(cur, Rr[i] + h * HALF, Cc[i], g.lda); vN[h][i] = vA[h][i]; }
    PG8_STAGE(PG8_SB(0, 0), cB, voffB); PG8_STAGE(PG8_SB(0, 1), cB + hstepB, voffB); PG8_STAGE(PG8_SA(0, 0), cA, vA[0]); PG8_STAGE(PG8_SA(0, 1), cA, vA[1]);
    if (wr == 1) PG8_BAR;
    PG8_WAIT_V(2); PG8_BAR;
    PG8_STAGE(PG8_SB(1, 0), cB + kstep, voffB); PG8_STAGE(PG8_SA(1, 0), cA + kstep, vA[0]); PG8_STAGE(PG8_SB(1, 1), cB + hstepB + kstep, voffB);
    PG8_WAIT_V(6); PG8_BAR;
    for (;;) {
        const bool has_next = S.next(ui + 1, nxt);
        const char* nA = has_next ? S.a_base(nxt) : cA; const char* nB = has_next ? S.b_base(nxt) : cB;
        if (has_next) {
#pragma unroll
            for (int h = 0; h < 2; ++h)
#pragma unroll
                for (int i = 0; i < 2; ++i) vN[h][i] = S.a_voff(nxt, Rr[i] + h * HALF, Cc[i], g.lda);
        }
#pragma nounroll
        for (int t = 0; t < nt; t += 2) {
            const bool last = (t == nt - 2);
            const char* a1 = cA + (size_t)(t + 1) * kstep;
            const char* a2 = last ? nA : cA + (size_t)(t + 2) * kstep; const char* b2 = last ? nB : cB + (size_t)(t + 2) * kstep;
            const char* a3 = a2 + kstep; const char* b3 = b2 + kstep;
            unsigned w0[2], w1[2];
#pragma unroll
            for (int i = 0; i < 2; ++i) { w0[i] = last ? vN[0][i] : vA[0][i]; w1[i] = last ? vN[1][i] : vA[1][i]; }
            PG8_LDB(B0, 0, 0); PG8_LDB(B1, 0, 1); PG8_SCHED; PG8_LDA(At, 0, 0); PG8_STAGE(PG8_SA(1, 1), a1, vA[1]);
            PG8_WAIT_V(8); PG8_WAIT_L(0); PG8_BAR; PG8_MMA(0, 0, At, B0); PG8_MMA(0, 1, At, B1); PG8_BAR; PG8_SCHED;
            PG8_LDA(At, 0, 1); PG8_STAGE(PG8_SB(0, 0), b2, voffB); PG8_STAGE(PG8_SB(0, 1), b2 + hstepB, voffB); PG8_STAGE(PG8_SA(0, 0), a2, w0);
            PG8_WAIT_V(8); PG8_WAIT_L(0); PG8_BAR; PG8_MMA(1, 0, At, B0); PG8_MMA(1, 1, At, B1); PG8_BAR; PG8_SCHED;
            PG8_LDB(B0, 1, 0); PG8_LDB(B1, 1, 1); PG8_SCHED; PG8_LDA(At, 1, 0); PG8_STAGE(PG8_SA(0, 1), a2, w1);
            PG8_WAIT_V(8); PG8_WAIT_L(0); PG8_BAR; PG8_MMA(0, 0, At, B0); PG8_MMA(0, 1, At, B1); PG8_BAR; PG8_SCHED;
            PG8_LDA(At, 1, 1); PG8_STAGE(PG8_SB(1, 0), b3, voffB); PG8_STAGE(PG8_SB(1, 1), b3 + hstepB, voffB); PG8_STAGE(PG8_SA(1, 0), a3, w0);
            PG8_WAIT_V(8); PG8_WAIT_L(0); PG8_BAR; PG8_MMA(1, 0, At, B0); PG8_MMA(1, 1, At, B1); PG8_BAR; PG8_SCHED;
        }
        if constexpr (ALIGN_EPI) { if (wr == 0) PG8_BAR; }
        E(acc, cur, wr, wc, fr, fq);
        if (!has_next) break;
#pragma unroll
        for (int a = 0; a < 2; ++a)
#pragma unroll
            for (int b = 0; b < 2; ++b)
#pragma unroll
                for (int m = 0; m < 4; ++m)
#pragma unroll
                    for (int n = 0; n < 2; ++n) acc[a][b][m][n] = (f32x4){0.f, 0.f, 0.f, 0.f};
        cur = nxt; cA = nA; cB = nB; ++ui;
#pragma unroll
        for (int h = 0; h < 2; ++h)
#pragma unroll
            for (int i = 0; i < 2; ++i) vA[h][i] = vN[h][i];
        if constexpr (ALIGN_EPI) { if (wr == 1) PG8_BAR; }
    }
    PG8_WAIT_V(0);
    if constexpr (!ALIGN_EPI) { if (wr == 0) PG8_BAR; }
    PG8_BAR;
#undef PG8_SA
#undef PG8_SB
#undef PG8_STAGE
#undef PG8_LDA
#undef PG8_LDB
#undef PG8_MMA
#undef PG8_WAIT_V
#undef PG8_WAIT_L
#undef PG8_BAR
#undef PG8_SCHED
}
}

namespace att {
constexpr int KSLOT = 12288, VSLOT = 8192, LDS_K = 0, LDS_V = 3 * KSLOT, LDS_BYTES = LDS_V + 3 * VSLOT;
constexpr float THR = 6.0f;
__device__ __forceinline__ int nx3(int s) { return s == 2 ? 0 : s + 1; }
__device__ __forceinline__ int pv3(int s) { return s == 0 ? 2 : s - 1; }
__device__ __forceinline__ void glds16(const void* g, LAS unsigned char* l) { __builtin_amdgcn_global_load_lds((const unsigned*)g, (LAS unsigned*)l, 16, 0, 0); }

template <bool FIRST, bool GEN>
__device__ __forceinline__ void att_step(f32x16& c0, f32x16& c1, f32x16& n0, f32x16& n1, f32x16& o0, f32x16& o1, f32x16& negm, float& mhat, float& lsum, u32x4 (&pw)[4], const bf16x8 (&qr)[6],
                                         const LAS unsigned char* kb_next, const LAS unsigned char* vb_prev, bool act_prev, bool act_cur, bool act_nxt, int jb, int qrel, int hi) {
    const bool do_pv = !FIRST && (!GEN || act_prev), do_cur = !GEN || act_cur, do_qk = !GEN || act_nxt;
    bf16x8 vfr[8], kfa[6], kfb[6];
    if (do_pv) {
#pragma unroll
        for (int kc2 = 0; kc2 < 4; ++kc2) { vfr[2 * kc2] = *(const LAS bf16x8*)(vb_prev + kc2 * 2048); vfr[2 * kc2 + 1] = *(const LAS bf16x8*)(vb_prev + kc2 * 2048 + 512); }
    }
    if (do_qk) {
#pragma unroll
        for (int d0 = 0; d0 < 3; ++d0) { kfa[2 * d0] = *(const LAS bf16x8*)(kb_next + d0 * 2048); kfa[2 * d0 + 1] = *(const LAS bf16x8*)(kb_next + d0 * 2048 + 512); }
    }
    __builtin_amdgcn_sched_barrier(0);
    float rm = 0.f;
    if (do_cur) {
        if ((GEN || FIRST) && jb >= 0) {
            const int kb0 = 64 * jb + 8 * hi;
#pragma unroll
            for (int r = 0; r < 16; ++r) { const int key = kb0 + (r & 3) + 4 * ((r >> 2) & 1) + 16 * (r >> 3);
                if (key > qrel) c0[r] = -INFINITY; if (key + 32 > qrel) c1[r] = -INFINITY; }
        }
        float ra = fmaxf(fmaxf(c0[0], c0[1]), c1[0]), rb = fmaxf(fmaxf(c0[2], c0[3]), c1[1]);
        ra = fmaxf(fmaxf(ra, c1[2]), c1[3]);
#pragma unroll
        for (int r = 4; r < 16; r += 4) { ra = fmaxf(fmaxf(ra, c0[r]), c0[r + 1]); rb = fmaxf(fmaxf(rb, c0[r + 2]), c0[r + 3]); ra = fmaxf(fmaxf(ra, c1[r]), c1[r + 1]); rb = fmaxf(fmaxf(rb, c1[r + 2]), c1[r + 3]); }
        rm = fmaxf(ra, rb);
        { auto rr = __builtin_amdgcn_permlane32_swap(__float_as_uint(rm), __float_as_uint(rm), false, false); rm = fmaxf(__uint_as_float(rr[0]), __uint_as_float(rr[1])); }
    }
    if (do_pv) {
#pragma unroll
        for (int kc2 = 0; kc2 < 4; ++kc2) {
            const bf16x8 pf = __builtin_bit_cast(bf16x8, pw[kc2]);
            o0 = __builtin_amdgcn_mfma_f32_32x32x16_bf16(vfr[2 * kc2], pf, o0, 0, 0, 0);
            o1 = __builtin_amdgcn_mfma_f32_32x32x16_bf16(vfr[2 * kc2 + 1], pf, o1, 0, 0, 0);
        }
    }
    __builtin_amdgcn_sched_barrier(0);
    if (do_qk) {
#pragma unroll
        for (int d0 = 0; d0 < 3; ++d0) { kfb[2 * d0] = *(const LAS bf16x8*)(kb_next + (d0 + 3) * 2048); kfb[2 * d0 + 1] = *(const LAS bf16x8*)(kb_next + (d0 + 3) * 2048 + 512); }
    }
    __builtin_amdgcn_sched_barrier(0);
    if (do_cur) {
        if (FIRST) {
            mhat = rm;
#pragma unroll
            for (int r = 0; r < 16; ++r) { c0[r] -= rm; c1[r] -= rm; negm[r] = -rm; }
        } else if (__any(rm > THR)) {
            const float dl = fmaxf(rm, 0.f); mhat += dl;
            const float f = __builtin_amdgcn_exp2f(-dl); lsum *= f;
#pragma unroll
            for (int r = 0; r < 16; ++r) { c0[r] -= dl; c1[r] -= dl; o0[r] *= f; o1[r] *= f; negm[r] = -mhat; }
        }
    }
    if (do_qk) {
        n0 = __builtin_amdgcn_mfma_f32_32x32x16_bf16(kfa[0], qr[0], negm, 0, 0, 0);
        n1 = __builtin_amdgcn_mfma_f32_32x32x16_bf16(kfa[1], qr[0], negm, 0, 0, 0);
#pragma unroll
        for (int d0 = 1; d0 < 3; ++d0) { n0 = __builtin_amdgcn_mfma_f32_32x32x16_bf16(kfa[2 * d0], qr[d0], n0, 0, 0, 0); n1 = __builtin_amdgcn_mfma_f32_32x32x16_bf16(kfa[2 * d0 + 1], qr[d0], n1, 0, 0, 0); }
#pragma unroll
        for (int d0 = 0; d0 < 3; ++d0) { n0 = __builtin_amdgcn_mfma_f32_32x32x16_bf16(kfb[2 * d0], qr[d0 + 3], n0, 0, 0, 0); n1 = __builtin_amdgcn_mfma_f32_32x32x16_bf16(kfb[2 * d0 + 1], qr[d0 + 3], n1, 0, 0, 0); }
    }
    if (do_cur) {
        float sa = 0.f, sb = 0.f;
#pragma unroll
        for (int r = 0; r < 16; ++r) { c0[r] = __builtin_amdgcn_exp2f(c0[r]); c1[r] = __builtin_amdgcn_exp2f(c1[r]); sa += c0[r]; sb += c1[r]; }
        lsum += sa + sb;
#pragma unroll
        for (int i = 0; i < 2; ++i) {
            pw[i] = (u32x4){cvtpk(c0[8 * i], c0[8 * i + 1]), cvtpk(c0[8 * i + 2], c0[8 * i + 3]), cvtpk(c0[8 * i + 4], c0[8 * i + 5]), cvtpk(c0[8 * i + 6], c0[8 * i + 7])};
            pw[2 + i] = (u32x4){cvtpk(c1[8 * i], c1[8 * i + 1]), cvtpk(c1[8 * i + 2], c1[8 * i + 3]), cvtpk(c1[8 * i + 4], c1[8 * i + 5]), cvtpk(c1[8 * i + 6], c1[8 * i + 7])};
        }
        asm volatile("" : "+v"(pw[0]), "+v"(pw[1]), "+v"(pw[2]), "+v"(pw[3]), "+v"(lsum));
    }
    __builtin_amdgcn_sched_barrier(0);
}

__device__ __forceinline__ void attn_unit(int b, int h, int qb, const bf16_t* __restrict__ Q, const bf16_t* __restrict__ KN, const bf16_t* __restrict__ KR, const bf16_t* __restrict__ VT, bf16_t* __restrict__ O, LAS unsigned char* lds) {
    const int tid = opaque(threadIdx.x), lane = tid & 63, r32 = lane & 31, hi = lane >> 5;
    const int w = __builtin_amdgcn_readfirstlane(tid >> 6);
    const size_t tok0 = (size_t)b * SEQ;
    const int q0 = qb * 256, NT = 4 * (qb + 1);
    const bf16_t* ksrc = KN + (tok0 + lane) * 1024 + h * 64 + 8 * w;
    const bf16_t* rsrc = KR + (tok0 + lane) * 32 + 8 * (w & 3);
    const bf16_t* vsrc = VT + (size_t)(h * 64 + lane) * NTOK + tok0 + 8 * w;
#define ATT_ISSUE_K(t, slot) do { glds16(ksrc + (size_t)(t) * 65536, lds + LDS_K + (slot) * KSLOT + w * 1024); \
        if (w < 4) glds16(rsrc + (size_t)(t) * 2048, lds + LDS_K + (slot) * KSLOT + (8 + w) * 1024); } while (0)
#define ATT_ISSUE_V(t, slot) glds16(vsrc + (size_t)(t) * 64, lds + LDS_V + (slot) * VSLOT + w * 1024)
    ATT_ISSUE_K(0, 0); ATT_ISSUE_K(1, 1); ATT_ISSUE_K(2, 2); ATT_ISSUE_V(0, 0);
    bf16x8 qr[6];
    { const bf16_t* qp = Q + (tok0 + q0 + w * 32 + r32) * QPITCH + h * 96 + hi * 8;
#pragma unroll
      for (int d0 = 0; d0 < 6; ++d0) qr[d0] = *(const bf16x8*)(qp + d0 * 16); }
    const int kvp = (r32 & 19) | ((r32 & 4) << 1) | ((r32 & 8) >> 1);
    const LAS unsigned char* kf = lds + LDS_K + hi * 1024 + kvp * 16;
    const LAS unsigned char* vf = lds + LDS_V + hi * 1024 + r32 * 16;
    float mhat = 0.f, lsum = 0.f;
    f32x16 o0 = {}, o1 = {}, negm = {}, sA0 = {}, sA1 = {}, sB0, sB1;
    u32x4 pw[4] = {};
    const int qrel = w * 32 + r32, wb = w >> 1;
    asm volatile("s_waitcnt vmcnt(0)" ::: "memory");
    __builtin_amdgcn_s_barrier();
    asm volatile("" ::: "memory");
#pragma unroll
    for (int d0 = 0; d0 < 6; ++d0) {
        const bf16x8 k0 = *(const LAS bf16x8*)(kf + d0 * 2048), k1 = *(const LAS bf16x8*)(kf + d0 * 2048 + 512);
        sA0 = __builtin_amdgcn_mfma_f32_32x32x16_bf16(k0, qr[d0], sA0, 0, 0, 0);
        sA1 = __builtin_amdgcn_mfma_f32_32x32x16_bf16(k1, qr[d0], sA1, 0, 0, 0);
    }
    int st = 0;
#define ATT_SYNC(t) do { \
        if ((t) == 0 || (t) + 2 >= NT) asm volatile("s_waitcnt vmcnt(0)" ::: "memory"); \
        else if (w < 4) asm volatile("s_waitcnt vmcnt(3)" ::: "memory"); \
        else asm volatile("s_waitcnt vmcnt(2)" ::: "memory"); \
        __builtin_amdgcn_s_barrier(); asm volatile("" ::: "memory"); \
        if ((t) + 3 < NT) ATT_ISSUE_K((t) + 3, st); \
        if ((t) + 1 < NT) ATT_ISSUE_V((t) + 1, nx3(st)); } while (0)
#define ATT_ACT(tt) (((tt) - (NT - 4)) < 0 || ((tt) - (NT - 4)) <= wb)
#define ATT_STEP(FIRST, GEN, C0, C1, N0, N1, t) do { ATT_SYNC(t); \
        att_step<FIRST, GEN>(C0, C1, N0, N1, o0, o1, negm, mhat, lsum, pw, qr, kf + nx3(st) * KSLOT, vf + pv3(st) * VSLOT, \
                             (t) > 0 && ATT_ACT((t) - 1), ATT_ACT(t), (t) + 1 < NT && ATT_ACT((t) + 1), (t) - (NT - 4), qrel, hi); \
        st = nx3(st); } while (0)
    ATT_STEP(true, true, sA0, sA1, sB0, sB1, 0);
    int t = 1;
    const int ts = (NT > 4) ? NT - 5 : 1;
    for (; t + 1 < ts; t += 2) {
        ATT_STEP(false, false, sB0, sB1, sA0, sA1, t);
        ATT_STEP(false, false, sA0, sA1, sB0, sB1, t + 1);
    }
    if (NT > 4) { ATT_STEP(false, true, sB0, sB1, sA0, sA1, NT - 5); ATT_STEP(false, true, sA0, sA1, sB0, sB1, NT - 4); }
    ATT_STEP(false, true, sB0, sB1, sA0, sA1, NT - 3);
    ATT_STEP(false, true, sA0, sA1, sB0, sB1, NT - 2);
    ATT_STEP(false, true, sB0, sB1, sA0, sA1, NT - 1);
    if (ATT_ACT(NT - 1)) {
        const LAS unsigned char* vb = vf + pv3(st) * VSLOT;
#pragma unroll
        for (int kc2 = 0; kc2 < 4; ++kc2) {
            const bf16x8 v0 = *(const LAS bf16x8*)(vb + kc2 * 2048), v1 = *(const LAS bf16x8*)(vb + kc2 * 2048 + 512);
            const bf16x8 pf = __builtin_bit_cast(bf16x8, pw[kc2]);
            o0 = __builtin_amdgcn_mfma_f32_32x32x16_bf16(v0, pf, o0, 0, 0, 0);
            o1 = __builtin_amdgcn_mfma_f32_32x32x16_bf16(v1, pf, o1, 0, 0, 0);
        }
    }
    { auto rr = __builtin_amdgcn_permlane32_swap(__float_as_uint(lsum), __float_as_uint(lsum), false, false); lsum = __uint_as_float(rr[0]) + __uint_as_float(rr[1]); }
    const float inv = 1.0f / lsum;
    bf16_t* op = O + (tok0 + q0 + w * 32 + r32) * 1024 + h * 64 + 4 * hi;
#pragma unroll
    for (int g = 0; g < 4; ++g) {
        u32x2 a, c; a.x = cvtpk(o0[4 * g] * inv, o0[4 * g + 1] * inv); a.y = cvtpk(o0[4 * g + 2] * inv, o0[4 * g + 3] * inv);
        c.x = cvtpk(o1[4 * g] * inv, o1[4 * g + 1] * inv); c.y = cvtpk(o1[4 * g + 2] * inv, o1[4 * g + 3] * inv);
        *(u32x2*)(op + 8 * g) = a; *(u32x2*)(op + 32 + 8 * g) = c;
    }
    asm volatile("s_waitcnt lgkmcnt(0)" ::: "memory");
    __builtin_amdgcn_s_barrier();
#undef ATT_ISSUE_K
#undef ATT_ISSUE_V
#undef ATT_SYNC
#undef ATT_ACT
#undef ATT_STEP
}
}

#define XB_TMO      128
#define XB_XCNT(j)  (256  + 64 * (j))
#define XB_XSUB(j)  (1280 + 64 * (j))
#define XB_XGEN(j)  (2304 + 64 * (j))
#define XB_TOP      3328
#define XB_TOPGEN   3392
#define XCD_BAR_WORDS 3456
#define XB_SPIN_CAP (1u << 18)
__device__ __forceinline__ unsigned xb_ld(unsigned* p)              { return __hip_atomic_load(p, __ATOMIC_RELAXED, __HIP_MEMORY_SCOPE_AGENT); }
__device__ __forceinline__ unsigned xb_add(unsigned* p, unsigned v) { return __hip_atomic_fetch_add(p, v, __ATOMIC_RELAXED, __HIP_MEMORY_SCOPE_AGENT); }
__device__ __forceinline__ unsigned xb_xcc_id() { return (unsigned)__builtin_amdgcn_s_getreg((3 << 11) | 20) & 0xFu; }
#define XB_SPIN(cond, bar) do { unsigned _sp = 0; while (cond) { __builtin_amdgcn_s_sleep(1); \
    if ((++_sp & 255u) == 0u) { if (xb_ld(&(bar)[XB_TMO])) break; if (_sp > XB_SPIN_CAP) { atomicAdd(&(bar)[XB_TMO], 1u); break; } } } } while (0)
struct XcdBarrier { unsigned* bar; unsigned x; volatile LAS unsigned* st; };
__device__ __forceinline__ XcdBarrier xcd_barrier_post(unsigned* bar, volatile LAS unsigned* st) {
    XcdBarrier b; b.bar = bar; b.x = xb_xcc_id(); b.st = st;
    if (threadIdx.x == 0) (void)xb_add(&bar[XB_XCNT(b.x)], 1u);
    return b;
}
__device__ __forceinline__ void xcd_barrier_complete(unsigned* bar, unsigned x, unsigned& nloc, unsigned& nx) {
    const unsigned G = gridDim.x * gridDim.y * gridDim.z;
    unsigned sum, cnt, mine, sp = 0u;
    for (;;) {
        sum = 0u; cnt = 0u; mine = 0u;
#pragma unroll
        for (unsigned j = 0; j < 16; ++j) { const unsigned c = xb_ld(&bar[XB_XCNT(j)]); sum += c; cnt += (c > 0u) ? 1u : 0u; mine = (j == x) ? c : mine; }
        if (sum == G) break;
        __builtin_amdgcn_s_sleep(1);
        if ((++sp & 255u) == 0u) { if (xb_ld(&bar[XB_TMO])) break; if (sp > XB_SPIN_CAP) { atomicAdd(&bar[XB_TMO], 1u); break; } }
    }
    nloc = mine > 0u ? mine : 1u; nx = cnt > 0u ? cnt : 1u;
}
__device__ __forceinline__ void xcd_barrier(const XcdBarrier& b) {
    asm volatile("s_waitcnt vmcnt(0)" ::: "memory");
    __syncthreads();
    if (threadIdx.x == 0) {
        unsigned* bar = b.bar;
        __builtin_amdgcn_s_waitcnt(0);
        unsigned nloc = b.st[0], nx = b.st[1];
        if (nloc == 0u) { xcd_barrier_complete(bar, b.x, nloc, nx); b.st[0] = nloc; b.st[1] = nx; }
        const unsigned old = xb_add(&bar[XB_XSUB(b.x)], 1u);
        const unsigned gen = old / nloc;
        if (old + 1u == (gen + 1u) * nloc) {
            __builtin_amdgcn_fence(__ATOMIC_RELEASE, "agent");
            asm volatile("s_waitcnt vmcnt(0)" ::: "memory");
            const unsigned og = xb_add(&bar[XB_TOP], 1u);
            const unsigned tg = og / nx;
            if (og + 1u == (tg + 1u) * nx) xb_add(&bar[XB_TOPGEN], 1u);
            else XB_SPIN(xb_ld(&bar[XB_TOPGEN]) == tg, bar);
            __builtin_amdgcn_fence(__ATOMIC_ACQUIRE, "agent");
            xb_add(&bar[XB_XGEN(b.x)], 1u);
            asm volatile("s_waitcnt vmcnt(0)" ::: "memory");
        } else {
            XB_SPIN(xb_ld(&bar[XB_XGEN(b.x)]) == gen, bar);
            __builtin_amdgcn_fence(__ATOMIC_ACQUIRE, "agent");
            asm volatile("s_waitcnt vmcnt(0)" ::: "memory");
        }
    }
    __syncthreads();
}

struct Args { const void* in[20]; float* out; unsigned char* ws; int ph_lo, ph_hi; };
typedef const __attribute__((address_space(4))) Args* KArgs;
__device__ __forceinline__ KArgs kargs() { KArgs p = (KArgs)__builtin_amdgcn_kernarg_segment_ptr(); asm volatile("" : "+s"(p)); return p; }
constexpr int NWAVES = 8;
constexpr int PPL = 12;
constexpr int NPHASE = 1 + DEPTH * PPL;

__constant__ double c_invf[16] = {1.0, 0.5623413251903491, 0.31622776601683794, 0.1778279410038923, 0.1, 0.05623413251903491, 0.03162277660168379, 0.01778279410038923,
                                  0.01, 0.005623413251903491, 0.0031622776601683794, 0.0017782794100389228, 0.001, 0.0005623413251903491, 0.00031622776601683794, 0.00017782794100389227};

__device__ __forceinline__ void transpose_item(const float* __restrict__ W, int ldw, int k0, int n0, bf16_t* __restrict__ WT, int ldt, int drow0, float mul, LAS float* scr, int lane) {
#pragma unroll 8
    for (int i = 0; i < 32; ++i) { const int kk = 2 * i + (lane >> 5); scr[kk * 33 + (lane & 31)] = W[(size_t)(k0 + kk) * ldw + n0 + (lane & 31)]; }
    LDS_WAIT(); asm volatile("" ::: "memory");
    const int c = lane & 7;
#pragma unroll
    for (int j = 0; j < 4; ++j) { const int n = (lane >> 3) + 8 * j; const LAS float* s = scr + (8 * c) * 33 + n;
        u32x4 o; o.x = cvtpk(s[0 * 33] * mul, s[1 * 33] * mul); o.y = cvtpk(s[2 * 33] * mul, s[3 * 33] * mul); o.z = cvtpk(s[4 * 33] * mul, s[5 * 33] * mul); o.w = cvtpk(s[6 * 33] * mul, s[7 * 33] * mul);
        *(u32x4*)(WT + (size_t)(drow0 + n) * ldt + k0 + 8 * c) = o; }
    LDS_WAIT(); asm volatile("" ::: "memory");
}

__device__ __forceinline__ void transpose_item64(const float* __restrict__ W, int ldw, int k0, int n0, bf16_t* __restrict__ WT, int ldt, int drow0, LAS float* scr, int lane) {
    f32x4 v[16];
    const float* src = W + (size_t)(k0 + (lane >> 4)) * ldw + n0 + 4 * (lane & 15);
#pragma unroll
    for (int i = 0; i < 16; ++i) v[i] = *(const f32x4*)(src + (size_t)(4 * i) * ldw);
#pragma unroll
    for (int i = 0; i < 16; ++i) *(LAS f32x4*)(scr + (4 * i + (lane >> 4)) * 68 + 4 * (lane & 15)) = v[i];
    LDS_WAIT(); asm volatile("" ::: "memory");
    bf16_t* dst = WT + (size_t)(drow0 + lane) * ldt + k0;
#pragma unroll
    for (int c = 0; c < 8; ++c) { const LAS float* sp = scr + (8 * c) * 68 + lane;
        u32x4 o; o.x = cvtpk(sp[0], sp[68]); o.y = cvtpk(sp[2 * 68], sp[3 * 68]); o.z = cvtpk(sp[4 * 68], sp[5 * 68]); o.w = cvtpk(sp[6 * 68], sp[7 * 68]);
        *(u32x4*)(dst + 8 * c) = o; }
    LDS_WAIT(); asm volatile("" ::: "memory");
}

__device__ __forceinline__ void sincos_d(double a, float& s, float& c) {
    const double TWO_PI_HI = 6.283185307179586, TWO_PI_LO = 2.4492935982947064e-16, INV_2PI = 0.15915494309189535;
    const double n = __builtin_rint(a * INV_2PI);
    double r = __builtin_fma(-n, TWO_PI_HI, a); r = __builtin_fma(-n, TWO_PI_LO, r);
    const double HALF_PI = 1.5707963267948966, HALF_PI_LO = 6.123233995736766e-17;
    const double qd = __builtin_rint(r * 0.6366197723675814);
    double y = __builtin_fma(-qd, HALF_PI, r); y = __builtin_fma(-qd, HALF_PI_LO, y);
    const int q = ((int)qd) & 3;
    const double y2 = y * y;
    double sp = -7.647163731819816e-13; sp = sp * y2 + 1.6059043836821613e-10; sp = sp * y2 - 2.505210838544172e-08; sp = sp * y2 + 2.7557319223985893e-06; sp = sp * y2 - 0.0001984126984126984;
    sp = sp * y2 + 0.008333333333333333; sp = sp * y2 - 0.16666666666666666; sp = y + y * y2 * sp;
    double cp = 4.779477332387385e-14; cp = cp * y2 - 1.1470745597729725e-11; cp = cp * y2 + 2.08767569878681e-09; cp = cp * y2 - 2.755731922398589e-07; cp = cp * y2 + 2.48015873015873e-05;
    cp = cp * y2 - 0.001388888888888889; cp = cp * y2 + 0.041666666666666664; cp = cp * y2 - 0.5; cp = 1.0 + y2 * cp;
    double ss, cc;
    if (q == 0) { ss = sp; cc = cp; } else if (q == 1) { ss = cp; cc = -sp; } else if (q == 2) { ss = -sp; cc = -cp; } else { ss = -cp; cc = sp; }
    s = (float)ss; c = (float)cc;
}

__global__ void __launch_bounds__(NWAVES * 64, 2) mk_fwd(Args args_unused) {
    extern __shared__ __attribute__((aligned(16))) unsigned char lds_raw[];
    LAS unsigned char* lds = (LAS unsigned char*)lds_raw;
    volatile LAS unsigned* MISC = (volatile LAS unsigned*)(lds + MISC_OFF);
    int tid = threadIdx.x, lane = tid & 63, wave = __builtin_amdgcn_readfirstlane(tid >> 6);
    const int G = gridDim.x, bx = blockIdx.x;
    const int vcu = (G % 8 == 0) ? (bx % 8) * (G / 8) + bx / 8 : bx;
    int gw = vcu * NWAVES + wave; const int NGW = G * NWAVES;
#define ws (kargs()->ws)
    unsigned* ctl = (unsigned*)(ws + WS_CTL);
    for (int u = tid; u < (LDS_BYTES - LDSCTL_OFF) / 4; u += NWAVES * 64) ((LAS unsigned*)(lds + LDSCTL_OFF))[u] = 0u;
    __syncthreads();
    XcdBarrier bar; bar.bar = ctl + CW_BAR; bar.x = 0; bar.st = nullptr;
#if MK_ONE_LAUNCH
    bar = xcd_barrier_post(ctl + CW_BAR, MISC + 8);
#endif
    const int lo = kargs()->ph_lo, hi = kargs()->ph_hi;
#ifndef MK_REP_MASK
#define MK_REP_MASK 0u
#endif
#define NREP(b) (1 + (int)((MK_REP_MASK >> (b)) & 1u))
#ifndef MK_PH_MASK
#define MK_PH_MASK 0xffffffffu
#endif
#define PHON(b) ((MK_PH_MASK >> (b)) & 1u)
#define IN(k) (lo <= (k) && (k) < hi)
#if MK_ONE_LAUNCH
#define SEAM(k) do { if ((k) + 1 < hi) xcd_barrier(bar); } while (0)
#else
#define SEAM(k) do { } while (0)
#endif
#define in_x ((const float*)kargs()->in[0])
#define in_pos ((const int*)kargs()->in[1])
#define ln_g ((const float*)kargs()->in[2])
#define ln_b ((const float*)kargs()->in[3])
#define w_in ((const float*)kargs()->in[4])
#define q_norm ((const float*)kargs()->in[5])
#define w_uq ((const float*)kargs()->in[6])
#define kv_norm ((const float*)kargs()->in[7])
#define w_ukv ((const float*)kargs()->in[8])
#define w_o ((const float*)kargs()->in[9])
#define pool_w ((const float*)kargs()->in[10])
#define pool_b ((const float*)kargs()->in[11])
#define pool_scale ((const float*)kargs()->in[12])
#define w_grp ((const float*)kargs()->in[13])
#define b_grp ((const float*)kargs()->in[14])
#define w_exp ((const float*)kargs()->in[15])
#define b_exp ((const float*)kargs()->in[16])
#define w1 ((const float*)kargs()->in[17])
#define w3 ((const float*)kargs()->in[18])
#define w2 ((const float*)kargs()->in[19])
#define COS ((float*)(ws + WS_COS))
#define SIN ((float*)(ws + WS_SIN))
#define CNT ((int*)(ws + WS_CNT))
#define TILE ((int*)(ws + WS_TILE))
#define AE ((int*)(ws + WS_AE))
#define APOS ((int*)(ws + WS_APOS))
#define AG ((float*)(ws + WS_AG))
#define RSLOT ((int*)(ws + WS_RSLOT))
#define RGATE ((float*)(ws + WS_RGATE))
#define WIN ((bf16_t*)(ws + WS_WIN))
#define WUQ ((bf16_t*)(ws + WS_WUQ))
#define WUK ((bf16_t*)(ws + WS_WUK))
#define WUV ((bf16_t*)(ws + WS_WUV))
#define WO ((bf16_t*)(ws + WS_WO))
#define WP ((bf16_t*)(ws + WS_WP))
#define WR ((bf16_t*)(ws + WS_WR))
#define W13L(ll) ((bf16_t*)(ws + (((ll) & 1) ? WS_W13B : WS_W13)))
#define W2TL(ll) ((bf16_t*)(ws + (((ll) & 1) ? WS_W2TB : WS_W2T)))
#define FB ((bf16_t*)(ws + WS_FB))
#define XHL ((bf16_t*)(ws + WS_XHL))
#define LATB ((float*)(ws + WS_LAT))
#define CQ ((bf16_t*)(ws + WS_CQ))
#define CKV ((bf16_t*)(ws + WS_CKV))
#define KR ((bf16_t*)(ws + WS_KR))
#define QB ((bf16_t*)(ws + WS_Q))
#define KN ((bf16_t*)(ws + WS_KN))
#define VT ((bf16_t*)(ws + WS_VT))
#define OB ((bf16_t*)(ws + WS_O))
#define POOLED ((bf16_t*)(ws + WS_POOLED))
#define LG ((float*)(ws + WS_LG))
#define ROWLIST ((int*)(ws + WS_LIST))
#define LGATE ((float*)(ws + WS_LGATE))
#define HS ((bf16_t*)(ws + WS_HS))
#define YB ((bf16_t*)(ws + WS_Y))
    LAS float* scr = (LAS float*)(lds + RING_OFF + wave * SCR_WAVE);

    if (PHON(12) && IN(0)) {
        for (int m = gw; m < NTOK; m += NGW) {
            const f32x4* xr = (const f32x4*)(in_x + (size_t)m * D_MODEL) + 2 * lane; u32x4* oh = (u32x4*)(XHL + (size_t)m * 2048) + lane;
#pragma unroll
            for (int j = 0; j < 2; ++j) oh[64 * j] = pk8(xr[128 * j], xr[128 * j + 1]);
        }
        for (int idx = gw * 64 + lane; idx < NTOK * 16; idx += NGW * 64) { float s, c; sincos_d((double)in_pos[idx >> 4] * c_invf[idx & 15], s, c); COS[idx] = c; SIN[idx] = s; }
        for (int idx = gw * 64 + lane; idx < DEPTH * 2 * 256 * 1024; idx += NGW * 64) {
            const int l = idx >> 19, ks = (idx >> 18) & 1, row = (idx >> 10) & 255, k = idx & 1023;
            const int j = row < 72 ? row : ((row >= 128 && row < 200) ? row - 128 : -1);
            float v = 0.f;
            if (j >= 0 && !(ks == 1 && row >= 128)) { const float wv = (j < 8) ? w_grp[((size_t)l * 1024 + k) * 8 + j] : w_exp[((size_t)l * 1024 + k) * 64 + (j - 8)];
                const float whi = bflo(cvtpk(wv, 0.f)); v = (row < 72) ? whi : (wv - whi); }
            WR[idx] = (bf16_t)(cvtpk(v, 0.f) & 0xffffu);
        }
        for (int idx = gw * 64 + lane; idx < 2 * 96 * 1024 / 8; idx += NGW * 64) { const int j = idx / (96 * 128), r = idx % (96 * 128); *(u32x4*)(WIN + ((size_t)j * 512 + 416) * 1024 + (size_t)r * 8) = (u32x4){0u, 0u, 0u, 0u}; }
        constexpr int I_IN = 16 * 13, I_UQ = 4 * 48, I_UKV = 2 * 64, I_O = 16 * 32, I_P = 4 * 8;
        constexpr int NIT = 2 * (I_IN + I_UQ + I_UKV + I_O) + 8 * I_P;
        for (int it = gw; it < NIT; it += NGW) {
            int r = it;
            if (r < 2 * I_IN) { const int j = r / I_IN, q = r % I_IN, kb = q / 13, nb = q % 13;
                transpose_item(w_in + (size_t)j * 1024 * LAT, LAT, 64 * kb, 32 * nb, WIN + (size_t)j * 512 * 1024, 1024, 32 * nb, 1.f, scr, lane); continue; } r -= 2 * I_IN;
            if (r < 2 * I_UQ) { const int j = r / I_UQ, q = r % I_UQ, kb = q / 48, nb = q % 48; const int n0 = 32 * nb, head = n0 / 96, r0 = n0 % 96;
                if (r0 < 64) transpose_item(w_uq + (size_t)j * 256 * QPITCH, QPITCH, 64 * kb, n0, WUQ + (size_t)j * 1536 * 256, 256, head * 64 + r0, QSCALE, scr, lane);
                else {
                    const float* W = w_uq + (size_t)j * 256 * QPITCH; bf16_t* WT = WUQ + (size_t)j * 1536 * 256; const int k0 = 64 * kb;
#pragma unroll 8
                    for (int i = 0; i < 32; ++i) { const int kk = 2 * i + (lane >> 5); scr[kk * 33 + (lane & 31)] = W[(size_t)(k0 + kk) * QPITCH + n0 + (lane & 31)]; }
                    LDS_WAIT(); asm volatile("" ::: "memory");
                    const int c = lane & 7;
#pragma unroll
                    for (int jj = 0; jj < 4; ++jj) { const int n = (lane >> 3) + 8 * jj; const LAS float* s = scr + (8 * c) * 33 + n;
                        const int drow = 1024 + (head >> 3) * 256 + (head & 7) * 16 + (n < 16 ? n : 128 + n - 16);
                        u32x4 o; o.x = cvtpk(s[0 * 33] * QSCALE, s[1 * 33] * QSCALE); o.y = cvtpk(s[2 * 33] * QSCALE, s[3 * 33] * QSCALE); o.z = cvtpk(s[4 * 33] * QSCALE, s[5 * 33] * QSCALE); o.w = cvtpk(s[6 * 33] * QSCALE, s[7 * 33] * QSCALE);
                        *(u32x4*)(WT + (size_t)drow * 256 + k0 + 8 * c) = o; }
                    LDS_WAIT(); asm volatile("" ::: "memory");
                }
                continue; } r -= 2 * I_UQ;
            if (r < 2 * I_UKV) { const int j = r / I_UKV, q = r % I_UKV, kb = q / 64, nb = q % 64; const int n0 = 32 * nb, head = n0 >> 7, r0 = n0 & 127;
                if (r0 < 64) transpose_item(w_ukv + (size_t)j * 128 * 2048, 2048, 64 * kb, n0, WUK + (size_t)j * 1024 * 128, 128, head * 64 + r0, 1.f, scr, lane);
                else transpose_item(w_ukv + (size_t)j * 128 * 2048, 2048, 64 * kb, n0, WUV + (size_t)j * 1024 * 128, 128, head * 64 + r0 - 64, 1.f, scr, lane);
                continue; } r -= 2 * I_UKV;
            if (r < 2 * I_O) { const int j = r / I_O, q = r % I_O, kb = q / 32, nb = q % 32;
                transpose_item(w_o + (size_t)j * 1024 * 1024, 1024, 64 * kb, 32 * nb, WO + (size_t)j * 1024 * 1024, 1024, 32 * nb, 1.f, scr, lane); continue; } r -= 2 * I_O;
            { const int jg = r / I_P, q = r % I_P, kb = q / 8, nb = q % 8;
                transpose_item(pool_w + (size_t)jg * 65536, 256, 64 * kb, 32 * nb, WP + (size_t)jg * 65536, 256, 32 * nb, 1.f, scr, lane); }
        }
        SEAM(0);
    }

    for (int l = 0; l < DEPTH; ++l) {
        const int pb = 1 + PPL * l, j = l >> 1;
        tid = opaque(threadIdx.x); lane = tid & 63; wave = __builtin_amdgcn_readfirstlane(tid >> 6); gw = vcu * NWAVES + wave; scr = (LAS float*)(lds + RING_OFF + wave * SCR_WAVE);
        const bool mla = (l & 1) == 0;
#define MOE_CONV_ITEM(it) do { const int cl = l + ((it) >= 12288 ? 1 : 0); int r = (it) - ((it) >= 12288 ? 12288 : 0); \
            if (r < 8192) { const int which = r >> 12, q = r & 4095, e = q >> 6, kb = (q >> 2) & 15, nb = q & 3; const int n0 = 64 * nb; \
                const float* W = (which ? w3 : w1) + ((size_t)cl * 64 + e) * 1024 * 256; \
                transpose_item64(W, 256, 64 * kb, n0, W13L(cl) + (size_t)e * 512 * 1024, 1024, (n0 >> 7) * 256 + (n0 & 127) + which * 128, scr, lane); } \
            else { r -= 8192; const int e = r >> 6, kb = (r >> 4) & 3, nb = r & 15; \
                transpose_item64(w2 + ((size_t)cl * 64 + e) * 256 * 1024, 1024, 64 * kb, 64 * nb, W2TL(cl) + (size_t)e * 1024 * 256, 256, 64 * nb, scr, lane); } } while (0)

        if (mla) {
            if (PHON(0) && IN(pb + 0)) {
                for (int rep = 0; rep < NREP(0); ++rep) { if (rep) __syncthreads();
                pg8::Gemm g{2048, 1024, 1024}; pg8::DenseOrder S; S.init(NTOK, 512, G, bx, XHL, (size_t)256 * 2048 * 2, 0, WIN + (size_t)j * 512 * 1024, (size_t)256 * 1024 * 2);
                pg8::EpiF32 E{LATB, 512};
                pg8::gemm_phase<pg8::EpiF32, pg8::DenseOrder, true>(lds + RING_OFF, g, S, E);
                }
                SEAM(pb + 0);
            }
            if (PHON(1) && IN(pb + 1)) {
                const float* gq = q_norm + j * 256; const float* gk = kv_norm + j * 128;
                const f32x4 gqv = *(const f32x4*)(gq + 4 * lane); const f32x4 gkv = *(const f32x4*)(gk + 4 * (lane & 31));
                for (int m = gw; m < NTOK; m += NGW) {
                    const float* lr = LATB + (size_t)m * 512;
                    const f32x4 a = *(const f32x4*)(lr + 4 * lane), c = *(const f32x4*)(lr + 256 + 4 * lane);
                    const float sq = wave_sum(a.x * a.x + a.y * a.y + a.z * a.z + a.w * a.w);
                    const float sk = wave_sum(lane < 32 ? (c.x * c.x + c.y * c.y + c.z * c.z + c.w * c.w) : 0.f);
                    const float rq = 1.0f / sqrtf(sq * (1.f / 256.f) + RMS_EPS), rk = 1.0f / sqrtf(sk * (1.f / 128.f) + RMS_EPS);
                    { u32x2 o; o.x = cvtpk(a.x * rq * gqv.x, a.y * rq * gqv.y); o.y = cvtpk(a.z * rq * gqv.z, a.w * rq * gqv.w); *((u32x2*)(CQ + (size_t)m * 256) + lane) = o; }
                    if (lane < 32) { u32x2 o; o.x = cvtpk(c.x * rk * gkv.x, c.y * rk * gkv.y); o.y = cvtpk(c.z * rk * gkv.z, c.w * rk * gkv.w); *((u32x2*)(CKV + (size_t)m * 128) + lane) = o; }
                    f32x4 p; p.x = __shfl_xor(c.x, 4); p.y = __shfl_xor(c.y, 4); p.z = __shfl_xor(c.z, 4); p.w = __shfl_xor(c.w, 4);
                    if (lane >= 32 && lane < 40) {
                        const f32x4 cv = *(const f32x4*)(COS + (size_t)m * 16 + 4 * (lane & 3)), sv = *(const f32x4*)(SIN + (size_t)m * 16 + 4 * (lane & 3));
                        f32x4 y; if (lane < 36) y = c * cv - p * sv; else y = c * cv + p * sv;
                        u32x2 o; o.x = cvtpk(y.x, y.y); o.y = cvtpk(y.z, y.w); *((u32x2*)(KR + (size_t)m * 32) + (lane - 32)) = o;
                    }
                }
                SEAM(pb + 1);
            }
            if (PHON(2) && IN(pb + 2)) {
                for (int rep = 0; rep < NREP(2); ++rep) {
                { pg8::Gemm g{256, 256, 256}; pg8::DenseOrder S; S.init(NTOK, 1536, G, bx, CQ, (size_t)256 * 256 * 2, 0, WUQ + (size_t)j * 1536 * 256, (size_t)256 * 256 * 2);
                  pg8::EpiQ E{QB, COS, SIN};
                  pg8::gemm_phase<pg8::EpiQ, pg8::DenseOrder, true>(lds + RING_OFF, g, S, E); }
                { pg8::Gemm g{128, 128, 128}; pg8::DenseOrder S; S.init(NTOK, 1024, G, bx, CKV, (size_t)256 * 128 * 2, 0, WUK + (size_t)j * 1024 * 128, (size_t)256 * 128 * 2);
                  pg8::EpiBf16 E{KN, 1024};
                  pg8::gemm_phase<pg8::EpiBf16, pg8::DenseOrder, true>(lds + RING_OFF, g, S, E); }
                { pg8::Gemm g{128, 128, 128}; pg8::DenseOrder S; S.init(1024, NTOK, G, bx, WUV + (size_t)j * 1024 * 128, (size_t)256 * 128 * 2, 0, CKV, (size_t)256 * 128 * 2);
                  pg8::EpiBf16 E{VT, (size_t)NTOK};
                  pg8::gemm_phase<pg8::EpiBf16, pg8::DenseOrder, true>(lds + RING_OFF, g, S, E); }
                }
                SEAM(pb + 2);
            }
            if (PHON(3) && IN(pb + 3)) {
                for (int rep = 0; rep < NREP(3); ++rep) {
                int cj = 0;
                for (int i = 0;; ++i) {
                    const int L = i * G + vcu; if (L >= 2048) break;
                    const int sl = L & 255, rnd = L >> 8, s = sl & 7, bh = (sl >> 3) + 32 * (rnd >> 2), k = rnd & 3;
                    const int qb = (k == 0) ? s : (k == 1) ? 15 - s : (k == 2) ? 16 + s : 31 - s;
                    att::attn_unit(bh >> 4, bh & 15, qb, QB, KN, KR, VT, OB, lds + RING_OFF);
                    if (rep == 0 && i < 6) {
                        for (int e2 = 0; e2 < 2; ++e2, ++cj) { const int it = gw + cj * NGW; if (it < 2 * 12288) MOE_CONV_ITEM(it); }
                        __syncthreads();
                    }
                }
                if (rep == 0) { for (;; ++cj) { const int it = gw + cj * NGW; if (it >= 2 * 12288) break; MOE_CONV_ITEM(it); } __syncthreads(); }
                }
                SEAM(pb + 3);
            }
            if (PHON(4) && IN(pb + 4)) {
                for (int rep = 0; rep < NREP(4); ++rep) {
                pg8::Gemm g{1024, 1024, 1024}; pg8::DenseOrder S; S.init(NTOK, 1024, G, bx, OB, (size_t)256 * 1024 * 2, 0, WO + (size_t)j * 1024 * 1024, (size_t)256 * 1024 * 2);
                pg8::EpiBf16 E{FB, 1024};
                pg8::gemm_phase<pg8::EpiBf16, pg8::DenseOrder, true>(lds + RING_OFF, g, S, E);
                }
                SEAM(pb + 4);
            }
        } else {
            if (PHON(13) && IN(pb + 0)) {
                for (int rep = 0; rep < NREP(13); ++rep) {
                for (int it = gw; it < 2 * (NTOK / 32); it += NGW) {
                    const int q = it & 1, t0 = (it >> 1) * 32, s0 = t0 & (SEQ - 1), grp = 2 * q + (lane >> 5), win = 2 << grp;
                    const bf16_t* xb = XHL + grp * 256 + 8 * (lane & 31);
                    bf16_t* pout = POOLED + grp * 256 + 8 * (lane & 31);
                    f32x4 Sa = {0.f, 0.f, 0.f, 0.f}, Sb = {0.f, 0.f, 0.f, 0.f};
#pragma unroll
                    for (int jj = 1; jj < 16; ++jj) { if (jj < win && s0 - jj >= 0) { const F8 r = bf8(*(const u32x4*)(xb + (size_t)(t0 - jj) * 2048)); Sa += r.a; Sb += r.b; } }
                    for (int tb = 0; tb < 32; tb += 8) {
                        u32x4 xn[8], xe[8];
#pragma unroll
                        for (int i = 0; i < 8; ++i) { const int t = t0 + tb + i; xn[i] = *(const u32x4*)(xb + (size_t)t * 2048);
                            xe[i] = (s0 + tb + i - win + 1 >= 0) ? *(const u32x4*)(xb + (size_t)(t - win + 1) * 2048) : (u32x4){0u, 0u, 0u, 0u}; }
#pragma unroll
                        for (int i = 0; i < 8; ++i) { const int sI = s0 + tb + i; const F8 xv = bf8(xn[i]), ev = bf8(xe[i]);
                            Sa += xv.a; Sb += xv.b;
                            const float rc = 1.0f / (float)((sI + 1 < win) ? sI + 1 : win);
                            *(u32x4*)(pout + (size_t)(t0 + tb + i) * 1024) = pk8(Sa * rc - xv.a, Sb * rc - xv.b);
                            Sa -= ev.a; Sb -= ev.b; }
                    }
                }
                }
                SEAM(pb + 0);
            }
            if (PHON(14) && IN(pb + 1)) {
                for (int rep = 0; rep < NREP(14); ++rep) {
                pg8::Gemm g{1024, 256, 256}; pg8::DenseOrder S; S.init(NTOK, 1024, G, bx, POOLED, (size_t)256 * 1024 * 2, (size_t)256 * 2, WP + (size_t)j * 4 * 65536, (size_t)65536 * 2);
                pg8::EpiPool E{FB, pool_b + j * 1024, pool_scale + j * 1024};
                pg8::gemm_phase<pg8::EpiPool, pg8::DenseOrder, true>(lds + RING_OFF, g, S, E);
                }
                SEAM(pb + 1);
            }
        }
        if (PHON(5) && IN(pb + 5)) {
                for (int rep = 0; rep < NREP(5); ++rep) {
            f32x4 gv[4], bv[4];
#pragma unroll
            for (int jj = 0; jj < 4; ++jj) { const int c = 8 * lane + 512 * (jj >> 1) + 4 * (jj & 1); gv[jj] = *(const f32x4*)(ln_g + (size_t)(l * 2 + 0) * 1024 + c); bv[jj] = *(const f32x4*)(ln_b + (size_t)(l * 2 + 0) * 1024 + c); }
            for (int m = gw; m < NTOK; m += NGW) {
                u32x4* xh = (u32x4*)(XHL + (size_t)m * 2048) + lane; const u32x4* fr2 = (const u32x4*)(FB + (size_t)m * 1024) + lane;
                const F8 x0 = bf8(xh[0]), x1 = bf8(xh[64]), f0 = bf8(fr2[0]), f1 = bf8(fr2[64]);
                f32x4 v[4] = {x0.a * DN_ALPHA + f0.a, x0.b * DN_ALPHA + f0.b, x1.a * DN_ALPHA + f1.a, x1.b * DN_ALPHA + f1.b}; float s = 0.f;
#pragma unroll
                for (int jj = 0; jj < 4; ++jj) s += (v[jj].x + v[jj].y) + (v[jj].z + v[jj].w);
                const float mean = wave_sum(s) * (1.f / 1024.f); float s2 = 0.f;
#pragma unroll
                for (int jj = 0; jj < 4; ++jj) { v[jj] = v[jj] - mean; s2 += (v[jj].x * v[jj].x + v[jj].y * v[jj].y) + (v[jj].z * v[jj].z + v[jj].w * v[jj].w); }
                const float rstd = 1.0f / sqrtf(wave_sum(s2) * (1.f / 1024.f) + LN_EPS);
#pragma unroll
                for (int jj = 0; jj < 4; ++jj) v[jj] = v[jj] * rstd * gv[jj] + bv[jj];
#pragma unroll
                for (int j = 0; j < 2; ++j) { const u32x4 h = pk8(v[2 * j], v[2 * j + 1]); const F8 hf = bf8(h);
                    xh[64 * j] = h; xh[128 + 64 * j] = pk8(v[2 * j] - hf.a, v[2 * j + 1] - hf.b); }
            }
            }
                SEAM(pb + 5);
        }
        if (PHON(6) && IN(pb + 6)) {
                for (int rep = 0; rep < NREP(6); ++rep) {
            pg8::Gemm g{2048, 1024, 1024}; pg8::DenseOrder S; S.init(NTOK, 512, G, bx, XHL, (size_t)256 * 2048 * 2, (size_t)1024 * 2, WR + (size_t)l * 2 * 256 * 1024, (size_t)256 * 1024 * 2);
            pg8::EpiRouter E{LG};
            pg8::gemm_phase<pg8::EpiRouter, pg8::DenseOrder, true>(lds + RING_OFF, g, S, E);
            }
                SEAM(pb + 6);
        }
        if (PHON(7) && IN(pb + 7)) {
            for (int rep = 0; rep < NREP(7); ++rep) {
            LAS int* hist = (LAS int*)(lds + RING_OFF); LAS int* cbase = hist + 64;
            const float* bg = b_grp + l * 8; const float* be = b_exp + l * 64;
            unsigned* gcnt = ctl + CW_GCNT + 64 * l;
            for (int c = bx; c < 256; c += G) {
                if (tid < 64) hist[tid] = 0;
                __syncthreads();
                int ex1 = 0, ex2 = 0, p1 = 0, p2 = 0; float ga1 = 0.f, ga2 = 0.f;
                const int t = c * 128 + tid;
                if (tid < 128) {
                    const float* lg = LG + (size_t)t * LGP;
                    const float* lg2 = lg + (size_t)NTOK * LGP;
                    const f32x4 g0 = *(const f32x4*)lg + *(const f32x4*)lg2, g1 = *(const f32x4*)(lg + 4) + *(const f32x4*)(lg2 + 4);
                    float gl[8] = {g0.x + bg[0], g0.y + bg[1], g0.z + bg[2], g0.w + bg[3], g1.x + bg[4], g1.y + bg[5], g1.z + bg[6], g1.w + bg[7]};
                    int gs = 0; float gm = gl[0];
#pragma unroll
                    for (int i = 1; i < 8; ++i) if (gl[i] > gm) { gm = gl[i]; gs = i; }
                    float se = 0.f;
#pragma unroll
                    for (int i = 0; i < 8; ++i) se += __expf(gl[i] - gm);
                    const float ggate = 1.0f / se;
                    const f32x4 e0 = *(const f32x4*)(lg + 8 + gs * 8) + *(const f32x4*)(lg2 + 8 + gs * 8), e1 = *(const f32x4*)(lg + 12 + gs * 8) + *(const f32x4*)(lg2 + 12 + gs * 8);
                    const f32x4 b0 = *(const f32x4*)(be + gs * 8), b1 = *(const f32x4*)(be + gs * 8 + 4);
                    float el[8] = {e0.x + b0.x, e0.y + b0.y, e0.z + b0.z, e0.w + b0.w, e1.x + b1.x, e1.y + b1.y, e1.z + b1.z, e1.w + b1.w};
                    int i1 = 0; float m1 = el[0];
#pragma unroll
                    for (int i = 1; i < 8; ++i) if (el[i] > m1) { m1 = el[i]; i1 = i; }
                    int i2 = -1; float m2 = -INFINITY;
#pragma unroll
                    for (int i = 0; i < 8; ++i) if (i != i1 && el[i] > m2) { m2 = el[i]; i2 = i; }
                    const float x2 = __expf(m2 - m1), rs = 1.0f / (1.0f + x2);
                    ex1 = gs * 8 + i1; ex2 = gs * 8 + i2; ga1 = ggate * rs; ga2 = ggate * x2 * rs;
                    p1 = __hip_atomic_fetch_add(&hist[ex1], 1, __ATOMIC_RELAXED, __HIP_MEMORY_SCOPE_WORKGROUP); p2 = __hip_atomic_fetch_add(&hist[ex2], 1, __ATOMIC_RELAXED, __HIP_MEMORY_SCOPE_WORKGROUP);
                }
                __syncthreads();
                if (tid < 64) { const int n = hist[tid]; cbase[tid] = n ? (int)__hip_atomic_fetch_add(gcnt + tid, (unsigned)n, __ATOMIC_RELAXED, __HIP_MEMORY_SCOPE_AGENT) : 0; }
                __syncthreads();
                if (tid < 128) {
                    const size_t i1 = (size_t)ex1 * pg8::LIST_CAP + cbase[ex1] + p1, i2 = (size_t)ex2 * pg8::LIST_CAP + cbase[ex2] + p2;
                    ROWLIST[i1] = 2 * t; LGATE[i1] = ga1; ROWLIST[i2] = 2 * t + 1; LGATE[i2] = ga2;
                }
                __syncthreads();
            }
            }
            SEAM(pb + 7);
        }
#define MOE_TILE_TABLE() \
            LAS int* tinfo = (LAS int*)(lds + TINFO_OFF); \
            __syncthreads(); \
            if (tid < 64) tinfo[pg8::TI_CNT + tid] = (int)__hip_atomic_load(ctl + CW_GCNT + 64 * l + tid, __ATOMIC_RELAXED, __HIP_MEMORY_SCOPE_AGENT); \
            __syncthreads(); \
            if (tid == 0) { int tt = 0; for (int e = 0; e < 64; ++e) { const int n = (tinfo[pg8::TI_CNT + e] + 255) >> 8; for (int i = 0; i < n && tt < MAX_TILES; ++i) tinfo[tt++] = e | (i << 8); } tinfo[pg8::TI_CNT + 64] = tt; } \
            __syncthreads(); \
            const int ntl = tinfo[pg8::TI_CNT + 64];
        if (PHON(9) && IN(pb + 9)) {
            for (int rep = 0; rep < NREP(9); ++rep) {
            MOE_TILE_TABLE();
            pg8::Gemm g{2048, 1024, 1024}; pg8::GatherOrder S; S.init(tinfo, ntl, 2, G, bx, XHL, ROWLIST, W13L(l), (size_t)512 * 1024 * 2, (size_t)256 * 1024 * 2);
            pg8::EpiSwiglu E{HS};
            pg8::gemm_phase<pg8::EpiSwiglu, pg8::GatherOrder, true>(lds + RING_OFF, g, S, E);
            }
            SEAM(pb + 9);
        }
        if (PHON(10) && IN(pb + 10)) {
            for (int rep = 0; rep < NREP(10); ++rep) {
            MOE_TILE_TABLE();
            pg8::Gemm g{256, 256, 256}; pg8::MoeOrder S; S.init(tinfo, ntl, 4, G, bx, HS, (size_t)256 * 256 * 2, W2TL(l), (size_t)1024 * 256 * 2, (size_t)256 * 256 * 2);
            pg8::EpiMoeOut E{YB, tinfo, ROWLIST, LGATE};
            pg8::gemm_phase<pg8::EpiMoeOut, pg8::MoeOrder, true>(lds + RING_OFF, g, S, E);
            }
            SEAM(pb + 10);
        }
        if (PHON(11) && IN(pb + 11)) {
            f32x4 gv[4], bv[4];
#pragma unroll
            for (int jj = 0; jj < 4; ++jj) { const int c = 8 * lane + 512 * (jj >> 1) + 4 * (jj & 1); gv[jj] = *(const f32x4*)(ln_g + (size_t)(l * 2 + 1) * 1024 + c); bv[jj] = *(const f32x4*)(ln_b + (size_t)(l * 2 + 1) * 1024 + c); }
            const bool lastl = (l == DEPTH - 1);
            for (int m = gw; m < NTOK; m += NGW) {
                u32x4* xh = (u32x4*)(XHL + (size_t)m * 2048) + lane;
                const u32x4* y0 = (const u32x4*)(YB + (size_t)(2 * m) * 1024) + lane; const u32x4* y1 = (const u32x4*)(YB + (size_t)(2 * m + 1) * 1024) + lane;
                const F8 x0 = bf8(xh[0]), x1 = bf8(xh[64]), a0 = bf8(y0[0]), a1 = bf8(y0[64]), c0 = bf8(y1[0]), c1 = bf8(y1[64]);
                f32x4 v[4] = {x0.a * DN_ALPHA + (a0.a + c0.a), x0.b * DN_ALPHA + (a0.b + c0.b), x1.a * DN_ALPHA + (a1.a + c1.a), x1.b * DN_ALPHA + (a1.b + c1.b)}; float s = 0.f;
#pragma unroll
                for (int jj = 0; jj < 4; ++jj) s += (v[jj].x + v[jj].y) + (v[jj].z + v[jj].w);
                const float mean = wave_sum(s) * (1.f / 1024.f); float s2 = 0.f;
#pragma unroll
                for (int jj = 0; jj < 4; ++jj) { v[jj] = v[jj] - mean; s2 += (v[jj].x * v[jj].x + v[jj].y * v[jj].y) + (v[jj].z * v[jj].z + v[jj].w * v[jj].w); }
                const float rstd = 1.0f / sqrtf(wave_sum(s2) * (1.f / 1024.f) + LN_EPS);
#pragma unroll
                for (int jj = 0; jj < 4; ++jj) v[jj] = v[jj] * rstd * gv[jj] + bv[jj];
                if (lastl) { f32x4* orow = (f32x4*)(kargs()->out + (size_t)m * 1024) + 2 * lane;
                    orow[0] = v[0]; orow[1] = v[1]; orow[128] = v[2]; orow[129] = v[3];
                } else { xh[0] = pk8(v[0], v[1]); xh[64] = pk8(v[2], v[3]); }
            }
            SEAM(pb + 11);
        }
    }
#undef IN
#undef SEAM
}
#undef ws
#undef in_x
#undef in_pos
#undef ln_g
#undef ln_b
#undef w_in
#undef q_norm
#undef w_uq
#undef kv_norm
#undef w_ukv
#undef w_o
#undef pool_w
#undef pool_b
#undef pool_scale
#undef w_grp
#undef b_grp
#undef w_exp
#undef b_exp
#undef w1
#undef w3
#undef w2
#undef COS
#undef SIN
#undef CNT
#undef TILE
#undef AE
#undef APOS
#undef AG
#undef RSLOT
#undef RGATE
#undef WIN
#undef WUQ
#undef WUK
#undef WUV
#undef WO
#undef WP
#undef WR
#undef W13L
#undef W2TL
#undef FB
#undef XHL
#undef LATB
#undef CQ
#undef CKV
#undef KR
#undef QB
#undef KN
#undef VT
#undef OB
#undef POOLED
#undef LG
#undef ROWLIST
#undef LGATE
#undef HS
#undef YB

static bool phase_exists(int p) {
    if (p == 0) return true;
    const int l = (p - 1) / PPL, k = (p - 1) % PPL;
    if (k == 8) return false;
    if (k >= 5) return true;
    return (l & 1) == 0 ? true : (k < 2);
}
extern "C" void kernel_launch(void* const* d_in, const int* in_sizes, int n_in, void* d_out, int out_size, void* d_ws, size_t ws_size, hipStream_t stream) {
    static int grid = 0;
    if (grid == 0) {
        if (n_in != 20 || in_sizes[0] != NTOK * D_MODEL || out_size != NTOK * D_MODEL || ws_size < WS_END) { fprintf(stderr, "kernel_launch: unexpected shapes / workspace (%zu < %zu)\n", ws_size, (size_t)WS_END); grid = -1; return; }
        int dev = 0, cus = 0, per_cu = 0;
        if (hipGetDevice(&dev) != hipSuccess || hipDeviceGetAttribute(&cus, hipDeviceAttributeMultiprocessorCount, dev) != hipSuccess) { grid = -1; return; }
        if (hipFuncSetAttribute((const void*)mk_fwd, hipFuncAttributeMaxDynamicSharedMemorySize, LDS_BYTES) != hipSuccess) { fprintf(stderr, "kernel_launch: hipFuncSetAttribute failed\n"); grid = -1; return; }
        if (hipOccupancyMaxActiveBlocksPerMultiprocessor(&per_cu, (const void*)mk_fwd, NWAVES * 64, LDS_BYTES) != hipSuccess || per_cu < 1) fprintf(stderr, "kernel_launch: occupancy query reports %d\n", per_cu);
        (void)hipGetLastError();
        grid = cus;
    }
    if (grid < 0) return;
    if (hipMemsetAsync((char*)d_ws + WS_CTL, 0, CTL_ZERO_BYTES, stream) != hipSuccess) return;
    Args a{};
    for (int i = 0; i < 20; ++i) a.in[i] = d_in[i];
    a.out = (float*)d_out; a.ws = (unsigned char*)d_ws;
#if MK_ONE_LAUNCH
    a.ph_lo = 0; a.ph_hi = NPHASE;
    hipLaunchKernelGGL(mk_fwd, dim3(grid), dim3(NWAVES * 64), LDS_BYTES, stream, a);
#else
    for (int p = 0; p < NPHASE; ++p) {
        if (!phase_exists(p)) continue;
        a.ph_lo = p; a.ph_hi = p + 1;
        hipLaunchKernelGGL(mk_fwd, dim3(grid), dim3(NWAVES * 64), LDS_BYTES, stream, a);
    }
#endif
}
```

```cpp
#include <hip/hip_runtime.h>
#include <cstdio>
#include <cstdint>

#ifndef MK_ONE_LAUNCH
#define MK_ONE_LAUNCH 1
#endif

#define LAS __attribute__((address_space(3)))
#define GAS __attribute__((address_space(1)))

constexpr int D_MODEL = 1024, BATCH = 4, SEQ = 8192, DEPTH = 4, NTOK = BATCH * SEQ;
constexpr int N_HEADS = 16, QK_NOPE = 64, QK_ROPE = 32, V_HEAD = 64, Q_LORA = 256, KV_LORA = 128, LAT = Q_LORA + KV_LORA + QK_ROPE;
constexpr int QPITCH = N_HEADS * (QK_NOPE + QK_ROPE);
constexpr int N_GROUPS = 8, EPG = 8, N_EXPERTS = 64, D_EXPERT = 256;
constexpr int MAX_TILES = 320;
constexpr float DN_ALPHA = 1.681792830507429f;
constexpr float LN_EPS = 1e-5f, RMS_EPS = 1e-6f;
constexpr float QSCALE = 0.14724444602590306f;
constexpr int LGP = 80;

constexpr size_t MiB = 1u << 20;
constexpr size_t WS_CTL = 0, CTL_ZERO_BYTES = 1 * MiB;
constexpr size_t WS_COS = 1 * MiB, WS_SIN = 3 * MiB;
constexpr size_t WS_CNT = 5 * MiB;
constexpr size_t WS_TILE = 5 * MiB + 65536;
constexpr size_t WS_AE = 5 * MiB + 131072, WS_APOS = WS_AE + 262144, WS_AG = WS_APOS + 262144;
constexpr size_t WS_RSLOT = 6 * MiB, WS_RGATE = 6 * MiB + 512 * 1024;
constexpr size_t WS_WIN = 8 * MiB;
constexpr size_t WS_WUQ = 10 * MiB;
constexpr size_t WS_WUK = 12 * MiB;
constexpr size_t WS_WUV = 13 * MiB;
constexpr size_t WS_WO = 14 * MiB;
constexpr size_t WS_WP = 18 * MiB;
constexpr size_t WS_WR = 19 * MiB;
constexpr size_t WS_W13 = 24 * MiB;
constexpr size_t WS_W2T = 88 * MiB;
constexpr size_t WS_W13B = 184 * MiB;
constexpr size_t WS_W2TB = 760 * MiB;
constexpr size_t WS_FB = 120 * MiB;
constexpr size_t WS_XHL = 248 * MiB;
constexpr size_t WS_R1 = 376 * MiB;
constexpr size_t WS_LAT = WS_R1;
constexpr size_t WS_CQ = WS_R1 + 64 * MiB;
constexpr size_t WS_CKV = WS_R1 + 80 * MiB;
constexpr size_t WS_KR = WS_R1 + 88 * MiB;
constexpr size_t WS_Q = WS_R1 + 92 * MiB;
constexpr size_t WS_KN = WS_R1 + 188 * MiB;
constexpr size_t WS_VT = WS_R1 + 252 * MiB;
constexpr size_t WS_O = WS_R1 + 316 * MiB;
constexpr size_t WS_POOLED = WS_R1;
constexpr size_t WS_LG = WS_R1;
constexpr size_t WS_LIST = WS_R1 + 20 * MiB;
constexpr size_t WS_LGATE = WS_R1 + 36 * MiB;
constexpr size_t WS_HS = WS_R1 + 180 * MiB;
constexpr size_t WS_Y = WS_R1 + 220 * MiB;
constexpr size_t WS_END = 792 * MiB;
static_assert(WS_O + 64 * MiB <= WS_END && WS_Y + 128 * MiB <= WS_END, "ws map");

constexpr int CW_TMO = 0, CW_CODE = 1, CW_BAR = 4096, CW_GCNT = 16384;

constexpr int RING_OFF = 0, RING_BYTES = 131072, SCR_WAVE = 17408;
constexpr int LDSCTL_OFF = 8 * SCR_WAVE, MISC_OFF = LDSCTL_OFF + 320, TINFO_OFF = LDSCTL_OFF + 1024;
constexpr int LDS_BYTES = 147456;

typedef unsigned short bf16_t;
typedef short bf16x8 __attribute__((ext_vector_type(8)));
typedef float f32x4 __attribute__((ext_vector_type(4)));
typedef float f32x16 __attribute__((ext_vector_type(16)));
typedef unsigned u32x4 __attribute__((ext_vector_type(4)));
typedef unsigned u32x2 __attribute__((ext_vector_type(2)));
typedef float f32x2_t __attribute__((ext_vector_type(2)));
typedef __bf16 bf16x2_t __attribute__((ext_vector_type(2)));
#define RLX_AGENT __ATOMIC_RELAXED, __HIP_MEMORY_SCOPE_AGENT
#define LDS_WAIT() asm volatile("s_waitcnt lgkmcnt(0)" ::: "memory")
#define VM_WAIT() asm volatile("s_waitcnt vmcnt(0)" ::: "memory")

__device__ __forceinline__ unsigned cvtpk(float lo, float hi) { f32x2_t v = {lo, hi}; bf16x2_t b = __builtin_convertvector(v, bf16x2_t); return __builtin_bit_cast(unsigned, b); }
__device__ __forceinline__ int opaque(int x) { asm volatile("" : "+v"(x)); return x; }
__device__ __forceinline__ int opaque_s(int x) { asm volatile("" : "+s"(x)); return x; }
__device__ __forceinline__ float bflo(unsigned u) { return __uint_as_float(u << 16); }
__device__ __forceinline__ float bfhi(unsigned u) { return __uint_as_float(u & 0xffff0000u); }
__device__ __forceinline__ float wave_sum(float v) {
#pragma unroll
    for (int o = 1; o < 64; o <<= 1) v += __shfl_xor(v, o);
    return v;
}
__device__ __forceinline__ void split4(const f32x4 v, u32x2& h, u32x2& l) {
    h.x = cvtpk(v.x, v.y); h.y = cvtpk(v.z, v.w);
    l.x = cvtpk(v.x - bflo(h.x), v.y - bfhi(h.x)); l.y = cvtpk(v.z - bflo(h.y), v.w - bfhi(h.y));
}
__device__ __forceinline__ f32x4 join4(const u32x2 h, const u32x2 l) {
    return (f32x4){bflo(h.x) + bflo(l.x), bfhi(h.x) + bfhi(l.x), bflo(h.y) + bflo(l.y), bfhi(h.y) + bfhi(l.y)};
}
struct F8 { f32x4 a, b; };
__device__ __forceinline__ F8 bf8(const u32x4 w) { F8 r; r.a = (f32x4){bflo(w.x), bfhi(w.x), bflo(w.y), bfhi(w.y)}; r.b = (f32x4){bflo(w.z), bfhi(w.z), bflo(w.w), bfhi(w.w)}; return r; }
__device__ __forceinline__ u32x4 pk8(const f32x4 a, const f32x4 b) { u32x4 w; w.x = cvtpk(a.x, a.y); w.y = cvtpk(a.z, a.w); w.z = cvtpk(b.x, b.y); w.w = cvtpk(b.z, b.w); return w; }
__device__ __forceinline__ f32x4 bf4(const u32x2 h) { return (f32x4){bflo(h.x), bfhi(h.x), bflo(h.y), bfhi(h.y)}; }

namespace pg8 {
constexpr int BM = 256, BK = 64, HALF = 128, HTB = HALF * BK * 2, STAGE_BYTES = 8 * HTB, NXCD = 8, WGM = 8;
__host__ __device__ __forceinline__ int lds_byte(int r, int c) { const int st = (r >> 4) * 2 + (c >> 5), rr = r & 15, cc = c & 31, ob = rr * 64 + cc * 2; return st * 1024 + (ob ^ (((ob >> 9) & 1) << 5)); }
__host__ __device__ __forceinline__ void stage_rc(int b, int& R, int& C) { const int st = b / 1024, sb = b % 1024, swz = sb ^ (((sb >> 9) & 1) << 5); R = (st >> 1) * 16 + swz / 64; C = (st & 1) * 32 + (swz % 64) / 2; }
__host__ __device__ __forceinline__ int perm32(int rho) { const int n = rho >> 4, i = rho & 15; return 8 * (i >> 2) + 4 * n + (i & 3); }

struct Unit { int pm, pn; };
struct Gemm { int lda, ldb, K; };

struct DenseOrder {
    int nM, nN, nwg, G, c;
    const char* A; const char* B; size_t a_pm, a_pn, b_pn;
    __device__ __forceinline__ void init(int M, int N, int G_, int c_, const void* A_, size_t a_pm_, size_t a_pn_, const void* B_, size_t b_pn_) {
        nM = M / BM; nN = N / BM; nwg = nM * nN; G = G_; c = c_; A = (const char*)A_; B = (const char*)B_; a_pm = a_pm_; a_pn = a_pn_; b_pn = b_pn_; }
    __device__ __forceinline__ bool next(int i, Unit& u) const {
        const long L = (long)i * G + c; if (L >= nwg) return false;
        int wgid = (int)L; { const int q = nwg / NXCD, r = nwg % NXCD, xcd = wgid % NXCD, off = wgid / NXCD; wgid = (xcd < r ? xcd * (q + 1) : r * (q + 1) + (xcd - r) * q) + off; }
        const int nig = WGM * nN, gid = wgid / nig, fm = gid * WGM, gsz = (nM - fm) < WGM ? (nM - fm) : WGM;
        u.pm = fm + ((wgid % nig) % gsz); u.pn = (wgid % nig) / gsz; return true;
    }
    __device__ __forceinline__ const char* a_base(const Unit& u) const { return A + (size_t)u.pm * a_pm + (size_t)u.pn * a_pn; }
    __device__ __forceinline__ unsigned a_voff(const Unit&, int R, int C, int lda) const { return (unsigned)(R * lda + C) * 2u; }
    __device__ __forceinline__ const char* b_base(const Unit& u) const { return B + (size_t)u.pn * b_pn; }
};
constexpr int TI_CNT = 320, LIST_CAP = 65536;
struct MoeOrder {
    const LAS int* tinfo; int ntiles, nN, nwg, G, c;
    const char* A; const char* W; size_t a_tile, w_e, w_pn;
    __device__ __forceinline__ void init(const LAS int* ti, int ntiles_, int nN_, int G_, int c_, const void* A_, size_t a_tile_, const void* W_, size_t w_e_, size_t w_pn_) {
        tinfo = ti; ntiles = ntiles_; nN = nN_; nwg = ntiles_ * nN_; G = G_; c = c_; A = (const char*)A_; a_tile = a_tile_; W = (const char*)W_; w_e = w_e_; w_pn = w_pn_; }
    __device__ __forceinline__ bool next(int i, Unit& u) const {
        const long L = (long)i * G + c; if (L >= nwg) return false;
        int wgid = (int)L; { const int q = nwg / NXCD, r = nwg % NXCD, xcd = wgid % NXCD, off = wgid / NXCD; wgid = (xcd < r ? xcd * (q + 1) : r * (q + 1) + (xcd - r) * q) + off; }
        u.pm = wgid / nN; u.pn = wgid % nN; return true;
    }
    __device__ __forceinline__ const char* a_base(const Unit& u) const { return A + (size_t)u.pm * a_tile; }
    __device__ __forceinline__ const char* b_base(const Unit& u) const { const int e = __builtin_amdgcn_readfirstlane(tinfo[u.pm]) & 255; return W + (size_t)e * w_e + (size_t)u.pn * w_pn; }
    __device__ __forceinline__ unsigned a_voff(const Unit&, int R, int C, int lda) const { return (unsigned)(R * lda + C) * 2u; }
};
struct GatherOrder {
    const LAS int* tinfo; int ntiles, nN, nwg, G, c;
    const char* A; const int* list; const char* W; size_t w_e, w_pn;
    __device__ __forceinline__ void init(const LAS int* ti, int ntiles_, int nN_, int G_, int c_, const void* A_, const int* list_, const void* W_, size_t w_e_, size_t w_pn_) {
        tinfo = ti; ntiles = ntiles_; nN = nN_; nwg = ntiles_ * nN_; G = G_; c = c_; A = (const char*)A_; list = list_; W = (const char*)W_; w_e = w_e_; w_pn = w_pn_; }
    __device__ __forceinline__ bool next(int i, Unit& u) const {
        const long L = (long)i * G + c; if (L >= nwg) return false;
        int wgid = (int)L; { const int q = nwg / NXCD, r = nwg % NXCD, xcd = wgid % NXCD, off = wgid / NXCD; wgid = (xcd < r ? xcd * (q + 1) : r * (q + 1) + (xcd - r) * q) + off; }
        u.pm = wgid / nN; u.pn = wgid % nN; return true;
    }
    __device__ __forceinline__ const char* a_base(const Unit&) const { return A; }
    __device__ __forceinline__ const char* b_base(const Unit& u) const { const int e = __builtin_amdgcn_readfirstlane(tinfo[u.pm]) & 255; return W + (size_t)e * w_e + (size_t)u.pn * w_pn; }
    __device__ __forceinline__ unsigned a_voff(const Unit& u, int R, int C, int lda) const {
        const int ti = tinfo[u.pm], e = ti & 255, r = (ti >> 8) * 256 + R; const int n = tinfo[TI_CNT + e];
        const int ga = (r < n) ? list[(size_t)e * LIST_CAP + r] : 0;
        return (unsigned)(ga >> 1) * (unsigned)(lda * 2) + (unsigned)C * 2u; }
};

#define ACC_T const f32x4 (&acc)[2][2][4][2]
__device__ __forceinline__ u32x4 pack_acc(const f32x4 v0, const f32x4 v1) { u32x4 w; w.x = cvtpk(v0[0], v0[1]); w.y = cvtpk(v0[2], v0[3]); w.z = cvtpk(v1[0], v1[1]); w.w = cvtpk(v1[2], v1[3]); return w; }
struct EpiBf16 {
    static constexpr bool PERM = true, AFTER_DRAIN = false;
    bf16_t* O; size_t ldc;
    __device__ __forceinline__ void operator()(ACC_T, const Unit& u, int wr, int wc, int fr, int fq) const {
        const int row0 = u.pm * BM + wr * 64 + fr, col0 = u.pn * BM + wc * 32 + 8 * fq;
#pragma unroll
        for (int ai = 0; ai < 2; ++ai)
#pragma unroll
            for (int m = 0; m < 4; ++m) { bf16_t* rowp = O + (size_t)(row0 + ai * HALF + m * 16) * ldc + col0;
#pragma unroll
                for (int bj = 0; bj < 2; ++bj) { const f32x4 v0 = acc[ai][bj][m][0], v1 = acc[ai][bj][m][1];
                    u32x4 w; w.x = cvtpk(v0[0], v0[1]); w.y = cvtpk(v0[2], v0[3]); w.z = cvtpk(v1[0], v1[1]); w.w = cvtpk(v1[2], v1[3]);
                    *(u32x4*)(rowp + bj * HALF) = w; } }
    }
};
struct EpiF32 {
    static constexpr bool PERM = false, AFTER_DRAIN = false;
    float* O; size_t ldc;
    __device__ __forceinline__ void operator()(ACC_T, const Unit& u, int wr, int wc, int fr, int fq) const {
        const int row0 = u.pm * BM + wr * 64 + fr, col0 = u.pn * BM + wc * 32 + 4 * fq;
#pragma unroll
        for (int ai = 0; ai < 2; ++ai)
#pragma unroll
            for (int m = 0; m < 4; ++m) { float* rowp = O + (size_t)(row0 + ai * HALF + m * 16) * ldc + col0;
#pragma unroll
                for (int bj = 0; bj < 2; ++bj)
#pragma unroll
                    for (int n = 0; n < 2; ++n) *(f32x4*)(rowp + bj * HALF + n * 16) = acc[ai][bj][m][n]; }
    }
};
struct EpiLatNorm {
    static constexpr bool PERM = true, AFTER_DRAIN = true;
    bf16_t* CQo; bf16_t* CKVo; bf16_t* KRo; const float* gq; const float* gk; const float* cs; const float* sn;
    __device__ __forceinline__ void fused(f32x4 (&acc)[2][2][4][2], const Unit& u, int wr, int wc, int fr, int fq, LAS unsigned char* lds, int lane) const {
        LAS float* P = (LAS float*)lds;
        const int nbj = (u.pn == 0) ? 2 : 1;
#pragma unroll
        for (int ai = 0; ai < 2; ++ai)
#pragma unroll
            for (int m = 0; m < 4; ++m) { float ss = 0.f;
#pragma unroll
                for (int bj = 0; bj < 2; ++bj) if (bj < nbj) {
#pragma unroll
                    for (int n = 0; n < 2; ++n) { const f32x4 v = acc[ai][bj][m][n]; ss += (v[0] * v[0] + v[1] * v[1]) + (v[2] * v[2] + v[3] * v[3]); } }
                ss += __shfl_xor(ss, 16); ss += __shfl_xor(ss, 32);
                if (fq == 0) P[(ai * HALF + wr * 64 + m * 16 + fr) * 4 + wc] = ss; }
        asm volatile("s_waitcnt lgkmcnt(0)" ::: "memory"); __builtin_amdgcn_s_barrier(); asm volatile("" ::: "memory");
        const float inv_dim = (u.pn == 0) ? (1.f / 256.f) : (1.f / 128.f);
#pragma unroll
        for (int ai = 0; ai < 2; ++ai)
#pragma unroll
            for (int m = 0; m < 4; ++m) { const int rl = ai * HALF + wr * 64 + m * 16 + fr; const size_t row = (size_t)u.pm * BM + rl;
                const f32x4 p4 = *(const LAS f32x4*)(P + rl * 4); const float rs = 1.0f / sqrtf(((p4[0] + p4[1]) + (p4[2] + p4[3])) * inv_dim + RMS_EPS);
                if (u.pn == 0) {
#pragma unroll
                    for (int bj = 0; bj < 2; ++bj) { const int col = bj * HALF + wc * 32 + 8 * fq; const f32x4 g0 = *(const f32x4*)(gq + col), g1 = *(const f32x4*)(gq + col + 4);
                        *(u32x4*)(CQo + row * 256 + col) = pack_acc(acc[ai][bj][m][0] * rs * g0, acc[ai][bj][m][1] * rs * g1); }
                } else {
                    { const int col = wc * 32 + 8 * fq; const f32x4 g0 = *(const f32x4*)(gk + col), g1 = *(const f32x4*)(gk + col + 4);
                      *(u32x4*)(CKVo + row * 128 + col) = pack_acc(acc[ai][0][m][0] * rs * g0, acc[ai][0][m][1] * rs * g1); }
                    if (wc == 0) {
                        const f32x4 v0 = acc[ai][1][m][0], v1 = acc[ai][1][m][1];
                        f32x4 q0, q1;
#pragma unroll
                        for (int e = 0; e < 4; ++e) { q0[e] = __shfl_xor(v0[e], 32); q1[e] = __shfl_xor(v1[e], 32); }
                        const int i0 = 8 * (fq & 1);
                        const f32x4 c0 = *(const f32x4*)(cs + row * 16 + i0), c1 = *(const f32x4*)(cs + row * 16 + i0 + 4), s0 = *(const f32x4*)(sn + row * 16 + i0), s1 = *(const f32x4*)(sn + row * 16 + i0 + 4);
                        const bool first = fq < 2;
                        const f32x4 y0 = first ? (v0 * c0 - q0 * s0) : (v0 * c0 + q0 * s0), y1 = first ? (v1 * c1 - q1 * s1) : (v1 * c1 + q1 * s1);
                        *(u32x4*)(KRo + row * 32 + 8 * fq) = pack_acc(y0, y1);
                    }
                } }
    }
};
struct EpiQ {
    static constexpr bool PERM = true, AFTER_DRAIN = false;
    bf16_t* Q; const float* cs; const float* sn;
    __device__ __forceinline__ void operator()(ACC_T, const Unit& u, int wr, int wc, int fr, int fq) const {
        const int row0 = u.pm * BM + wr * 64 + fr;
        if (u.pn < 4) {
#pragma unroll
            for (int ai = 0; ai < 2; ++ai)
#pragma unroll
                for (int m = 0; m < 4; ++m) { const int row = row0 + ai * HALF + m * 16;
#pragma unroll
                    for (int bj = 0; bj < 2; ++bj) { const int col = u.pn * BM + bj * HALF + wc * 32 + 8 * fq; const f32x4 v0 = acc[ai][bj][m][0], v1 = acc[ai][bj][m][1];
                        u32x4 w; w.x = cvtpk(v0[0], v0[1]); w.y = cvtpk(v0[2], v0[3]); w.z = cvtpk(v1[0], v1[1]); w.w = cvtpk(v1[2], v1[3]);
                        *(u32x4*)(Q + (size_t)row * QPITCH + (col >> 6) * 96 + (col & 63)) = w; } }
        } else {
            const int head = (u.pn - 4) * 8 + 2 * wc + (fq >> 1), i0 = 8 * (fq & 1);
#pragma unroll
            for (int ai = 0; ai < 2; ++ai)
#pragma unroll
                for (int m = 0; m < 4; ++m) { const int row = row0 + ai * HALF + m * 16;
                    const f32x4 c0 = *(const f32x4*)(cs + (size_t)row * 16 + i0), c1 = *(const f32x4*)(cs + (size_t)row * 16 + i0 + 4);
                    const f32x4 s0 = *(const f32x4*)(sn + (size_t)row * 16 + i0), s1 = *(const f32x4*)(sn + (size_t)row * 16 + i0 + 4);
                    const f32x4 a0 = acc[ai][0][m][0], a1 = acc[ai][0][m][1], b0 = acc[ai][1][m][0], b1 = acc[ai][1][m][1];
                    const f32x4 y10 = a0 * c0 - b0 * s0, y11 = a1 * c1 - b1 * s1, y20 = b0 * c0 + a0 * s0, y21 = b1 * c1 + a1 * s1;
                    u32x4 w1, w2; w1.x = cvtpk(y10[0], y10[1]); w1.y = cvtpk(y10[2], y10[3]); w1.z = cvtpk(y11[0], y11[1]); w1.w = cvtpk(y11[2], y11[3]);
                    w2.x = cvtpk(y20[0], y20[1]); w2.y = cvtpk(y20[2], y20[3]); w2.z = cvtpk(y21[0], y21[1]); w2.w = cvtpk(y21[2], y21[3]);
                    bf16_t* qp = Q + (size_t)row * QPITCH + head * 96 + 64 + i0;
                    *(u32x4*)qp = w1; *(u32x4*)(qp + 16) = w2; asm volatile("" ::: "memory"); }
        }
    }
};
struct EpiPool {
    static constexpr bool PERM = true, AFTER_DRAIN = false;
    bf16_t* F; const float* bias; const float* scale;
    __device__ __forceinline__ void operator()(ACC_T, const Unit& u, int wr, int wc, int fr, int fq) const {
        const int row0 = u.pm * BM + wr * 64 + fr, col0 = u.pn * BM + wc * 32 + 8 * fq;
#pragma unroll
        for (int bj = 0; bj < 2; ++bj) { const int c = col0 + bj * HALF;
            const f32x4 b0 = *(const f32x4*)(bias + c), b1 = *(const f32x4*)(bias + c + 4), s0 = *(const f32x4*)(scale + c), s1 = *(const f32x4*)(scale + c + 4);
#pragma unroll
            for (int ai = 0; ai < 2; ++ai)
#pragma unroll
                for (int m = 0; m < 4; ++m) { const f32x4 v0 = (acc[ai][bj][m][0] + b0) * s0, v1 = (acc[ai][bj][m][1] + b1) * s1;
                    u32x4 w; w.x = cvtpk(v0[0], v0[1]); w.y = cvtpk(v0[2], v0[3]); w.z = cvtpk(v1[0], v1[1]); w.w = cvtpk(v1[2], v1[3]);
                    *(u32x4*)(F + (size_t)(row0 + ai * HALF + m * 16) * 1024 + c) = w; } }
    }
};
struct EpiRouter {
    static constexpr bool PERM = false, AFTER_DRAIN = false;
    float* LG;
    __device__ __forceinline__ void operator()(ACC_T, const Unit& u, int wr, int wc, int fr, int fq) const {
        const int row0 = u.pm * BM + wr * 64 + fr;
#pragma unroll
        for (int ai = 0; ai < 2; ++ai)
#pragma unroll
            for (int m = 0; m < 4; ++m) { float* lr = LG + ((size_t)u.pn * NTOK + (size_t)(row0 + ai * HALF + m * 16)) * LGP;
#pragma unroll
                for (int n = 0; n < 2; ++n) { const int j = wc * 32 + 16 * n + 4 * fq; if (j < 72) *(f32x4*)(lr + j) = acc[ai][0][m][n] + acc[ai][1][m][n]; } }
    }
};
struct EpiSwiglu {
    static constexpr bool PERM = true, AFTER_DRAIN = false;
    bf16_t* H;
    __device__ __forceinline__ void operator()(ACC_T, const Unit& u, int wr, int wc, int fr, int fq) const {
        const int row0 = u.pm * BM + wr * 64 + fr, col0 = u.pn * HALF + wc * 32 + 8 * fq;
#pragma unroll
        for (int ai = 0; ai < 2; ++ai)
#pragma unroll
            for (int m = 0; m < 4; ++m) { float h[8];
#pragma unroll
                for (int n = 0; n < 2; ++n)
#pragma unroll
                    for (int e = 0; e < 4; ++e) { const float a = acc[ai][0][m][n][e], b = acc[ai][1][m][n][e];
                        h[n * 4 + e] = a * __builtin_amdgcn_rcpf(1.0f + __builtin_amdgcn_exp2f(-1.4426950408889634f * a)) * b; }
                u32x4 w; w.x = cvtpk(h[0], h[1]); w.y = cvtpk(h[2], h[3]); w.z = cvtpk(h[4], h[5]); w.w = cvtpk(h[6], h[7]);
                *(u32x4*)(H + (size_t)(row0 + ai * HALF + m * 16) * D_EXPERT + col0) = w; }
    }
};
struct EpiMoeOut {
    static constexpr bool PERM = true, AFTER_DRAIN = false;
    bf16_t* Y; const LAS int* tinfo; const int* list; const float* lgate;
    __device__ __forceinline__ void operator()(ACC_T, const Unit& u, int wr, int wc, int fr, int fq) const {
        const int ti = tinfo[u.pm], e = ti & 255, n = tinfo[TI_CNT + e], r0 = (ti >> 8) * 256 + wr * 64 + fr, col0 = u.pn * BM + wc * 32 + 8 * fq;
#pragma unroll
        for (int ai = 0; ai < 2; ++ai)
#pragma unroll
            for (int m = 0; m < 4; ++m) { const int r = r0 + ai * HALF + m * 16;
                if (r < n) { const size_t li = (size_t)e * LIST_CAP + r; const int ga = list[li]; const float g = lgate[li]; bf16_t* yp = Y + (size_t)ga * D_MODEL + col0;
#pragma unroll
                    for (int bj = 0; bj < 2; ++bj) { const f32x4 v0 = acc[ai][bj][m][0] * g, v1 = acc[ai][bj][m][1] * g;
                        u32x4 w; w.x = cvtpk(v0[0], v0[1]); w.y = cvtpk(v0[2], v0[3]); w.z = cvtpk(v1[0], v1[1]); w.w = cvtpk(v1[2], v1[3]);
                        *(u32x4*)(yp + bj * HALF) = w; } }
                if (m & 1) asm volatile("" ::: "memory"); }
    }
};
#undef ACC_T

template <class Epi, class Sched, bool ALIGN_EPI>
__device__ __forceinline__ void gemm_phase(LAS unsigned char* lds, const Gemm g, const Sched& S, const Epi& E) {
    const int tid = opaque(threadIdx.x), wid = __builtin_amdgcn_readfirstlane(tid >> 6), lane = tid & 63, wr = wid >> 2, wc = wid & 3, fr = lane & 15, fq = lane >> 4;
    const int K = opaque_s(g.K), nt = K / BK;
    unsigned voffB[2]; int Rr[2], Cc[2];
#pragma unroll
    for (int i = 0; i < 2; ++i) { int R, C; stage_rc(tid * 16 + i * 8192, R, C); const int Rb = Epi::PERM ? ((R & ~31) + perm32(R & 31)) : R;
        Rr[i] = R; Cc[i] = C; voffB[i] = (unsigned)(Rb * g.ldb + C) * 2u; }
    const size_t kstep = (size_t)(BK * 2);
    const size_t hstepB = (size_t)HALF * g.ldb * 2;
    const unsigned ldsw = (unsigned)wid * 1024u;
    const int aoff = lds_byte(wr * 64 + fr, fq * 8), boff = lds_byte(wc * 32 + fr, fq * 8);
#define PG8_SA(b, h) (((b) * 2 + (h)) * HTB)
#define PG8_SB(b, h) ((4 + (b) * 2 + (h)) * HTB)
#define PG8_STAGE(bufoff, gbase, voff) do { _Pragma("unroll") for (int _i = 0; _i < 2; ++_i) \
        __builtin_amdgcn_global_load_lds((const unsigned*)((const char*)(gbase) + (voff)[_i]), (LAS unsigned*)(lds + (bufoff) + ldsw + _i * 8192), 16, 0, 0); } while (0)
#define PG8_LDA(dst, b, h) do { _Pragma("unroll") for (int m = 0; m < 4; ++m) _Pragma("unroll") for (int k = 0; k < 2; ++k) dst[m][k] = *(const LAS bf16x8*)(lds + PG8_SA(b, h) + aoff + m * 2048 + k * 1024); } while (0)
#define PG8_LDB(dst, b, h) do { _Pragma("unroll") for (int n = 0; n < 2; ++n) _Pragma("unroll") for (int k = 0; k < 2; ++k) dst[n][k] = *(const LAS bf16x8*)(lds + PG8_SB(b, h) + boff + n * 2048 + k * 1024); } while (0)
#define PG8_MMA(ai, bj, At, Bt) do { __builtin_amdgcn_s_setprio(1); _Pragma("unroll") for (int m = 0; m < 4; ++m) _Pragma("unroll") for (int n = 0; n < 2; ++n) _Pragma("unroll") for (int k = 0; k < 2; ++k) \
        acc[ai][bj][m][n] = __builtin_amdgcn_mfma_f32_16x16x32_bf16(Bt[n][k], At[m][k], acc[ai][bj][m][n], 0, 0, 0); __builtin_amdgcn_s_setprio(0); } while (0)
#define PG8_WAIT_V(n) asm volatile("s_waitcnt vmcnt(" #n ")" ::: "memory")
#define PG8_WAIT_L(n) asm volatile("s_waitcnt lgkmcnt(" #n ")" ::: "memory")
#define PG8_BAR __builtin_amdgcn_s_barrier()
#define PG8_SCHED __builtin_amdgcn_sched_barrier(0)
    Unit cur, nxt; int ui = 0;
    if (!S.next(0, cur)) return;
    f32x4 acc[2][2][4][2];
#pragma unroll
    for (int a = 0; a < 2; ++a)
#pragma unroll
        for (int b = 0; b < 2; ++b)
#pragma unroll
            for (int m = 0; m < 4; ++m)
#pragma unroll
                for (int n = 0; n < 2; ++n) acc[a][b][m][n] = (f32x4){0.f, 0.f, 0.f, 0.f};
    bf16x8 At[4][2], B0[2][2], B1[2][2];
    const char* cA = S.a_base(cur); const char* cB = S.b_base(cur);
    unsigned vA[2][2], vN[2][2];
#pragma unroll
    for (int h = 0; h < 2; ++h)
#pragma unroll
        for (int i = 0; i < 2; ++i) { vA[h][i] = S.a_voff(cur, Rr[i] + h * HALF, Cc[i], g.lda); vN[h][i] = vA[h][i]; }
    PG8_STAGE(PG8_SB(0, 0), cB, voffB); PG8_STAGE(PG8_SB(0, 1), cB + hstepB, voffB); PG8_STAGE(PG8_SA(0, 0), cA, vA[0]); PG8_STAGE(PG8_SA(0, 1), cA, vA[1]);
    if (wr == 1) PG8_BAR;
    PG8_WAIT_V(2); PG8_BAR;
    PG8_STAGE(PG8_SB(1, 0), cB + kstep, voffB); PG8_STAGE(PG8_SA(1, 0), cA + kstep, vA[0]); PG8_STAGE(PG8_SB(1, 1), cB + hstepB + kstep, voffB);
    PG8_WAIT_V(6); PG8_BAR;
    for (;;) {
        const bool has_next = S.next(ui + 1, nxt);
        const char* nA = has_next ? S.a_base(nxt) : cA; const char* nB = has_next ? S.b_base(nxt) : cB;
        if (has_next) {
#pragma unroll
            for (int h = 0; h < 2; ++h)
#pragma unroll
                for (int i = 0; i < 2; ++i) vN[h][i] = S.a_voff(nxt, Rr[i] + h * HALF, Cc[i], g.lda);
        }
#pragma nounroll
        for (int t = 0; t < nt; t += 2) {
            const bool last = (t == nt - 2);
            const char* a1 = cA + (size_t)(t + 1) * kstep;
            const char* a2 = last ? nA : cA + (size_t)(t + 2) * kstep; const char* b2 = last ? nB : cB + (size_t)(t + 2) * kstep;
            const char* a3 = a2 + kstep; const char* b3 = b2 + kstep;
            unsigned w0[2], w1[2];
#pragma unroll
            for (int i = 0; i < 2; ++i) { w0[i] = last ? vN[0][i] : vA[0][i]; w1[i] = last ? vN[1][i] : vA[1][i]; }
            PG8_LDB(B0, 0, 0); PG8_LDB(B1, 0, 1); PG8_SCHED; PG8_LDA(At, 0, 0); PG8_STAGE(PG8_SA(1, 1), a1, vA[1]);
            PG8_WAIT_V(8); PG8_WAIT_L(0); PG8_BAR; PG8_MMA(0, 0, At, B0); PG8_MMA(0, 1, At, B1); PG8_BAR; PG8_SCHED;
            PG8_LDA(At, 0, 1); PG8_STAGE(PG8_SB(0, 0), b2, voffB); PG8_STAGE(PG8_SB(0, 1), b2 + hstepB, voffB); PG8_STAGE(PG8_SA(0, 0), a2, w0);
            PG8_WAIT_V(8); PG8_WAIT_L(0); PG8_BAR; PG8_MMA(1, 0, At, B0); PG8_MMA(1, 1, At, B1); PG8_BAR; PG8_SCHED;
            PG8_LDB(B0, 1, 0); PG8_LDB(B1, 1, 1); PG8_SCHED; PG8_LDA(At, 1, 0); PG8_STAGE(PG8_SA(0, 1), a2, w1);
            PG8_WAIT_V(8); PG8_WAIT_L(0); PG8_BAR; PG8_MMA(0, 0, At, B0); PG8_MMA(0, 1, At, B1); PG8_BAR; PG8_SCHED;
            PG8_LDA(At, 1, 1); PG8_STAGE(PG8_SB(1, 0), b3, voffB); PG8_STAGE(PG8_SB(1, 1), b3 + hstepB, voffB); PG8_STAGE(PG8_SA(1, 0), a3, w0);
            PG8_WAIT_V(8); PG8_WAIT_L(0); PG8_BAR; PG8_MMA(1, 0, At, B0); PG8_MMA(1, 1, At, B1); PG8_BAR; PG8_SCHED;
        }
        if constexpr (ALIGN_EPI) { if (wr == 0) PG8_BAR; }
        if constexpr (!Epi::AFTER_DRAIN) E(acc, cur, wr, wc, fr, fq);
        if (!has_next) break;
#pragma unroll
        for (int a = 0; a < 2; ++a)
#pragma unroll
            for (int b = 0; b < 2; ++b)
#pragma unroll
                for (int m = 0; m < 4; ++m)
#pragma unroll
                    for (int n = 0; n < 2; ++n) acc[a][b][m][n] = (f32x4){0.f, 0.f, 0.f, 0.f};
        cur = nxt; cA = nA; cB = nB; ++ui;
#pragma unroll
        for (int h = 0; h < 2; ++h)
#pragma unroll
            for (int i = 0; i < 2; ++i) vA[h][i] = vN[h][i];
        if constexpr (ALIGN_EPI) { if (wr == 1) PG8_BAR; }
    }
    PG8_WAIT_V(0);
    if constexpr (!ALIGN_EPI) { if (wr == 0) PG8_BAR; }
    PG8_BAR;
    if constexpr (Epi::AFTER_DRAIN) E.fused(acc, cur, wr, wc, fr, fq, lds, lane);
#undef PG8_SA
#undef PG8_SB
#undef PG8_STAGE
#undef PG8_LDA
#undef PG8_LDB
#undef PG8_MMA
#undef PG8_WAIT_V
#undef PG8_WAIT_L
#undef PG8_BAR
#undef PG8_SCHED
}
}

namespace att {
constexpr int KSLOT = 12288, VSLOT = 8192, LDS_K = 0, LDS_V = 3 * KSLOT, LDS_BYTES = LDS_V + 3 * VSLOT;
constexpr float THR = 6.0f;
__device__ __forceinline__ int nx3(int s) { return s == 2 ? 0 : s + 1; }
__device__ __forceinline__ int pv3(int s) { return s == 0 ? 2 : s - 1; }
__device__ __forceinline__ void glds16(const void* g, LAS unsigned char* l) { __builtin_amdgcn_global_load_lds((const unsigned*)g, (LAS unsigned*)l, 16, 0, 0); }

template <bool FIRST, bool GEN>
__device__ __forceinline__ void att_step(f32x16& c0, f32x16& c1, f32x16& n0, f32x16& n1, f32x16& o0, f32x16& o1, f32x16& negm, float& mhat, float& lsum, u32x4 (&pw)[4], const bf16x8 (&qr)[6],
                                         const LAS unsigned char* kb_next, const LAS unsigned char* vb_prev, bool act_prev, bool act_cur, bool act_nxt, int jb, int qrel, int hi) {
    const bool do_pv = !FIRST && (!GEN || act_prev), do_cur = !GEN || act_cur, do_qk = !GEN || act_nxt;
    bf16x8 vfr[8], kfa[6], kfb[6];
    if (do_pv) {
#pragma unroll
        for (int kc2 = 0; kc2 < 4; ++kc2) { vfr[2 * kc2] = *(const LAS bf16x8*)(vb_prev + kc2 * 2048); vfr[2 * kc2 + 1] = *(const LAS bf16x8*)(vb_prev + kc2 * 2048 + 512); }
    }
    if (do_qk) {
#pragma unroll
        for (int d0 = 0; d0 < 3; ++d0) { kfa[2 * d0] = *(const LAS bf16x8*)(kb_next + d0 * 2048); kfa[2 * d0 + 1] = *(const LAS bf16x8*)(kb_next + d0 * 2048 + 512); }
    }
    __builtin_amdgcn_sched_barrier(0);
    float rm = 0.f;
    if (do_cur) {
        if ((GEN || FIRST) && jb >= 0) {
            const int kb0 = 64 * jb + 8 * hi;
#pragma unroll
            for (int r = 0; r < 16; ++r) { const int key = kb0 + (r & 3) + 4 * ((r >> 2) & 1) + 16 * (r >> 3);
                if (key > qrel) c0[r] = -INFINITY; if (key + 32 > qrel) c1[r] = -INFINITY; }
        }
        float ra = fmaxf(fmaxf(c0[0], c0[1]), c1[0]), rb = fmaxf(fmaxf(c0[2], c0[3]), c1[1]);
        ra = fmaxf(fmaxf(ra, c1[2]), c1[3]);
#pragma unroll
        for (int r = 4; r < 16; r += 4) { ra = fmaxf(fmaxf(ra, c0[r]), c0[r + 1]); rb = fmaxf(fmaxf(rb, c0[r + 2]), c0[r + 3]); ra = fmaxf(fmaxf(ra, c1[r]), c1[r + 1]); rb = fmaxf(fmaxf(rb, c1[r + 2]), c1[r + 3]); }
        rm = fmaxf(ra, rb);
        { auto rr = __builtin_amdgcn_permlane32_swap(__float_as_uint(rm), __float_as_uint(rm), false, false); rm = fmaxf(__uint_as_float(rr[0]), __uint_as_float(rr[1])); }
    }
    if (do_pv) {
#pragma unroll
        for (int kc2 = 0; kc2 < 4; ++kc2) {
            const bf16x8 pf = __builtin_bit_cast(bf16x8, pw[kc2]);
            o0 = __builtin_amdgcn_mfma_f32_32x32x16_bf16(vfr[2 * kc2], pf, o0, 0, 0, 0);
            o1 = __builtin_amdgcn_mfma_f32_32x32x16_bf16(vfr[2 * kc2 + 1], pf, o1, 0, 0, 0);
        }
    }
    __builtin_amdgcn_sched_barrier(0);
    if (do_qk) {
#pragma unroll
        for (int d0 = 0; d0 < 3; ++d0) { kfb[2 * d0] = *(const LAS bf16x8*)(kb_next + (d0 + 3) * 2048); kfb[2 * d0 + 1] = *(const LAS bf16x8*)(kb_next + (d0 + 3) * 2048 + 512); }
    }
    __builtin_amdgcn_sched_barrier(0);
    if (do_cur) {
        if (FIRST) {
            mhat = rm;
#pragma unroll
            for (int r = 0; r < 16; ++r) { c0[r] -= rm; c1[r] -= rm; negm[r] = -rm; }
        } else if (__any(rm > THR)) {
            const float dl = fmaxf(rm, 0.f); mhat += dl;
            const float f = __builtin_amdgcn_exp2f(-dl); lsum *= f;
#pragma unroll
            for (int r = 0; r < 16; ++r) { c0[r] -= dl; c1[r] -= dl; o0[r] *= f; o1[r] *= f; negm[r] = -mhat; }
        }
    }
    if (do_qk) {
        n0 = __builtin_amdgcn_mfma_f32_32x32x16_bf16(kfa[0], qr[0], negm, 0, 0, 0);
        n1 = __builtin_amdgcn_mfma_f32_32x32x16_bf16(kfa[1], qr[0], negm, 0, 0, 0);
#pragma unroll
        for (int d0 = 1; d0 < 3; ++d0) { n0 = __builtin_amdgcn_mfma_f32_32x32x16_bf16(kfa[2 * d0], qr[d0], n0, 0, 0, 0); n1 = __builtin_amdgcn_mfma_f32_32x32x16_bf16(kfa[2 * d0 + 1], qr[d0], n1, 0, 0, 0); }
#pragma unroll
        for (int d0 = 0; d0 < 3; ++d0) { n0 = __builtin_amdgcn_mfma_f32_32x32x16_bf16(kfb[2 * d0], qr[d0 + 3], n0, 0, 0, 0); n1 = __builtin_amdgcn_mfma_f32_32x32x16_bf16(kfb[2 * d0 + 1], qr[d0 + 3], n1, 0, 0, 0); }
    }
    if (do_cur) {
        float sa = 0.f, sb = 0.f;
#pragma unroll
        for (int r = 0; r < 16; ++r) { c0[r] = __builtin_amdgcn_exp2f(c0[r]); c1[r] = __builtin_amdgcn_exp2f(c1[r]); sa += c0[r]; sb += c1[r]; }
        lsum += sa + sb;
#pragma unroll
        for (int i = 0; i < 2; ++i) {
            pw[i] = (u32x4){cvtpk(c0[8 * i], c0[8 * i + 1]), cvtpk(c0[8 * i + 2], c0[8 * i + 3]), cvtpk(c0[8 * i + 4], c0[8 * i + 5]), cvtpk(c0[8 * i + 6], c0[8 * i + 7])};
            pw[2 + i] = (u32x4){cvtpk(c1[8 * i], c1[8 * i + 1]), cvtpk(c1[8 * i + 2], c1[8 * i + 3]), cvtpk(c1[8 * i + 4], c1[8 * i + 5]), cvtpk(c1[8 * i + 6], c1[8 * i + 7])};
        }
        asm volatile("" : "+v"(pw[0]), "+v"(pw[1]), "+v"(pw[2]), "+v"(pw[3]), "+v"(lsum));
    }
    __builtin_amdgcn_sched_barrier(0);
}

__device__ __forceinline__ void attn_unit(int b, int h, int qb, const bf16_t* __restrict__ Q, const bf16_t* __restrict__ KN, const bf16_t* __restrict__ KR, const bf16_t* __restrict__ VT, bf16_t* __restrict__ O, LAS unsigned char* lds) {
    const int tid = opaque(threadIdx.x), lane = tid & 63, r32 = lane & 31, hi = lane >> 5;
    const int w = __builtin_amdgcn_readfirstlane(tid >> 6);
    const size_t tok0 = (size_t)b * SEQ;
    const int q0 = qb * 256, NT = 4 * (qb + 1);
    const bf16_t* ksrc = KN + (tok0 + lane) * 1024 + h * 64 + 8 * w;
    const bf16_t* rsrc = KR + (tok0 + lane) * 32 + 8 * (w & 3);
    const bf16_t* vsrc = VT + (size_t)(h * 64 + lane) * NTOK + tok0 + 8 * w;
#define ATT_ISSUE_K(t, slot) do { glds16(ksrc + (size_t)(t) * 65536, lds + LDS_K + (slot) * KSLOT + w * 1024); \
        if (w < 4) glds16(rsrc + (size_t)(t) * 2048, lds + LDS_K + (slot) * KSLOT + (8 + w) * 1024); } while (0)
#define ATT_ISSUE_V(t, slot) glds16(vsrc + (size_t)(t) * 64, lds + LDS_V + (slot) * VSLOT + w * 1024)
    ATT_ISSUE_K(0, 0); ATT_ISSUE_K(1, 1); ATT_ISSUE_K(2, 2); ATT_ISSUE_V(0, 0);
    bf16x8 qr[6];
    { const bf16_t* qp = Q + (tok0 + q0 + w * 32 + r32) * QPITCH + h * 96 + hi * 8;
#pragma unroll
      for (int d0 = 0; d0 < 6; ++d0) qr[d0] = *(const bf16x8*)(qp + d0 * 16); }
    const int kvp = (r32 & 19) | ((r32 & 4) << 1) | ((r32 & 8) >> 1);
    const LAS unsigned char* kf = lds + LDS_K + hi * 1024 + kvp * 16;
    const LAS unsigned char* vf = lds + LDS_V + hi * 1024 + r32 * 16;
    float mhat = 0.f, lsum = 0.f;
    f32x16 o0 = {}, o1 = {}, negm = {}, sA0 = {}, sA1 = {}, sB0, sB1;
    u32x4 pw[4] = {};
    const int qrel = w * 32 + r32, wb = w >> 1;
    asm volatile("s_waitcnt vmcnt(0)" ::: "memory");
    __builtin_amdgcn_s_barrier();
    asm volatile("" ::: "memory");
#pragma unroll
    for (int d0 = 0; d0 < 6; ++d0) {
        const bf16x8 k0 = *(const LAS bf16x8*)(kf + d0 * 2048), k1 = *(const LAS bf16x8*)(kf + d0 * 2048 + 512);
        sA0 = __builtin_amdgcn_mfma_f32_32x32x16_bf16(k0, qr[d0], sA0, 0, 0, 0);
        sA1 = __builtin_amdgcn_mfma_f32_32x32x16_bf16(k1, qr[d0], sA1, 0, 0, 0);
    }
    int st = 0;
#define ATT_SYNC(t) do { \
        if ((t) == 0 || (t) + 2 >= NT) asm volatile("s_waitcnt vmcnt(0)" ::: "memory"); \
        else if (w < 4) asm volatile("s_waitcnt vmcnt(3)" ::: "memory"); \
        else asm volatile("s_waitcnt vmcnt(2)" ::: "memory"); \
        __builtin_amdgcn_s_barrier(); asm volatile("" ::: "memory"); \
        if ((t) + 3 < NT) ATT_ISSUE_K((t) + 3, st); \
        if ((t) + 1 < NT) ATT_ISSUE_V((t) + 1, nx3(st)); } while (0)
#define ATT_ACT(tt) (((tt) - (NT - 4)) < 0 || ((tt) - (NT - 4)) <= wb)
#define ATT_STEP(FIRST, GEN, C0, C1, N0, N1, t) do { ATT_SYNC(t); \
        att_step<FIRST, GEN>(C0, C1, N0, N1, o0, o1, negm, mhat, lsum, pw, qr, kf + nx3(st) * KSLOT, vf + pv3(st) * VSLOT, \
                             (t) > 0 && ATT_ACT((t) - 1), ATT_ACT(t), (t) + 1 < NT && ATT_ACT((t) + 1), (t) - (NT - 4), qrel, hi); \
        st = nx3(st); } while (0)
    ATT_STEP(true, true, sA0, sA1, sB0, sB1, 0);
    int t = 1;
    const int ts = (NT > 4) ? NT - 5 : 1;
    for (; t + 1 < ts; t += 2) {
        ATT_STEP(false, false, sB0, sB1, sA0, sA1, t);
        ATT_STEP(false, false, sA0, sA1, sB0, sB1, t + 1);
    }
    if (NT > 4) { ATT_STEP(false, true, sB0, sB1, sA0, sA1, NT - 5); ATT_STEP(false, true, sA0, sA1, sB0, sB1, NT - 4); }
    ATT_STEP(false, true, sB0, sB1, sA0, sA1, NT - 3);
    ATT_STEP(false, true, sA0, sA1, sB0, sB1, NT - 2);
    ATT_STEP(false, true, sB0, sB1, sA0, sA1, NT - 1);
    if (ATT_ACT(NT - 1)) {
        const LAS unsigned char* vb = vf + pv3(st) * VSLOT;
#pragma unroll
        for (int kc2 = 0; kc2 < 4; ++kc2) {
            const bf16x8 v0 = *(const LAS bf16x8*)(vb + kc2 * 2048), v1 = *(const LAS bf16x8*)(vb + kc2 * 2048 + 512);
            const bf16x8 pf = __builtin_bit_cast(bf16x8, pw[kc2]);
            o0 = __builtin_amdgcn_mfma_f32_32x32x16_bf16(v0, pf, o0, 0, 0, 0);
            o1 = __builtin_amdgcn_mfma_f32_32x32x16_bf16(v1, pf, o1, 0, 0, 0);
        }
    }
    { auto rr = __builtin_amdgcn_permlane32_swap(__float_as_uint(lsum), __float_as_uint(lsum), false, false); lsum = __uint_as_float(rr[0]) + __uint_as_float(rr[1]); }
    const float inv = 1.0f / lsum;
    bf16_t* op = O + (tok0 + q0 + w * 32 + r32) * 1024 + h * 64 + 4 * hi;
#pragma unroll
    for (int g = 0; g < 4; ++g) {
        u32x2 a, c; a.x = cvtpk(o0[4 * g] * inv, o0[4 * g + 1] * inv); a.y = cvtpk(o0[4 * g + 2] * inv, o0[4 * g + 3] * inv);
        c.x = cvtpk(o1[4 * g] * inv, o1[4 * g + 1] * inv); c.y = cvtpk(o1[4 * g + 2] * inv, o1[4 * g + 3] * inv);
        *(u32x2*)(op + 8 * g) = a; *(u32x2*)(op + 32 + 8 * g) = c;
    }
    asm volatile("s_waitcnt lgkmcnt(0)" ::: "memory");
    __builtin_amdgcn_s_barrier();
#undef ATT_ISSUE_K
#undef ATT_ISSUE_V
#undef ATT_SYNC
#undef ATT_ACT
#undef ATT_STEP
}
}

#define XB_TMO      128
#define XB_XCNT(j)  (256  + 64 * (j))
#define XB_XSUB(j)  (1280 + 64 * (j))
#define XB_XGEN(j)  (2304 + 64 * (j))
#define XB_TOP      3328
#define XB_TOPGEN   3392
#define XCD_BAR_WORDS 3456
#define XB_SPIN_CAP (1u << 18)
__device__ __forceinline__ unsigned xb_ld(unsigned* p)              { return __hip_atomic_load(p, __ATOMIC_RELAXED, __HIP_MEMORY_SCOPE_AGENT); }
__device__ __forceinline__ unsigned xb_add(unsigned* p, unsigned v) { return __hip_atomic_fetch_add(p, v, __ATOMIC_RELAXED, __HIP_MEMORY_SCOPE_AGENT); }
__device__ __forceinline__ unsigned xb_xcc_id() { return (unsigned)__builtin_amdgcn_s_getreg((3 << 11) | 20) & 0xFu; }
#define XB_SPIN(cond, bar) do { unsigned _sp = 0; while (cond) { __builtin_amdgcn_s_sleep(1); \
    if ((++_sp & 255u) == 0u) { if (xb_ld(&(bar)[XB_TMO])) break; if (_sp > XB_SPIN_CAP) { atomicAdd(&(bar)[XB_TMO], 1u); break; } } } } while (0)
struct XcdBarrier { unsigned* bar; unsigned x; volatile LAS unsigned* st; };
__device__ __forceinline__ XcdBarrier xcd_barrier_post(unsigned* bar, volatile LAS unsigned* st) {
    XcdBarrier b; b.bar = bar; b.x = xb_xcc_id(); b.st = st;
    if (threadIdx.x == 0) (void)xb_add(&bar[XB_XCNT(b.x)], 1u);
    return b;
}
__device__ __forceinline__ void xcd_barrier_complete(unsigned* bar, unsigned x, unsigned& nloc, unsigned& nx) {
    const unsigned G = gridDim.x * gridDim.y * gridDim.z;
    unsigned sum, cnt, mine, sp = 0u;
    for (;;) {
        sum = 0u; cnt = 0u; mine = 0u;
#pragma unroll
        for (unsigned j = 0; j < 16; ++j) { const unsigned c = xb_ld(&bar[XB_XCNT(j)]); sum += c; cnt += (c > 0u) ? 1u : 0u; mine = (j == x) ? c : mine; }
        if (sum == G) break;
        __builtin_amdgcn_s_sleep(1);
        if ((++sp & 255u) == 0u) { if (xb_ld(&bar[XB_TMO])) break; if (sp > XB_SPIN_CAP) { atomicAdd(&bar[XB_TMO], 1u); break; } }
    }
    nloc = mine > 0u ? mine : 1u; nx = cnt > 0u ? cnt : 1u;
}
__device__ __forceinline__ void xcd_barrier(const XcdBarrier& b) {
    asm volatile("s_waitcnt vmcnt(0)" ::: "memory");
    __syncthreads();
    if (threadIdx.x == 0) {
        unsigned* bar = b.bar;
        __builtin_amdgcn_s_waitcnt(0);
        unsigned nloc = b.st[0], nx = b.st[1];
        if (nloc == 0u) { xcd_barrier_complete(bar, b.x, nloc, nx); b.st[0] = nloc; b.st[1] = nx; }
        const unsigned old = xb_add(&bar[XB_XSUB(b.x)], 1u);
        const unsigned gen = old / nloc;
        if (old + 1u == (gen + 1u) * nloc) {
            __builtin_amdgcn_fence(__ATOMIC_RELEASE, "agent");
            asm volatile("s_waitcnt vmcnt(0)" ::: "memory");
            const unsigned og = xb_add(&bar[XB_TOP], 1u);
            const unsigned tg = og / nx;
            if (og + 1u == (tg + 1u) * nx) xb_add(&bar[XB_TOPGEN], 1u);
            else XB_SPIN(xb_ld(&bar[XB_TOPGEN]) == tg, bar);
            __builtin_amdgcn_fence(__ATOMIC_ACQUIRE, "agent");
            xb_add(&bar[XB_XGEN(b.x)], 1u);
            asm volatile("s_waitcnt vmcnt(0)" ::: "memory");
        } else {
            XB_SPIN(xb_ld(&bar[XB_XGEN(b.x)]) == gen, bar);
            __builtin_amdgcn_fence(__ATOMIC_ACQUIRE, "agent");
            asm volatile("s_waitcnt vmcnt(0)" ::: "memory");
        }
    }
    __syncthreads();
}

struct Args { const void* in[20]; float* out; unsigned char* ws; int ph_lo, ph_hi; };
typedef const __attribute__((address_space(4))) Args* KArgs;
__device__ __forceinline__ KArgs kargs() { KArgs p = (KArgs)__builtin_amdgcn_kernarg_segment_ptr(); asm volatile("" : "+s"(p)); return p; }
constexpr int NWAVES = 8;
constexpr int PPL = 12;
constexpr int NPHASE = 1 + DEPTH * PPL;

__constant__ double c_invf[16] = {1.0, 0.5623413251903491, 0.31622776601683794, 0.1778279410038923, 0.1, 0.05623413251903491, 0.03162277660168379, 0.01778279410038923,
                                  0.01, 0.005623413251903491, 0.0031622776601683794, 0.0017782794100389228, 0.001, 0.0005623413251903491, 0.00031622776601683794, 0.00017782794100389227};

__device__ __forceinline__ void transpose_item(const float* __restrict__ W, int ldw, int k0, int n0, bf16_t* __restrict__ WT, int ldt, int drow0, float mul, LAS float* scr, int lane) {
#pragma unroll 8
    for (int i = 0; i < 32; ++i) { const int kk = 2 * i + (lane >> 5); scr[kk * 33 + (lane & 31)] = W[(size_t)(k0 + kk) * ldw + n0 + (lane & 31)]; }
    LDS_WAIT(); asm volatile("" ::: "memory");
    const int c = lane & 7;
#pragma unroll
    for (int j = 0; j < 4; ++j) { const int n = (lane >> 3) + 8 * j; const LAS float* s = scr + (8 * c) * 33 + n;
        u32x4 o; o.x = cvtpk(s[0 * 33] * mul, s[1 * 33] * mul); o.y = cvtpk(s[2 * 33] * mul, s[3 * 33] * mul); o.z = cvtpk(s[4 * 33] * mul, s[5 * 33] * mul); o.w = cvtpk(s[6 * 33] * mul, s[7 * 33] * mul);
        *(u32x4*)(WT + (size_t)(drow0 + n) * ldt + k0 + 8 * c) = o; }
    LDS_WAIT(); asm volatile("" ::: "memory");
}

struct ConvItem { const float* src; bf16_t* dst; int ldw, ldt; };
__device__ __forceinline__ void conv_load(const ConvItem& c, f32x4 (&v)[16], int lane) {
    const float* src = c.src + (size_t)(lane >> 4) * c.ldw + 4 * (lane & 15);
#pragma unroll
    for (int i = 0; i < 16; ++i) v[i] = *(const f32x4*)(src + (size_t)(4 * i) * c.ldw);
}
__device__ __forceinline__ void conv_finish(const ConvItem& c, const f32x4 (&v)[16], LAS float* scr, int lane) {
#pragma unroll
    for (int i = 0; i < 16; ++i) *(LAS f32x4*)(scr + (4 * i + (lane >> 4)) * 68 + 4 * (lane & 15)) = v[i];
    LDS_WAIT(); asm volatile("" ::: "memory");
    bf16_t* dst = c.dst + (size_t)lane * c.ldt;
#pragma unroll
    for (int cc = 0; cc < 8; ++cc) { const LAS float* sp = scr + (8 * cc) * 68 + lane;
        u32x4 o; o.x = cvtpk(sp[0], sp[68]); o.y = cvtpk(sp[2 * 68], sp[3 * 68]); o.z = cvtpk(sp[4 * 68], sp[5 * 68]); o.w = cvtpk(sp[6 * 68], sp[7 * 68]);
        *(u32x4*)(dst + 8 * cc) = o; }
    LDS_WAIT(); asm volatile("" ::: "memory");
}

__device__ __forceinline__ void sincos_d(double a, float& s, float& c) {
    const double TWO_PI_HI = 6.283185307179586, TWO_PI_LO = 2.4492935982947064e-16, INV_2PI = 0.15915494309189535;
    const double n = __builtin_rint(a * INV_2PI);
    double r = __builtin_fma(-n, TWO_PI_HI, a); r = __builtin_fma(-n, TWO_PI_LO, r);
    const double HALF_PI = 1.5707963267948966, HALF_PI_LO = 6.123233995736766e-17;
    const double qd = __builtin_rint(r * 0.6366197723675814);
    double y = __builtin_fma(-qd, HALF_PI, r); y = __builtin_fma(-qd, HALF_PI_LO, y);
    const int q = ((int)qd) & 3;
    const double y2 = y * y;
    double sp = -7.647163731819816e-13; sp = sp * y2 + 1.6059043836821613e-10; sp = sp * y2 - 2.505210838544172e-08; sp = sp * y2 + 2.7557319223985893e-06; sp = sp * y2 - 0.0001984126984126984;
    sp = sp * y2 + 0.008333333333333333; sp = sp * y2 - 0.16666666666666666; sp = y + y * y2 * sp;
    double cp = 4.779477332387385e-14; cp = cp * y2 - 1.1470745597729725e-11; cp = cp * y2 + 2.08767569878681e-09; cp = cp * y2 - 2.755731922398589e-07; cp = cp * y2 + 2.48015873015873e-05;
    cp = cp * y2 - 0.001388888888888889; cp = cp * y2 + 0.041666666666666664; cp = cp * y2 - 0.5; cp = 1.0 + y2 * cp;
    double ss, cc;
    if (q == 0) { ss = sp; cc = cp; } else if (q == 1) { ss = cp; cc = -sp; } else if (q == 2) { ss = -sp; cc = -cp; } else { ss = -cp; cc = sp; }
    s = (float)ss; c = (float)cc;
}

__global__ void __launch_bounds__(NWAVES * 64, 2) mk_fwd(Args args_unused) {
    extern __shared__ __attribute__((aligned(16))) unsigned char lds_raw[];
    LAS unsigned char* lds = (LAS unsigned char*)lds_raw;
    volatile LAS unsigned* MISC = (volatile LAS unsigned*)(lds + MISC_OFF);
    int tid = threadIdx.x, lane = tid & 63, wave = __builtin_amdgcn_readfirstlane(tid >> 6);
    const int G = gridDim.x, bx = blockIdx.x;
    const int vcu = (G % 8 == 0) ? (bx % 8) * (G / 8) + bx / 8 : bx;
    int gw = vcu * NWAVES + wave; const int NGW = G * NWAVES;
#define ws (kargs()->ws)
    unsigned* ctl = (unsigned*)(ws + WS_CTL);
    for (int u = tid; u < (LDS_BYTES - LDSCTL_OFF) / 4; u += NWAVES * 64) ((LAS unsigned*)(lds + LDSCTL_OFF))[u] = 0u;
    __syncthreads();
    XcdBarrier bar; bar.bar = ctl + CW_BAR; bar.x = 0; bar.st = nullptr;
#if MK_ONE_LAUNCH
    bar = xcd_barrier_post(ctl + CW_BAR, MISC + 8);
#endif
    const int lo = kargs()->ph_lo, hi = kargs()->ph_hi;
#ifndef MK_REP_MASK
#define MK_REP_MASK 0u
#endif
#define NREP(b) (1 + (int)((MK_REP_MASK >> (b)) & 1u))
#ifndef MK_PH_MASK
#define MK_PH_MASK 0xffffffffu
#endif
#define PHON(b) ((MK_PH_MASK >> (b)) & 1u)
#define IN(k) (lo <= (k) && (k) < hi)
#if MK_ONE_LAUNCH
#define SEAM(k) do { if ((k) + 1 < hi) xcd_barrier(bar); } while (0)
#else
#define SEAM(k) do { } while (0)
#endif
#define in_x ((const float*)kargs()->in[0])
#define in_pos ((const int*)kargs()->in[1])
#define ln_g ((const float*)kargs()->in[2])
#define ln_b ((const float*)kargs()->in[3])
#define w_in ((const float*)kargs()->in[4])
#define q_norm ((const float*)kargs()->in[5])
#define w_uq ((const float*)kargs()->in[6])
#define kv_norm ((const float*)kargs()->in[7])
#define w_ukv ((const float*)kargs()->in[8])
#define w_o ((const float*)kargs()->in[9])
#define pool_w ((const float*)kargs()->in[10])
#define pool_b ((const float*)kargs()->in[11])
#define pool_scale ((const float*)kargs()->in[12])
#define w_grp ((const float*)kargs()->in[13])
#define b_grp ((const float*)kargs()->in[14])
#define w_exp ((const float*)kargs()->in[15])
#define b_exp ((const float*)kargs()->in[16])
#define w1 ((const float*)kargs()->in[17])
#define w3 ((const float*)kargs()->in[18])
#define w2 ((const float*)kargs()->in[19])
#define COS ((float*)(ws + WS_COS))
#define SIN ((float*)(ws + WS_SIN))
#define CNT ((int*)(ws + WS_CNT))
#define TILE ((int*)(ws + WS_TILE))
#define AE ((int*)(ws + WS_AE))
#define APOS ((int*)(ws + WS_APOS))
#define AG ((float*)(ws + WS_AG))
#define RSLOT ((int*)(ws + WS_RSLOT))
#define RGATE ((float*)(ws + WS_RGATE))
#define WIN ((bf16_t*)(ws + WS_WIN))
#define WUQ ((bf16_t*)(ws + WS_WUQ))
#define WUK ((bf16_t*)(ws + WS_WUK))
#define WUV ((bf16_t*)(ws + WS_WUV))
#define WO ((bf16_t*)(ws + WS_WO))
#define WP ((bf16_t*)(ws + WS_WP))
#define WR ((bf16_t*)(ws + WS_WR))
#define W13L(ll) ((bf16_t*)(ws + (((ll) & 1) ? WS_W13B : WS_W13)))
#define W2TL(ll) ((bf16_t*)(ws + (((ll) & 1) ? WS_W2TB : WS_W2T)))
#define FB ((bf16_t*)(ws + WS_FB))
#define XHL ((bf16_t*)(ws + WS_XHL))
#define LATB ((float*)(ws + WS_LAT))
#define CQ ((bf16_t*)(ws + WS_CQ))
#define CKV ((bf16_t*)(ws + WS_CKV))
#define KR ((bf16_t*)(ws + WS_KR))
#define QB ((bf16_t*)(ws + WS_Q))
#define KN ((bf16_t*)(ws + WS_KN))
#define VT ((bf16_t*)(ws + WS_VT))
#define OB ((bf16_t*)(ws + WS_O))
#define POOLED ((bf16_t*)(ws + WS_POOLED))
#define LG ((float*)(ws + WS_LG))
#define ROWLIST ((int*)(ws + WS_LIST))
#define LGATE ((float*)(ws + WS_LGATE))
#define HS ((bf16_t*)(ws + WS_HS))
#define YB ((bf16_t*)(ws + WS_Y))
    LAS float* scr = (LAS float*)(lds + RING_OFF + wave * SCR_WAVE);

    if (PHON(12) && IN(0)) {
        for (int m = gw; m < NTOK; m += NGW) {
            const f32x4* xr = (const f32x4*)(in_x + (size_t)m * D_MODEL) + 2 * lane; u32x4* oh = (u32x4*)(XHL + (size_t)m * 2048) + lane;
#pragma unroll
            for (int j = 0; j < 2; ++j) oh[64 * j] = pk8(xr[128 * j], xr[128 * j + 1]);
        }
        for (int idx = gw * 64 + lane; idx < NTOK * 16; idx += NGW * 64) { float s, c; sincos_d((double)in_pos[idx >> 4] * c_invf[idx & 15], s, c); COS[idx] = c; SIN[idx] = s; }
        for (int idx = gw * 64 + lane; idx < DEPTH * 2 * 256 * 1024; idx += NGW * 64) {
            const int l = idx >> 19, ks = (idx >> 18) & 1, row = (idx >> 10) & 255, k = idx & 1023;
            const int j = row < 72 ? row : ((row >= 128 && row < 200) ? row - 128 : -1);
            float v = 0.f;
            if (j >= 0 && !(ks == 1 && row >= 128)) { const float wv = (j < 8) ? w_grp[((size_t)l * 1024 + k) * 8 + j] : w_exp[((size_t)l * 1024 + k) * 64 + (j - 8)];
                const float whi = bflo(cvtpk(wv, 0.f)); v = (row < 72) ? whi : (wv - whi); }
            WR[idx] = (bf16_t)(cvtpk(v, 0.f) & 0xffffu);
        }
        for (int idx = gw * 64 + lane; idx < 2 * 96 * 1024 / 8; idx += NGW * 64) { const int j = idx / (96 * 128), r = idx % (96 * 128); *(u32x4*)(WIN + ((size_t)j * 512 + 416) * 1024 + (size_t)r * 8) = (u32x4){0u, 0u, 0u, 0u}; }
        constexpr int I_IN = 16 * 13, I_UQ = 4 * 48, I_UKV = 2 * 64, I_O = 16 * 32, I_P = 4 * 8;
        constexpr int NIT = 2 * (I_IN + I_UQ + I_UKV + I_O) + 8 * I_P;
        for (int it = gw; it < NIT; it += NGW) {
            int r = it;
            if (r < 2 * I_IN) { const int j = r / I_IN, q = r % I_IN, kb = q / 13, nb = q % 13;
                transpose_item(w_in + (size_t)j * 1024 * LAT, LAT, 64 * kb, 32 * nb, WIN + (size_t)j * 512 * 1024, 1024, 32 * nb, 1.f, scr, lane); continue; } r -= 2 * I_IN;
            if (r < 2 * I_UQ) { const int j = r / I_UQ, q = r % I_UQ, kb = q / 48, nb = q % 48; const int n0 = 32 * nb, head = n0 / 96, r0 = n0 % 96;
                if (r0 < 64) transpose_item(w_uq + (size_t)j * 256 * QPITCH, QPITCH, 64 * kb, n0, WUQ + (size_t)j * 1536 * 256, 256, head * 64 + r0, QSCALE, scr, lane);
                else {
                    const float* W = w_uq + (size_t)j * 256 * QPITCH; bf16_t* WT = WUQ + (size_t)j * 1536 * 256; const int k0 = 64 * kb;
#pragma unroll 8
                    for (int i = 0; i < 32; ++i) { const int kk = 2 * i + (lane >> 5); scr[kk * 33 + (lane & 31)] = W[(size_t)(k0 + kk) * QPITCH + n0 + (lane & 31)]; }
                    LDS_WAIT(); asm volatile("" ::: "memory");
                    const int c = lane & 7;
#pragma unroll
                    for (int jj = 0; jj < 4; ++jj) { const int n = (lane >> 3) + 8 * jj; const LAS float* s = scr + (8 * c) * 33 + n;
                        const int drow = 1024 + (head >> 3) * 256 + (head & 7) * 16 + (n < 16 ? n : 128 + n - 16);
                        u32x4 o; o.x = cvtpk(s[0 * 33] * QSCALE, s[1 * 33] * QSCALE); o.y = cvtpk(s[2 * 33] * QSCALE, s[3 * 33] * QSCALE); o.z = cvtpk(s[4 * 33] * QSCALE, s[5 * 33] * QSCALE); o.w = cvtpk(s[6 * 33] * QSCALE, s[7 * 33] * QSCALE);
                        *(u32x4*)(WT + (size_t)drow * 256 + k0 + 8 * c) = o; }
                    LDS_WAIT(); asm volatile("" ::: "memory");
                }
                continue; } r -= 2 * I_UQ;
            if (r < 2 * I_UKV) { const int j = r / I_UKV, q = r % I_UKV, kb = q / 64, nb = q % 64; const int n0 = 32 * nb, head = n0 >> 7, r0 = n0 & 127;
                if (r0 < 64) transpose_item(w_ukv + (size_t)j * 128 * 2048, 2048, 64 * kb, n0, WUK + (size_t)j * 1024 * 128, 128, head * 64 + r0, 1.f, scr, lane);
                else transpose_item(w_ukv + (size_t)j * 128 * 2048, 2048, 64 * kb, n0, WUV + (size_t)j * 1024 * 128, 128, head * 64 + r0 - 64, 1.f, scr, lane);
                continue; } r -= 2 * I_UKV;
            if (r < 2 * I_O) { const int j = r / I_O, q = r % I_O, kb = q / 32, nb = q % 32;
                transpose_item(w_o + (size_t)j * 1024 * 1024, 1024, 64 * kb, 32 * nb, WO + (size_t)j * 1024 * 1024, 1024, 32 * nb, 1.f, scr, lane); continue; } r -= 2 * I_O;
            { const int jg = r / I_P, q = r % I_P, kb = q / 8, nb = q % 8;
                transpose_item(pool_w + (size_t)jg * 65536, 256, 64 * kb, 32 * nb, WP + (size_t)jg * 65536, 256, 32 * nb, 1.f, scr, lane); }
        }
        SEAM(0);
    }

    for (int l = 0; l < DEPTH; ++l) {
        const int pb = 1 + PPL * l, j = l >> 1;
        tid = opaque(threadIdx.x); lane = tid & 63; wave = __builtin_amdgcn_readfirstlane(tid >> 6); gw = vcu * NWAVES + wave; scr = (LAS float*)(lds + RING_OFF + wave * SCR_WAVE);
        const bool mla = (l & 1) == 0;
#define MOE_CONV_DECODE(it, C) do { const int cl = l + ((it) >= 12288 ? 1 : 0); int r = (it) - ((it) >= 12288 ? 12288 : 0); \
            if (r < 8192) { const int which = r >> 12, q = r & 4095, e = q >> 6, kb = (q >> 2) & 15, nb = q & 3; const int n0 = 64 * nb; \
                C.src = (which ? w3 : w1) + ((size_t)cl * 64 + e) * 1024 * 256 + (size_t)(64 * kb) * 256 + n0; C.ldw = 256; \
                C.dst = W13L(cl) + (size_t)e * 512 * 1024 + (size_t)((n0 >> 7) * 256 + (n0 & 127) + which * 128) * 1024 + 64 * kb; C.ldt = 1024; } \
            else { r -= 8192; const int e = r >> 6, kb = (r >> 4) & 3, nb = r & 15; \
                C.src = w2 + ((size_t)cl * 64 + e) * 256 * 1024 + (size_t)(64 * kb) * 1024 + 64 * nb; C.ldw = 1024; \
                C.dst = W2TL(cl) + (size_t)e * 1024 * 256 + (size_t)(64 * nb) * 256 + 64 * kb; C.ldt = 256; } } while (0)

        if (mla) {
            if (PHON(0) && IN(pb + 0)) {
                for (int rep = 0; rep < NREP(0); ++rep) { if (rep) __syncthreads();
                pg8::Gemm g{2048, 1024, 1024}; pg8::DenseOrder S; S.init(NTOK, 512, G, bx, XHL, (size_t)256 * 2048 * 2, 0, WIN + (size_t)j * 512 * 1024, (size_t)256 * 1024 * 2);
                if (G == 256) { pg8::EpiLatNorm E{CQ, CKV, KR, q_norm + j * 256, kv_norm + j * 128, COS, SIN};
                    pg8::gemm_phase<pg8::EpiLatNorm, pg8::DenseOrder, true>(lds + RING_OFF, g, S, E); }
                else { pg8::EpiF32 E{LATB, 512};
                    pg8::gemm_phase<pg8::EpiF32, pg8::DenseOrder, true>(lds + RING_OFF, g, S, E); }
                }
                SEAM(pb + 0);
            }
            if (PHON(1) && IN(pb + 1) && G != 256) {
                const float* gq = q_norm + j * 256; const float* gk = kv_norm + j * 128;
                const f32x4 gqv = *(const f32x4*)(gq + 4 * lane); const f32x4 gkv = *(const f32x4*)(gk + 4 * (lane & 31));
                for (int m = gw; m < NTOK; m += NGW) {
                    const float* lr = LATB + (size_t)m * 512;
                    const f32x4 a = *(const f32x4*)(lr + 4 * lane), c = *(const f32x4*)(lr + 256 + 4 * lane);
                    const float sq = wave_sum(a.x * a.x + a.y * a.y + a.z * a.z + a.w * a.w);
                    const float sk = wave_sum(lane < 32 ? (c.x * c.x + c.y * c.y + c.z * c.z + c.w * c.w) : 0.f);
                    const float rq = 1.0f / sqrtf(sq * (1.f / 256.f) + RMS_EPS), rk = 1.0f / sqrtf(sk * (1.f / 128.f) + RMS_EPS);
                    { u32x2 o; o.x = cvtpk(a.x * rq * gqv.x, a.y * rq * gqv.y); o.y = cvtpk(a.z * rq * gqv.z, a.w * rq * gqv.w); *((u32x2*)(CQ + (size_t)m * 256) + lane) = o; }
                    if (lane < 32) { u32x2 o; o.x = cvtpk(c.x * rk * gkv.x, c.y * rk * gkv.y); o.y = cvtpk(c.z * rk * gkv.z, c.w * rk * gkv.w); *((u32x2*)(CKV + (size_t)m * 128) + lane) = o; }
                    f32x4 p; p.x = __shfl_xor(c.x, 4); p.y = __shfl_xor(c.y, 4); p.z = __shfl_xor(c.z, 4); p.w = __shfl_xor(c.w, 4);
                    if (lane >= 32 && lane < 40) {
                        const f32x4 cv = *(const f32x4*)(COS + (size_t)m * 16 + 4 * (lane & 3)), sv = *(const f32x4*)(SIN + (size_t)m * 16 + 4 * (lane & 3));
                        f32x4 y; if (lane < 36) y = c * cv - p * sv; else y = c * cv + p * sv;
                        u32x2 o; o.x = cvtpk(y.x, y.y); o.y = cvtpk(y.z, y.w); *((u32x2*)(KR + (size_t)m * 32) + (lane - 32)) = o;
                    }
                }
                SEAM(pb + 1);
            }
            if (PHON(2) && IN(pb + 2)) {
                for (int rep = 0; rep < NREP(2); ++rep) {
                { pg8::Gemm g{256, 256, 256}; pg8::DenseOrder S; S.init(NTOK, 1536, G, bx, CQ, (size_t)256 * 256 * 2, 0, WUQ + (size_t)j * 1536 * 256, (size_t)256 * 256 * 2);
                  pg8::EpiQ E{QB, COS, SIN};
                  pg8::gemm_phase<pg8::EpiQ, pg8::DenseOrder, true>(lds + RING_OFF, g, S, E); }
                { pg8::Gemm g{128, 128, 128}; pg8::DenseOrder S; S.init(NTOK, 1024, G, bx, CKV, (size_t)256 * 128 * 2, 0, WUK + (size_t)j * 1024 * 128, (size_t)256 * 128 * 2);
                  pg8::EpiBf16 E{KN, 1024};
                  pg8::gemm_phase<pg8::EpiBf16, pg8::DenseOrder, true>(lds + RING_OFF, g, S, E); }
                { pg8::Gemm g{128, 128, 128}; pg8::DenseOrder S; S.init(1024, NTOK, G, bx, WUV + (size_t)j * 1024 * 128, (size_t)256 * 128 * 2, 0, CKV, (size_t)256 * 128 * 2);
                  pg8::EpiBf16 E{VT, (size_t)NTOK};
                  pg8::gemm_phase<pg8::EpiBf16, pg8::DenseOrder, true>(lds + RING_OFF, g, S, E); }
                }
                SEAM(pb + 2);
            }
            if (PHON(3) && IN(pb + 3)) {
                for (int rep = 0; rep < NREP(3); ++rep) {
                int cj = 0;
                for (int i = 0;; ++i) {
                    const int L = i * G + vcu; if (L >= 2048) break;
                    const int sl = L & 255, rnd = L >> 8, s = sl & 7, bh = (sl >> 3) + 32 * (rnd >> 2), k = rnd & 3;
                    const int qb = (k == 0) ? s : (k == 1) ? 15 - s : (k == 2) ? 16 + s : 31 - s;
                    att::attn_unit(bh >> 4, bh & 15, qb, QB, KN, KR, VT, OB, lds + RING_OFF);
                    if (rep == 0 && i < 6) {
                        int it0 = gw + cj * NGW, it1 = it0 + NGW; cj += 2;
                        it0 = it0 < 2 * 12288 ? it0 : 2 * 12288 - 1; it1 = it1 < 2 * 12288 ? it1 : 2 * 12288 - 1;
                        ConvItem c0, c1; f32x4 v0[16], v1[16];
                        MOE_CONV_DECODE(it0, c0); conv_load(c0, v0, lane);
                        MOE_CONV_DECODE(it1, c1); conv_load(c1, v1, lane);
                        conv_finish(c0, v0, scr, lane);
                        conv_finish(c1, v1, scr, lane);
                        __syncthreads();
                    }
                }
                if (rep == 0) { for (;; ++cj) { const int it = gw + cj * NGW; if (it >= 2 * 12288) break; ConvItem c0; f32x4 v0[16]; MOE_CONV_DECODE(it, c0); conv_load(c0, v0, lane); conv_finish(c0, v0, scr, lane); } __syncthreads(); }
                }
                SEAM(pb + 3);
            }
            if (PHON(4) && IN(pb + 4)) {
                for (int rep = 0; rep < NREP(4); ++rep) {
                pg8::Gemm g{1024, 1024, 1024}; pg8::DenseOrder S; S.init(NTOK, 1024, G, bx, OB, (size_t)256 * 1024 * 2, 0, WO + (size_t)j * 1024 * 1024, (size_t)256 * 1024 * 2);
                pg8::EpiBf16 E{FB, 1024};
                pg8::gemm_phase<pg8::EpiBf16, pg8::DenseOrder, true>(lds + RING_OFF, g, S, E);
                }
                SEAM(pb + 4);
            }
        } else {
            if (PHON(13) && IN(pb + 0)) {
                for (int rep = 0; rep < NREP(13); ++rep) {
                for (int it = gw; it < 2 * (NTOK / 32); it += NGW) {
                    const int q = it & 1, t0 = (it >> 1) * 32, s0 = t0 & (SEQ - 1), grp = 2 * q + (lane >> 5), win = 2 << grp;
                    const bf16_t* xb = XHL + grp * 256 + 8 * (lane & 31);
                    bf16_t* pout = POOLED + grp * 256 + 8 * (lane & 31);
                    f32x4 Sa = {0.f, 0.f, 0.f, 0.f}, Sb = {0.f, 0.f, 0.f, 0.f};
#pragma unroll
                    for (int jj = 1; jj < 16; ++jj) { if (jj < win && s0 - jj >= 0) { const F8 r = bf8(*(const u32x4*)(xb + (size_t)(t0 - jj) * 2048)); Sa += r.a; Sb += r.b; } }
                    for (int tb = 0; tb < 32; tb += 8) {
                        u32x4 xn[8], xe[8];
#pragma unroll
                        for (int i = 0; i < 8; ++i) { const int t = t0 + tb + i; xn[i] = *(const u32x4*)(xb + (size_t)t * 2048);
                            xe[i] = (s0 + tb + i - win + 1 >= 0) ? *(const u32x4*)(xb + (size_t)(t - win + 1) * 2048) : (u32x4){0u, 0u, 0u, 0u}; }
#pragma unroll
                        for (int i = 0; i < 8; ++i) { const int sI = s0 + tb + i; const F8 xv = bf8(xn[i]), ev = bf8(xe[i]);
                            Sa += xv.a; Sb += xv.b;
                            const float rc = 1.0f / (float)((sI + 1 < win) ? sI + 1 : win);
                            *(u32x4*)(pout + (size_t)(t0 + tb + i) * 1024) = pk8(Sa * rc - xv.a, Sb * rc - xv.b);
                            Sa -= ev.a; Sb -= ev.b; }
                    }
                }
                }
                SEAM(pb + 0);
            }
            if (PHON(14) && IN(pb + 1)) {
                for (int rep = 0; rep < NREP(14); ++rep) {
                pg8::Gemm g{1024, 256, 256}; pg8::DenseOrder S; S.init(NTOK, 1024, G, bx, POOLED, (size_t)256 * 1024 * 2, (size_t)256 * 2, WP + (size_t)j * 4 * 65536, (size_t)65536 * 2);
                pg8::EpiPool E{FB, pool_b + j * 1024, pool_scale + j * 1024};
                pg8::gemm_phase<pg8::EpiPool, pg8::DenseOrder, true>(lds + RING_OFF, g, S, E);
                }
                SEAM(pb + 1);
            }
        }
        if (PHON(5) && IN(pb + 5)) {
                for (int rep = 0; rep < NREP(5); ++rep) {
            f32x4 gv[4], bv[4];
#pragma unroll
            for (int jj = 0; jj < 4; ++jj) { const int c = 8 * lane + 512 * (jj >> 1) + 4 * (jj & 1); gv[jj] = *(const f32x4*)(ln_g + (size_t)(l * 2 + 0) * 1024 + c); bv[jj] = *(const f32x4*)(ln_b + (size_t)(l * 2 + 0) * 1024 + c); }
            for (int m = gw; m < NTOK; m += NGW) {
                u32x4* xh = (u32x4*)(XHL + (size_t)m * 2048) + lane; const u32x4* fr2 = (const u32x4*)(FB + (size_t)m * 1024) + lane;
                const F8 x0 = bf8(xh[0]), x1 = bf8(xh[64]), f0 = bf8(fr2[0]), f1 = bf8(fr2[64]);
                f32x4 v[4] = {x0.a * DN_ALPHA + f0.a, x0.b * DN_ALPHA + f0.b, x1.a * DN_ALPHA + f1.a, x1.b * DN_ALPHA + f1.b}; float s = 0.f;
#pragma unroll
                for (int jj = 0; jj < 4; ++jj) s += (v[jj].x + v[jj].y) + (v[jj].z + v[jj].w);
                const float mean = wave_sum(s) * (1.f / 1024.f); float s2 = 0.f;
#pragma unroll
                for (int jj = 0; jj < 4; ++jj) { v[jj] = v[jj] - mean; s2 += (v[jj].x * v[jj].x + v[jj].y * v[jj].y) + (v[jj].z * v[jj].z + v[jj].w * v[jj].w); }
                const float rstd = 1.0f / sqrtf(wave_sum(s2) * (1.f / 1024.f) + LN_EPS);
#pragma unroll
                for (int jj = 0; jj < 4; ++jj) v[jj] = v[jj] * rstd * gv[jj] + bv[jj];
#pragma unroll
                for (int j = 0; j < 2; ++j) { const u32x4 h = pk8(v[2 * j], v[2 * j + 1]); const F8 hf = bf8(h);
                    xh[64 * j] = h; xh[128 + 64 * j] = pk8(v[2 * j] - hf.a, v[2 * j + 1] - hf.b); }
            }
            }
                SEAM(pb + 5);
        }
        if (PHON(6) && IN(pb + 6)) {
                for (int rep = 0; rep < NREP(6); ++rep) {
            pg8::Gemm g{2048, 1024, 1024}; pg8::DenseOrder S; S.init(NTOK, 512, G, bx, XHL, (size_t)256 * 2048 * 2, (size_t)1024 * 2, WR + (size_t)l * 2 * 256 * 1024, (size_t)256 * 1024 * 2);
            pg8::EpiRouter E{LG};
            pg8::gemm_phase<pg8::EpiRouter, pg8::DenseOrder, true>(lds + RING_OFF, g, S, E);
            }
                SEAM(pb + 6);
        }
        if (PHON(7) && IN(pb + 7)) {
            for (int rep = 0; rep < NREP(7); ++rep) {
            LAS int* hist = (LAS int*)(lds + RING_OFF); LAS int* cbase = hist + 64;
            const float* bg = b_grp + l * 8; const float* be = b_exp + l * 64;
            unsigned* gcnt = ctl + CW_GCNT + 64 * l;
            for (int c = bx; c < 256; c += G) {
                if (tid < 64) hist[tid] = 0;
                __syncthreads();
                int ex1 = 0, ex2 = 0, p1 = 0, p2 = 0; float ga1 = 0.f, ga2 = 0.f;
                const int t = c * 128 + tid;
                if (tid < 128) {
                    const float* lg = LG + (size_t)t * LGP;
                    const float* lg2 = lg + (size_t)NTOK * LGP;
                    const f32x4 g0 = *(const f32x4*)lg + *(const f32x4*)lg2, g1 = *(const f32x4*)(lg + 4) + *(const f32x4*)(lg2 + 4);
                    float gl[8] = {g0.x + bg[0], g0.y + bg[1], g0.z + bg[2], g0.w + bg[3], g1.x + bg[4], g1.y + bg[5], g1.z + bg[6], g1.w + bg[7]};
                    int gs = 0; float gm = gl[0];
#pragma unroll
                    for (int i = 1; i < 8; ++i) if (gl[i] > gm) { gm = gl[i]; gs = i; }
                    float se = 0.f;
#pragma unroll
                    for (int i = 0; i < 8; ++i) se += __expf(gl[i] - gm);
                    const float ggate = 1.0f / se;
                    const f32x4 e0 = *(const f32x4*)(lg + 8 + gs * 8) + *(const f32x4*)(lg2 + 8 + gs * 8), e1 = *(const f32x4*)(lg + 12 + gs * 8) + *(const f32x4*)(lg2 + 12 + gs * 8);
                    const f32x4 b0 = *(const f32x4*)(be + gs * 8), b1 = *(const f32x4*)(be + gs * 8 + 4);
                    float el[8] = {e0.x + b0.x, e0.y + b0.y, e0.z + b0.z, e0.w + b0.w, e1.x + b1.x, e1.y + b1.y, e1.z + b1.z, e1.w + b1.w};
                    int i1 = 0; float m1 = el[0];
#pragma unroll
                    for (int i = 1; i < 8; ++i) if (el[i] > m1) { m1 = el[i]; i1 = i; }
                    int i2 = -1; float m2 = -INFINITY;
#pragma unroll
                    for (int i = 0; i < 8; ++i) if (i != i1 && el[i] > m2) { m2 = el[i]; i2 = i; }
                    const float x2 = __expf(m2 - m1), rs = 1.0f / (1.0f + x2);
                    ex1 = gs * 8 + i1; ex2 = gs * 8 + i2; ga1 = ggate * rs; ga2 = ggate * x2 * rs;
                    p1 = __hip_atomic_fetch_add(&hist[ex1], 1, __ATOMIC_RELAXED, __HIP_MEMORY_SCOPE_WORKGROUP); p2 = __hip_atomic_fetch_add(&hist[ex2], 1, __ATOMIC_RELAXED, __HIP_MEMORY_SCOPE_WORKGROUP);
                }
                __syncthreads();
                if (tid < 64) { const int n = hist[tid]; cbase[tid] = n ? (int)__hip_atomic_fetch_add(gcnt + tid, (unsigned)n, __ATOMIC_RELAXED, __HIP_MEMORY_SCOPE_AGENT) : 0; }
                __syncthreads();
                if (tid < 128) {
                    const size_t i1 = (size_t)ex1 * pg8::LIST_CAP + cbase[ex1] + p1, i2 = (size_t)ex2 * pg8::LIST_CAP + cbase[ex2] + p2;
                    ROWLIST[i1] = 2 * t; LGATE[i1] = ga1; ROWLIST[i2] = 2 * t + 1; LGATE[i2] = ga2;
                }
                __syncthreads();
            }
            }
            SEAM(pb + 7);
        }
#define MOE_TILE_TABLE() \
            LAS int* tinfo = (LAS int*)(lds + TINFO_OFF); \
            __syncthreads(); \
            if (tid < 64) tinfo[pg8::TI_CNT + tid] = (int)__hip_atomic_load(ctl + CW_GCNT + 64 * l + tid, __ATOMIC_RELAXED, __HIP_MEMORY_SCOPE_AGENT); \
            __syncthreads(); \
            if (tid == 0) { int tt = 0; for (int e = 0; e < 64; ++e) { const int n = (tinfo[pg8::TI_CNT + e] + 255) >> 8; for (int i = 0; i < n && tt < MAX_TILES; ++i) tinfo[tt++] = e | (i << 8); } tinfo[pg8::TI_CNT + 64] = tt; } \
            __syncthreads(); \
            const int ntl = tinfo[pg8::TI_CNT + 64];
        if (PHON(9) && IN(pb + 9)) {
            for (int rep = 0; rep < NREP(9); ++rep) {
            MOE_TILE_TABLE();
            pg8::Gemm g{2048, 1024, 1024}; pg8::GatherOrder S; S.init(tinfo, ntl, 2, G, bx, XHL, ROWLIST, W13L(l), (size_t)512 * 1024 * 2, (size_t)256 * 1024 * 2);
            pg8::EpiSwiglu E{HS};
            pg8::gemm_phase<pg8::EpiSwiglu, pg8::GatherOrder, true>(lds + RING_OFF, g, S, E);
            }
            SEAM(pb + 9);
        }
        if (PHON(10) && IN(pb + 10)) {
            for (int rep = 0; rep < NREP(10); ++rep) {
            MOE_TILE_TABLE();
            pg8::Gemm g{256, 256, 256}; pg8::MoeOrder S; S.init(tinfo, ntl, 4, G, bx, HS, (size_t)256 * 256 * 2, W2TL(l), (size_t)1024 * 256 * 2, (size_t)256 * 256 * 2);
            pg8::EpiMoeOut E{YB, tinfo, ROWLIST, LGATE};
            pg8::gemm_phase<pg8::EpiMoeOut, pg8::MoeOrder, true>(lds + RING_OFF, g, S, E);
            }
            SEAM(pb + 10);
        }
        if (PHON(11) && IN(pb + 11)) {
            f32x4 gv[4], bv[4];
#pragma unroll
            for (int jj = 0; jj < 4; ++jj) { const int c = 8 * lane + 512 * (jj >> 1) + 4 * (jj & 1); gv[jj] = *(const f32x4*)(ln_g + (size_t)(l * 2 + 1) * 1024 + c); bv[jj] = *(const f32x4*)(ln_b + (size_t)(l * 2 + 1) * 1024 + c); }
            const bool lastl = (l == DEPTH - 1);
            for (int m = gw; m < NTOK; m += NGW) {
                u32x4* xh = (u32x4*)(XHL + (size_t)m * 2048) + lane;
                const u32x4* y0 = (const u32x4*)(YB + (size_t)(2 * m) * 1024) + lane; const u32x4* y1 = (const u32x4*)(YB + (size_t)(2 * m + 1) * 1024) + lane;
                const F8 x0 = bf8(xh[0]), x1 = bf8(xh[64]), a0 = bf8(y0[0]), a1 = bf8(y0[64]), c0 = bf8(y1[0]), c1 = bf8(y1[64]);
                f32x4 v[4] = {x0.a * DN_ALPHA + (a0.a + c0.a), x0.b * DN_ALPHA + (a0.b + c0.b), x1.a * DN_ALPHA + (a1.a + c1.a), x1.b * DN_ALPHA + (a1.b + c1.b)}; float s = 0.f;
#pragma unroll
                for (int jj = 0; jj < 4; ++jj) s += (v[jj].x + v[jj].y) + (v[jj].z + v[jj].w);
                const float mean = wave_sum(s) * (1.f / 1024.f); float s2 = 0.f;
#pragma unroll
                for (int jj = 0; jj < 4; ++jj) { v[jj] = v[jj] - mean; s2 += (v[jj].x * v[jj].x + v[jj].y * v[jj].y) + (v[jj].z * v[jj].z + v[jj].w * v[jj].w); }
                const float rstd = 1.0f / sqrtf(wave_sum(s2) * (1.f / 1024.f) + LN_EPS);
#pragma unroll
                for (int jj = 0; jj < 4; ++jj) v[jj] = v[jj] * rstd * gv[jj] + bv[jj];
                if (lastl) { f32x4* orow = (f32x4*)(kargs()->out + (size_t)m * 1024) + 2 * lane;
                    orow[0] = v[0]; orow[1] = v[1]; orow[128] = v[2]; orow[129] = v[3];
                } else { xh[0] = pk8(v[0], v[1]); xh[64] = pk8(v[2], v[3]); }
            }
            SEAM(pb + 11);
        }
    }
#undef IN
#undef SEAM
}
#undef ws
#undef in_x
#undef in_pos
#undef ln_g
#undef ln_b
#undef w_in
#undef q_norm
#undef w_uq
#undef kv_norm
#undef w_ukv
#undef w_o
#undef pool_w
#undef pool_b
#undef pool_scale
#undef w_grp
#undef b_grp
#undef w_exp
#undef b_exp
#undef w1
#undef w3
#undef w2
#undef COS
#undef SIN
#undef CNT
#undef TILE
#undef AE
#undef APOS
#undef AG
#undef RSLOT
#undef RGATE
#undef WIN
#undef WUQ
#undef WUK
#undef WUV
#undef WO
#undef WP
#undef WR
#undef W13L
#undef W2TL
#undef FB
#undef XHL
#undef LATB
#undef CQ
#undef CKV
#undef KR
#undef QB
#undef KN
#undef VT
#undef OB
#undef POOLED
#undef LG
#undef ROWLIST
#undef LGATE
#undef HS
#undef YB

static bool phase_exists(int p) {
    if (p == 0) return true;
    const int l = (p - 1) / PPL, k = (p - 1) % PPL;
    if (k == 8) return false;
    if (k >= 5) return true;
    return (l & 1) == 0 ? true : (k < 2);
}
extern "C" void kernel_launch(void* const* d_in, const int* in_sizes, int n_in, void* d_out, int out_size, void* d_ws, size_t ws_size, hipStream_t stream) {
    static int grid = 0;
    if (grid == 0) {
        if (n_in != 20 || in_sizes[0] != NTOK * D_MODEL || out_size != NTOK * D_MODEL || ws_size < WS_END) { fprintf(stderr, "kernel_launch: unexpected shapes / workspace (%zu < %zu)\n", ws_size, (size_t)WS_END); grid = -1; return; }
        int dev = 0, cus = 0, per_cu = 0;
        if (hipGetDevice(&dev) != hipSuccess || hipDeviceGetAttribute(&cus, hipDeviceAttributeMultiprocessorCount, dev) != hipSuccess) { grid = -1; return; }
        if (hipFuncSetAttribute((const void*)mk_fwd, hipFuncAttributeMaxDynamicSharedMemorySize, LDS_BYTES) != hipSuccess) { fprintf(stderr, "kernel_launch: hipFuncSetAttribute failed\n"); grid = -1; return; }
        if (hipOccupancyMaxActiveBlocksPerMultiprocessor(&per_cu, (const void*)mk_fwd, NWAVES * 64, LDS_BYTES) != hipSuccess || per_cu < 1) fprintf(stderr, "kernel_launch: occupancy query reports %d\n", per_cu);
        (void)hipGetLastError();
        grid = cus;
    }
    if (grid < 0) return;
    if (hipMemsetAsync((char*)d_ws + WS_CTL, 0, CTL_ZERO_BYTES, stream) != hipSuccess) return;
    Args a{};
    for (int i = 0; i < 20; ++i) a.in[i] = d_in[i];
    a.out = (float*)d_out; a.ws = (unsigned char*)d_ws;
#if MK_ONE_LAUNCH
    a.ph_lo = 0; a.ph_hi = NPHASE;
    hipLaunchKernelGGL(mk_fwd, dim3(grid), dim3(NWAVES * 64), LDS_BYTES, stream, a);
#else
    for (int p = 0; p < NPHASE; ++p) {
        if (!phase_exists(p)) continue;
        a.ph_lo = p; a.ph_hi = p + 1;
        hipLaunchKernelGGL(mk_fwd, dim3(grid), dim3(NWAVES * 64), LDS_BYTES, stream, a);
    }
#endif
}
```

```cpp
#include <hip/hip_runtime.h>
#include <cstdio>
#include <cstdint>

#ifndef MK_ONE_LAUNCH
#define MK_ONE_LAUNCH 1
#endif

#define LAS __attribute__((address_space(3)))
#define GAS __attribute__((address_space(1)))

constexpr int D_MODEL = 1024, BATCH = 4, SEQ = 8192, DEPTH = 4, NTOK = BATCH * SEQ;
constexpr int N_HEADS = 16, QK_NOPE = 64, QK_ROPE = 32, V_HEAD = 64, Q_LORA = 256, KV_LORA = 128, LAT = Q_LORA + KV_LORA + QK_ROPE;
constexpr int QPITCH = N_HEADS * (QK_NOPE + QK_ROPE);
constexpr int N_GROUPS = 8, EPG = 8, N_EXPERTS = 64, D_EXPERT = 256;
constexpr int MAX_TILES = 320;
constexpr float DN_ALPHA = 1.681792830507429f;
constexpr float LN_EPS = 1e-5f, RMS_EPS = 1e-6f;
constexpr float QSCALE = 0.14724444602590306f;
constexpr int LGP = 80;

constexpr size_t MiB = 1u << 20;
constexpr size_t WS_CTL = 0, CTL_ZERO_BYTES = 1 * MiB;
constexpr size_t WS_COS = 1 * MiB, WS_SIN = 3 * MiB;
constexpr size_t WS_CNT = 5 * MiB;
constexpr size_t WS_TILE = 5 * MiB + 65536;
constexpr size_t WS_AE = 5 * MiB + 131072, WS_APOS = WS_AE + 262144, WS_AG = WS_APOS + 262144;
constexpr size_t WS_RSLOT = 6 * MiB, WS_RGATE = 6 * MiB + 512 * 1024;
constexpr size_t WS_WIN = 8 * MiB;
constexpr size_t WS_WUQ = 10 * MiB;
constexpr size_t WS_WUK = 12 * MiB;
constexpr size_t WS_WUV = 13 * MiB;
constexpr size_t WS_WO = 14 * MiB;
constexpr size_t WS_WP = 18 * MiB;
constexpr size_t WS_WR = 19 * MiB;
constexpr size_t WS_W13 = 24 * MiB;
constexpr size_t WS_W2T = 88 * MiB;
constexpr size_t WS_W13B = 184 * MiB;
constexpr size_t WS_W2TB = 760 * MiB;
constexpr size_t WS_FB = 120 * MiB;
constexpr size_t WS_XHL = 248 * MiB;
constexpr size_t WS_R1 = 376 * MiB;
constexpr size_t WS_LAT = WS_R1;
constexpr size_t WS_CQ = WS_R1 + 64 * MiB;
constexpr size_t WS_CKV = WS_R1 + 80 * MiB;
constexpr size_t WS_KR = WS_R1 + 88 * MiB;
constexpr size_t WS_Q = WS_R1 + 92 * MiB;
constexpr size_t WS_KN = WS_R1 + 188 * MiB;
constexpr size_t WS_VT = WS_R1 + 252 * MiB;
constexpr size_t WS_O = WS_R1 + 316 * MiB;
constexpr size_t WS_POOLED = WS_R1;
constexpr size_t WS_LG = WS_R1;
constexpr size_t WS_LIST = WS_R1 + 20 * MiB;
constexpr size_t WS_LGATE = WS_R1 + 36 * MiB;
constexpr size_t WS_HS = WS_R1 + 180 * MiB;
constexpr size_t WS_Y = WS_R1 + 220 * MiB;
constexpr size_t WS_END = 792 * MiB;
static_assert(WS_O + 64 * MiB <= WS_END && WS_Y + 128 * MiB <= WS_END, "ws map");

constexpr int CW_TMO = 0, CW_CODE = 1, CW_BAR = 4096, CW_GCNT = 16384;

constexpr int RING_OFF = 0, RING_BYTES = 131072, SCR_WAVE = 17408;
constexpr int LDSCTL_OFF = 8 * SCR_WAVE, MISC_OFF = LDSCTL_OFF + 320, TINFO_OFF = LDSCTL_OFF + 1024;
constexpr int LDS_BYTES = 155648;
static_assert(TINFO_OFF + (512 + 2 * 5 * 256) * 4 <= LDS_BYTES && LDS_BYTES <= 163840, "LDS map");

typedef unsigned short bf16_t;
typedef short bf16x8 __attribute__((ext_vector_type(8)));
typedef float f32x4 __attribute__((ext_vector_type(4)));
typedef float f32x16 __attribute__((ext_vector_type(16)));
typedef unsigned u32x4 __attribute__((ext_vector_type(4)));
typedef unsigned u32x2 __attribute__((ext_vector_type(2)));
typedef float f32x2_t __attribute__((ext_vector_type(2)));
typedef __bf16 bf16x2_t __attribute__((ext_vector_type(2)));
#define RLX_AGENT __ATOMIC_RELAXED, __HIP_MEMORY_SCOPE_AGENT
#define LDS_WAIT() asm volatile("s_waitcnt lgkmcnt(0)" ::: "memory")
#define VM_WAIT() asm volatile("s_waitcnt vmcnt(0)" ::: "memory")

__device__ __forceinline__ unsigned cvtpk(float lo, float hi) { f32x2_t v = {lo, hi}; bf16x2_t b = __builtin_convertvector(v, bf16x2_t); return __builtin_bit_cast(unsigned, b); }
__device__ __forceinline__ int opaque(int x) { asm volatile("" : "+v"(x)); return x; }
__device__ __forceinline__ int opaque_s(int x) { asm volatile("" : "+s"(x)); return x; }
__device__ __forceinline__ float bflo(unsigned u) { return __uint_as_float(u << 16); }
__device__ __forceinline__ float bfhi(unsigned u) { return __uint_as_float(u & 0xffff0000u); }
__device__ __forceinline__ float wave_sum(float v) {
#pragma unroll
    for (int o = 1; o < 64; o <<= 1) v += __shfl_xor(v, o);
    return v;
}
__device__ __forceinline__ void split4(const f32x4 v, u32x2& h, u32x2& l) {
    h.x = cvtpk(v.x, v.y); h.y = cvtpk(v.z, v.w);
    l.x = cvtpk(v.x - bflo(h.x), v.y - bfhi(h.x)); l.y = cvtpk(v.z - bflo(h.y), v.w - bfhi(h.y));
}
__device__ __forceinline__ f32x4 join4(const u32x2 h, const u32x2 l) {
    return (f32x4){bflo(h.x) + bflo(l.x), bfhi(h.x) + bfhi(l.x), bflo(h.y) + bflo(l.y), bfhi(h.y) + bfhi(l.y)};
}
struct F8 { f32x4 a, b; };
__device__ __forceinline__ F8 bf8(const u32x4 w) { F8 r; r.a = (f32x4){bflo(w.x), bfhi(w.x), bflo(w.y), bfhi(w.y)}; r.b = (f32x4){bflo(w.z), bfhi(w.z), bflo(w.w), bfhi(w.w)}; return r; }
__device__ __forceinline__ u32x4 pk8(const f32x4 a, const f32x4 b) { u32x4 w; w.x = cvtpk(a.x, a.y); w.y = cvtpk(a.z, a.w); w.z = cvtpk(b.x, b.y); w.w = cvtpk(b.z, b.w); return w; }
__device__ __forceinline__ f32x4 bf4(const u32x2 h) { return (f32x4){bflo(h.x), bfhi(h.x), bflo(h.y), bfhi(h.y)}; }

namespace pg8 {
constexpr int BM = 256, BK = 64, HALF = 128, HTB = HALF * BK * 2, STAGE_BYTES = 8 * HTB, NXCD = 8, WGM = 8;
__host__ __device__ __forceinline__ int lds_byte(int r, int c) { const int st = (r >> 4) * 2 + (c >> 5), rr = r & 15, cc = c & 31, ob = rr * 64 + cc * 2; return st * 1024 + (ob ^ (((ob >> 9) & 1) << 5)); }
__host__ __device__ __forceinline__ void stage_rc(int b, int& R, int& C) { const int st = b / 1024, sb = b % 1024, swz = sb ^ (((sb >> 9) & 1) << 5); R = (st >> 1) * 16 + swz / 64; C = (st & 1) * 32 + (swz % 64) / 2; }
__host__ __device__ __forceinline__ int perm32(int rho) { const int n = rho >> 4, i = rho & 15; return 8 * (i >> 2) + 4 * n + (i & 3); }

struct Unit { int pm, pn, ui; };
struct Gemm { int lda, ldb, K; };

struct DenseOrder {
    int nM, nN, nwg, G, c;
    const char* A; const char* B; size_t a_pm, a_pn, b_pn;
    __device__ __forceinline__ void init(int M, int N, int G_, int c_, const void* A_, size_t a_pm_, size_t a_pn_, const void* B_, size_t b_pn_) {
        nM = M / BM; nN = N / BM; nwg = nM * nN; G = G_; c = c_; A = (const char*)A_; B = (const char*)B_; a_pm = a_pm_; a_pn = a_pn_; b_pn = b_pn_; }
    __device__ __forceinline__ bool next(int i, Unit& u) const {
        const long L = (long)i * G + c; if (L >= nwg) return false;
        int wgid = (int)L; { const int q = nwg / NXCD, r = nwg % NXCD, xcd = wgid % NXCD, off = wgid / NXCD; wgid = (xcd < r ? xcd * (q + 1) : r * (q + 1) + (xcd - r) * q) + off; }
        const int nig = WGM * nN, gid = wgid / nig, fm = gid * WGM, gsz = (nM - fm) < WGM ? (nM - fm) : WGM;
        u.pm = fm + ((wgid % nig) % gsz); u.pn = (wgid % nig) / gsz; u.ui = i; return true;
    }
    __device__ __forceinline__ const char* a_base(const Unit& u) const { return A + (size_t)u.pm * a_pm + (size_t)u.pn * a_pn; }
    __device__ __forceinline__ unsigned a_voff(const Unit&, int R, int C, int lda) const { return (unsigned)(R * lda + C) * 2u; }
    __device__ __forceinline__ const char* b_base(const Unit& u) const { return B + (size_t)u.pn * b_pn; }
};
constexpr int TI_CNT = 320, LIST_CAP = 65536, TI_ROWOFF = 512, MOE_LDS_UNITS = 5;
struct MoeOrder {
    const LAS int* tinfo; int ntiles, nN, nwg, G, c;
    const char* A; const char* W; size_t a_tile, w_e, w_pn;
    __device__ __forceinline__ void init(const LAS int* ti, int ntiles_, int nN_, int G_, int c_, const void* A_, size_t a_tile_, const void* W_, size_t w_e_, size_t w_pn_) {
        tinfo = ti; ntiles = ntiles_; nN = nN_; nwg = ntiles_ * nN_; G = G_; c = c_; A = (const char*)A_; a_tile = a_tile_; W = (const char*)W_; w_e = w_e_; w_pn = w_pn_; }
    __device__ __forceinline__ bool next(int i, Unit& u) const {
        const long L = (long)i * G + c; if (L >= nwg) return false;
        int wgid = (int)L; { const int q = nwg / NXCD, r = nwg % NXCD, xcd = wgid % NXCD, off = wgid / NXCD; wgid = (xcd < r ? xcd * (q + 1) : r * (q + 1) + (xcd - r) * q) + off; }
        u.pm = wgid / nN; u.pn = wgid % nN; u.ui = i; return true;
    }
    __device__ __forceinline__ const char* a_base(const Unit& u) const { return A + (size_t)u.pm * a_tile; }
    __device__ __forceinline__ const char* b_base(const Unit& u) const { const int e = __builtin_amdgcn_readfirstlane(tinfo[u.pm]) & 255; return W + (size_t)e * w_e + (size_t)u.pn * w_pn; }
    __device__ __forceinline__ unsigned a_voff(const Unit&, int R, int C, int lda) const { return (unsigned)(R * lda + C) * 2u; }
};
struct GatherOrder {
    const LAS int* tinfo; int ntiles, nN, nwg, G, c;
    const char* A; const int* list; const char* W; size_t w_e, w_pn; const LAS unsigned* rowoff;
    __device__ __forceinline__ void init(const LAS int* ti, int ntiles_, int nN_, int G_, int c_, const void* A_, const int* list_, const void* W_, size_t w_e_, size_t w_pn_) {
        rowoff = (const LAS unsigned*)(ti + TI_ROWOFF); tinfo = ti; ntiles = ntiles_; nN = nN_; nwg = ntiles_ * nN_; G = G_; c = c_; A = (const char*)A_; list = list_; W = (const char*)W_; w_e = w_e_; w_pn = w_pn_; }
    __device__ __forceinline__ bool next(int i, Unit& u) const {
        const long L = (long)i * G + c; if (L >= nwg) return false;
        int wgid = (int)L; { const int q = nwg / NXCD, r = nwg % NXCD, xcd = wgid % NXCD, off = wgid / NXCD; wgid = (xcd < r ? xcd * (q + 1) : r * (q + 1) + (xcd - r) * q) + off; }
        u.pm = wgid / nN; u.pn = wgid % nN; u.ui = i; return true;
    }
    __device__ __forceinline__ const char* a_base(const Unit&) const { return A; }
    __device__ __forceinline__ const char* b_base(const Unit& u) const { const int e = __builtin_amdgcn_readfirstlane(tinfo[u.pm]) & 255; return W + (size_t)e * w_e + (size_t)u.pn * w_pn; }
    __device__ __forceinline__ unsigned row_off(const Unit& u, int R, int lda) const {
        const int ti = tinfo[u.pm], e = ti & 255, r = (ti >> 8) * 256 + R; const int n = tinfo[TI_CNT + e];
        const int ga = (r < n) ? list[(size_t)e * LIST_CAP + r] : 0;
        return (unsigned)(ga >> 1) * (unsigned)(lda * 2); }
    __device__ __forceinline__ unsigned a_voff(const Unit& u, int R, int C, int lda) const {
        return (u.ui < MOE_LDS_UNITS ? rowoff[u.ui * 256 + R] : row_off(u, R, lda)) + (unsigned)C * 2u; }
};

#define ACC_T const f32x4 (&acc)[2][2][4][2]
__device__ __forceinline__ u32x4 pack_acc(const f32x4 v0, const f32x4 v1) { u32x4 w; w.x = cvtpk(v0[0], v0[1]); w.y = cvtpk(v0[2], v0[3]); w.z = cvtpk(v1[0], v1[1]); w.w = cvtpk(v1[2], v1[3]); return w; }
struct EpiBf16 {
    static constexpr bool PERM = true, AFTER_DRAIN = false;
    bf16_t* O; size_t ldc;
    __device__ __forceinline__ void operator()(ACC_T, const Unit& u, int wr, int wc, int fr, int fq) const {
        const int row0 = u.pm * BM + wr * 64 + fr, col0 = u.pn * BM + wc * 32 + 8 * fq;
#pragma unroll
        for (int ai = 0; ai < 2; ++ai)
#pragma unroll
            for (int m = 0; m < 4; ++m) { bf16_t* rowp = O + (size_t)(row0 + ai * HALF + m * 16) * ldc + col0;
#pragma unroll
                for (int bj = 0; bj < 2; ++bj) { const f32x4 v0 = acc[ai][bj][m][0], v1 = acc[ai][bj][m][1];
                    u32x4 w; w.x = cvtpk(v0[0], v0[1]); w.y = cvtpk(v0[2], v0[3]); w.z = cvtpk(v1[0], v1[1]); w.w = cvtpk(v1[2], v1[3]);
                    *(u32x4*)(rowp + bj * HALF) = w; } }
    }
};
struct EpiF32 {
    static constexpr bool PERM = false, AFTER_DRAIN = false;
    float* O; size_t ldc;
    __device__ __forceinline__ void operator()(ACC_T, const Unit& u, int wr, int wc, int fr, int fq) const {
        const int row0 = u.pm * BM + wr * 64 + fr, col0 = u.pn * BM + wc * 32 + 4 * fq;
#pragma unroll
        for (int ai = 0; ai < 2; ++ai)
#pragma unroll
            for (int m = 0; m < 4; ++m) { float* rowp = O + (size_t)(row0 + ai * HALF + m * 16) * ldc + col0;
#pragma unroll
                for (int bj = 0; bj < 2; ++bj)
#pragma unroll
                    for (int n = 0; n < 2; ++n) *(f32x4*)(rowp + bj * HALF + n * 16) = acc[ai][bj][m][n]; }
    }
};
struct EpiLatNorm {
    static constexpr bool PERM = true, AFTER_DRAIN = true;
    bf16_t* CQo; bf16_t* CKVo; bf16_t* KRo; const float* gq; const float* gk; const float* cs; const float* sn;
    __device__ __forceinline__ void fused(f32x4 (&acc)[2][2][4][2], const Unit& u, int wr, int wc, int fr, int fq, LAS unsigned char* lds, int lane) const {
        LAS float* P = (LAS float*)lds;
        const int nbj = (u.pn == 0) ? 2 : 1;
#pragma unroll
        for (int ai = 0; ai < 2; ++ai)
#pragma unroll
            for (int m = 0; m < 4; ++m) { float ss = 0.f;
#pragma unroll
                for (int bj = 0; bj < 2; ++bj) if (bj < nbj) {
#pragma unroll
                    for (int n = 0; n < 2; ++n) { const f32x4 v = acc[ai][bj][m][n]; ss += (v[0] * v[0] + v[1] * v[1]) + (v[2] * v[2] + v[3] * v[3]); } }
                ss += __shfl_xor(ss, 16); ss += __shfl_xor(ss, 32);
                if (fq == 0) P[(ai * HALF + wr * 64 + m * 16 + fr) * 4 + wc] = ss; }
        asm volatile("s_waitcnt lgkmcnt(0)" ::: "memory"); __builtin_amdgcn_s_barrier(); asm volatile("" ::: "memory");
        const float inv_dim = (u.pn == 0) ? (1.f / 256.f) : (1.f / 128.f);
#pragma unroll
        for (int ai = 0; ai < 2; ++ai)
#pragma unroll
            for (int m = 0; m < 4; ++m) { const int rl = ai * HALF + wr * 64 + m * 16 + fr; const size_t row = (size_t)u.pm * BM + rl;
                const f32x4 p4 = *(const LAS f32x4*)(P + rl * 4); const float rs = 1.0f / sqrtf(((p4[0] + p4[1]) + (p4[2] + p4[3])) * inv_dim + RMS_EPS);
                if (u.pn == 0) {
#pragma unroll
                    for (int bj = 0; bj < 2; ++bj) { const int col = bj * HALF + wc * 32 + 8 * fq; const f32x4 g0 = *(const f32x4*)(gq + col), g1 = *(const f32x4*)(gq + col + 4);
                        *(u32x4*)(CQo + row * 256 + col) = pack_acc(acc[ai][bj][m][0] * rs * g0, acc[ai][bj][m][1] * rs * g1); }
                } else {
                    { const int col = wc * 32 + 8 * fq; const f32x4 g0 = *(const f32x4*)(gk + col), g1 = *(const f32x4*)(gk + col + 4);
                      *(u32x4*)(CKVo + row * 128 + col) = pack_acc(acc[ai][0][m][0] * rs * g0, acc[ai][0][m][1] * rs * g1); }
                    if (wc == 0) {
                        const f32x4 v0 = acc[ai][1][m][0], v1 = acc[ai][1][m][1];
                        f32x4 q0, q1;
#pragma unroll
                        for (int e = 0; e < 4; ++e) { q0[e] = __shfl_xor(v0[e], 32); q1[e] = __shfl_xor(v1[e], 32); }
                        const int i0 = 8 * (fq & 1);
                        const f32x4 c0 = *(const f32x4*)(cs + row * 16 + i0), c1 = *(const f32x4*)(cs + row * 16 + i0 + 4), s0 = *(const f32x4*)(sn + row * 16 + i0), s1 = *(const f32x4*)(sn + row * 16 + i0 + 4);
                        const bool first = fq < 2;
                        const f32x4 y0 = first ? (v0 * c0 - q0 * s0) : (v0 * c0 + q0 * s0), y1 = first ? (v1 * c1 - q1 * s1) : (v1 * c1 + q1 * s1);
                        *(u32x4*)(KRo + row * 32 + 8 * fq) = pack_acc(y0, y1);
                    }
                } }
    }
};
struct EpiQ {
    static constexpr bool PERM = true, AFTER_DRAIN = false;
    bf16_t* Q; const float* cs; const float* sn;
    __device__ __forceinline__ void operator()(ACC_T, const Unit& u, int wr, int wc, int fr, int fq) const {
        const int row0 = u.pm * BM + wr * 64 + fr;
        if (u.pn < 4) {
#pragma unroll
            for (int ai = 0; ai < 2; ++ai)
#pragma unroll
                for (int m = 0; m < 4; ++m) { const int row = row0 + ai * HALF + m * 16;
#pragma unroll
                    for (int bj = 0; bj < 2; ++bj) { const int col = u.pn * BM + bj * HALF + wc * 32 + 8 * fq; const f32x4 v0 = acc[ai][bj][m][0], v1 = acc[ai][bj][m][1];
                        u32x4 w; w.x = cvtpk(v0[0], v0[1]); w.y = cvtpk(v0[2], v0[3]); w.z = cvtpk(v1[0], v1[1]); w.w = cvtpk(v1[2], v1[3]);
                        *(u32x4*)(Q + (size_t)row * QPITCH + (col >> 6) * 96 + (col & 63)) = w; } }
        } else {
            const int head = (u.pn - 4) * 8 + 2 * wc + (fq >> 1), i0 = 8 * (fq & 1);
#pragma unroll
            for (int ai = 0; ai < 2; ++ai)
#pragma unroll
                for (int m = 0; m < 4; ++m) { const int row = row0 + ai * HALF + m * 16;
                    const f32x4 c0 = *(const f32x4*)(cs + (size_t)row * 16 + i0), c1 = *(const f32x4*)(cs + (size_t)row * 16 + i0 + 4);
                    const f32x4 s0 = *(const f32x4*)(sn + (size_t)row * 16 + i0), s1 = *(const f32x4*)(sn + (size_t)row * 16 + i0 + 4);
                    const f32x4 a0 = acc[ai][0][m][0], a1 = acc[ai][0][m][1], b0 = acc[ai][1][m][0], b1 = acc[ai][1][m][1];
                    const f32x4 y10 = a0 * c0 - b0 * s0, y11 = a1 * c1 - b1 * s1, y20 = b0 * c0 + a0 * s0, y21 = b1 * c1 + a1 * s1;
                    u32x4 w1, w2; w1.x = cvtpk(y10[0], y10[1]); w1.y = cvtpk(y10[2], y10[3]); w1.z = cvtpk(y11[0], y11[1]); w1.w = cvtpk(y11[2], y11[3]);
                    w2.x = cvtpk(y20[0], y20[1]); w2.y = cvtpk(y20[2], y20[3]); w2.z = cvtpk(y21[0], y21[1]); w2.w = cvtpk(y21[2], y21[3]);
                    bf16_t* qp = Q + (size_t)row * QPITCH + head * 96 + 64 + i0;
                    *(u32x4*)qp = w1; *(u32x4*)(qp + 16) = w2; asm volatile("" ::: "memory"); }
        }
    }
};
struct EpiPool {
    static constexpr bool PERM = true, AFTER_DRAIN = false;
    bf16_t* F; const float* bias; const float* scale;
    __device__ __forceinline__ void operator()(ACC_T, const Unit& u, int wr, int wc, int fr, int fq) const {
        const int row0 = u.pm * BM + wr * 64 + fr, col0 = u.pn * BM + wc * 32 + 8 * fq;
#pragma unroll
        for (int bj = 0; bj < 2; ++bj) { const int c = col0 + bj * HALF;
            const f32x4 b0 = *(const f32x4*)(bias + c), b1 = *(const f32x4*)(bias + c + 4), s0 = *(const f32x4*)(scale + c), s1 = *(const f32x4*)(scale + c + 4);
#pragma unroll
            for (int ai = 0; ai < 2; ++ai)
#pragma unroll
                for (int m = 0; m < 4; ++m) { const f32x4 v0 = (acc[ai][bj][m][0] + b0) * s0, v1 = (acc[ai][bj][m][1] + b1) * s1;
                    u32x4 w; w.x = cvtpk(v0[0], v0[1]); w.y = cvtpk(v0[2], v0[3]); w.z = cvtpk(v1[0], v1[1]); w.w = cvtpk(v1[2], v1[3]);
                    *(u32x4*)(F + (size_t)(row0 + ai * HALF + m * 16) * 1024 + c) = w; } }
    }
};
struct EpiRouter {
    static constexpr bool PERM = false, AFTER_DRAIN = false;
    float* LG;
    __device__ __forceinline__ void operator()(ACC_T, const Unit& u, int wr, int wc, int fr, int fq) const {
        const int row0 = u.pm * BM + wr * 64 + fr;
#pragma unroll
        for (int ai = 0; ai < 2; ++ai)
#pragma unroll
            for (int m = 0; m < 4; ++m) { float* lr = LG + ((size_t)u.pn * NTOK + (size_t)(row0 + ai * HALF + m * 16)) * LGP;
#pragma unroll
                for (int n = 0; n < 2; ++n) { const int j = wc * 32 + 16 * n + 4 * fq; if (j < 72) *(f32x4*)(lr + j) = acc[ai][0][m][n] + acc[ai][1][m][n]; } }
    }
};
struct EpiSwiglu {
    static constexpr bool PERM = true, AFTER_DRAIN = false;
    bf16_t* H;
    __device__ __forceinline__ void operator()(ACC_T, const Unit& u, int wr, int wc, int fr, int fq) const {
        const int row0 = u.pm * BM + wr * 64 + fr, col0 = u.pn * HALF + wc * 32 + 8 * fq;
#pragma unroll
        for (int ai = 0; ai < 2; ++ai)
#pragma unroll
            for (int m = 0; m < 4; ++m) { float h[8];
#pragma unroll
                for (int n = 0; n < 2; ++n)
#pragma unroll
                    for (int e = 0; e < 4; ++e) { const float a = acc[ai][0][m][n][e], b = acc[ai][1][m][n][e];
                        h[n * 4 + e] = a * __builtin_amdgcn_rcpf(1.0f + __builtin_amdgcn_exp2f(-1.4426950408889634f * a)) * b; }
                u32x4 w; w.x = cvtpk(h[0], h[1]); w.y = cvtpk(h[2], h[3]); w.z = cvtpk(h[4], h[5]); w.w = cvtpk(h[6], h[7]);
                *(u32x4*)(H + (size_t)(row0 + ai * HALF + m * 16) * D_EXPERT + col0) = w; }
    }
};
struct EpiMoeOut {
    static constexpr bool PERM = true, AFTER_DRAIN = false;
    bf16_t* Y; const LAS int* tinfo; const int* list; const float* lgate;
    __device__ __forceinline__ void operator()(ACC_T, const Unit& u, int wr, int wc, int fr, int fq) const {
        const int ti = tinfo[u.pm], e = ti & 255, n = tinfo[TI_CNT + e], r0 = (ti >> 8) * 256 + wr * 64 + fr, col0 = u.pn * BM + wc * 32 + 8 * fq;
#pragma unroll
        for (int ai = 0; ai < 2; ++ai)
#pragma unroll
            for (int m = 0; m < 4; ++m) { const int r = r0 + ai * HALF + m * 16;
                if (r < n) { int ga; float g;
                    if (u.ui < MOE_LDS_UNITS) { const int rl = u.ui * 256 + (r & 255); ga = tinfo[TI_ROWOFF + rl]; g = __int_as_float(tinfo[TI_ROWOFF + MOE_LDS_UNITS * 256 + rl]); }
                    else { const size_t li = (size_t)e * LIST_CAP + r; ga = list[li]; g = lgate[li]; }
                    bf16_t* yp = Y + (size_t)ga * D_MODEL + col0;
#pragma unroll
                    for (int bj = 0; bj < 2; ++bj) { const f32x4 v0 = acc[ai][bj][m][0] * g, v1 = acc[ai][bj][m][1] * g;
                        u32x4 w; w.x = cvtpk(v0[0], v0[1]); w.y = cvtpk(v0[2], v0[3]); w.z = cvtpk(v1[0], v1[1]); w.w = cvtpk(v1[2], v1[3]);
                        *(u32x4*)(yp + bj * HALF) = w; } }
                if (m & 1) asm volatile("" ::: "memory"); }
    }
};
#undef ACC_T

template <class Epi, class Sched, bool ALIGN_EPI>
__device__ __forceinline__ void gemm_phase(LAS unsigned char* lds, const Gemm g, const Sched& S, const Epi& E) {
    const int tid = opaque(threadIdx.x), wid = __builtin_amdgcn_readfirstlane(tid >> 6), lane = tid & 63, wr = wid >> 2, wc = wid & 3, fr = lane & 15, fq = lane >> 4;
    const int K = opaque_s(g.K), nt = K / BK;
    unsigned voffB[2]; int Rr[2], Cc[2];
#pragma unroll
    for (int i = 0; i < 2; ++i) { int R, C; stage_rc(tid * 16 + i * 8192, R, C); const int Rb = Epi::PERM ? ((R & ~31) + perm32(R & 31)) : R;
        Rr[i] = R; Cc[i] = C; voffB[i] = (unsigned)(Rb * g.ldb + C) * 2u; }
    const size_t kstep = (size_t)(BK * 2);
    const size_t hstepB = (size_t)HALF * g.ldb * 2;
    const unsigned ldsw = (unsigned)wid * 1024u;
    const int aoff = lds_byte(wr * 64 + fr, fq * 8), boff = lds_byte(wc * 32 + fr, fq * 8);
#define PG8_SA(b, h) (((b) * 2 + (h)) * HTB)
#define PG8_SB(b, h) ((4 + (b) * 2 + (h)) * HTB)
#define PG8_STAGE(bufoff, gbase, voff) do { _Pragma("unroll") for (int _i = 0; _i < 2; ++_i) \
        __builtin_amdgcn_global_load_lds((const unsigned*)((const char*)(gbase) + (voff)[_i]), (LAS unsigned*)(lds + (bufoff) + ldsw + _i * 8192), 16, 0, 0); } while (0)
#define PG8_LDA(dst, b, h) do { _Pragma("unroll") for (int m = 0; m < 4; ++m) _Pragma("unroll") for (int k = 0; k < 2; ++k) dst[m][k] = *(const LAS bf16x8*)(lds + PG8_SA(b, h) + aoff + m * 2048 + k * 1024); } while (0)
#define PG8_LDB(dst, b, h) do { _Pragma("unroll") for (int n = 0; n < 2; ++n) _Pragma("unroll") for (int k = 0; k < 2; ++k) dst[n][k] = *(const LAS bf16x8*)(lds + PG8_SB(b, h) + boff + n * 2048 + k * 1024); } while (0)
#define PG8_MMA(ai, bj, At, Bt) do { __builtin_amdgcn_s_setprio(1); _Pragma("unroll") for (int m = 0; m < 4; ++m) _Pragma("unroll") for (int n = 0; n < 2; ++n) _Pragma("unroll") for (int k = 0; k < 2; ++k) \
        acc[ai][bj][m][n] = __builtin_amdgcn_mfma_f32_16x16x32_bf16(Bt[n][k], At[m][k], acc[ai][bj][m][n], 0, 0, 0); __builtin_amdgcn_s_setprio(0); } while (0)
#define PG8_WAIT_V(n) asm volatile("s_waitcnt vmcnt(" #n ")" ::: "memory")
#define PG8_WAIT_L(n) asm volatile("s_waitcnt lgkmcnt(" #n ")" ::: "memory")
#define PG8_BAR __builtin_amdgcn_s_barrier()
#define PG8_SCHED __builtin_amdgcn_sched_barrier(0)
    Unit cur, nxt; int ui = 0;
    if (!S.next(0, cur)) return;
    f32x4 acc[2][2][4][2];
#pragma unroll
    for (int a = 0; a < 2; ++a)
#pragma unroll
        for (int b = 0; b < 2; ++b)
#pragma unroll
            for (int m = 0; m < 4; ++m)
#pragma unroll
                for (int n = 0; n < 2; ++n) acc[a][b][m][n] = (f32x4){0.f, 0.f, 0.f, 0.f};
    bf16x8 At[4][2], B0[2][2], B1[2][2];
    const char* cA = S.a_base(cur); const char* cB = S.b_base(cur);
    unsigned vA[2][2], vN[2][2];
#pragma unroll
    for (int h = 0; h < 2; ++h)
#pragma unroll
        for (int i = 0; i < 2; ++i) { vA[h][i] = S.a_voff(cur, Rr[i] + h * HALF, Cc[i], g.lda); vN[h][i] = vA[h][i]; }
    PG8_STAGE(PG8_SB(0, 0), cB, voffB); PG8_STAGE(PG8_SB(0, 1), cB + hstepB, voffB); PG8_STAGE(PG8_SA(0, 0), cA, vA[0]); PG8_STAGE(PG8_SA(0, 1), cA, vA[1]);
    if (wr == 1) PG8_BAR;
    PG8_WAIT_V(2); PG8_BAR;
    PG8_STAGE(PG8_SB(1, 0), cB + kstep, voffB); PG8_STAGE(PG8_SA(1, 0), cA + kstep, vA[0]); PG8_STAGE(PG8_SB(1, 1), cB + hstepB + kstep, voffB);
    PG8_WAIT_V(6); PG8_BAR;
    for (;;) {
        const bool has_next = S.next(ui + 1, nxt);
        const char* nA = has_next ? S.a_base(nxt) : cA; const char* nB = has_next ? S.b_base(nxt) : cB;
        if (has_next) {
#pragma unroll
            for (int h = 0; h < 2; ++h)
#pragma unroll
                for (int i = 0; i < 2; ++i) vN[h][i] = S.a_voff(nxt, Rr[i] + h * HALF, Cc[i], g.lda);
        }
#pragma nounroll
        for (int t = 0; t < nt; t += 2) {
            const bool last = (t == nt - 2);
            const char* a1 = cA + (size_t)(t + 1) * kstep;
            const char* a2 = last ? nA : cA + (size_t)(t + 2) * kstep; const char* b2 = last ? nB : cB + (size_t)(t + 2) * kstep;
            const char* a3 = a2 + kstep; const char* b3 = b2 + kstep;
            unsigned w0[2], w1[2];
#pragma unroll
            for (int i = 0; i < 2; ++i) { w0[i] = last ? vN[0][i] : vA[0][i]; w1[i] = last ? vN[1][i] : vA[1][i]; }
            PG8_LDB(B0, 0, 0); PG8_LDB(B1, 0, 1); PG8_SCHED; PG8_LDA(At, 0, 0); PG8_STAGE(PG8_SA(1, 1), a1, vA[1]);
            PG8_WAIT_V(8); PG8_WAIT_L(0); PG8_BAR; PG8_MMA(0, 0, At, B0); PG8_MMA(0, 1, At, B1); PG8_BAR; PG8_SCHED;
            PG8_LDA(At, 0, 1); PG8_STAGE(PG8_SB(0, 0), b2, voffB); PG8_STAGE(PG8_SB(0, 1), b2 + hstepB, voffB); PG8_STAGE(PG8_SA(0, 0), a2, w0);
            PG8_WAIT_V(8); PG8_WAIT_L(0); PG8_BAR; PG8_MMA(1, 0, At, B0); PG8_MMA(1, 1, At, B1); PG8_BAR; PG8_SCHED;
            PG8_LDB(B0, 1, 0); PG8_LDB(B1, 1, 1); PG8_SCHED; PG8_LDA(At, 1, 0); PG8_STAGE(PG8_SA(0, 1), a2, w1);
            PG8_WAIT_V(8); PG8_WAIT_L(0); PG8_BAR; PG8_MMA(0, 0, At, B0); PG8_MMA(0, 1, At, B1); PG8_BAR; PG8_SCHED;
            PG8_LDA(At, 1, 1); PG8_STAGE(PG8_SB(1, 0), b3, voffB); PG8_STAGE(PG8_SB(1, 1), b3 + hstepB, voffB); PG8_STAGE(PG8_SA(1, 0), a3, w0);
            PG8_WAIT_V(8); PG8_WAIT_L(0); PG8_BAR; PG8_MMA(1, 0, At, B0); PG8_MMA(1, 1, At, B1); PG8_BAR; PG8_SCHED;
        }
        if constexpr (ALIGN_EPI) { if (wr == 0) PG8_BAR; }
        if constexpr (!Epi::AFTER_DRAIN) E(acc, cur, wr, wc, fr, fq);
        if (!has_next) break;
#pragma unroll
        for (int a = 0; a < 2; ++a)
#pragma unroll
            for (int b = 0; b < 2; ++b)
#pragma unroll
                for (int m = 0; m < 4; ++m)
#pragma unroll
                    for (int n = 0; n < 2; ++n) acc[a][b][m][n] = (f32x4){0.f, 0.f, 0.f, 0.f};
        cur = nxt; cA = nA; cB = nB; ++ui;
#pragma unroll
        for (int h = 0; h < 2; ++h)
#pragma unroll
            for (int i = 0; i < 2; ++i) vA[h][i] = vN[h][i];
        if constexpr (ALIGN_EPI) { if (wr == 1) PG8_BAR; }
    }
    PG8_WAIT_V(0);
    if constexpr (!ALIGN_EPI) { if (wr == 0) PG8_BAR; }
    PG8_BAR;
    if constexpr (Epi::AFTER_DRAIN) E.fused(acc, cur, wr, wc, fr, fq, lds, lane);
#undef PG8_SA
#undef PG8_SB
#undef PG8_STAGE
#undef PG8_LDA
#undef PG8_LDB
#undef PG8_MMA
#undef PG8_WAIT_V
#undef PG8_WAIT_L
#undef PG8_BAR
#undef PG8_SCHED
}
}

namespace att {
constexpr int KSLOT = 12288, VSLOT = 8192, LDS_K = 0, LDS_V = 3 * KSLOT, LDS_BYTES = LDS_V + 3 * VSLOT;
constexpr float THR = 6.0f;
__device__ __forceinline__ int nx3(int s) { return s == 2 ? 0 : s + 1; }
__device__ __forceinline__ int pv3(int s) { return s == 0 ? 2 : s - 1; }
__device__ __forceinline__ void glds16(const void* g, LAS unsigned char* l) { __builtin_amdgcn_global_load_lds((const unsigned*)g, (LAS unsigned*)l, 16, 0, 0); }

template <bool FIRST, bool GEN>
__device__ __forceinline__ void att_step(f32x16& c0, f32x16& c1, f32x16& n0, f32x16& n1, f32x16& o0, f32x16& o1, f32x16& negm, float& mhat, float& lsum, u32x4 (&pw)[4], const bf16x8 (&qr)[6],
                                         const LAS unsigned char* kb_next, const LAS unsigned char* vb_prev, bool act_prev, bool act_cur, bool act_nxt, int jb, int qrel, int hi) {
    const bool do_pv = !FIRST && (!GEN || act_prev), do_cur = !GEN || act_cur, do_qk = !GEN || act_nxt;
    bf16x8 vfr[8], kfa[6], kfb[6];
    if (do_pv) {
#pragma unroll
        for (int kc2 = 0; kc2 < 4; ++kc2) { vfr[2 * kc2] = *(const LAS bf16x8*)(vb_prev + kc2 * 2048); vfr[2 * kc2 + 1] = *(const LAS bf16x8*)(vb_prev + kc2 * 2048 + 512); }
    }
    if (do_qk) {
#pragma unroll
        for (int d0 = 0; d0 < 3; ++d0) { kfa[2 * d0] = *(const LAS bf16x8*)(kb_next + d0 * 2048); kfa[2 * d0 + 1] = *(const LAS bf16x8*)(kb_next + d0 * 2048 + 512); }
    }
    __builtin_amdgcn_sched_barrier(0);
    float rm = 0.f;
    if (do_cur) {
        if ((GEN || FIRST) && jb >= 0) {
            const int kb0 = 64 * jb + 8 * hi;
#pragma unroll
            for (int r = 0; r < 16; ++r) { const int key = kb0 + (r & 3) + 4 * ((r >> 2) & 1) + 16 * (r >> 3);
                if (key > qrel) c0[r] = -INFINITY; if (key + 32 > qrel) c1[r] = -INFINITY; }
        }
        float ra = fmaxf(fmaxf(c0[0], c0[1]), c1[0]), rb = fmaxf(fmaxf(c0[2], c0[3]), c1[1]);
        ra = fmaxf(fmaxf(ra, c1[2]), c1[3]);
#pragma unroll
        for (int r = 4; r < 16; r += 4) { ra = fmaxf(fmaxf(ra, c0[r]), c0[r + 1]); rb = fmaxf(fmaxf(rb, c0[r + 2]), c0[r + 3]); ra = fmaxf(fmaxf(ra, c1[r]), c1[r + 1]); rb = fmaxf(fmaxf(rb, c1[r + 2]), c1[r + 3]); }
        rm = fmaxf(ra, rb);
        { auto rr = __builtin_amdgcn_permlane32_swap(__float_as_uint(rm), __float_as_uint(rm), false, false); rm = fmaxf(__uint_as_float(rr[0]), __uint_as_float(rr[1])); }
    }
    if (do_pv) {
#pragma unroll
        for (int kc2 = 0; kc2 < 4; ++kc2) {
            const bf16x8 pf = __builtin_bit_cast(bf16x8, pw[kc2]);
            o0 = __builtin_amdgcn_mfma_f32_32x32x16_bf16(vfr[2 * kc2], pf, o0, 0, 0, 0);
            o1 = __builtin_amdgcn_mfma_f32_32x32x16_bf16(vfr[2 * kc2 + 1], pf, o1, 0, 0, 0);
        }
    }
    __builtin_amdgcn_sched_barrier(0);
    if (do_qk) {
#pragma unroll
        for (int d0 = 0; d0 < 3; ++d0) { kfb[2 * d0] = *(const LAS bf16x8*)(kb_next + (d0 + 3) * 2048); kfb[2 * d0 + 1] = *(const LAS bf16x8*)(kb_next + (d0 + 3) * 2048 + 512); }
    }
    __builtin_amdgcn_sched_barrier(0);
    if (do_cur) {
        if (FIRST) {
            mhat = rm;
#pragma unroll
            for (int r = 0; r < 16; ++r) { c0[r] -= rm; c1[r] -= rm; negm[r] = -rm; }
        } else if (__any(rm > THR)) {
            const float dl = fmaxf(rm, 0.f); mhat += dl;
            const float f = __builtin_amdgcn_exp2f(-dl); lsum *= f;
#pragma unroll
            for (int r = 0; r < 16; ++r) { c0[r] -= dl; c1[r] -= dl; o0[r] *= f; o1[r] *= f; negm[r] = -mhat; }
        }
    }
    if (do_qk) {
        n0 = __builtin_amdgcn_mfma_f32_32x32x16_bf16(kfa[0], qr[0], negm, 0, 0, 0);
        n1 = __builtin_amdgcn_mfma_f32_32x32x16_bf16(kfa[1], qr[0], negm, 0, 0, 0);
#pragma unroll
        for (int d0 = 1; d0 < 3; ++d0) { n0 = __builtin_amdgcn_mfma_f32_32x32x16_bf16(kfa[2 * d0], qr[d0], n0, 0, 0, 0); n1 = __builtin_amdgcn_mfma_f32_32x32x16_bf16(kfa[2 * d0 + 1], qr[d0], n1, 0, 0, 0); }
#pragma unroll
        for (int d0 = 0; d0 < 3; ++d0) { n0 = __builtin_amdgcn_mfma_f32_32x32x16_bf16(kfb[2 * d0], qr[d0 + 3], n0, 0, 0, 0); n1 = __builtin_amdgcn_mfma_f32_32x32x16_bf16(kfb[2 * d0 + 1], qr[d0 + 3], n1, 0, 0, 0); }
    }
    if (do_cur) {
        float sa = 0.f, sb = 0.f;
#pragma unroll
        for (int r = 0; r < 16; ++r) { c0[r] = __builtin_amdgcn_exp2f(c0[r]); c1[r] = __builtin_amdgcn_exp2f(c1[r]); sa += c0[r]; sb += c1[r]; }
        lsum += sa + sb;
#pragma unroll
        for (int i = 0; i < 2; ++i) {
            pw[i] = (u32x4){cvtpk(c0[8 * i], c0[8 * i + 1]), cvtpk(c0[8 * i + 2], c0[8 * i + 3]), cvtpk(c0[8 * i + 4], c0[8 * i + 5]), cvtpk(c0[8 * i + 6], c0[8 * i + 7])};
            pw[2 + i] = (u32x4){cvtpk(c1[8 * i], c1[8 * i + 1]), cvtpk(c1[8 * i + 2], c1[8 * i + 3]), cvtpk(c1[8 * i + 4], c1[8 * i + 5]), cvtpk(c1[8 * i + 6], c1[8 * i + 7])};
        }
        asm volatile("" : "+v"(pw[0]), "+v"(pw[1]), "+v"(pw[2]), "+v"(pw[3]), "+v"(lsum));
    }
    __builtin_amdgcn_sched_barrier(0);
}

__device__ __forceinline__ void attn_unit(int b, int h, int qb, const bf16_t* __restrict__ Q, const bf16_t* __restrict__ KN, const bf16_t* __restrict__ KR, const bf16_t* __restrict__ VT, bf16_t* __restrict__ O, LAS unsigned char* lds) {
    const int tid = opaque(threadIdx.x), lane = tid & 63, r32 = lane & 31, hi = lane >> 5;
    const int w = __builtin_amdgcn_readfirstlane(tid >> 6);
    const size_t tok0 = (size_t)b * SEQ;
    const int q0 = qb * 256, NT = 4 * (qb + 1);
    const bf16_t* ksrc = KN + (tok0 + lane) * 1024 + h * 64 + 8 * w;
    const bf16_t* rsrc = KR + (tok0 + lane) * 32 + 8 * (w & 3);
    const bf16_t* vsrc = VT + (size_t)(h * 64 + lane) * NTOK + tok0 + 8 * w;
#define ATT_ISSUE_K(t, slot) do { glds16(ksrc + (size_t)(t) * 65536, lds + LDS_K + (slot) * KSLOT + w * 1024); \
        if (w < 4) glds16(rsrc + (size_t)(t) * 2048, lds + LDS_K + (slot) * KSLOT + (8 + w) * 1024); } while (0)
#define ATT_ISSUE_V(t, slot) glds16(vsrc + (size_t)(t) * 64, lds + LDS_V + (slot) * VSLOT + w * 1024)
    ATT_ISSUE_K(0, 0); ATT_ISSUE_K(1, 1); ATT_ISSUE_K(2, 2); ATT_ISSUE_V(0, 0);
    bf16x8 qr[6];
    { const bf16_t* qp = Q + (tok0 + q0 + w * 32 + r32) * QPITCH + h * 96 + hi * 8;
#pragma unroll
      for (int d0 = 0; d0 < 6; ++d0) qr[d0] = *(const bf16x8*)(qp + d0 * 16); }
    const int kvp = (r32 & 19) | ((r32 & 4) << 1) | ((r32 & 8) >> 1);
    const LAS unsigned char* kf = lds + LDS_K + hi * 1024 + kvp * 16;
    const LAS unsigned char* vf = lds + LDS_V + hi * 1024 + r32 * 16;
    float mhat = 0.f, lsum = 0.f;
    f32x16 o0 = {}, o1 = {}, negm = {}, sA0 = {}, sA1 = {}, sB0, sB1;
    u32x4 pw[4] = {};
    const int qrel = w * 32 + r32, wb = w >> 1;
    asm volatile("s_waitcnt vmcnt(0)" ::: "memory");
    __builtin_amdgcn_s_barrier();
    asm volatile("" ::: "memory");
#pragma unroll
    for (int d0 = 0; d0 < 6; ++d0) {
        const bf16x8 k0 = *(const LAS bf16x8*)(kf + d0 * 2048), k1 = *(const LAS bf16x8*)(kf + d0 * 2048 + 512);
        sA0 = __builtin_amdgcn_mfma_f32_32x32x16_bf16(k0, qr[d0], sA0, 0, 0, 0);
        sA1 = __builtin_amdgcn_mfma_f32_32x32x16_bf16(k1, qr[d0], sA1, 0, 0, 0);
    }
    int st = 0;
#define ATT_SYNC(t) do { \
        if ((t) == 0 || (t) + 2 >= NT) asm volatile("s_waitcnt vmcnt(0)" ::: "memory"); \
        else if (w < 4) asm volatile("s_waitcnt vmcnt(3)" ::: "memory"); \
        else asm volatile("s_waitcnt vmcnt(2)" ::: "memory"); \
        __builtin_amdgcn_s_barrier(); asm volatile("" ::: "memory"); \
        if ((t) + 3 < NT) ATT_ISSUE_K((t) + 3, st); \
        if ((t) + 1 < NT) ATT_ISSUE_V((t) + 1, nx3(st)); } while (0)
#define ATT_ACT(tt) (((tt) - (NT - 4)) < 0 || ((tt) - (NT - 4)) <= wb)
#define ATT_STEP(FIRST, GEN, C0, C1, N0, N1, t) do { ATT_SYNC(t); \
        att_step<FIRST, GEN>(C0, C1, N0, N1, o0, o1, negm, mhat, lsum, pw, qr, kf + nx3(st) * KSLOT, vf + pv3(st) * VSLOT, \
                             (t) > 0 && ATT_ACT((t) - 1), ATT_ACT(t), (t) + 1 < NT && ATT_ACT((t) + 1), (t) - (NT - 4), qrel, hi); \
        st = nx3(st); } while (0)
    ATT_STEP(true, true, sA0, sA1, sB0, sB1, 0);
    int t = 1;
    const int ts = (NT > 4) ? NT - 5 : 1;
    for (; t + 1 < ts; t += 2) {
        ATT_STEP(false, false, sB0, sB1, sA0, sA1, t);
        ATT_STEP(false, false, sA0, sA1, sB0, sB1, t + 1);
    }
    if (NT > 4) { ATT_STEP(false, true, sB0, sB1, sA0, sA1, NT - 5); ATT_STEP(false, true, sA0, sA1, sB0, sB1, NT - 4); }
    ATT_STEP(false, true, sB0, sB1, sA0, sA1, NT - 3);
    ATT_STEP(false, true, sA0, sA1, sB0, sB1, NT - 2);
    ATT_STEP(false, true, sB0, sB1, sA0, sA1, NT - 1);
    if (ATT_ACT(NT - 1)) {
        const LAS unsigned char* vb = vf + pv3(st) * VSLOT;
#pragma unroll
        for (int kc2 = 0; kc2 < 4; ++kc2) {
            const bf16x8 v0 = *(const LAS bf16x8*)(vb + kc2 * 2048), v1 = *(const LAS bf16x8*)(vb + kc2 * 2048 + 512);
            const bf16x8 pf = __builtin_bit_cast(bf16x8, pw[kc2]);
            o0 = __builtin_amdgcn_mfma_f32_32x32x16_bf16(v0, pf, o0, 0, 0, 0);
            o1 = __builtin_amdgcn_mfma_f32_32x32x16_bf16(v1, pf, o1, 0, 0, 0);
        }
    }
    { auto rr = __builtin_amdgcn_permlane32_swap(__float_as_uint(lsum), __float_as_uint(lsum), false, false); lsum = __uint_as_float(rr[0]) + __uint_as_float(rr[1]); }
    const float inv = 1.0f / lsum;
    bf16_t* op = O + (tok0 + q0 + w * 32 + r32) * 1024 + h * 64 + 4 * hi;
#pragma unroll
    for (int g = 0; g < 4; ++g) {
        u32x2 a, c; a.x = cvtpk(o0[4 * g] * inv, o0[4 * g + 1] * inv); a.y = cvtpk(o0[4 * g + 2] * inv, o0[4 * g + 3] * inv);
        c.x = cvtpk(o1[4 * g] * inv, o1[4 * g + 1] * inv); c.y = cvtpk(o1[4 * g + 2] * inv, o1[4 * g + 3] * inv);
        *(u32x2*)(op + 8 * g) = a; *(u32x2*)(op + 32 + 8 * g) = c;
    }
    asm volatile("s_waitcnt lgkmcnt(0)" ::: "memory");
    __builtin_amdgcn_s_barrier();
#undef ATT_ISSUE_K
#undef ATT_ISSUE_V
#undef ATT_SYNC
#undef ATT_ACT
#undef ATT_STEP
}
}

#define XB_TMO      128
#define XB_XCNT(j)  (256  + 64 * (j))
#define XB_XSUB(j)  (1280 + 64 * (j))
#define XB_XGEN(j)  (2304 + 64 * (j))
#define XB_TOP      3328
#define XB_TOPGEN   3392
#define XCD_BAR_WORDS 3456
#define XB_SPIN_CAP (1u << 18)
__device__ __forceinline__ unsigned xb_ld(unsigned* p)              { return __hip_atomic_load(p, __ATOMIC_RELAXED, __HIP_MEMORY_SCOPE_AGENT); }
__device__ __forceinline__ unsigned xb_add(unsigned* p, unsigned v) { return __hip_atomic_fetch_add(p, v, __ATOMIC_RELAXED, __HIP_MEMORY_SCOPE_AGENT); }
__device__ __forceinline__ unsigned xb_xcc_id() { return (unsigned)__builtin_amdgcn_s_getreg((3 << 11) | 20) & 0xFu; }
#define XB_SPIN(cond, bar) do { unsigned _sp = 0; while (cond) { __builtin_amdgcn_s_sleep(1); \
    if ((++_sp & 255u) == 0u) { if (xb_ld(&(bar)[XB_TMO])) break; if (_sp > XB_SPIN_CAP) { atomicAdd(&(bar)[XB_TMO], 1u); break; } } } } while (0)
struct XcdBarrier { unsigned* bar; unsigned x; volatile LAS unsigned* st; };
__device__ __forceinline__ XcdBarrier xcd_barrier_post(unsigned* bar, volatile LAS unsigned* st) {
    XcdBarrier b; b.bar = bar; b.x = xb_xcc_id(); b.st = st;
    if (threadIdx.x == 0) (void)xb_add(&bar[XB_XCNT(b.x)], 1u);
    return b;
}
__device__ __forceinline__ void xcd_barrier_complete(unsigned* bar, unsigned x, unsigned& nloc, unsigned& nx) {
    const unsigned G = gridDim.x * gridDim.y * gridDim.z;
    unsigned sum, cnt, mine, sp = 0u;
    for (;;) {
        sum = 0u; cnt = 0u; mine = 0u;
#pragma unroll
        for (unsigned j = 0; j < 16; ++j) { const unsigned c = xb_ld(&bar[XB_XCNT(j)]); sum += c; cnt += (c > 0u) ? 1u : 0u; mine = (j == x) ? c : mine; }
        if (sum == G) break;
        __builtin_amdgcn_s_sleep(1);
        if ((++sp & 255u) == 0u) { if (xb_ld(&bar[XB_TMO])) break; if (sp > XB_SPIN_CAP) { atomicAdd(&bar[XB_TMO], 1u); break; } }
    }
    nloc = mine > 0u ? mine : 1u; nx = cnt > 0u ? cnt : 1u;
}
__device__ __forceinline__ void xcd_barrier(const XcdBarrier& b) {
    asm volatile("s_waitcnt vmcnt(0)" ::: "memory");
    __syncthreads();
    if (threadIdx.x == 0) {
        unsigned* bar = b.bar;
        __builtin_amdgcn_s_waitcnt(0);
        unsigned nloc = b.st[0], nx = b.st[1];
        if (nloc == 0u) { xcd_barrier_complete(bar, b.x, nloc, nx); b.st[0] = nloc; b.st[1] = nx; }
        const unsigned old = xb_add(&bar[XB_XSUB(b.x)], 1u);
        const unsigned gen = old / nloc;
        if (old + 1u == (gen + 1u) * nloc) {
            __builtin_amdgcn_fence(__ATOMIC_RELEASE, "agent");
            asm volatile("s_waitcnt vmcnt(0)" ::: "memory");
            const unsigned og = xb_add(&bar[XB_TOP], 1u);
            const unsigned tg = og / nx;
            if (og + 1u == (tg + 1u) * nx) xb_add(&bar[XB_TOPGEN], 1u);
            else XB_SPIN(xb_ld(&bar[XB_TOPGEN]) == tg, bar);
            __builtin_amdgcn_fence(__ATOMIC_ACQUIRE, "agent");
            xb_add(&bar[XB_XGEN(b.x)], 1u);
            asm volatile("s_waitcnt vmcnt(0)" ::: "memory");
        } else {
            XB_SPIN(xb_ld(&bar[XB_XGEN(b.x)]) == gen, bar);
            __builtin_amdgcn_fence(__ATOMIC_ACQUIRE, "agent");
            asm volatile("s_waitcnt vmcnt(0)" ::: "memory");
        }
    }
    __syncthreads();
}

struct Args { const void* in[20]; float* out; unsigned char* ws; int ph_lo, ph_hi; };
typedef const __attribute__((address_space(4))) Args* KArgs;
__device__ __forceinline__ KArgs kargs() { KArgs p = (KArgs)__builtin_amdgcn_kernarg_segment_ptr(); asm volatile("" : "+s"(p)); return p; }
constexpr int NWAVES = 8;
constexpr int PPL = 12;
constexpr int NPHASE = 1 + DEPTH * PPL;

__constant__ double c_invf[16] = {1.0, 0.5623413251903491, 0.31622776601683794, 0.1778279410038923, 0.1, 0.05623413251903491, 0.03162277660168379, 0.01778279410038923,
                                  0.01, 0.005623413251903491, 0.0031622776601683794, 0.0017782794100389228, 0.001, 0.0005623413251903491, 0.00031622776601683794, 0.00017782794100389227};

__device__ __forceinline__ void transpose_item(const float* __restrict__ W, int ldw, int k0, int n0, bf16_t* __restrict__ WT, int ldt, int drow0, float mul, LAS float* scr, int lane) {
#pragma unroll 8
    for (int i = 0; i < 32; ++i) { const int kk = 2 * i + (lane >> 5); scr[kk * 33 + (lane & 31)] = W[(size_t)(k0 + kk) * ldw + n0 + (lane & 31)]; }
    LDS_WAIT(); asm volatile("" ::: "memory");
    const int c = lane & 7;
#pragma unroll
    for (int j = 0; j < 4; ++j) { const int n = (lane >> 3) + 8 * j; const LAS float* s = scr + (8 * c) * 33 + n;
        u32x4 o; o.x = cvtpk(s[0 * 33] * mul, s[1 * 33] * mul); o.y = cvtpk(s[2 * 33] * mul, s[3 * 33] * mul); o.z = cvtpk(s[4 * 33] * mul, s[5 * 33] * mul); o.w = cvtpk(s[6 * 33] * mul, s[7 * 33] * mul);
        *(u32x4*)(WT + (size_t)(drow0 + n) * ldt + k0 + 8 * c) = o; }
    LDS_WAIT(); asm volatile("" ::: "memory");
}

struct ConvItem { const float* src; bf16_t* dst; int ldw, ldt; };
__device__ __forceinline__ void conv_load(const ConvItem& c, f32x4 (&v)[16], int lane) {
    const float* src = c.src + (size_t)(lane >> 4) * c.ldw + 4 * (lane & 15);
#pragma unroll
    for (int i = 0; i < 16; ++i) v[i] = *(const f32x4*)(src + (size_t)(4 * i) * c.ldw);
}
__device__ __forceinline__ void conv_finish(const ConvItem& c, const f32x4 (&v)[16], LAS float* scr, int lane) {
#pragma unroll
    for (int i = 0; i < 16; ++i) *(LAS f32x4*)(scr + (4 * i + (lane >> 4)) * 68 + 4 * (lane & 15)) = v[i];
    LDS_WAIT(); asm volatile("" ::: "memory");
    bf16_t* dst = c.dst + (size_t)lane * c.ldt;
#pragma unroll
    for (int cc = 0; cc < 8; ++cc) { const LAS float* sp = scr + (8 * cc) * 68 + lane;
        u32x4 o; o.x = cvtpk(sp[0], sp[68]); o.y = cvtpk(sp[2 * 68], sp[3 * 68]); o.z = cvtpk(sp[4 * 68], sp[5 * 68]); o.w = cvtpk(sp[6 * 68], sp[7 * 68]);
        *(u32x4*)(dst + 8 * cc) = o; }
    LDS_WAIT(); asm volatile("" ::: "memory");
}

__device__ __forceinline__ void sincos_d(double a, float& s, float& c) {
    const double TWO_PI_HI = 6.283185307179586, TWO_PI_LO = 2.4492935982947064e-16, INV_2PI = 0.15915494309189535;
    const double n = __builtin_rint(a * INV_2PI);
    double r = __builtin_fma(-n, TWO_PI_HI, a); r = __builtin_fma(-n, TWO_PI_LO, r);
    const double HALF_PI = 1.5707963267948966, HALF_PI_LO = 6.123233995736766e-17;
    const double qd = __builtin_rint(r * 0.6366197723675814);
    double y = __builtin_fma(-qd, HALF_PI, r); y = __builtin_fma(-qd, HALF_PI_LO, y);
    const int q = ((int)qd) & 3;
    const double y2 = y * y;
    double sp = -7.647163731819816e-13; sp = sp * y2 + 1.6059043836821613e-10; sp = sp * y2 - 2.505210838544172e-08; sp = sp * y2 + 2.7557319223985893e-06; sp = sp * y2 - 0.0001984126984126984;
    sp = sp * y2 + 0.008333333333333333; sp = sp * y2 - 0.16666666666666666; sp = y + y * y2 * sp;
    double cp = 4.779477332387385e-14; cp = cp * y2 - 1.1470745597729725e-11; cp = cp * y2 + 2.08767569878681e-09; cp = cp * y2 - 2.755731922398589e-07; cp = cp * y2 + 2.48015873015873e-05;
    cp = cp * y2 - 0.001388888888888889; cp = cp * y2 + 0.041666666666666664; cp = cp * y2 - 0.5; cp = 1.0 + y2 * cp;
    double ss, cc;
    if (q == 0) { ss = sp; cc = cp; } else if (q == 1) { ss = cp; cc = -sp; } else if (q == 2) { ss = -sp; cc = -cp; } else { ss = -cp; cc = sp; }
    s = (float)ss; c = (float)cc;
}

__global__ void __launch_bounds__(NWAVES * 64, 2) mk_fwd(Args args_unused) {
    extern __shared__ __attribute__((aligned(16))) unsigned char lds_raw[];
    LAS unsigned char* lds = (LAS unsigned char*)lds_raw;
    volatile LAS unsigned* MISC = (volatile LAS unsigned*)(lds + MISC_OFF);
    int tid = threadIdx.x, lane = tid & 63, wave = __builtin_amdgcn_readfirstlane(tid >> 6);
    const int G = gridDim.x, bx = blockIdx.x;
    const int vcu = (G % 8 == 0) ? (bx % 8) * (G / 8) + bx / 8 : bx;
    int gw = vcu * NWAVES + wave; const int NGW = G * NWAVES;
#define ws (kargs()->ws)
    unsigned* ctl = (unsigned*)(ws + WS_CTL);
    for (int u = tid; u < (LDS_BYTES - LDSCTL_OFF) / 4; u += NWAVES * 64) ((LAS unsigned*)(lds + LDSCTL_OFF))[u] = 0u;
    __syncthreads();
    XcdBarrier bar; bar.bar = ctl + CW_BAR; bar.x = 0; bar.st = nullptr;
#if MK_ONE_LAUNCH
    bar = xcd_barrier_post(ctl + CW_BAR, MISC + 8);
#endif
    const int lo = kargs()->ph_lo, hi = kargs()->ph_hi;
#ifndef MK_REP_MASK
#define MK_REP_MASK 0u
#endif
#define NREP(b) (1 + (int)((MK_REP_MASK >> (b)) & 1u))
#ifndef MK_PH_MASK
#define MK_PH_MASK 0xffffffffu
#endif
#define PHON(b) ((MK_PH_MASK >> (b)) & 1u)
#define IN(k) (lo <= (k) && (k) < hi)
#if MK_ONE_LAUNCH
#define SEAM(k) do { if ((k) + 1 < hi) xcd_barrier(bar); } while (0)
#else
#define SEAM(k) do { } while (0)
#endif
#define in_x ((const float*)kargs()->in[0])
#define in_pos ((const int*)kargs()->in[1])
#define ln_g ((const float*)kargs()->in[2])
#define ln_b ((const float*)kargs()->in[3])
#define w_in ((const float*)kargs()->in[4])
#define q_norm ((const float*)kargs()->in[5])
#define w_uq ((const float*)kargs()->in[6])
#define kv_norm ((const float*)kargs()->in[7])
#define w_ukv ((const float*)kargs()->in[8])
#define w_o ((const float*)kargs()->in[9])
#define pool_w ((const float*)kargs()->in[10])
#define pool_b ((const float*)kargs()->in[11])
#define pool_scale ((const float*)kargs()->in[12])
#define w_grp ((const float*)kargs()->in[13])
#define b_grp ((const float*)kargs()->in[14])
#define w_exp ((const float*)kargs()->in[15])
#define b_exp ((const float*)kargs()->in[16])
#define w1 ((const float*)kargs()->in[17])
#define w3 ((const float*)kargs()->in[18])
#define w2 ((const float*)kargs()->in[19])
#define COS ((float*)(ws + WS_COS))
#define SIN ((float*)(ws + WS_SIN))
#define CNT ((int*)(ws + WS_CNT))
#define TILE ((int*)(ws + WS_TILE))
#define AE ((int*)(ws + WS_AE))
#define APOS ((int*)(ws + WS_APOS))
#define AG ((float*)(ws + WS_AG))
#define RSLOT ((int*)(ws + WS_RSLOT))
#define RGATE ((float*)(ws + WS_RGATE))
#define WIN ((bf16_t*)(ws + WS_WIN))
#define WUQ ((bf16_t*)(ws + WS_WUQ))
#define WUK ((bf16_t*)(ws + WS_WUK))
#define WUV ((bf16_t*)(ws + WS_WUV))
#define WO ((bf16_t*)(ws + WS_WO))
#define WP ((bf16_t*)(ws + WS_WP))
#define WR ((bf16_t*)(ws + WS_WR))
#define W13L(ll) ((bf16_t*)(ws + (((ll) & 1) ? WS_W13B : WS_W13)))
#define W2TL(ll) ((bf16_t*)(ws + (((ll) & 1) ? WS_W2TB : WS_W2T)))
#define FB ((bf16_t*)(ws + WS_FB))
#define XHL ((bf16_t*)(ws + WS_XHL))
#define LATB ((float*)(ws + WS_LAT))
#define CQ ((bf16_t*)(ws + WS_CQ))
#define CKV ((bf16_t*)(ws + WS_CKV))
#define KR ((bf16_t*)(ws + WS_KR))
#define QB ((bf16_t*)(ws + WS_Q))
#define KN ((bf16_t*)(ws + WS_KN))
#define VT ((bf16_t*)(ws + WS_VT))
#define OB ((bf16_t*)(ws + WS_O))
#define POOLED ((bf16_t*)(ws + WS_POOLED))
#define LG ((float*)(ws + WS_LG))
#define ROWLIST ((int*)(ws + WS_LIST))
#define LGATE ((float*)(ws + WS_LGATE))
#define HS ((bf16_t*)(ws + WS_HS))
#define YB ((bf16_t*)(ws + WS_Y))
    LAS float* scr = (LAS float*)(lds + RING_OFF + wave * SCR_WAVE);

    if (PHON(12) && IN(0)) {
        for (int m = gw; m < NTOK; m += NGW) {
            const f32x4* xr = (const f32x4*)(in_x + (size_t)m * D_MODEL) + 2 * lane; u32x4* oh = (u32x4*)(XHL + (size_t)m * 2048) + lane;
#pragma unroll
            for (int j = 0; j < 2; ++j) oh[64 * j] = pk8(xr[128 * j], xr[128 * j + 1]);
        }
        for (int idx = gw * 64 + lane; idx < NTOK * 16; idx += NGW * 64) { float s, c; sincos_d((double)in_pos[idx >> 4] * c_invf[idx & 15], s, c); COS[idx] = c; SIN[idx] = s; }
        for (int idx = gw * 64 + lane; idx < DEPTH * 2 * 256 * 1024; idx += NGW * 64) {
            const int l = idx >> 19, ks = (idx >> 18) & 1, row = (idx >> 10) & 255, k = idx & 1023;
            const int j = row < 72 ? row : ((row >= 128 && row < 200) ? row - 128 : -1);
            float v = 0.f;
            if (j >= 0 && !(ks == 1 && row >= 128)) { const float wv = (j < 8) ? w_grp[((size_t)l * 1024 + k) * 8 + j] : w_exp[((size_t)l * 1024 + k) * 64 + (j - 8)];
                const float whi = bflo(cvtpk(wv, 0.f)); v = (row < 72) ? whi : (wv - whi); }
            WR[idx] = (bf16_t)(cvtpk(v, 0.f) & 0xffffu);
        }
        for (int idx = gw * 64 + lane; idx < 2 * 96 * 1024 / 8; idx += NGW * 64) { const int j = idx / (96 * 128), r = idx % (96 * 128); *(u32x4*)(WIN + ((size_t)j * 512 + 416) * 1024 + (size_t)r * 8) = (u32x4){0u, 0u, 0u, 0u}; }
        constexpr int I_IN = 16 * 13, I_UQ = 4 * 48, I_UKV = 2 * 64, I_O = 16 * 32, I_P = 4 * 8;
        constexpr int NIT = 2 * (I_IN + I_UQ + I_UKV + I_O) + 8 * I_P;
        for (int it = gw; it < NIT; it += NGW) {
            int r = it;
            if (r < 2 * I_IN) { const int j = r / I_IN, q = r % I_IN, kb = q / 13, nb = q % 13;
                transpose_item(w_in + (size_t)j * 1024 * LAT, LAT, 64 * kb, 32 * nb, WIN + (size_t)j * 512 * 1024, 1024, 32 * nb, 1.f, scr, lane); continue; } r -= 2 * I_IN;
            if (r < 2 * I_UQ) { const int j = r / I_UQ, q = r % I_UQ, kb = q / 48, nb = q % 48; const int n0 = 32 * nb, head = n0 / 96, r0 = n0 % 96;
                if (r0 < 64) transpose_item(w_uq + (size_t)j * 256 * QPITCH, QPITCH, 64 * kb, n0, WUQ + (size_t)j * 1536 * 256, 256, head * 64 + r0, QSCALE, scr, lane);
                else {
                    const float* W = w_uq + (size_t)j * 256 * QPITCH; bf16_t* WT = WUQ + (size_t)j * 1536 * 256; const int k0 = 64 * kb;
#pragma unroll 8
                    for (int i = 0; i < 32; ++i) { const int kk = 2 * i + (lane >> 5); scr[kk * 33 + (lane & 31)] = W[(size_t)(k0 + kk) * QPITCH + n0 + (lane & 31)]; }
                    LDS_WAIT(); asm volatile("" ::: "memory");
                    const int c = lane & 7;
#pragma unroll
                    for (int jj = 0; jj < 4; ++jj) { const int n = (lane >> 3) + 8 * jj; const LAS float* s = scr + (8 * c) * 33 + n;
                        const int drow = 1024 + (head >> 3) * 256 + (head & 7) * 16 + (n < 16 ? n : 128 + n - 16);
                        u32x4 o; o.x = cvtpk(s[0 * 33] * QSCALE, s[1 * 33] * QSCALE); o.y = cvtpk(s[2 * 33] * QSCALE, s[3 * 33] * QSCALE); o.z = cvtpk(s[4 * 33] * QSCALE, s[5 * 33] * QSCALE); o.w = cvtpk(s[6 * 33] * QSCALE, s[7 * 33] * QSCALE);
                        *(u32x4*)(WT + (size_t)drow * 256 + k0 + 8 * c) = o; }
                    LDS_WAIT(); asm volatile("" ::: "memory");
                }
                continue; } r -= 2 * I_UQ;
            if (r < 2 * I_UKV) { const int j = r / I_UKV, q = r % I_UKV, kb = q / 64, nb = q % 64; const int n0 = 32 * nb, head = n0 >> 7, r0 = n0 & 127;
                if (r0 < 64) transpose_item(w_ukv + (size_t)j * 128 * 2048, 2048, 64 * kb, n0, WUK + (size_t)j * 1024 * 128, 128, head * 64 + r0, 1.f, scr, lane);
                else transpose_item(w_ukv + (size_t)j * 128 * 2048, 2048, 64 * kb, n0, WUV + (size_t)j * 1024 * 128, 128, head * 64 + r0 - 64, 1.f, scr, lane);
                continue; } r -= 2 * I_UKV;
            if (r < 2 * I_O) { const int j = r / I_O, q = r % I_O, kb = q / 32, nb = q % 32;
                transpose_item(w_o + (size_t)j * 1024 * 1024, 1024, 64 * kb, 32 * nb, WO + (size_t)j * 1024 * 1024, 1024, 32 * nb, 1.f, scr, lane); continue; } r -= 2 * I_O;
            { const int jg = r / I_P, q = r % I_P, kb = q / 8, nb = q % 8;
                transpose_item(pool_w + (size_t)jg * 65536, 256, 64 * kb, 32 * nb, WP + (size_t)jg * 65536, 256, 32 * nb, 1.f, scr, lane); }
        }
        SEAM(0);
    }

    for (int l = 0; l < DEPTH; ++l) {
        const int pb = 1 + PPL * l, j = l >> 1;
        tid = opaque(threadIdx.x); lane = tid & 63; wave = __builtin_amdgcn_readfirstlane(tid >> 6); gw = vcu * NWAVES + wave; scr = (LAS float*)(lds + RING_OFF + wave * SCR_WAVE);
        const bool mla = (l & 1) == 0;
#define MOE_CONV_DECODE(it, C) do { const int cl = l + ((it) >= 12288 ? 1 : 0); int r = (it) - ((it) >= 12288 ? 12288 : 0); \
            if (r < 8192) { const int which = r >> 12, q = r & 4095, e = q >> 6, kb = (q >> 2) & 15, nb = q & 3; const int n0 = 64 * nb; \
                C.src = (which ? w3 : w1) + ((size_t)cl * 64 + e) * 1024 * 256 + (size_t)(64 * kb) * 256 + n0; C.ldw = 256; \
                C.dst = W13L(cl) + (size_t)e * 512 * 1024 + (size_t)((n0 >> 7) * 256 + (n0 & 127) + which * 128) * 1024 + 64 * kb; C.ldt = 1024; } \
            else { r -= 8192; const int e = r >> 6, kb = (r >> 4) & 3, nb = r & 15; \
                C.src = w2 + ((size_t)cl * 64 + e) * 256 * 1024 + (size_t)(64 * kb) * 1024 + 64 * nb; C.ldw = 1024; \
                C.dst = W2TL(cl) + (size_t)e * 1024 * 256 + (size_t)(64 * nb) * 256 + 64 * kb; C.ldt = 256; } } while (0)

        if (mla) {
            if (PHON(0) && IN(pb + 0)) {
                for (int rep = 0; rep < NREP(0); ++rep) { if (rep) __syncthreads();
                pg8::Gemm g{2048, 1024, 1024}; pg8::DenseOrder S; S.init(NTOK, 512, G, bx, XHL, (size_t)256 * 2048 * 2, 0, WIN + (size_t)j * 512 * 1024, (size_t)256 * 1024 * 2);
                if (G == 256) { pg8::EpiLatNorm E{CQ, CKV, KR, q_norm + j * 256, kv_norm + j * 128, COS, SIN};
                    pg8::gemm_phase<pg8::EpiLatNorm, pg8::DenseOrder, true>(lds + RING_OFF, g, S, E); }
                else { pg8::EpiF32 E{LATB, 512};
                    pg8::gemm_phase<pg8::EpiF32, pg8::DenseOrder, true>(lds + RING_OFF, g, S, E); }
                }
                SEAM(pb + 0);
            }
            if (PHON(1) && IN(pb + 1) && G != 256) {
                const float* gq = q_norm + j * 256; const float* gk = kv_norm + j * 128;
                const f32x4 gqv = *(const f32x4*)(gq + 4 * lane); const f32x4 gkv = *(const f32x4*)(gk + 4 * (lane & 31));
                for (int m = gw; m < NTOK; m += NGW) {
                    const float* lr = LATB + (size_t)m * 512;
                    const f32x4 a = *(const f32x4*)(lr + 4 * lane), c = *(const f32x4*)(lr + 256 + 4 * lane);
                    const float sq = wave_sum(a.x * a.x + a.y * a.y + a.z * a.z + a.w * a.w);
                    const float sk = wave_sum(lane < 32 ? (c.x * c.x + c.y * c.y + c.z * c.z + c.w * c.w) : 0.f);
                    const float rq = 1.0f / sqrtf(sq * (1.f / 256.f) + RMS_EPS), rk = 1.0f / sqrtf(sk * (1.f / 128.f) + RMS_EPS);
                    { u32x2 o; o.x = cvtpk(a.x * rq * gqv.x, a.y * rq * gqv.y); o.y = cvtpk(a.z * rq * gqv.z, a.w * rq * gqv.w); *((u32x2*)(CQ + (size_t)m * 256) + lane) = o; }
                    if (lane < 32) { u32x2 o; o.x = cvtpk(c.x * rk * gkv.x, c.y * rk * gkv.y); o.y = cvtpk(c.z * rk * gkv.z, c.w * rk * gkv.w); *((u32x2*)(CKV + (size_t)m * 128) + lane) = o; }
                    f32x4 p; p.x = __shfl_xor(c.x, 4); p.y = __shfl_xor(c.y, 4); p.z = __shfl_xor(c.z, 4); p.w = __shfl_xor(c.w, 4);
                    if (lane >= 32 && lane < 40) {
                        const f32x4 cv = *(const f32x4*)(COS + (size_t)m * 16 + 4 * (lane & 3)), sv = *(const f32x4*)(SIN + (size_t)m * 16 + 4 * (lane & 3));
                        f32x4 y; if (lane < 36) y = c * cv - p * sv; else y = c * cv + p * sv;
                        u32x2 o; o.x = cvtpk(y.x, y.y); o.y = cvtpk(y.z, y.w); *((u32x2*)(KR + (size_t)m * 32) + (lane - 32)) = o;
                    }
                }
                SEAM(pb + 1);
            }
            if (PHON(2) && IN(pb + 2)) {
                for (int rep = 0; rep < NREP(2); ++rep) {
                { pg8::Gemm g{256, 256, 256}; pg8::DenseOrder S; S.init(NTOK, 1536, G, bx, CQ, (size_t)256 * 256 * 2, 0, WUQ + (size_t)j * 1536 * 256, (size_t)256 * 256 * 2);
                  pg8::EpiQ E{QB, COS, SIN};
                  pg8::gemm_phase<pg8::EpiQ, pg8::DenseOrder, true>(lds + RING_OFF, g, S, E); }
                { pg8::Gemm g{128, 128, 128}; pg8::DenseOrder S; S.init(NTOK, 1024, G, bx, CKV, (size_t)256 * 128 * 2, 0, WUK + (size_t)j * 1024 * 128, (size_t)256 * 128 * 2);
                  pg8::EpiBf16 E{KN, 1024};
                  pg8::gemm_phase<pg8::EpiBf16, pg8::DenseOrder, true>(lds + RING_OFF, g, S, E); }
                { pg8::Gemm g{128, 128, 128}; pg8::DenseOrder S; S.init(1024, NTOK, G, bx, WUV + (size_t)j * 1024 * 128, (size_t)256 * 128 * 2, 0, CKV, (size_t)256 * 128 * 2);
                  pg8::EpiBf16 E{VT, (size_t)NTOK};
                  pg8::gemm_phase<pg8::EpiBf16, pg8::DenseOrder, true>(lds + RING_OFF, g, S, E); }
                }
                SEAM(pb + 2);
            }
            if (PHON(3) && IN(pb + 3)) {
                for (int rep = 0; rep < NREP(3); ++rep) {
                int cj = 0;
                for (int i = 0;; ++i) {
                    const int L = i * G + vcu; if (L >= 2048) break;
                    const int sl = L & 255, rnd = L >> 8, s = sl & 7, bh = (sl >> 3) + 32 * (rnd >> 2), k = rnd & 3;
                    const int qb = (k == 0) ? s : (k == 1) ? 15 - s : (k == 2) ? 16 + s : 31 - s;
                    att::attn_unit(bh >> 4, bh & 15, qb, QB, KN, KR, VT, OB, lds + RING_OFF);
                    if (rep == 0 && i < 6) {
                        int it0 = gw + cj * NGW, it1 = it0 + NGW; cj += 2;
                        it0 = it0 < 2 * 12288 ? it0 : 2 * 12288 - 1; it1 = it1 < 2 * 12288 ? it1 : 2 * 12288 - 1;
                        ConvItem c0, c1; f32x4 v0[16], v1[16];
                        MOE_CONV_DECODE(it0, c0); conv_load(c0, v0, lane);
                        MOE_CONV_DECODE(it1, c1); conv_load(c1, v1, lane);
                        conv_finish(c0, v0, scr, lane);
                        conv_finish(c1, v1, scr, lane);
                        __syncthreads();
                    }
                }
                if (rep == 0) { for (;; ++cj) { const int it = gw + cj * NGW; if (it >= 2 * 12288) break; ConvItem c0; f32x4 v0[16]; MOE_CONV_DECODE(it, c0); conv_load(c0, v0, lane); conv_finish(c0, v0, scr, lane); } __syncthreads(); }
                }
                SEAM(pb + 3);
            }
            if (PHON(4) && IN(pb + 4)) {
                for (int rep = 0; rep < NREP(4); ++rep) {
                pg8::Gemm g{1024, 1024, 1024}; pg8::DenseOrder S; S.init(NTOK, 1024, G, bx, OB, (size_t)256 * 1024 * 2, 0, WO + (size_t)j * 1024 * 1024, (size_t)256 * 1024 * 2);
                pg8::EpiBf16 E{FB, 1024};
                pg8::gemm_phase<pg8::EpiBf16, pg8::DenseOrder, true>(lds + RING_OFF, g, S, E);
                }
                SEAM(pb + 4);
            }
        } else {
            if (PHON(13) && IN(pb + 0)) {
                for (int rep = 0; rep < NREP(13); ++rep) {
                for (int it = gw; it < 2 * (NTOK / 32); it += NGW) {
                    const int q = it & 1, t0 = (it >> 1) * 32, s0 = t0 & (SEQ - 1), grp = 2 * q + (lane >> 5), win = 2 << grp;
                    const bf16_t* xb = XHL + grp * 256 + 8 * (lane & 31);
                    bf16_t* pout = POOLED + grp * 256 + 8 * (lane & 31);
                    f32x4 Sa = {0.f, 0.f, 0.f, 0.f}, Sb = {0.f, 0.f, 0.f, 0.f};
#pragma unroll
                    for (int jj = 1; jj < 16; ++jj) { if (jj < win && s0 - jj >= 0) { const F8 r = bf8(*(const u32x4*)(xb + (size_t)(t0 - jj) * 2048)); Sa += r.a; Sb += r.b; } }
                    for (int tb = 0; tb < 32; tb += 8) {
                        u32x4 xn[8], xe[8];
#pragma unroll
                        for (int i = 0; i < 8; ++i) { const int t = t0 + tb + i; xn[i] = *(const u32x4*)(xb + (size_t)t * 2048);
                            xe[i] = (s0 + tb + i - win + 1 >= 0) ? *(const u32x4*)(xb + (size_t)(t - win + 1) * 2048) : (u32x4){0u, 0u, 0u, 0u}; }
#pragma unroll
                        for (int i = 0; i < 8; ++i) { const int sI = s0 + tb + i; const F8 xv = bf8(xn[i]), ev = bf8(xe[i]);
                            Sa += xv.a; Sb += xv.b;
                            const float rc = 1.0f / (float)((sI + 1 < win) ? sI + 1 : win);
                            *(u32x4*)(pout + (size_t)(t0 + tb + i) * 1024) = pk8(Sa * rc - xv.a, Sb * rc - xv.b);
                            Sa -= ev.a; Sb -= ev.b; }
                    }
                }
                }
                SEAM(pb + 0);
            }
            if (PHON(14) && IN(pb + 1)) {
                for (int rep = 0; rep < NREP(14); ++rep) {
                pg8::Gemm g{1024, 256, 256}; pg8::DenseOrder S; S.init(NTOK, 1024, G, bx, POOLED, (size_t)256 * 1024 * 2, (size_t)256 * 2, WP + (size_t)j * 4 * 65536, (size_t)65536 * 2);
                pg8::EpiPool E{FB, pool_b + j * 1024, pool_scale + j * 1024};
                pg8::gemm_phase<pg8::EpiPool, pg8::DenseOrder, true>(lds + RING_OFF, g, S, E);
                }
                SEAM(pb + 1);
            }
        }
        if (PHON(5) && IN(pb + 5)) {
                for (int rep = 0; rep < NREP(5); ++rep) {
            f32x4 gv[4], bv[4];
#pragma unroll
            for (int jj = 0; jj < 4; ++jj) { const int c = 8 * lane + 512 * (jj >> 1) + 4 * (jj & 1); gv[jj] = *(const f32x4*)(ln_g + (size_t)(l * 2 + 0) * 1024 + c); bv[jj] = *(const f32x4*)(ln_b + (size_t)(l * 2 + 0) * 1024 + c); }
            for (int m = gw; m < NTOK; m += NGW) {
                u32x4* xh = (u32x4*)(XHL + (size_t)m * 2048) + lane; const u32x4* fr2 = (const u32x4*)(FB + (size_t)m * 1024) + lane;
                const F8 x0 = bf8(xh[0]), x1 = bf8(xh[64]), f0 = bf8(fr2[0]), f1 = bf8(fr2[64]);
                f32x4 v[4] = {x0.a * DN_ALPHA + f0.a, x0.b * DN_ALPHA + f0.b, x1.a * DN_ALPHA + f1.a, x1.b * DN_ALPHA + f1.b}; float s = 0.f;
#pragma unroll
                for (int jj = 0; jj < 4; ++jj) s += (v[jj].x + v[jj].y) + (v[jj].z + v[jj].w);
                const float mean = wave_sum(s) * (1.f / 1024.f); float s2 = 0.f;
#pragma unroll
                for (int jj = 0; jj < 4; ++jj) { v[jj] = v[jj] - mean; s2 += (v[jj].x * v[jj].x + v[jj].y * v[jj].y) + (v[jj].z * v[jj].z + v[jj].w * v[jj].w); }
                const float rstd = 1.0f / sqrtf(wave_sum(s2) * (1.f / 1024.f) + LN_EPS);
#pragma unroll
                for (int jj = 0; jj < 4; ++jj) v[jj] = v[jj] * rstd * gv[jj] + bv[jj];
#pragma unroll
                for (int j = 0; j < 2; ++j) { const u32x4 h = pk8(v[2 * j], v[2 * j + 1]); const F8 hf = bf8(h);
                    xh[64 * j] = h; xh[128 + 64 * j] = pk8(v[2 * j] - hf.a, v[2 * j + 1] - hf.b); }
            }
            }
                SEAM(pb + 5);
        }
        if (PHON(6) && IN(pb + 6)) {
                for (int rep = 0; rep < NREP(6); ++rep) {
            pg8::Gemm g{2048, 1024, 1024}; pg8::DenseOrder S; S.init(NTOK, 512, G, bx, XHL, (size_t)256 * 2048 * 2, (size_t)1024 * 2, WR + (size_t)l * 2 * 256 * 1024, (size_t)256 * 1024 * 2);
            pg8::EpiRouter E{LG};
            pg8::gemm_phase<pg8::EpiRouter, pg8::DenseOrder, true>(lds + RING_OFF, g, S, E);
            }
                SEAM(pb + 6);
        }
        if (PHON(7) && IN(pb + 7)) {
            for (int rep = 0; rep < NREP(7); ++rep) {
            LAS int* hist = (LAS int*)(lds + RING_OFF); LAS int* cbase = hist + 64;
            const float* bg = b_grp + l * 8; const float* be = b_exp + l * 64;
            unsigned* gcnt = ctl + CW_GCNT + 64 * l;
            for (int c = bx; c < 256; c += G) {
                if (tid < 64) hist[tid] = 0;
                __syncthreads();
                int ex1 = 0, ex2 = 0, p1 = 0, p2 = 0; float ga1 = 0.f, ga2 = 0.f;
                const int t = c * 128 + tid;
                if (tid < 128) {
                    const float* lg = LG + (size_t)t * LGP;
                    const float* lg2 = lg + (size_t)NTOK * LGP;
                    const f32x4 g0 = *(const f32x4*)lg + *(const f32x4*)lg2, g1 = *(const f32x4*)(lg + 4) + *(const f32x4*)(lg2 + 4);
                    float gl[8] = {g0.x + bg[0], g0.y + bg[1], g0.z + bg[2], g0.w + bg[3], g1.x + bg[4], g1.y + bg[5], g1.z + bg[6], g1.w + bg[7]};
                    int gs = 0; float gm = gl[0];
#pragma unroll
                    for (int i = 1; i < 8; ++i) if (gl[i] > gm) { gm = gl[i]; gs = i; }
                    float se = 0.f;
#pragma unroll
                    for (int i = 0; i < 8; ++i) se += __expf(gl[i] - gm);
                    const float ggate = 1.0f / se;
                    const f32x4 e0 = *(const f32x4*)(lg + 8 + gs * 8) + *(const f32x4*)(lg2 + 8 + gs * 8), e1 = *(const f32x4*)(lg + 12 + gs * 8) + *(const f32x4*)(lg2 + 12 + gs * 8);
                    const f32x4 b0 = *(const f32x4*)(be + gs * 8), b1 = *(const f32x4*)(be + gs * 8 + 4);
                    float el[8] = {e0.x + b0.x, e0.y + b0.y, e0.z + b0.z, e0.w + b0.w, e1.x + b1.x, e1.y + b1.y, e1.z + b1.z, e1.w + b1.w};
                    int i1 = 0; float m1 = el[0];
#pragma unroll
                    for (int i = 1; i < 8; ++i) if (el[i] > m1) { m1 = el[i]; i1 = i; }
                    int i2 = -1; float m2 = -INFINITY;
#pragma unroll
                    for (int i = 0; i < 8; ++i) if (i != i1 && el[i] > m2) { m2 = el[i]; i2 = i; }
                    const float x2 = __expf(m2 - m1), rs = 1.0f / (1.0f + x2);
                    ex1 = gs * 8 + i1; ex2 = gs * 8 + i2; ga1 = ggate * rs; ga2 = ggate * x2 * rs;
                    p1 = __hip_atomic_fetch_add(&hist[ex1], 1, __ATOMIC_RELAXED, __HIP_MEMORY_SCOPE_WORKGROUP); p2 = __hip_atomic_fetch_add(&hist[ex2], 1, __ATOMIC_RELAXED, __HIP_MEMORY_SCOPE_WORKGROUP);
                }
                __syncthreads();
                if (tid < 64) { const int n = hist[tid]; cbase[tid] = n ? (int)__hip_atomic_fetch_add(gcnt + tid, (unsigned)n, __ATOMIC_RELAXED, __HIP_MEMORY_SCOPE_AGENT) : 0; }
                __syncthreads();
                if (tid < 128) {
                    const size_t i1 = (size_t)ex1 * pg8::LIST_CAP + cbase[ex1] + p1, i2 = (size_t)ex2 * pg8::LIST_CAP + cbase[ex2] + p2;
                    ROWLIST[i1] = 2 * t; LGATE[i1] = ga1; ROWLIST[i2] = 2 * t + 1; LGATE[i2] = ga2;
                }
                __syncthreads();
            }
            }
            SEAM(pb + 7);
        }
#define MOE_TILE_TABLE() \
            LAS int* tinfo = (LAS int*)(lds + TINFO_OFF); \
            __syncthreads(); \
            if (tid < 64) tinfo[pg8::TI_CNT + tid] = (int)__hip_atomic_load(ctl + CW_GCNT + 64 * l + tid, __ATOMIC_RELAXED, __HIP_MEMORY_SCOPE_AGENT); \
            __syncthreads(); \
            if (tid == 0) { int tt = 0; for (int e = 0; e < 64; ++e) { const int n = (tinfo[pg8::TI_CNT + e] + 255) >> 8; for (int i = 0; i < n && tt < MAX_TILES; ++i) tinfo[tt++] = e | (i << 8); } tinfo[pg8::TI_CNT + 64] = tt; } \
            __syncthreads(); \
            const int ntl = tinfo[pg8::TI_CNT + 64];
        if (PHON(9) && IN(pb + 9)) {
            for (int rep = 0; rep < NREP(9); ++rep) {
            MOE_TILE_TABLE();
            pg8::Gemm g{2048, 1024, 1024}; pg8::GatherOrder S; S.init(tinfo, ntl, 2, G, bx, XHL, ROWLIST, W13L(l), (size_t)512 * 1024 * 2, (size_t)256 * 1024 * 2);
            { pg8::Unit uu;
              for (int ui = 0; ui < pg8::MOE_LDS_UNITS; ++ui) if (S.next(ui, uu) && tid < 256) tinfo[pg8::TI_ROWOFF + ui * 256 + tid] = (int)S.row_off(uu, tid, 2048);
              __syncthreads(); }
            pg8::EpiSwiglu E{HS};
            pg8::gemm_phase<pg8::EpiSwiglu, pg8::GatherOrder, true>(lds + RING_OFF, g, S, E);
            }
            SEAM(pb + 9);
        }
        if (PHON(10) && IN(pb + 10)) {
            for (int rep = 0; rep < NREP(10); ++rep) {
            MOE_TILE_TABLE();
            pg8::Gemm g{256, 256, 256}; pg8::MoeOrder S; S.init(tinfo, ntl, 4, G, bx, HS, (size_t)256 * 256 * 2, W2TL(l), (size_t)1024 * 256 * 2, (size_t)256 * 256 * 2);
            { pg8::Unit uu;
              for (int ui = 0; ui < pg8::MOE_LDS_UNITS; ++ui) if (S.next(ui, uu) && tid < 256) {
                  const int ti = tinfo[uu.pm], e = ti & 255, r = (ti >> 8) * 256 + tid; const bool ok = r < tinfo[pg8::TI_CNT + e]; const size_t li = (size_t)e * pg8::LIST_CAP + r;
                  tinfo[pg8::TI_ROWOFF + ui * 256 + tid] = ok ? ROWLIST[li] : 0; tinfo[pg8::TI_ROWOFF + pg8::MOE_LDS_UNITS * 256 + ui * 256 + tid] = ok ? __float_as_int(LGATE[li]) : 0; }
              __syncthreads(); }
            pg8::EpiMoeOut E{YB, tinfo, ROWLIST, LGATE};
            pg8::gemm_phase<pg8::EpiMoeOut, pg8::MoeOrder, true>(lds + RING_OFF, g, S, E);
            }
            SEAM(pb + 10);
        }
        if (PHON(11) && IN(pb + 11)) {
            f32x4 gv[4], bv[4];
#pragma unroll
            for (int jj = 0; jj < 4; ++jj) { const int c = 8 * lane + 512 * (jj >> 1) + 4 * (jj & 1); gv[jj] = *(const f32x4*)(ln_g + (size_t)(l * 2 + 1) * 1024 + c); bv[jj] = *(const f32x4*)(ln_b + (size_t)(l * 2 + 1) * 1024 + c); }
            const bool lastl = (l == DEPTH - 1);
            for (int m = gw; m < NTOK; m += NGW) {
                u32x4* xh = (u32x4*)(XHL + (size_t)m * 2048) + lane;
                const u32x4* y0 = (const u32x4*)(YB + (size_t)(2 * m) * 1024) + lane; const u32x4* y1 = (const u32x4*)(YB + (size_t)(2 * m + 1) * 1024) + lane;
                const F8 x0 = bf8(xh[0]), x1 = bf8(xh[64]), a0 = bf8(y0[0]), a1 = bf8(y0[64]), c0 = bf8(y1[0]), c1 = bf8(y1[64]);
                f32x4 v[4] = {x0.a * DN_ALPHA + (a0.a + c0.a), x0.b * DN_ALPHA + (a0.b + c0.b), x1.a * DN_ALPHA + (a1.a + c1.a), x1.b * DN_ALPHA + (a1.b + c1.b)}; float s = 0.f;
#pragma unroll
                for (int jj = 0; jj < 4; ++jj) s += (v[jj].x + v[jj].y) + (v[jj].z + v[jj].w);
                const float mean = wave_sum(s) * (1.f / 1024.f); float s2 = 0.f;
#pragma unroll
                for (int jj = 0; jj < 4; ++jj) { v[jj] = v[jj] - mean; s2 += (v[jj].x * v[jj].x + v[jj].y * v[jj].y) + (v[jj].z * v[jj].z + v[jj].w * v[jj].w); }
                const float rstd = 1.0f / sqrtf(wave_sum(s2) * (1.f / 1024.f) + LN_EPS);
#pragma unroll
                for (int jj = 0; jj < 4; ++jj) v[jj] = v[jj] * rstd * gv[jj] + bv[jj];
                if (lastl) { f32x4* orow = (f32x4*)(kargs()->out + (size_t)m * 1024) + 2 * lane;
                    orow[0] = v[0]; orow[1] = v[1]; orow[128] = v[2]; orow[129] = v[3];
                } else { xh[0] = pk8(v[0], v[1]); xh[64] = pk8(v[2], v[3]); }
            }
            SEAM(pb + 11);
        }
    }
#undef IN
#undef SEAM
}
#undef ws
#undef in_x
#undef in_pos
#undef ln_g
#undef ln_b
#undef w_in
#undef q_norm
#undef w_uq
#undef kv_norm
#undef w_ukv
#undef w_o
#undef pool_w
#undef pool_b
#undef pool_scale
#undef w_grp
#undef b_grp
#undef w_exp
#undef b_exp
#undef w1
#undef w3
#undef w2
#undef COS
#undef SIN
#undef CNT
#undef TILE
#undef AE
#undef APOS
#undef AG
#undef RSLOT
#undef RGATE
#undef WIN
#undef WUQ
#undef WUK
#undef WUV
#undef WO
#undef WP
#undef WR
#undef W13L
#undef W2TL
#undef FB
#undef XHL
#undef LATB
#undef CQ
#undef CKV
#undef KR
#undef QB
#undef KN
#undef VT
#undef OB
#undef POOLED
#undef LG
#undef ROWLIST
#undef LGATE
#undef HS
#undef YB

static bool phase_exists(int p) {
    if (p == 0) return true;
    const int l = (p - 1) / PPL, k = (p - 1) % PPL;
    if (k == 8) return false;
    if (k >= 5) return true;
    return (l & 1) == 0 ? true : (k < 2);
}
extern "C" void kernel_launch(void* const* d_in, const int* in_sizes, int n_in, void* d_out, int out_size, void* d_ws, size_t ws_size, hipStream_t stream) {
    static int grid = 0;
    if (grid == 0) {
        if (n_in != 20 || in_sizes[0] != NTOK * D_MODEL || out_size != NTOK * D_MODEL || ws_size < WS_END) { fprintf(stderr, "kernel_launch: unexpected shapes / workspace (%zu < %zu)\n", ws_size, (size_t)WS_END); grid = -1; return; }
        int dev = 0, cus = 0, per_cu = 0;
        if (hipGetDevice(&dev) != hipSuccess || hipDeviceGetAttribute(&cus, hipDeviceAttributeMultiprocessorCount, dev) != hipSuccess) { grid = -1; return; }
        if (hipFuncSetAttribute((const void*)mk_fwd, hipFuncAttributeMaxDynamicSharedMemorySize, LDS_BYTES) != hipSuccess) { fprintf(stderr, "kernel_launch: hipFuncSetAttribute failed\n"); grid = -1; return; }
        if (hipOccupancyMaxActiveBlocksPerMultiprocessor(&per_cu, (const void*)mk_fwd, NWAVES * 64, LDS_BYTES) != hipSuccess || per_cu < 1) fprintf(stderr, "kernel_launch: occupancy query reports %d\n", per_cu);
        (void)hipGetLastError();
        grid = cus;
    }
    if (grid < 0) return;
    if (hipMemsetAsync((char*)d_ws + WS_CTL, 0, CTL_ZERO_BYTES, stream) != hipSuccess) return;
    Args a{};
    for (int i = 0; i < 20; ++i) a.in[i] = d_in[i];
    a.out = (float*)d_out; a.ws = (unsigned char*)d_ws;
#if MK_ONE_LAUNCH
    a.ph_lo = 0; a.ph_hi = NPHASE;
    hipLaunchKernelGGL(mk_fwd, dim3(grid), dim3(NWAVES * 64), LDS_BYTES, stream, a);
#else
    for (int p = 0; p < NPHASE; ++p) {
        if (!phase_exists(p)) continue;
        a.ph_lo = p; a.ph_hi = p + 1;
        hipLaunchKernelGGL(mk_fwd, dim3(grid), dim3(NWAVES * 64), LDS_BYTES, stream, a);
    }
#endif
}
```

```cpp
#include <hip/hip_runtime.h>
#include <cstdio>
#include <cstdint>

#ifndef MK_ONE_LAUNCH
#define MK_ONE_LAUNCH 1
#endif

#define LAS __attribute__((address_space(3)))
#define GAS __attribute__((address_space(1)))

constexpr int D_MODEL = 1024, BATCH = 4, SEQ = 8192, DEPTH = 4, NTOK = BATCH * SEQ;
constexpr int N_HEADS = 16, QK_NOPE = 64, QK_ROPE = 32, V_HEAD = 64, Q_LORA = 256, KV_LORA = 128, LAT = Q_LORA + KV_LORA + QK_ROPE;
constexpr int QPITCH = N_HEADS * (QK_NOPE + QK_ROPE);
constexpr int N_GROUPS = 8, EPG = 8, N_EXPERTS = 64, D_EXPERT = 256;
constexpr int MAX_TILES = 320;
constexpr float DN_ALPHA = 1.681792830507429f;
constexpr float LN_EPS = 1e-5f, RMS_EPS = 1e-6f;
constexpr float QSCALE = 0.14724444602590306f;
constexpr int LGP = 80;

constexpr size_t MiB = 1u << 20;
constexpr size_t WS_CTL = 0, CTL_ZERO_BYTES = 1 * MiB;
constexpr size_t WS_COS = 1 * MiB, WS_SIN = 3 * MiB;
constexpr size_t WS_CNT = 5 * MiB;
constexpr size_t WS_TILE = 5 * MiB + 65536;
constexpr size_t WS_AE = 5 * MiB + 131072, WS_APOS = WS_AE + 262144, WS_AG = WS_APOS + 262144;
constexpr size_t WS_RSLOT = 6 * MiB, WS_RGATE = 6 * MiB + 512 * 1024;
constexpr size_t WS_WIN = 8 * MiB;
constexpr size_t WS_WUQ = 10 * MiB;
constexpr size_t WS_WUK = 12 * MiB;
constexpr size_t WS_WUV = 13 * MiB;
constexpr size_t WS_WO = 14 * MiB;
constexpr size_t WS_WP = 18 * MiB;
constexpr size_t WS_WR = 19 * MiB;
constexpr size_t WS_W13 = 24 * MiB;
constexpr size_t WS_W2T = 88 * MiB;
constexpr size_t WS_W13B = 184 * MiB;
constexpr size_t WS_W2TB = 760 * MiB;
constexpr size_t WS_FB = 120 * MiB;
constexpr size_t WS_XHL = 248 * MiB;
constexpr size_t WS_R1 = 376 * MiB;
constexpr size_t WS_LAT = WS_R1;
constexpr size_t WS_CQ = WS_R1 + 64 * MiB;
constexpr size_t WS_CKV = WS_R1 + 80 * MiB;
constexpr size_t WS_KR = WS_R1 + 88 * MiB;
constexpr size_t WS_Q = WS_R1 + 92 * MiB;
constexpr size_t WS_KN = WS_R1 + 188 * MiB;
constexpr size_t WS_VT = WS_R1 + 252 * MiB;
constexpr size_t WS_O = WS_R1 + 316 * MiB;
constexpr size_t WS_POOLED = WS_R1;
constexpr size_t WS_LG = WS_R1;
constexpr size_t WS_LIST = WS_R1 + 20 * MiB;
constexpr size_t WS_LGATE = WS_R1 + 36 * MiB;
constexpr size_t WS_HS = WS_R1 + 180 * MiB;
constexpr size_t WS_Y = WS_R1 + 220 * MiB;
constexpr size_t WS_END = 792 * MiB;
static_assert(WS_O + 64 * MiB <= WS_END && WS_Y + 128 * MiB <= WS_END, "ws map");

constexpr int CW_TMO = 0, CW_CODE = 1, CW_BAR = 4096, CW_GCNT = 16384;

constexpr int RING_OFF = 0, RING_BYTES = 131072, SCR_WAVE = 17408;
constexpr int LDSCTL_OFF = 8 * SCR_WAVE, MISC_OFF = LDSCTL_OFF + 320, TINFO_OFF = LDSCTL_OFF + 1024;
constexpr int LDS_BYTES = 155648;
static_assert(TINFO_OFF + (512 + 2 * 5 * 256) * 4 <= LDS_BYTES && LDS_BYTES <= 163840, "LDS map");

typedef unsigned short bf16_t;
typedef short bf16x8 __attribute__((ext_vector_type(8)));
typedef float f32x4 __attribute__((ext_vector_type(4)));
typedef float f32x16 __attribute__((ext_vector_type(16)));
typedef unsigned u32x4 __attribute__((ext_vector_type(4)));
typedef unsigned u32x2 __attribute__((ext_vector_type(2)));
typedef float f32x2_t __attribute__((ext_vector_type(2)));
typedef __bf16 bf16x2_t __attribute__((ext_vector_type(2)));
#define RLX_AGENT __ATOMIC_RELAXED, __HIP_MEMORY_SCOPE_AGENT
#define LDS_WAIT() asm volatile("s_waitcnt lgkmcnt(0)" ::: "memory")
#define VM_WAIT() asm volatile("s_waitcnt vmcnt(0)" ::: "memory")

__device__ __forceinline__ unsigned cvtpk(float lo, float hi) { f32x2_t v = {lo, hi}; bf16x2_t b = __builtin_convertvector(v, bf16x2_t); return __builtin_bit_cast(unsigned, b); }
__device__ __forceinline__ int opaque(int x) { asm volatile("" : "+v"(x)); return x; }
__device__ __forceinline__ int opaque_s(int x) { asm volatile("" : "+s"(x)); return x; }
__device__ __forceinline__ float bflo(unsigned u) { return __uint_as_float(u << 16); }
__device__ __forceinline__ float bfhi(unsigned u) { return __uint_as_float(u & 0xffff0000u); }
__device__ __forceinline__ float wave_sum(float v) {
#pragma unroll
    for (int o = 1; o < 64; o <<= 1) v += __shfl_xor(v, o);
    return v;
}
__device__ __forceinline__ void split4(const f32x4 v, u32x2& h, u32x2& l) {
    h.x = cvtpk(v.x, v.y); h.y = cvtpk(v.z, v.w);
    l.x = cvtpk(v.x - bflo(h.x), v.y - bfhi(h.x)); l.y = cvtpk(v.z - bflo(h.y), v.w - bfhi(h.y));
}
__device__ __forceinline__ f32x4 join4(const u32x2 h, const u32x2 l) {
    return (f32x4){bflo(h.x) + bflo(l.x), bfhi(h.x) + bfhi(l.x), bflo(h.y) + bflo(l.y), bfhi(h.y) + bfhi(l.y)};
}
struct F8 { f32x4 a, b; };
__device__ __forceinline__ F8 bf8(const u32x4 w) { F8 r; r.a = (f32x4){bflo(w.x), bfhi(w.x), bflo(w.y), bfhi(w.y)}; r.b = (f32x4){bflo(w.z), bfhi(w.z), bflo(w.w), bfhi(w.w)}; return r; }
__device__ __forceinline__ u32x4 pk8(const f32x4 a, const f32x4 b) { u32x4 w; w.x = cvtpk(a.x, a.y); w.y = cvtpk(a.z, a.w); w.z = cvtpk(b.x, b.y); w.w = cvtpk(b.z, b.w); return w; }
__device__ __forceinline__ f32x4 bf4(const u32x2 h) { return (f32x4){bflo(h.x), bfhi(h.x), bflo(h.y), bfhi(h.y)}; }

namespace pg8 {
constexpr int BM = 256, BK = 64, HALF = 128, HTB = HALF * BK * 2, STAGE_BYTES = 8 * HTB, NXCD = 8, WGM = 8;
__host__ __device__ __forceinline__ int lds_byte(int r, int c) { const int st = (r >> 4) * 2 + (c >> 5), rr = r & 15, cc = c & 31, ob = rr * 64 + cc * 2; return st * 1024 + (ob ^ (((ob >> 9) & 1) << 5)); }
__host__ __device__ __forceinline__ void stage_rc(int b, int& R, int& C) { const int st = b / 1024, sb = b % 1024, swz = sb ^ (((sb >> 9) & 1) << 5); R = (st >> 1) * 16 + swz / 64; C = (st & 1) * 32 + (swz % 64) / 2; }
__host__ __device__ __forceinline__ int perm32(int rho) { const int n = rho >> 4, i = rho & 15; return 8 * (i >> 2) + 4 * n + (i & 3); }

struct Unit { int pm, pn, ui; };
struct Gemm { int lda, ldb, K; };

struct DenseOrder {
    int nM, nN, nwg, G, c;
    const char* A; const char* B; size_t a_pm, a_pn, b_pn;
    __device__ __forceinline__ void init(int M, int N, int G_, int c_, const void* A_, size_t a_pm_, size_t a_pn_, const void* B_, size_t b_pn_) {
        nM = M / BM; nN = N / BM; nwg = nM * nN; G = G_; c = c_; A = (const char*)A_; B = (const char*)B_; a_pm = a_pm_; a_pn = a_pn_; b_pn = b_pn_; }
    __device__ __forceinline__ bool next(int i, Unit& u) const {
        const long L = (long)i * G + c; if (L >= nwg) return false;
        int wgid = (int)L; { const int q = nwg / NXCD, r = nwg % NXCD, xcd = wgid % NXCD, off = wgid / NXCD; wgid = (xcd < r ? xcd * (q + 1) : r * (q + 1) + (xcd - r) * q) + off; }
        const int nig = WGM * nN, gid = wgid / nig, fm = gid * WGM, gsz = (nM - fm) < WGM ? (nM - fm) : WGM;
        u.pm = fm + ((wgid % nig) % gsz); u.pn = (wgid % nig) / gsz; u.ui = i; return true;
    }
    __device__ __forceinline__ const char* a_base(const Unit& u) const { return A + (size_t)u.pm * a_pm + (size_t)u.pn * a_pn; }
    __device__ __forceinline__ unsigned a_voff(const Unit&, int R, int C, int lda) const { return (unsigned)(R * lda + C) * 2u; }
    __device__ __forceinline__ const char* b_base(const Unit& u) const { return B + (size_t)u.pn * b_pn; }
};
constexpr int TI_CNT = 320, LIST_CAP = 65536, TI_ROWOFF = 512, MOE_LDS_UNITS = 5;
struct MoeOrder {
    const LAS int* tinfo; int ntiles, nN, nwg, G, c;
    const char* A; const char* W; size_t a_tile, w_e, w_pn;
    __device__ __forceinline__ void init(const LAS int* ti, int ntiles_, int nN_, int G_, int c_, const void* A_, size_t a_tile_, const void* W_, size_t w_e_, size_t w_pn_) {
        tinfo = ti; ntiles = ntiles_; nN = nN_; nwg = ntiles_ * nN_; G = G_; c = c_; A = (const char*)A_; a_tile = a_tile_; W = (const char*)W_; w_e = w_e_; w_pn = w_pn_; }
    __device__ __forceinline__ bool next(int i, Unit& u) const {
        const long L = (long)i * G + c; if (L >= nwg) return false;
        int wgid = (int)L; { const int q = nwg / NXCD, r = nwg % NXCD, xcd = wgid % NXCD, off = wgid / NXCD; wgid = (xcd < r ? xcd * (q + 1) : r * (q + 1) + (xcd - r) * q) + off; }
        u.pm = wgid / nN; u.pn = wgid % nN; u.ui = i; return true;
    }
    __device__ __forceinline__ const char* a_base(const Unit& u) const { return A + (size_t)u.pm * a_tile; }
    __device__ __forceinline__ const char* b_base(const Unit& u) const { const int e = __builtin_amdgcn_readfirstlane(tinfo[u.pm]) & 255; return W + (size_t)e * w_e + (size_t)u.pn * w_pn; }
    __device__ __forceinline__ unsigned a_voff(const Unit&, int R, int C, int lda) const { return (unsigned)(R * lda + C) * 2u; }
};
struct GatherOrder {
    const LAS int* tinfo; int ntiles, nN, nwg, G, c;
    const char* A; const int* list; const char* W; size_t w_e, w_pn; const LAS unsigned* rowoff;
    __device__ __forceinline__ void init(const LAS int* ti, int ntiles_, int nN_, int G_, int c_, const void* A_, const int* list_, const void* W_, size_t w_e_, size_t w_pn_) {
        rowoff = (const LAS unsigned*)(ti + TI_ROWOFF); tinfo = ti; ntiles = ntiles_; nN = nN_; nwg = ntiles_ * nN_; G = G_; c = c_; A = (const char*)A_; list = list_; W = (const char*)W_; w_e = w_e_; w_pn = w_pn_; }
    __device__ __forceinline__ bool next(int i, Unit& u) const {
        const long L = (long)i * G + c; if (L >= nwg) return false;
        int wgid = (int)L; { const int q = nwg / NXCD, r = nwg % NXCD, xcd = wgid % NXCD, off = wgid / NXCD; wgid = (xcd < r ? xcd * (q + 1) : r * (q + 1) + (xcd - r) * q) + off; }
        u.pm = wgid / nN; u.pn = wgid % nN; u.ui = i; return true;
    }
    __device__ __forceinline__ const char* a_base(const Unit&) const { return A; }
    __device__ __forceinline__ const char* b_base(const Unit& u) const { const int e = __builtin_amdgcn_readfirstlane(tinfo[u.pm]) & 255; return W + (size_t)e * w_e + (size_t)u.pn * w_pn; }
    __device__ __forceinline__ unsigned row_off(const Unit& u, int R, int lda) const {
        const int ti = tinfo[u.pm], e = ti & 255, r = (ti >> 8) * 256 + R; const int n = tinfo[TI_CNT + e];
        const int ga = (r < n) ? list[(size_t)e * LIST_CAP + r] : 0;
        return (unsigned)(ga >> 1) * (unsigned)(lda * 2); }
    __device__ __forceinline__ unsigned a_voff(const Unit& u, int R, int C, int lda) const {
        return (u.ui < MOE_LDS_UNITS ? rowoff[u.ui * 256 + R] : row_off(u, R, lda)) + (unsigned)C * 2u; }
};

#define ACC_T const f32x4 (&acc)[2][2][4][2]
__device__ __forceinline__ u32x4 pack_acc(const f32x4 v0, const f32x4 v1) { u32x4 w; w.x = cvtpk(v0[0], v0[1]); w.y = cvtpk(v0[2], v0[3]); w.z = cvtpk(v1[0], v1[1]); w.w = cvtpk(v1[2], v1[3]); return w; }
struct EpiBf16 {
    static constexpr bool PERM = true, AFTER_DRAIN = false;
    bf16_t* O; size_t ldc;
    __device__ __forceinline__ void operator()(ACC_T, const Unit& u, int wr, int wc, int fr, int fq) const {
        const int row0 = u.pm * BM + wr * 64 + fr, col0 = u.pn * BM + wc * 32 + 8 * fq;
#pragma unroll
        for (int ai = 0; ai < 2; ++ai)
#pragma unroll
            for (int m = 0; m < 4; ++m) { bf16_t* rowp = O + (size_t)(row0 + ai * HALF + m * 16) * ldc + col0;
#pragma unroll
                for (int bj = 0; bj < 2; ++bj) { const f32x4 v0 = acc[ai][bj][m][0], v1 = acc[ai][bj][m][1];
                    u32x4 w; w.x = cvtpk(v0[0], v0[1]); w.y = cvtpk(v0[2], v0[3]); w.z = cvtpk(v1[0], v1[1]); w.w = cvtpk(v1[2], v1[3]);
                    *(u32x4*)(rowp + bj * HALF) = w; } }
    }
};
struct EpiF32 {
    static constexpr bool PERM = false, AFTER_DRAIN = false;
    float* O; size_t ldc;
    __device__ __forceinline__ void operator()(ACC_T, const Unit& u, int wr, int wc, int fr, int fq) const {
        const int row0 = u.pm * BM + wr * 64 + fr, col0 = u.pn * BM + wc * 32 + 4 * fq;
#pragma unroll
        for (int ai = 0; ai < 2; ++ai)
#pragma unroll
            for (int m = 0; m < 4; ++m) { float* rowp = O + (size_t)(row0 + ai * HALF + m * 16) * ldc + col0;
#pragma unroll
                for (int bj = 0; bj < 2; ++bj)
#pragma unroll
                    for (int n = 0; n < 2; ++n) *(f32x4*)(rowp + bj * HALF + n * 16) = acc[ai][bj][m][n]; }
    }
};
struct EpiLatNorm {
    static constexpr bool PERM = true, AFTER_DRAIN = true;
    bf16_t* CQo; bf16_t* CKVo; bf16_t* KRo; const float* gq; const float* gk; const float* cs; const float* sn;
    __device__ __forceinline__ void fused(f32x4 (&acc)[2][2][4][2], const Unit& u, int wr, int wc, int fr, int fq, LAS unsigned char* lds, int lane) const {
        LAS float* P = (LAS float*)lds;
        const int nbj = (u.pn == 0) ? 2 : 1;
#pragma unroll
        for (int ai = 0; ai < 2; ++ai)
#pragma unroll
            for (int m = 0; m < 4; ++m) { float ss = 0.f;
#pragma unroll
                for (int bj = 0; bj < 2; ++bj) if (bj < nbj) {
#pragma unroll
                    for (int n = 0; n < 2; ++n) { const f32x4 v = acc[ai][bj][m][n]; ss += (v[0] * v[0] + v[1] * v[1]) + (v[2] * v[2] + v[3] * v[3]); } }
                ss += __shfl_xor(ss, 16); ss += __shfl_xor(ss, 32);
                if (fq == 0) P[(ai * HALF + wr * 64 + m * 16 + fr) * 4 + wc] = ss; }
        asm volatile("s_waitcnt lgkmcnt(0)" ::: "memory"); __builtin_amdgcn_s_barrier(); asm volatile("" ::: "memory");
        const float inv_dim = (u.pn == 0) ? (1.f / 256.f) : (1.f / 128.f);
#pragma unroll
        for (int ai = 0; ai < 2; ++ai)
#pragma unroll
            for (int m = 0; m < 4; ++m) { const int rl = ai * HALF + wr * 64 + m * 16 + fr; const size_t row = (size_t)u.pm * BM + rl;
                const f32x4 p4 = *(const LAS f32x4*)(P + rl * 4); const float rs = 1.0f / sqrtf(((p4[0] + p4[1]) + (p4[2] + p4[3])) * inv_dim + RMS_EPS);
                if (u.pn == 0) {
#pragma unroll
                    for (int bj = 0; bj < 2; ++bj) { const int col = bj * HALF + wc * 32 + 8 * fq; const f32x4 g0 = *(const f32x4*)(gq + col), g1 = *(const f32x4*)(gq + col + 4);
                        *(u32x4*)(CQo + row * 256 + col) = pack_acc(acc[ai][bj][m][0] * rs * g0, acc[ai][bj][m][1] * rs * g1); }
                } else {
                    { const int col = wc * 32 + 8 * fq; const f32x4 g0 = *(const f32x4*)(gk + col), g1 = *(const f32x4*)(gk + col + 4);
                      *(u32x4*)(CKVo + row * 128 + col) = pack_acc(acc[ai][0][m][0] * rs * g0, acc[ai][0][m][1] * rs * g1); }
                    if (wc == 0) {
                        const f32x4 v0 = acc[ai][1][m][0], v1 = acc[ai][1][m][1];
                        f32x4 q0, q1;
#pragma unroll
                        for (int e = 0; e < 4; ++e) { q0[e] = __shfl_xor(v0[e], 32); q1[e] = __shfl_xor(v1[e], 32); }
                        const int i0 = 8 * (fq & 1);
                        const f32x4 c0 = *(const f32x4*)(cs + row * 16 + i0), c1 = *(const f32x4*)(cs + row * 16 + i0 + 4), s0 = *(const f32x4*)(sn + row * 16 + i0), s1 = *(const f32x4*)(sn + row * 16 + i0 + 4);
                        const bool first = fq < 2;
                        const f32x4 y0 = first ? (v0 * c0 - q0 * s0) : (v0 * c0 + q0 * s0), y1 = first ? (v1 * c1 - q1 * s1) : (v1 * c1 + q1 * s1);
                        *(u32x4*)(KRo + row * 32 + 8 * fq) = pack_acc(y0, y1);
                    }
                } }
    }
};
struct EpiQ {
    static constexpr bool PERM = true, AFTER_DRAIN = false;
    bf16_t* Q; const float* cs; const float* sn;
    __device__ __forceinline__ void operator()(ACC_T, const Unit& u, int wr, int wc, int fr, int fq) const {
        const int row0 = u.pm * BM + wr * 64 + fr;
        if (u.pn < 4) {
#pragma unroll
            for (int ai = 0; ai < 2; ++ai)
#pragma unroll
                for (int m = 0; m < 4; ++m) { const int row = row0 + ai * HALF + m * 16;
#pragma unroll
                    for (int bj = 0; bj < 2; ++bj) { const int col = u.pn * BM + bj * HALF + wc * 32 + 8 * fq; const f32x4 v0 = acc[ai][bj][m][0], v1 = acc[ai][bj][m][1];
                        u32x4 w; w.x = cvtpk(v0[0], v0[1]); w.y = cvtpk(v0[2], v0[3]); w.z = cvtpk(v1[0], v1[1]); w.w = cvtpk(v1[2], v1[3]);
                        *(u32x4*)(Q + (size_t)row * QPITCH + (col >> 6) * 96 + (col & 63)) = w; } }
        } else {
            const int head = (u.pn - 4) * 8 + 2 * wc + (fq >> 1), i0 = 8 * (fq & 1);
#pragma unroll
            for (int ai = 0; ai < 2; ++ai)
#pragma unroll
                for (int m = 0; m < 4; ++m) { const int row = row0 + ai * HALF + m * 16;
                    const f32x4 c0 = *(const f32x4*)(cs + (size_t)row * 16 + i0), c1 = *(const f32x4*)(cs + (size_t)row * 16 + i0 + 4);
                    const f32x4 s0 = *(const f32x4*)(sn + (size_t)row * 16 + i0), s1 = *(const f32x4*)(sn + (size_t)row * 16 + i0 + 4);
                    const f32x4 a0 = acc[ai][0][m][0], a1 = acc[ai][0][m][1], b0 = acc[ai][1][m][0], b1 = acc[ai][1][m][1];
                    const f32x4 y10 = a0 * c0 - b0 * s0, y11 = a1 * c1 - b1 * s1, y20 = b0 * c0 + a0 * s0, y21 = b1 * c1 + a1 * s1;
                    u32x4 w1, w2; w1.x = cvtpk(y10[0], y10[1]); w1.y = cvtpk(y10[2], y10[3]); w1.z = cvtpk(y11[0], y11[1]); w1.w = cvtpk(y11[2], y11[3]);
                    w2.x = cvtpk(y20[0], y20[1]); w2.y = cvtpk(y20[2], y20[3]); w2.z = cvtpk(y21[0], y21[1]); w2.w = cvtpk(y21[2], y21[3]);
                    bf16_t* qp = Q + (size_t)row * QPITCH + head * 96 + 64 + i0;
                    *(u32x4*)qp = w1; *(u32x4*)(qp + 16) = w2; asm volatile("" ::: "memory"); }
        }
    }
};
struct EpiPool {
    static constexpr bool PERM = true, AFTER_DRAIN = false;
    bf16_t* F; const float* bias; const float* scale;
    __device__ __forceinline__ void operator()(ACC_T, const Unit& u, int wr, int wc, int fr, int fq) const {
        const int row0 = u.pm * BM + wr * 64 + fr, col0 = u.pn * BM + wc * 32 + 8 * fq;
#pragma unroll
        for (int bj = 0; bj < 2; ++bj) { const int c = col0 + bj * HALF;
            const f32x4 b0 = *(const f32x4*)(bias + c), b1 = *(const f32x4*)(bias + c + 4), s0 = *(const f32x4*)(scale + c), s1 = *(const f32x4*)(scale + c + 4);
#pragma unroll
            for (int ai = 0; ai < 2; ++ai)
#pragma unroll
                for (int m = 0; m < 4; ++m) { const f32x4 v0 = (acc[ai][bj][m][0] + b0) * s0, v1 = (acc[ai][bj][m][1] + b1) * s1;
                    u32x4 w; w.x = cvtpk(v0[0], v0[1]); w.y = cvtpk(v0[2], v0[3]); w.z = cvtpk(v1[0], v1[1]); w.w = cvtpk(v1[2], v1[3]);
                    *(u32x4*)(F + (size_t)(row0 + ai * HALF + m * 16) * 1024 + c) = w; } }
    }
};
struct EpiRouter {
    static constexpr bool PERM = false, AFTER_DRAIN = false;
    float* LG;
    __device__ __forceinline__ void operator()(ACC_T, const Unit& u, int wr, int wc, int fr, int fq) const {
        const int row0 = u.pm * BM + wr * 64 + fr;
#pragma unroll
        for (int ai = 0; ai < 2; ++ai)
#pragma unroll
            for (int m = 0; m < 4; ++m) { float* lr = LG + ((size_t)u.pn * NTOK + (size_t)(row0 + ai * HALF + m * 16)) * LGP;
#pragma unroll
                for (int n = 0; n < 2; ++n) { const int j = wc * 32 + 16 * n + 4 * fq; if (j < 72) *(f32x4*)(lr + j) = acc[ai][0][m][n] + acc[ai][1][m][n]; } }
    }
};
struct EpiSwiglu {
    static constexpr bool PERM = true, AFTER_DRAIN = false;
    bf16_t* H;
    __device__ __forceinline__ void operator()(ACC_T, const Unit& u, int wr, int wc, int fr, int fq) const {
        const int row0 = u.pm * BM + wr * 64 + fr, col0 = u.pn * HALF + wc * 32 + 8 * fq;
#pragma unroll
        for (int ai = 0; ai < 2; ++ai)
#pragma unroll
            for (int m = 0; m < 4; ++m) { float h[8];
#pragma unroll
                for (int n = 0; n < 2; ++n)
#pragma unroll
                    for (int e = 0; e < 4; ++e) { const float a = acc[ai][0][m][n][e], b = acc[ai][1][m][n][e];
                        h[n * 4 + e] = a * __builtin_amdgcn_rcpf(1.0f + __builtin_amdgcn_exp2f(-1.4426950408889634f * a)) * b; }
                u32x4 w; w.x = cvtpk(h[0], h[1]); w.y = cvtpk(h[2], h[3]); w.z = cvtpk(h[4], h[5]); w.w = cvtpk(h[6], h[7]);
                *(u32x4*)(H + (size_t)(row0 + ai * HALF + m * 16) * D_EXPERT + col0) = w; }
    }
};
struct EpiMoeOut {
    static constexpr bool PERM = true, AFTER_DRAIN = false;
    bf16_t* Y; const LAS int* tinfo; const int* list; const float* lgate;
    __device__ __forceinline__ void operator()(ACC_T, const Unit& u, int wr, int wc, int fr, int fq) const {
        const int ti = tinfo[u.pm], e = ti & 255, n = tinfo[TI_CNT + e], r0 = (ti >> 8) * 256 + wr * 64 + fr, col0 = u.pn * BM + wc * 32 + 8 * fq;
#pragma unroll
        for (int ai = 0; ai < 2; ++ai)
#pragma unroll
            for (int m = 0; m < 4; ++m) { const int r = r0 + ai * HALF + m * 16;
                if (r < n) { int ga; float g;
                    if (u.ui < MOE_LDS_UNITS) { const int rl = u.ui * 256 + (r & 255); ga = tinfo[TI_ROWOFF + rl]; g = __int_as_float(tinfo[TI_ROWOFF + MOE_LDS_UNITS * 256 + rl]); }
                    else { const size_t li = (size_t)e * LIST_CAP + r; ga = list[li]; g = lgate[li]; }
                    bf16_t* yp = Y + (size_t)ga * D_MODEL + col0;
#pragma unroll
                    for (int bj = 0; bj < 2; ++bj) { const f32x4 v0 = acc[ai][bj][m][0] * g, v1 = acc[ai][bj][m][1] * g;
                        u32x4 w; w.x = cvtpk(v0[0], v0[1]); w.y = cvtpk(v0[2], v0[3]); w.z = cvtpk(v1[0], v1[1]); w.w = cvtpk(v1[2], v1[3]);
                        *(u32x4*)(yp + bj * HALF) = w; } }
                if (m & 1) asm volatile("" ::: "memory"); }
    }
};
#undef ACC_T

template <class Epi, class Sched, bool ALIGN_EPI>
__device__ __forceinline__ void gemm_phase(LAS unsigned char* lds, const Gemm g, const Sched& S, const Epi& E) {
    const int tid = opaque(threadIdx.x), wid = __builtin_amdgcn_readfirstlane(tid >> 6), lane = tid & 63, wr = wid >> 2, wc = wid & 3, fr = lane & 15, fq = lane >> 4;
    const int K = opaque_s(g.K), nt = K / BK;
    unsigned voffB[2]; int Rr[2], Cc[2];
#pragma unroll
    for (int i = 0; i < 2; ++i) { int R, C; stage_rc(tid * 16 + i * 8192, R, C); const int Rb = Epi::PERM ? ((R & ~31) + perm32(R & 31)) : R;
        Rr[i] = R; Cc[i] = C; voffB[i] = (unsigned)(Rb * g.ldb + C) * 2u; }
    const size_t kstep = (size_t)(BK * 2);
    const size_t hstepB = (size_t)HALF * g.ldb * 2;
    const unsigned ldsw = (unsigned)wid * 1024u;
    const int aoff = lds_byte(wr * 64 + fr, fq * 8), boff = lds_byte(wc * 32 + fr, fq * 8);
#define PG8_SA(b, h) (((b) * 2 + (h)) * HTB)
#define PG8_SB(b, h) ((4 + (b) * 2 + (h)) * HTB)
#define PG8_STAGE(bufoff, gbase, voff) do { _Pragma("unroll") for (int _i = 0; _i < 2; ++_i) \
        __builtin_amdgcn_global_load_lds((const unsigned*)((const char*)(gbase) + (voff)[_i]), (LAS unsigned*)(lds + (bufoff) + ldsw + _i * 8192), 16, 0, 0); } while (0)
#define PG8_LDA(dst, b, h) do { _Pragma("unroll") for (int m = 0; m < 4; ++m) _Pragma("unroll") for (int k = 0; k < 2; ++k) dst[m][k] = *(const LAS bf16x8*)(lds + PG8_SA(b, h) + aoff + m * 2048 + k * 1024); } while (0)
#define PG8_LDB(dst, b, h) do { _Pragma("unroll") for (int n = 0; n < 2; ++n) _Pragma("unroll") for (int k = 0; k < 2; ++k) dst[n][k] = *(const LAS bf16x8*)(lds + PG8_SB(b, h) + boff + n * 2048 + k * 1024); } while (0)
#define PG8_MMA(ai, bj, At, Bt) do { __builtin_amdgcn_s_setprio(1); _Pragma("unroll") for (int m = 0; m < 4; ++m) _Pragma("unroll") for (int n = 0; n < 2; ++n) _Pragma("unroll") for (int k = 0; k < 2; ++k) \
        acc[ai][bj][m][n] = __builtin_amdgcn_mfma_f32_16x16x32_bf16(Bt[n][k], At[m][k], acc[ai][bj][m][n], 0, 0, 0); __builtin_amdgcn_s_setprio(0); } while (0)
#define PG8_WAIT_V(n) asm volatile("s_waitcnt vmcnt(" #n ")" ::: "memory")
#define PG8_WAIT_L(n) asm volatile("s_waitcnt lgkmcnt(" #n ")" ::: "memory")
#define PG8_BAR __builtin_amdgcn_s_barrier()
#define PG8_SCHED __builtin_amdgcn_sched_barrier(0)
    Unit cur, nxt; int ui = 0;
    if (!S.next(0, cur)) return;
    f32x4 acc[2][2][4][2];
#pragma unroll
    for (int a = 0; a < 2; ++a)
#pragma unroll
        for (int b = 0; b < 2; ++b)
#pragma unroll
            for (int m = 0; m < 4; ++m)
#pragma unroll
                for (int n = 0; n < 2; ++n) acc[a][b][m][n] = (f32x4){0.f, 0.f, 0.f, 0.f};
    bf16x8 At[4][2], B0[2][2], B1[2][2];
    const char* cA = S.a_base(cur); const char* cB = S.b_base(cur);
    unsigned vA[2][2], vN[2][2];
#pragma unroll
    for (int h = 0; h < 2; ++h)
#pragma unroll
        for (int i = 0; i < 2; ++i) { vA[h][i] = S.a_voff(cur, Rr[i] + h * HALF, Cc[i], g.lda); vN[h][i] = vA[h][i]; }
    PG8_STAGE(PG8_SB(0, 0), cB, voffB); PG8_STAGE(PG8_SB(0, 1), cB + hstepB, voffB); PG8_STAGE(PG8_SA(0, 0), cA, vA[0]); PG8_STAGE(PG8_SA(0, 1), cA, vA[1]);
    if (wr == 1) PG8_BAR;
    PG8_WAIT_V(2); PG8_BAR;
    PG8_STAGE(PG8_SB(1, 0), cB + kstep, voffB); PG8_STAGE(PG8_SA(1, 0), cA + kstep, vA[0]); PG8_STAGE(PG8_SB(1, 1), cB + hstepB + kstep, voffB);
    PG8_WAIT_V(6); PG8_BAR;
    for (;;) {
        const bool has_next = S.next(ui + 1, nxt);
        const char* nA = has_next ? S.a_base(nxt) : cA; const char* nB = has_next ? S.b_base(nxt) : cB;
        if (has_next) {
#pragma unroll
            for (int h = 0; h < 2; ++h)
#pragma unroll
                for (int i = 0; i < 2; ++i) vN[h][i] = S.a_voff(nxt, Rr[i] + h * HALF, Cc[i], g.lda);
        }
#pragma nounroll
        for (int t = 0; t < nt; t += 2) {
            const bool last = (t == nt - 2);
            const char* a1 = cA + (size_t)(t + 1) * kstep;
            const char* a2 = last ? nA : cA + (size_t)(t + 2) * kstep; const char* b2 = last ? nB : cB + (size_t)(t + 2) * kstep;
            const char* a3 = a2 + kstep; const char* b3 = b2 + kstep;
            unsigned w0[2], w1[2];
#pragma unroll
            for (int i = 0; i < 2; ++i) { w0[i] = last ? vN[0][i] : vA[0][i]; w1[i] = last ? vN[1][i] : vA[1][i]; }
            PG8_LDB(B0, 0, 0); PG8_LDB(B1, 0, 1); PG8_SCHED; PG8_LDA(At, 0, 0); PG8_STAGE(PG8_SA(1, 1), a1, vA[1]);
            PG8_WAIT_V(8); PG8_WAIT_L(0); PG8_BAR; PG8_MMA(0, 0, At, B0); PG8_MMA(0, 1, At, B1); PG8_BAR; PG8_SCHED;
            PG8_LDA(At, 0, 1); PG8_STAGE(PG8_SB(0, 0), b2, voffB); PG8_STAGE(PG8_SB(0, 1), b2 + hstepB, voffB); PG8_STAGE(PG8_SA(0, 0), a2, w0);
            PG8_WAIT_V(8); PG8_WAIT_L(0); PG8_BAR; PG8_MMA(1, 0, At, B0); PG8_MMA(1, 1, At, B1); PG8_BAR; PG8_SCHED;
            PG8_LDB(B0, 1, 0); PG8_LDB(B1, 1, 1); PG8_SCHED; PG8_LDA(At, 1, 0); PG8_STAGE(PG8_SA(0, 1), a2, w1);
            PG8_WAIT_V(8); PG8_WAIT_L(0); PG8_BAR; PG8_MMA(0, 0, At, B0); PG8_MMA(0, 1, At, B1); PG8_BAR; PG8_SCHED;
            PG8_LDA(At, 1, 1); PG8_STAGE(PG8_SB(1, 0), b3, voffB); PG8_STAGE(PG8_SB(1, 1), b3 + hstepB, voffB); PG8_STAGE(PG8_SA(1, 0), a3, w0);
            PG8_WAIT_V(8); PG8_WAIT_L(0); PG8_BAR; PG8_MMA(1, 0, At, B0); PG8_MMA(1, 1, At, B1); PG8_BAR; PG8_SCHED;
        }
        if constexpr (ALIGN_EPI) { if (wr == 0) PG8_BAR; }
        if constexpr (!Epi::AFTER_DRAIN) E(acc, cur, wr, wc, fr, fq);
        if (!has_next) break;
#pragma unroll
        for (int a = 0; a < 2; ++a)
#pragma unroll
            for (int b = 0; b < 2; ++b)
#pragma unroll
                for (int m = 0; m < 4; ++m)
#pragma unroll
                    for (int n = 0; n < 2; ++n) acc[a][b][m][n] = (f32x4){0.f, 0.f, 0.f, 0.f};
        cur = nxt; cA = nA; cB = nB; ++ui;
#pragma unroll
        for (int h = 0; h < 2; ++h)
#pragma unroll
            for (int i = 0; i < 2; ++i) vA[h][i] = vN[h][i];
        if constexpr (ALIGN_EPI) { if (wr == 1) PG8_BAR; }
    }
    PG8_WAIT_V(0);
    if constexpr (!ALIGN_EPI) { if (wr == 0) PG8_BAR; }
    PG8_BAR;
    if constexpr (Epi::AFTER_DRAIN) E.fused(acc, cur, wr, wc, fr, fq, lds, lane);
#undef PG8_SA
#undef PG8_SB
#undef PG8_STAGE
#undef PG8_LDA
#undef PG8_LDB
#undef PG8_MMA
#undef PG8_WAIT_V
#undef PG8_WAIT_L
#undef PG8_BAR
#undef PG8_SCHED
}
}

namespace att {
constexpr int KSLOT = 12288, VSLOT = 8192, LDS_K = 0, LDS_V = 3 * KSLOT, LDS_BYTES = LDS_V + 3 * VSLOT;
constexpr float THR = 6.0f;
__device__ __forceinline__ int nx3(int s) { return s == 2 ? 0 : s + 1; }
__device__ __forceinline__ int pv3(int s) { return s == 0 ? 2 : s - 1; }
__device__ __forceinline__ void glds16(const void* g, LAS unsigned char* l) { __builtin_amdgcn_global_load_lds((const unsigned*)g, (LAS unsigned*)l, 16, 0, 0); }

template <bool FIRST, bool GEN>
__device__ __forceinline__ void att_step(f32x16& c0, f32x16& c1, f32x16& n0, f32x16& n1, f32x16& o0, f32x16& o1, f32x16& negm, float& mhat, float& lsum, u32x4 (&pw)[4], const bf16x8 (&qr)[6],
                                         const LAS unsigned char* kb_next, const LAS unsigned char* vb_prev, bool act_prev, bool act_cur, bool act_nxt, int jb, int qrel, int hi) {
    const bool do_pv = !FIRST && (!GEN || act_prev), do_cur = !GEN || act_cur, do_qk = !GEN || act_nxt;
    bf16x8 vfr[8], kfa[6], kfb[6];
    if (do_pv) {
#pragma unroll
        for (int kc2 = 0; kc2 < 4; ++kc2) { vfr[2 * kc2] = *(const LAS bf16x8*)(vb_prev + kc2 * 2048); vfr[2 * kc2 + 1] = *(const LAS bf16x8*)(vb_prev + kc2 * 2048 + 512); }
    }
    if (do_qk) {
#pragma unroll
        for (int d0 = 0; d0 < 3; ++d0) { kfa[2 * d0] = *(const LAS bf16x8*)(kb_next + d0 * 2048); kfa[2 * d0 + 1] = *(const LAS bf16x8*)(kb_next + d0 * 2048 + 512); }
    }
    __builtin_amdgcn_sched_barrier(0);
    float rm = 0.f;
    if (do_cur) {
        if ((GEN || FIRST) && jb >= 0) {
            const int kb0 = 64 * jb + 8 * hi;
#pragma unroll
            for (int r = 0; r < 16; ++r) { const int key = kb0 + (r & 3) + 4 * ((r >> 2) & 1) + 16 * (r >> 3);
                if (key > qrel) c0[r] = -INFINITY; if (key + 32 > qrel) c1[r] = -INFINITY; }
        }
        float ra = fmaxf(fmaxf(c0[0], c0[1]), c1[0]), rb = fmaxf(fmaxf(c0[2], c0[3]), c1[1]);
        ra = fmaxf(fmaxf(ra, c1[2]), c1[3]);
#pragma unroll
        for (int r = 4; r < 16; r += 4) { ra = fmaxf(fmaxf(ra, c0[r]), c0[r + 1]); rb = fmaxf(fmaxf(rb, c0[r + 2]), c0[r + 3]); ra = fmaxf(fmaxf(ra, c1[r]), c1[r + 1]); rb = fmaxf(fmaxf(rb, c1[r + 2]), c1[r + 3]); }
        rm = fmaxf(ra, rb);
        { auto rr = __builtin_amdgcn_permlane32_swap(__float_as_uint(rm), __float_as_uint(rm), false, false); rm = fmaxf(__uint_as_float(rr[0]), __uint_as_float(rr[1])); }
    }
    if (do_pv) {
#pragma unroll
        for (int kc2 = 0; kc2 < 4; ++kc2) {
            const bf16x8 pf = __builtin_bit_cast(bf16x8, pw[kc2]);
            o0 = __builtin_amdgcn_mfma_f32_32x32x16_bf16(vfr[2 * kc2], pf, o0, 0, 0, 0);
            o1 = __builtin_amdgcn_mfma_f32_32x32x16_bf16(vfr[2 * kc2 + 1], pf, o1, 0, 0, 0);
        }
    }
    __builtin_amdgcn_sched_barrier(0);
    if (do_qk) {
#pragma unroll
        for (int d0 = 0; d0 < 3; ++d0) { kfb[2 * d0] = *(const LAS bf16x8*)(kb_next + (d0 + 3) * 2048); kfb[2 * d0 + 1] = *(const LAS bf16x8*)(kb_next + (d0 + 3) * 2048 + 512); }
    }
    __builtin_amdgcn_sched_barrier(0);
    if (do_cur) {
        if (FIRST) {
            mhat = rm;
#pragma unroll
            for (int r = 0; r < 16; ++r) { c0[r] -= rm; c1[r] -= rm; negm[r] = -rm; }
        } else if (__any(rm > THR)) {
            const float dl = fmaxf(rm, 0.f); mhat += dl;
            const float f = __builtin_amdgcn_exp2f(-dl); lsum *= f;
#pragma unroll
            for (int r = 0; r < 16; ++r) { c0[r] -= dl; c1[r] -= dl; o0[r] *= f; o1[r] *= f; negm[r] = -mhat; }
        }
    }
    if (do_qk) {
        n0 = __builtin_amdgcn_mfma_f32_32x32x16_bf16(kfa[0], qr[0], negm, 0, 0, 0);
        n1 = __builtin_amdgcn_mfma_f32_32x32x16_bf16(kfa[1], qr[0], negm, 0, 0, 0);
#pragma unroll
        for (int d0 = 1; d0 < 3; ++d0) { n0 = __builtin_amdgcn_mfma_f32_32x32x16_bf16(kfa[2 * d0], qr[d0], n0, 0, 0, 0); n1 = __builtin_amdgcn_mfma_f32_32x32x16_bf16(kfa[2 * d0 + 1], qr[d0], n1, 0, 0, 0); }
#pragma unroll
        for (int d0 = 0; d0 < 3; ++d0) { n0 = __builtin_amdgcn_mfma_f32_32x32x16_bf16(kfb[2 * d0], qr[d0 + 3], n0, 0, 0, 0); n1 = __builtin_amdgcn_mfma_f32_32x32x16_bf16(kfb[2 * d0 + 1], qr[d0 + 3], n1, 0, 0, 0); }
    }
    if (do_cur) {
        float sa = 0.f, sb = 0.f;
#pragma unroll
        for (int r = 0; r < 16; ++r) { c0[r] = __builtin_amdgcn_exp2f(c0[r]); c1[r] = __builtin_amdgcn_exp2f(c1[r]); sa += c0[r]; sb += c1[r]; }
        lsum += sa + sb;
#pragma unroll
        for (int i = 0; i < 2; ++i) {
            pw[i] = (u32x4){cvtpk(c0[8 * i], c0[8 * i + 1]), cvtpk(c0[8 * i + 2], c0[8 * i + 3]), cvtpk(c0[8 * i + 4], c0[8 * i + 5]), cvtpk(c0[8 * i + 6], c0[8 * i + 7])};
            pw[2 + i] = (u32x4){cvtpk(c1[8 * i], c1[8 * i + 1]), cvtpk(c1[8 * i + 2], c1[8 * i + 3]), cvtpk(c1[8 * i + 4], c1[8 * i + 5]), cvtpk(c1[8 * i + 6], c1[8 * i + 7])};
        }
        asm volatile("" : "+v"(pw[0]), "+v"(pw[1]), "+v"(pw[2]), "+v"(pw[3]), "+v"(lsum));
    }
    __builtin_amdgcn_sched_barrier(0);
}

__device__ __forceinline__ void attn_unit(int b, int h, int qb, const bf16_t* __restrict__ Q, const bf16_t* __restrict__ KN, const bf16_t* __restrict__ KR, const bf16_t* __restrict__ VT, bf16_t* __restrict__ O, LAS unsigned char* lds) {
    const int tid = opaque(threadIdx.x), lane = tid & 63, r32 = lane & 31, hi = lane >> 5;
    const int w = __builtin_amdgcn_readfirstlane(tid >> 6);
    const size_t tok0 = (size_t)b * SEQ;
    const int q0 = qb * 256, NT = 4 * (qb + 1);
    const bf16_t* ksrc = KN + (tok0 + lane) * 1024 + h * 64 + 8 * w;
    const bf16_t* rsrc = KR + (tok0 + lane) * 32 + 8 * (w & 3);
    const bf16_t* vsrc = VT + (size_t)(h * 64 + lane) * NTOK + tok0 + 8 * w;
#define ATT_ISSUE_K(t, slot) do { glds16(ksrc + (size_t)(t) * 65536, lds + LDS_K + (slot) * KSLOT + w * 1024); \
        if (w < 4) glds16(rsrc + (size_t)(t) * 2048, lds + LDS_K + (slot) * KSLOT + (8 + w) * 1024); } while (0)
#define ATT_ISSUE_V(t, slot) glds16(vsrc + (size_t)(t) * 64, lds + LDS_V + (slot) * VSLOT + w * 1024)
    ATT_ISSUE_K(0, 0); ATT_ISSUE_K(1, 1); ATT_ISSUE_K(2, 2); ATT_ISSUE_V(0, 0);
    bf16x8 qr[6];
    { const bf16_t* qp = Q + (tok0 + q0 + w * 32 + r32) * QPITCH + h * 96 + hi * 8;
#pragma unroll
      for (int d0 = 0; d0 < 6; ++d0) qr[d0] = *(const bf16x8*)(qp + d0 * 16); }
    const int kvp = (r32 & 19) | ((r32 & 4) << 1) | ((r32 & 8) >> 1);
    const LAS unsigned char* kf = lds + LDS_K + hi * 1024 + kvp * 16;
    const LAS unsigned char* vf = lds + LDS_V + hi * 1024 + r32 * 16;
    float mhat = 0.f, lsum = 0.f;
    f32x16 o0 = {}, o1 = {}, negm = {}, sA0 = {}, sA1 = {}, sB0, sB1;
    u32x4 pw[4] = {};
    const int qrel = w * 32 + r32, wb = w >> 1;
    asm volatile("s_waitcnt vmcnt(0)" ::: "memory");
    __builtin_amdgcn_s_barrier();
    asm volatile("" ::: "memory");
#pragma unroll
    for (int d0 = 0; d0 < 6; ++d0) {
        const bf16x8 k0 = *(const LAS bf16x8*)(kf + d0 * 2048), k1 = *(const LAS bf16x8*)(kf + d0 * 2048 + 512);
        sA0 = __builtin_amdgcn_mfma_f32_32x32x16_bf16(k0, qr[d0], sA0, 0, 0, 0);
        sA1 = __builtin_amdgcn_mfma_f32_32x32x16_bf16(k1, qr[d0], sA1, 0, 0, 0);
    }
    int st = 0;
#define ATT_SYNC(t) do { \
        if ((t) == 0 || (t) + 2 >= NT) asm volatile("s_waitcnt vmcnt(0)" ::: "memory"); \
        else if (w < 4) asm volatile("s_waitcnt vmcnt(3)" ::: "memory"); \
        else asm volatile("s_waitcnt vmcnt(2)" ::: "memory"); \
        __builtin_amdgcn_s_barrier(); asm volatile("" ::: "memory"); \
        if ((t) + 3 < NT) ATT_ISSUE_K((t) + 3, st); \
        if ((t) + 1 < NT) ATT_ISSUE_V((t) + 1, nx3(st)); } while (0)
#define ATT_ACT(tt) (((tt) - (NT - 4)) < 0 || ((tt) - (NT - 4)) <= wb)
#define ATT_STEP(FIRST, GEN, C0, C1, N0, N1, t) do { ATT_SYNC(t); \
        att_step<FIRST, GEN>(C0, C1, N0, N1, o0, o1, negm, mhat, lsum, pw, qr, kf + nx3(st) * KSLOT, vf + pv3(st) * VSLOT, \
                             (t) > 0 && ATT_ACT((t) - 1), ATT_ACT(t), (t) + 1 < NT && ATT_ACT((t) + 1), (t) - (NT - 4), qrel, hi); \
        st = nx3(st); } while (0)
    ATT_STEP(true, true, sA0, sA1, sB0, sB1, 0);
    int t = 1;
    const int ts = (NT > 4) ? NT - 5 : 1;
    for (; t + 1 < ts; t += 2) {
        ATT_STEP(false, false, sB0, sB1, sA0, sA1, t);
        ATT_STEP(false, false, sA0, sA1, sB0, sB1, t + 1);
    }
    if (NT > 4) { ATT_STEP(false, true, sB0, sB1, sA0, sA1, NT - 5); ATT_STEP(false, true, sA0, sA1, sB0, sB1, NT - 4); }
    ATT_STEP(false, true, sB0, sB1, sA0, sA1, NT - 3);
    ATT_STEP(false, true, sA0, sA1, sB0, sB1, NT - 2);
    ATT_STEP(false, true, sB0, sB1, sA0, sA1, NT - 1);
    if (ATT_ACT(NT - 1)) {
        const LAS unsigned char* vb = vf + pv3(st) * VSLOT;
#pragma unroll
        for (int kc2 = 0; kc2 < 4; ++kc2) {
            const bf16x8 v0 = *(const LAS bf16x8*)(vb + kc2 * 2048), v1 = *(const LAS bf16x8*)(vb + kc2 * 2048 + 512);
            const bf16x8 pf = __builtin_bit_cast(bf16x8, pw[kc2]);
            o0 = __builtin_amdgcn_mfma_f32_32x32x16_bf16(v0, pf, o0, 0, 0, 0);
            o1 = __builtin_amdgcn_mfma_f32_32x32x16_bf16(v1, pf, o1, 0, 0, 0);
        }
    }
    { auto rr = __builtin_amdgcn_permlane32_swap(__float_as_uint(lsum), __float_as_uint(lsum), false, false); lsum = __uint_as_float(rr[0]) + __uint_as_float(rr[1]); }
    const float inv = 1.0f / lsum;
    bf16_t* op = O + (tok0 + q0 + w * 32 + r32) * 1024 + h * 64 + 4 * hi;
#pragma unroll
    for (int g = 0; g < 4; ++g) {
        u32x2 a, c; a.x = cvtpk(o0[4 * g] * inv, o0[4 * g + 1] * inv); a.y = cvtpk(o0[4 * g + 2] * inv, o0[4 * g + 3] * inv);
        c.x = cvtpk(o1[4 * g] * inv, o1[4 * g + 1] * inv); c.y = cvtpk(o1[4 * g + 2] * inv, o1[4 * g + 3] * inv);
        *(u32x2*)(op + 8 * g) = a; *(u32x2*)(op + 32 + 8 * g) = c;
    }
    asm volatile("s_waitcnt lgkmcnt(0)" ::: "memory");
    __builtin_amdgcn_s_barrier();
#undef ATT_ISSUE_K
#undef ATT_ISSUE_V
#undef ATT_SYNC
#undef ATT_ACT
#undef ATT_STEP
}
}

#define XB_TMO      128
#define XB_XCNT(j)  (256  + 64 * (j))
#define XB_XSUB(j)  (1280 + 64 * (j))
#define XB_XGEN(j)  (2304 + 64 * (j))
#define XB_TOP      3328
#define XB_TOPGEN   3392
#define XCD_BAR_WORDS 3456
#define XB_SPIN_CAP (1u << 18)
__device__ __forceinline__ unsigned xb_ld(unsigned* p)              { return __hip_atomic_load(p, __ATOMIC_RELAXED, __HIP_MEMORY_SCOPE_AGENT); }
__device__ __forceinline__ unsigned xb_add(unsigned* p, unsigned v) { return __hip_atomic_fetch_add(p, v, __ATOMIC_RELAXED, __HIP_MEMORY_SCOPE_AGENT); }
__device__ __forceinline__ unsigned xb_xcc_id() { return (unsigned)__builtin_amdgcn_s_getreg((3 << 11) | 20) & 0xFu; }
#define XB_SPIN(cond, bar) do { unsigned _sp = 0; while (cond) { __builtin_amdgcn_s_sleep(1); \
    if ((++_sp & 255u) == 0u) { if (xb_ld(&(bar)[XB_TMO])) break; if (_sp > XB_SPIN_CAP) { atomicAdd(&(bar)[XB_TMO], 1u); break; } } } } while (0)
struct XcdBarrier { unsigned* bar; unsigned x; volatile LAS unsigned* st; };
__device__ __forceinline__ XcdBarrier xcd_barrier_post(unsigned* bar, volatile LAS unsigned* st) {
    XcdBarrier b; b.bar = bar; b.x = xb_xcc_id(); b.st = st;
    if (threadIdx.x == 0) (void)xb_add(&bar[XB_XCNT(b.x)], 1u);
    return b;
}
__device__ __forceinline__ void xcd_barrier_complete(unsigned* bar, unsigned x, unsigned& nloc, unsigned& nx) {
    const unsigned G = gridDim.x * gridDim.y * gridDim.z;
    unsigned sum, cnt, mine, sp = 0u;
    for (;;) {
        sum = 0u; cnt = 0u; mine = 0u;
#pragma unroll
        for (unsigned j = 0; j < 16; ++j) { const unsigned c = xb_ld(&bar[XB_XCNT(j)]); sum += c; cnt += (c > 0u) ? 1u : 0u; mine = (j == x) ? c : mine; }
        if (sum == G) break;
        __builtin_amdgcn_s_sleep(1);
        if ((++sp & 255u) == 0u) { if (xb_ld(&bar[XB_TMO])) break; if (sp > XB_SPIN_CAP) { atomicAdd(&bar[XB_TMO], 1u); break; } }
    }
    nloc = mine > 0u ? mine : 1u; nx = cnt > 0u ? cnt : 1u;
}
__device__ __forceinline__ void xcd_barrier(const XcdBarrier& b) {
    asm volatile("s_waitcnt vmcnt(0)" ::: "memory");
    __syncthreads();
    if (threadIdx.x == 0) {
        unsigned* bar = b.bar;
        __builtin_amdgcn_s_waitcnt(0);
        unsigned nloc = b.st[0], nx = b.st[1];
        if (nloc == 0u) { xcd_barrier_complete(bar, b.x, nloc, nx); b.st[0] = nloc; b.st[1] = nx; }
        const unsigned old = xb_add(&bar[XB_XSUB(b.x)], 1u);
        const unsigned gen = old / nloc;
        if (old + 1u == (gen + 1u) * nloc) {
            __builtin_amdgcn_fence(__ATOMIC_RELEASE, "agent");
            asm volatile("s_waitcnt vmcnt(0)" ::: "memory");
            const unsigned og = xb_add(&bar[XB_TOP], 1u);
            const unsigned tg = og / nx;
            if (og + 1u == (tg + 1u) * nx) xb_add(&bar[XB_TOPGEN], 1u);
            else XB_SPIN(xb_ld(&bar[XB_TOPGEN]) == tg, bar);
            __builtin_amdgcn_fence(__ATOMIC_ACQUIRE, "agent");
            xb_add(&bar[XB_XGEN(b.x)], 1u);
            asm volatile("s_waitcnt vmcnt(0)" ::: "memory");
        } else {
            XB_SPIN(xb_ld(&bar[XB_XGEN(b.x)]) == gen, bar);
            __builtin_amdgcn_fence(__ATOMIC_ACQUIRE, "agent");
            asm volatile("s_waitcnt vmcnt(0)" ::: "memory");
        }
    }
    __syncthreads();
}

struct Args { const void* in[20]; float* out; unsigned char* ws; int ph_lo, ph_hi; };
typedef const __attribute__((address_space(4))) Args* KArgs;
__device__ __forceinline__ KArgs kargs() { KArgs p = (KArgs)__builtin_amdgcn_kernarg_segment_ptr(); asm volatile("" : "+s"(p)); return p; }
constexpr int NWAVES = 8;
constexpr int PPL = 12;
constexpr int NPHASE = 1 + DEPTH * PPL;

__constant__ double c_invf[16] = {1.0, 0.5623413251903491, 0.31622776601683794, 0.1778279410038923, 0.1, 0.05623413251903491, 0.03162277660168379, 0.01778279410038923,
                                  0.01, 0.005623413251903491, 0.0031622776601683794, 0.0017782794100389228, 0.001, 0.0005623413251903491, 0.00031622776601683794, 0.00017782794100389227};

__device__ __forceinline__ void transpose_item(const float* __restrict__ W, int ldw, int k0, int n0, bf16_t* __restrict__ WT, int ldt, int drow0, float mul, LAS float* scr, int lane) {
#pragma unroll 8
    for (int i = 0; i < 32; ++i) { const int kk = 2 * i + (lane >> 5); scr[kk * 33 + (lane & 31)] = W[(size_t)(k0 + kk) * ldw + n0 + (lane & 31)]; }
    LDS_WAIT(); asm volatile("" ::: "memory");
    const int c = lane & 7;
#pragma unroll
    for (int j = 0; j < 4; ++j) { const int n = (lane >> 3) + 8 * j; const LAS float* s = scr + (8 * c) * 33 + n;
        u32x4 o; o.x = cvtpk(s[0 * 33] * mul, s[1 * 33] * mul); o.y = cvtpk(s[2 * 33] * mul, s[3 * 33] * mul); o.z = cvtpk(s[4 * 33] * mul, s[5 * 33] * mul); o.w = cvtpk(s[6 * 33] * mul, s[7 * 33] * mul);
        *(u32x4*)(WT + (size_t)(drow0 + n) * ldt + k0 + 8 * c) = o; }
    LDS_WAIT(); asm volatile("" ::: "memory");
}

struct ConvItem { const float* src; bf16_t* dst; int ldw, ldt; };
__device__ __forceinline__ void conv_load(const ConvItem& c, f32x4 (&v)[16], int lane) {
    const float* src = c.src + (size_t)(lane >> 4) * c.ldw + 4 * (lane & 15);
#pragma unroll
    for (int i = 0; i < 16; ++i) v[i] = *(const f32x4*)(src + (size_t)(4 * i) * c.ldw);
}
__device__ __forceinline__ void conv_finish(const ConvItem& c, const f32x4 (&v)[16], LAS float* scr, int lane) {
#pragma unroll
    for (int i = 0; i < 16; ++i) *(LAS f32x4*)(scr + (4 * i + (lane >> 4)) * 68 + 4 * (lane & 15)) = v[i];
    LDS_WAIT(); asm volatile("" ::: "memory");
    bf16_t* dst = c.dst + (size_t)lane * c.ldt;
#pragma unroll
    for (int cc = 0; cc < 8; ++cc) { const LAS float* sp = scr + (8 * cc) * 68 + lane;
        u32x4 o; o.x = cvtpk(sp[0], sp[68]); o.y = cvtpk(sp[2 * 68], sp[3 * 68]); o.z = cvtpk(sp[4 * 68], sp[5 * 68]); o.w = cvtpk(sp[6 * 68], sp[7 * 68]);
        *(u32x4*)(dst + 8 * cc) = o; }
    LDS_WAIT(); asm volatile("" ::: "memory");
}

__device__ __forceinline__ void sincos_d(double a, float& s, float& c) {
    const double TWO_PI_HI = 6.283185307179586, TWO_PI_LO = 2.4492935982947064e-16, INV_2PI = 0.15915494309189535;
    const double n = __builtin_rint(a * INV_2PI);
    double r = __builtin_fma(-n, TWO_PI_HI, a); r = __builtin_fma(-n, TWO_PI_LO, r);
    const double HALF_PI = 1.5707963267948966, HALF_PI_LO = 6.123233995736766e-17;
    const double qd = __builtin_rint(r * 0.6366197723675814);
    double y = __builtin_fma(-qd, HALF_PI, r); y = __builtin_fma(-qd, HALF_PI_LO, y);
    const int q = ((int)qd) & 3;
    const double y2 = y * y;
    double sp = -7.647163731819816e-13; sp = sp * y2 + 1.6059043836821613e-10; sp = sp * y2 - 2.505210838544172e-08; sp = sp * y2 + 2.7557319223985893e-06; sp = sp * y2 - 0.0001984126984126984;
    sp = sp * y2 + 0.008333333333333333; sp = sp * y2 - 0.16666666666666666; sp = y + y * y2 * sp;
    double cp = 4.779477332387385e-14; cp = cp * y2 - 1.1470745597729725e-11; cp = cp * y2 + 2.08767569878681e-09; cp = cp * y2 - 2.755731922398589e-07; cp = cp * y2 + 2.48015873015873e-05;
    cp = cp * y2 - 0.001388888888888889; cp = cp * y2 + 0.041666666666666664; cp = cp * y2 - 0.5; cp = 1.0 + y2 * cp;
    double ss, cc;
    if (q == 0) { ss = sp; cc = cp; } else if (q == 1) { ss = cp; cc = -sp; } else if (q == 2) { ss = -sp; cc = -cp; } else { ss = -cp; cc = sp; }
    s = (float)ss; c = (float)cc;
}

__global__ void __launch_bounds__(NWAVES * 64, 2) mk_fwd(Args args_unused) {
    extern __shared__ __attribute__((aligned(16))) unsigned char lds_raw[];
    LAS unsigned char* lds = (LAS unsigned char*)lds_raw;
    volatile LAS unsigned* MISC = (volatile LAS unsigned*)(lds + MISC_OFF);
    int tid = threadIdx.x, lane = tid & 63, wave = __builtin_amdgcn_readfirstlane(tid >> 6);
    const int G = gridDim.x, bx = blockIdx.x;
    const int vcu = (G % 8 == 0) ? (bx % 8) * (G / 8) + bx / 8 : bx;
    int gw = vcu * NWAVES + wave; const int NGW = G * NWAVES;
#define ws (kargs()->ws)
    unsigned* ctl = (unsigned*)(ws + WS_CTL);
    for (int u = tid; u < (LDS_BYTES - LDSCTL_OFF) / 4; u += NWAVES * 64) ((LAS unsigned*)(lds + LDSCTL_OFF))[u] = 0u;
    __syncthreads();
    XcdBarrier bar; bar.bar = ctl + CW_BAR; bar.x = 0; bar.st = nullptr;
#if MK_ONE_LAUNCH
    bar = xcd_barrier_post(ctl + CW_BAR, MISC + 8);
#endif
    const int lo = kargs()->ph_lo, hi = kargs()->ph_hi;
#ifndef MK_REP_MASK
#define MK_REP_MASK 0u
#endif
#define NREP(b) (1 + (int)((MK_REP_MASK >> (b)) & 1u))
#ifndef MK_PH_MASK
#define MK_PH_MASK 0xffffffffu
#endif
#define PHON(b) ((MK_PH_MASK >> (b)) & 1u)
#define IN(k) (lo <= (k) && (k) < hi)
#if MK_ONE_LAUNCH
#define SEAM(k) do { if ((k) + 1 < hi) xcd_barrier(bar); } while (0)
#else
#define SEAM(k) do { } while (0)
#endif
#define in_x ((const float*)kargs()->in[0])
#define in_pos ((const int*)kargs()->in[1])
#define ln_g ((const float*)kargs()->in[2])
#define ln_b ((const float*)kargs()->in[3])
#define w_in ((const float*)kargs()->in[4])
#define q_norm ((const float*)kargs()->in[5])
#define w_uq ((const float*)kargs()->in[6])
#define kv_norm ((const float*)kargs()->in[7])
#define w_ukv ((const float*)kargs()->in[8])
#define w_o ((const float*)kargs()->in[9])
#define pool_w ((const float*)kargs()->in[10])
#define pool_b ((const float*)kargs()->in[11])
#define pool_scale ((const float*)kargs()->in[12])
#define w_grp ((const float*)kargs()->in[13])
#define b_grp ((const float*)kargs()->in[14])
#define w_exp ((const float*)kargs()->in[15])
#define b_exp ((const float*)kargs()->in[16])
#define w1 ((const float*)kargs()->in[17])
#define w3 ((const float*)kargs()->in[18])
#define w2 ((const float*)kargs()->in[19])
#define COS ((float*)(ws + WS_COS))
#define SIN ((float*)(ws + WS_SIN))
#define CNT ((int*)(ws + WS_CNT))
#define TILE ((int*)(ws + WS_TILE))
#define AE ((int*)(ws + WS_AE))
#define APOS ((int*)(ws + WS_APOS))
#define AG ((float*)(ws + WS_AG))
#define RSLOT ((int*)(ws + WS_RSLOT))
#define RGATE ((float*)(ws + WS_RGATE))
#define WIN ((bf16_t*)(ws + WS_WIN))
#define WUQ ((bf16_t*)(ws + WS_WUQ))
#define WUK ((bf16_t*)(ws + WS_WUK))
#define WUV ((bf16_t*)(ws + WS_WUV))
#define WO ((bf16_t*)(ws + WS_WO))
#define WP ((bf16_t*)(ws + WS_WP))
#define WR ((bf16_t*)(ws + WS_WR))
#define W13L(ll) ((bf16_t*)(ws + (((ll) & 1) ? WS_W13B : WS_W13)))
#define W2TL(ll) ((bf16_t*)(ws + (((ll) & 1) ? WS_W2TB : WS_W2T)))
#define FB ((bf16_t*)(ws + WS_FB))
#define XHL ((bf16_t*)(ws + WS_XHL))
#define LATB ((float*)(ws + WS_LAT))
#define CQ ((bf16_t*)(ws + WS_CQ))
#define CKV ((bf16_t*)(ws + WS_CKV))
#define KR ((bf16_t*)(ws + WS_KR))
#define QB ((bf16_t*)(ws + WS_Q))
#define KN ((bf16_t*)(ws + WS_KN))
#define VT ((bf16_t*)(ws + WS_VT))
#define OB ((bf16_t*)(ws + WS_O))
#define POOLED ((bf16_t*)(ws + WS_POOLED))
#define LG ((float*)(ws + WS_LG))
#define ROWLIST ((int*)(ws + WS_LIST))
#define LGATE ((float*)(ws + WS_LGATE))
#define HS ((bf16_t*)(ws + WS_HS))
#define YB ((bf16_t*)(ws + WS_Y))
    LAS float* scr = (LAS float*)(lds + RING_OFF + wave * SCR_WAVE);

    if (PHON(12) && IN(0)) {
        for (int m = gw; m < NTOK; m += NGW) {
            const f32x4* xr = (const f32x4*)(in_x + (size_t)m * D_MODEL) + 2 * lane; u32x4* oh = (u32x4*)(XHL + (size_t)m * 2048) + lane;
#pragma unroll
            for (int j = 0; j < 2; ++j) oh[64 * j] = pk8(xr[128 * j], xr[128 * j + 1]);
        }
        for (int idx = gw * 64 + lane; idx < NTOK * 16; idx += NGW * 64) { float s, c; sincos_d((double)in_pos[idx >> 4] * c_invf[idx & 15], s, c); COS[idx] = c; SIN[idx] = s; }
        for (int idx = gw * 64 + lane; idx < DEPTH * 64 * 3072; idx += NGW * 64) {
            const int l = idx / (64 * 3072), r0 = idx % (64 * 3072), ks = r0 / 3072, r1 = r0 % 3072, part = r1 / 1536, r2 = r1 % 1536, nb = r2 / 512, r3 = r2 % 512, hh = r3 / 256, n = (r3 % 256) / 8, jj = r3 % 8;
            const int col = 32 * nb + n, k = 64 * (ks >> 2) + 32 * hh + 8 * (ks & 3) + jj;
            float v = 0.f;
            if (col < 72) { const float wv = (col < 8) ? w_grp[((size_t)l * 1024 + k) * 8 + col] : w_exp[((size_t)l * 1024 + k) * 64 + (col - 8)];
                const float whi = bflo(cvtpk(wv, 0.f)); v = part ? (wv - whi) : whi; }
            WR[idx] = (bf16_t)(cvtpk(v, 0.f) & 0xffffu);
        }
        for (int idx = gw * 64 + lane; idx < 2 * 96 * 1024 / 8; idx += NGW * 64) { const int j = idx / (96 * 128), r = idx % (96 * 128); *(u32x4*)(WIN + ((size_t)j * 512 + 416) * 1024 + (size_t)r * 8) = (u32x4){0u, 0u, 0u, 0u}; }
        constexpr int I_IN = 16 * 13, I_UQ = 4 * 48, I_UKV = 2 * 64, I_O = 16 * 32, I_P = 4 * 8;
        constexpr int NIT = 2 * (I_IN + I_UQ + I_UKV + I_O) + 8 * I_P;
        for (int it = gw; it < NIT; it += NGW) {
            int r = it;
            if (r < 2 * I_IN) { const int j = r / I_IN, q = r % I_IN, kb = q / 13, nb = q % 13;
                transpose_item(w_in + (size_t)j * 1024 * LAT, LAT, 64 * kb, 32 * nb, WIN + (size_t)j * 512 * 1024, 1024, 32 * nb, 1.f, scr, lane); continue; } r -= 2 * I_IN;
            if (r < 2 * I_UQ) { const int j = r / I_UQ, q = r % I_UQ, kb = q / 48, nb = q % 48; const int n0 = 32 * nb, head = n0 / 96, r0 = n0 % 96;
                if (r0 < 64) transpose_item(w_uq + (size_t)j * 256 * QPITCH, QPITCH, 64 * kb, n0, WUQ + (size_t)j * 1536 * 256, 256, head * 64 + r0, QSCALE, scr, lane);
                else {
                    const float* W = w_uq + (size_t)j * 256 * QPITCH; bf16_t* WT = WUQ + (size_t)j * 1536 * 256; const int k0 = 64 * kb;
#pragma unroll 8
                    for (int i = 0; i < 32; ++i) { const int kk = 2 * i + (lane >> 5); scr[kk * 33 + (lane & 31)] = W[(size_t)(k0 + kk) * QPITCH + n0 + (lane & 31)]; }
                    LDS_WAIT(); asm volatile("" ::: "memory");
                    const int c = lane & 7;
#pragma unroll
                    for (int jj = 0; jj < 4; ++jj) { const int n = (lane >> 3) + 8 * jj; const LAS float* s = scr + (8 * c) * 33 + n;
                        const int drow = 1024 + (head >> 3) * 256 + (head & 7) * 16 + (n < 16 ? n : 128 + n - 16);
                        u32x4 o; o.x = cvtpk(s[0 * 33] * QSCALE, s[1 * 33] * QSCALE); o.y = cvtpk(s[2 * 33] * QSCALE, s[3 * 33] * QSCALE); o.z = cvtpk(s[4 * 33] * QSCALE, s[5 * 33] * QSCALE); o.w = cvtpk(s[6 * 33] * QSCALE, s[7 * 33] * QSCALE);
                        *(u32x4*)(WT + (size_t)drow * 256 + k0 + 8 * c) = o; }
                    LDS_WAIT(); asm volatile("" ::: "memory");
                }
                continue; } r -= 2 * I_UQ;
            if (r < 2 * I_UKV) { const int j = r / I_UKV, q = r % I_UKV, kb = q / 64, nb = q % 64; const int n0 = 32 * nb, head = n0 >> 7, r0 = n0 & 127;
                if (r0 < 64) transpose_item(w_ukv + (size_t)j * 128 * 2048, 2048, 64 * kb, n0, WUK + (size_t)j * 1024 * 128, 128, head * 64 + r0, 1.f, scr, lane);
                else transpose_item(w_ukv + (size_t)j * 128 * 2048, 2048, 64 * kb, n0, WUV + (size_t)j * 1024 * 128, 128, head * 64 + r0 - 64, 1.f, scr, lane);
                continue; } r -= 2 * I_UKV;
            if (r < 2 * I_O) { const int j = r / I_O, q = r % I_O, kb = q / 32, nb = q % 32;
                transpose_item(w_o + (size_t)j * 1024 * 1024, 1024, 64 * kb, 32 * nb, WO + (size_t)j * 1024 * 1024, 1024, 32 * nb, 1.f, scr, lane); continue; } r -= 2 * I_O;
            { const int jg = r / I_P, q = r % I_P, kb = q / 8, nb = q % 8;
                transpose_item(pool_w + (size_t)jg * 65536, 256, 64 * kb, 32 * nb, WP + (size_t)jg * 65536, 256, 32 * nb, 1.f, scr, lane); }
        }
        SEAM(0);
    }

    for (int l = 0; l < DEPTH; ++l) {
        const int pb = 1 + PPL * l, j = l >> 1;
        tid = opaque(threadIdx.x); lane = tid & 63; wave = __builtin_amdgcn_readfirstlane(tid >> 6); gw = vcu * NWAVES + wave; scr = (LAS float*)(lds + RING_OFF + wave * SCR_WAVE);
        const bool mla = (l & 1) == 0;
#define MOE_CONV_DECODE(it, C) do { const int cl = l + ((it) >= 12288 ? 1 : 0); int r = (it) - ((it) >= 12288 ? 12288 : 0); \
            if (r < 8192) { const int which = r >> 12, q = r & 4095, e = q >> 6, kb = (q >> 2) & 15, nb = q & 3; const int n0 = 64 * nb; \
                C.src = (which ? w3 : w1) + ((size_t)cl * 64 + e) * 1024 * 256 + (size_t)(64 * kb) * 256 + n0; C.ldw = 256; \
                C.dst = W13L(cl) + (size_t)e * 512 * 1024 + (size_t)((n0 >> 7) * 256 + (n0 & 127) + which * 128) * 1024 + 64 * kb; C.ldt = 1024; } \
            else { r -= 8192; const int e = r >> 6, kb = (r >> 4) & 3, nb = r & 15; \
                C.src = w2 + ((size_t)cl * 64 + e) * 256 * 1024 + (size_t)(64 * kb) * 1024 + 64 * nb; C.ldw = 1024; \
                C.dst = W2TL(cl) + (size_t)e * 1024 * 256 + (size_t)(64 * nb) * 256 + 64 * kb; C.ldt = 256; } } while (0)

        if (mla) {
            if (PHON(0) && IN(pb + 0)) {
                for (int rep = 0; rep < NREP(0); ++rep) { if (rep) __syncthreads();
                pg8::Gemm g{2048, 1024, 1024}; pg8::DenseOrder S; S.init(NTOK, 512, G, bx, XHL, (size_t)256 * 2048 * 2, 0, WIN + (size_t)j * 512 * 1024, (size_t)256 * 1024 * 2);
                if (G == 256) { pg8::EpiLatNorm E{CQ, CKV, KR, q_norm + j * 256, kv_norm + j * 128, COS, SIN};
                    pg8::gemm_phase<pg8::EpiLatNorm, pg8::DenseOrder, true>(lds + RING_OFF, g, S, E); }
                else { pg8::EpiF32 E{LATB, 512};
                    pg8::gemm_phase<pg8::EpiF32, pg8::DenseOrder, true>(lds + RING_OFF, g, S, E); }
                }
                SEAM(pb + 0);
            }
            if (PHON(1) && IN(pb + 1) && G != 256) {
                const float* gq = q_norm + j * 256; const float* gk = kv_norm + j * 128;
                const f32x4 gqv = *(const f32x4*)(gq + 4 * lane); const f32x4 gkv = *(const f32x4*)(gk + 4 * (lane & 31));
                for (int m = gw; m < NTOK; m += NGW) {
                    const float* lr = LATB + (size_t)m * 512;
                    const f32x4 a = *(const f32x4*)(lr + 4 * lane), c = *(const f32x4*)(lr + 256 + 4 * lane);
                    const float sq = wave_sum(a.x * a.x + a.y * a.y + a.z * a.z + a.w * a.w);
                    const float sk = wave_sum(lane < 32 ? (c.x * c.x + c.y * c.y + c.z * c.z + c.w * c.w) : 0.f);
                    const float rq = 1.0f / sqrtf(sq * (1.f / 256.f) + RMS_EPS), rk = 1.0f / sqrtf(sk * (1.f / 128.f) + RMS_EPS);
                    { u32x2 o; o.x = cvtpk(a.x * rq * gqv.x, a.y * rq * gqv.y); o.y = cvtpk(a.z * rq * gqv.z, a.w * rq * gqv.w); *((u32x2*)(CQ + (size_t)m * 256) + lane) = o; }
                    if (lane < 32) { u32x2 o; o.x = cvtpk(c.x * rk * gkv.x, c.y * rk * gkv.y); o.y = cvtpk(c.z * rk * gkv.z, c.w * rk * gkv.w); *((u32x2*)(CKV + (size_t)m * 128) + lane) = o; }
                    f32x4 p; p.x = __shfl_xor(c.x, 4); p.y = __shfl_xor(c.y, 4); p.z = __shfl_xor(c.z, 4); p.w = __shfl_xor(c.w, 4);
                    if (lane >= 32 && lane < 40) {
                        const f32x4 cv = *(const f32x4*)(COS + (size_t)m * 16 + 4 * (lane & 3)), sv = *(const f32x4*)(SIN + (size_t)m * 16 + 4 * (lane & 3));
                        f32x4 y; if (lane < 36) y = c * cv - p * sv; else y = c * cv + p * sv;
                        u32x2 o; o.x = cvtpk(y.x, y.y); o.y = cvtpk(y.z, y.w); *((u32x2*)(KR + (size_t)m * 32) + (lane - 32)) = o;
                    }
                }
                SEAM(pb + 1);
            }
            if (PHON(2) && IN(pb + 2)) {
                for (int rep = 0; rep < NREP(2); ++rep) {
                { pg8::Gemm g{256, 256, 256}; pg8::DenseOrder S; S.init(NTOK, 1536, G, bx, CQ, (size_t)256 * 256 * 2, 0, WUQ + (size_t)j * 1536 * 256, (size_t)256 * 256 * 2);
                  pg8::EpiQ E{QB, COS, SIN};
                  pg8::gemm_phase<pg8::EpiQ, pg8::DenseOrder, true>(lds + RING_OFF, g, S, E); }
                { pg8::Gemm g{128, 128, 128}; pg8::DenseOrder S; S.init(NTOK, 1024, G, bx, CKV, (size_t)256 * 128 * 2, 0, WUK + (size_t)j * 1024 * 128, (size_t)256 * 128 * 2);
                  pg8::EpiBf16 E{KN, 1024};
                  pg8::gemm_phase<pg8::EpiBf16, pg8::DenseOrder, true>(lds + RING_OFF, g, S, E); }
                { pg8::Gemm g{128, 128, 128}; pg8::DenseOrder S; S.init(1024, NTOK, G, bx, WUV + (size_t)j * 1024 * 128, (size_t)256 * 128 * 2, 0, CKV, (size_t)256 * 128 * 2);
                  pg8::EpiBf16 E{VT, (size_t)NTOK};
                  pg8::gemm_phase<pg8::EpiBf16, pg8::DenseOrder, true>(lds + RING_OFF, g, S, E); }
                }
                SEAM(pb + 2);
            }
            if (PHON(3) && IN(pb + 3)) {
                for (int rep = 0; rep < NREP(3); ++rep) {
                int cj = 0;
                for (int i = 0;; ++i) {
                    const int L = i * G + vcu; if (L >= 2048) break;
                    const int sl = L & 255, rnd = L >> 8;
                    const int bh = (sl >> 5) + 8 * rnd, qb = (rnd & 1) ? 31 - (sl & 31) : (sl & 31);
                    att::attn_unit(bh >> 4, bh & 15, qb, QB, KN, KR, VT, OB, lds + RING_OFF);
                    if (rep == 0 && i < 6) {
                        int it0 = gw + cj * NGW, it1 = it0 + NGW; cj += 2;
                        it0 = it0 < 2 * 12288 ? it0 : 2 * 12288 - 1; it1 = it1 < 2 * 12288 ? it1 : 2 * 12288 - 1;
                        ConvItem c0, c1; f32x4 v0[16], v1[16];
                        MOE_CONV_DECODE(it0, c0); conv_load(c0, v0, lane);
                        MOE_CONV_DECODE(it1, c1); conv_load(c1, v1, lane);
                        conv_finish(c0, v0, scr, lane);
                        conv_finish(c1, v1, scr, lane);
                        __syncthreads();
                    }
                }
                if (rep == 0) { for (;; ++cj) { const int it = gw + cj * NGW; if (it >= 2 * 12288) break; ConvItem c0; f32x4 v0[16]; MOE_CONV_DECODE(it, c0); conv_load(c0, v0, lane); conv_finish(c0, v0, scr, lane); } __syncthreads(); }
                }
                SEAM(pb + 3);
            }
            if (PHON(4) && IN(pb + 4)) {
                for (int rep = 0; rep < NREP(4); ++rep) {
                pg8::Gemm g{1024, 1024, 1024}; pg8::DenseOrder S; S.init(NTOK, 1024, G, bx, OB, (size_t)256 * 1024 * 2, 0, WO + (size_t)j * 1024 * 1024, (size_t)256 * 1024 * 2);
                pg8::EpiBf16 E{FB, 1024};
                pg8::gemm_phase<pg8::EpiBf16, pg8::DenseOrder, true>(lds + RING_OFF, g, S, E);
                }
                SEAM(pb + 4);
            }
        } else {
            if (PHON(13) && IN(pb + 0)) {
                for (int rep = 0; rep < NREP(13); ++rep) {
                for (int it = gw; it < 2 * (NTOK / 32); it += NGW) {
                    const int q = it & 1, t0 = (it >> 1) * 32, s0 = t0 & (SEQ - 1), grp = 2 * q + (lane >> 5), win = 2 << grp;
                    const bf16_t* xb = XHL + grp * 256 + 8 * (lane & 31);
                    bf16_t* pout = POOLED + grp * 256 + 8 * (lane & 31);
                    f32x4 Sa = {0.f, 0.f, 0.f, 0.f}, Sb = {0.f, 0.f, 0.f, 0.f};
#pragma unroll
                    for (int jj = 1; jj < 16; ++jj) { if (jj < win && s0 - jj >= 0) { const F8 r = bf8(*(const u32x4*)(xb + (size_t)(t0 - jj) * 2048)); Sa += r.a; Sb += r.b; } }
                    for (int tb = 0; tb < 32; tb += 8) {
                        u32x4 xn[8], xe[8];
#pragma unroll
                        for (int i = 0; i < 8; ++i) { const int t = t0 + tb + i; xn[i] = *(const u32x4*)(xb + (size_t)t * 2048);
                            xe[i] = (s0 + tb + i - win + 1 >= 0) ? *(const u32x4*)(xb + (size_t)(t - win + 1) * 2048) : (u32x4){0u, 0u, 0u, 0u}; }
#pragma unroll
                        for (int i = 0; i < 8; ++i) { const int sI = s0 + tb + i; const F8 xv = bf8(xn[i]), ev = bf8(xe[i]);
                            Sa += xv.a; Sb += xv.b;
                            const float rc = 1.0f / (float)((sI + 1 < win) ? sI + 1 : win);
                            *(u32x4*)(pout + (size_t)(t0 + tb + i) * 1024) = pk8(Sa * rc - xv.a, Sb * rc - xv.b);
                            Sa -= ev.a; Sb -= ev.b; }
                    }
                }
                }
                SEAM(pb + 0);
            }
            if (PHON(14) && IN(pb + 1)) {
                for (int rep = 0; rep < NREP(14); ++rep) {
                pg8::Gemm g{1024, 256, 256}; pg8::DenseOrder S; S.init(NTOK, 1024, G, bx, POOLED, (size_t)256 * 1024 * 2, (size_t)256 * 2, WP + (size_t)j * 4 * 65536, (size_t)65536 * 2);
                pg8::EpiPool E{FB, pool_b + j * 1024, pool_scale + j * 1024};
                pg8::gemm_phase<pg8::EpiPool, pg8::DenseOrder, true>(lds + RING_OFF, g, S, E);
                }
                SEAM(pb + 1);
            }
        }
        if (PHON(5) && IN(pb + 5)) {
                for (int rep = 0; rep < NREP(5); ++rep) {
            f32x4 gv[4], bv[4];
#pragma unroll
            for (int jj = 0; jj < 4; ++jj) { const int c = 8 * lane + 512 * (jj >> 1) + 4 * (jj & 1); gv[jj] = *(const f32x4*)(ln_g + (size_t)(l * 2 + 0) * 1024 + c); bv[jj] = *(const f32x4*)(ln_b + (size_t)(l * 2 + 0) * 1024 + c); }
            for (int m = gw; m < NTOK; m += NGW) {
                u32x4* xh = (u32x4*)(XHL + (size_t)m * 2048) + lane; const u32x4* fr2 = (const u32x4*)(FB + (size_t)m * 1024) + lane;
                const F8 x0 = bf8(xh[0]), x1 = bf8(xh[64]), f0 = bf8(fr2[0]), f1 = bf8(fr2[64]);
                f32x4 v[4] = {x0.a * DN_ALPHA + f0.a, x0.b * DN_ALPHA + f0.b, x1.a * DN_ALPHA + f1.a, x1.b * DN_ALPHA + f1.b}; float s = 0.f;
#pragma unroll
                for (int jj = 0; jj < 4; ++jj) s += (v[jj].x + v[jj].y) + (v[jj].z + v[jj].w);
                const float mean = wave_sum(s) * (1.f / 1024.f); float s2 = 0.f;
#pragma unroll
                for (int jj = 0; jj < 4; ++jj) { v[jj] = v[jj] - mean; s2 += (v[jj].x * v[jj].x + v[jj].y * v[jj].y) + (v[jj].z * v[jj].z + v[jj].w * v[jj].w); }
                const float rstd = 1.0f / sqrtf(wave_sum(s2) * (1.f / 1024.f) + LN_EPS);
#pragma unroll
                for (int jj = 0; jj < 4; ++jj) v[jj] = v[jj] * rstd * gv[jj] + bv[jj];
#pragma unroll
                for (int j = 0; j < 2; ++j) { const u32x4 h = pk8(v[2 * j], v[2 * j + 1]); const F8 hf = bf8(h);
                    xh[64 * j] = h; xh[128 + 64 * j] = pk8(v[2 * j] - hf.a, v[2 * j + 1] - hf.b); }
            }
            }
                SEAM(pb + 5);
        }
        if (PHON(7) && IN(pb + 7)) {
            for (int rep = 0; rep < NREP(7); ++rep) {
            LAS unsigned char* rl = lds + RING_OFF;
            LAS float* RED = (LAS float*)rl; LAS float* LT = (LAS float*)(rl + 49152); LAS int* hist = (LAS int*)(rl + 98816); LAS int* cbase = hist + 64;
            const float* bg = b_grp + l * 8; const float* be = b_exp + l * 64;
            unsigned* gcnt = ctl + CW_GCNT + 64 * l;
            const int rb = wave & 3, kh = wave >> 2, r32 = lane & 31, hh = lane >> 5;
            const bf16_t* wr_l = WR + (size_t)l * 64 * 3072;
            for (int c = bx; c < 256; c += G) {
                __syncthreads();
                const bf16_t* xrow = XHL + (size_t)(c * 128 + rb * 32 + r32) * 2048 + 512 * kh + 32 * hh;
#define RK_STAGE(it, buf) do { _Pragma("unroll") for (int q_ = 0; q_ < 6; ++q_) { const int q = wave * 6 + q_, khp = q / 24, sp = (q % 24) / 6, pc = q % 6; \
                    __builtin_amdgcn_global_load_lds((const unsigned*)(wr_l + (size_t)(32 * khp + 4 * (it) + sp) * 3072 + pc * 512 + lane * 8), (LAS unsigned*)(rl + (buf) * 49152 + q * 1024), 16, 0, 0); } } while (0)
#define RK_LOADA(AH, AL, it) do { _Pragma("unroll") for (int s_ = 0; s_ < 4; ++s_) { AH[s_] = *(const bf16x8*)(xrow + 64 * (it) + 8 * s_); AL[s_] = *(const bf16x8*)(xrow + 1024 + 64 * (it) + 8 * s_); } } while (0)
#define RK_COMPUTE(AH, AL, buf) do { const LAS unsigned char* bb = rl + (buf) * 49152 + kh * 24576 + hh * 512 + r32 * 16; \
                    _Pragma("unroll") for (int s_ = 0; s_ < 4; ++s_) { _Pragma("unroll") for (int nb = 0; nb < 3; ++nb) { \
                        const bf16x8 wh = *(const LAS bf16x8*)(bb + s_ * 6144 + nb * 1024), wl = *(const LAS bf16x8*)(bb + s_ * 6144 + 3072 + nb * 1024); \
                        acc[nb] = __builtin_amdgcn_mfma_f32_32x32x16_bf16(AH[s_], wh, acc[nb], 0, 0, 0); \
                        acc[nb] = __builtin_amdgcn_mfma_f32_32x32x16_bf16(AL[s_], wh, acc[nb], 0, 0, 0); \
                        acc[nb] = __builtin_amdgcn_mfma_f32_32x32x16_bf16(AH[s_], wl, acc[nb], 0, 0, 0); } } } while (0)
                f32x16 acc[3] = {};
                bf16x8 a0h[4], a0l[4], a1h[4], a1l[4];
                RK_STAGE(0, 0); RK_LOADA(a0h, a0l, 0);
                for (int it = 0; it < 8; it += 2) {
                    asm volatile("s_waitcnt vmcnt(0)" ::: "memory"); __builtin_amdgcn_s_barrier(); asm volatile("" ::: "memory");
                    RK_STAGE(it + 1, 1); RK_LOADA(a1h, a1l, it + 1);
                    RK_COMPUTE(a0h, a0l, 0);
                    asm volatile("s_waitcnt vmcnt(0) lgkmcnt(0)" ::: "memory"); __builtin_amdgcn_s_barrier(); asm volatile("" ::: "memory");
                    if (it + 2 < 8) { RK_STAGE(it + 2, 0); RK_LOADA(a0h, a0l, it + 2); }
                    RK_COMPUTE(a1h, a1l, 1);
                    asm volatile("s_waitcnt lgkmcnt(0)" ::: "memory");
                }
#undef RK_STAGE
#undef RK_LOADA
#undef RK_COMPUTE
                if (kh == 1) {
#pragma unroll
                    for (int nb = 0; nb < 3; ++nb)
#pragma unroll
                        for (int q = 0; q < 4; ++q) *(LAS f32x4*)(RED + ((rb * 3 + nb) * 64 + lane) * 16 + 4 * q) = (f32x4){acc[nb][4 * q], acc[nb][4 * q + 1], acc[nb][4 * q + 2], acc[nb][4 * q + 3]};
                }
                __syncthreads();
                if (kh == 0) {
#pragma unroll
                    for (int nb = 0; nb < 3; ++nb)
#pragma unroll
                        for (int q = 0; q < 4; ++q) { const f32x4 o = *(const LAS f32x4*)(RED + ((rb * 3 + nb) * 64 + lane) * 16 + 4 * q);
#pragma unroll
                            for (int e = 0; e < 4; ++e) { const int r = 4 * q + e; LT[(rb * 32 + (r & 3) + 8 * (r >> 2) + 4 * hh) * 97 + nb * 32 + r32] = acc[nb][r] + o[e]; } }
                }
                if (tid < 64) hist[tid] = 0;
                __syncthreads();
                int ex1 = 0, ex2 = 0, p1 = 0, p2 = 0; float ga1 = 0.f, ga2 = 0.f;
                const int t = c * 128 + tid;
                if (tid < 128) {
                    const LAS float* lg = LT + tid * 97;
                    float gl[8];
#pragma unroll
                    for (int i = 0; i < 8; ++i) gl[i] = lg[i] + bg[i];
                    int gs = 0; float gm = gl[0];
#pragma unroll
                    for (int i = 1; i < 8; ++i) if (gl[i] > gm) { gm = gl[i]; gs = i; }
                    float se = 0.f;
#pragma unroll
                    for (int i = 0; i < 8; ++i) se += __expf(gl[i] - gm);
                    const float ggate = 1.0f / se;
                    float el[8];
#pragma unroll
                    for (int i = 0; i < 8; ++i) el[i] = lg[8 + gs * 8 + i] + be[gs * 8 + i];
                    int i1 = 0; float m1 = el[0];
#pragma unroll
                    for (int i = 1; i < 8; ++i) if (el[i] > m1) { m1 = el[i]; i1 = i; }
                    int i2 = -1; float m2 = -INFINITY;
#pragma unroll
                    for (int i = 0; i < 8; ++i) if (i != i1 && el[i] > m2) { m2 = el[i]; i2 = i; }
                    const float x2 = __expf(m2 - m1), rs = 1.0f / (1.0f + x2);
                    ex1 = gs * 8 + i1; ex2 = gs * 8 + i2; ga1 = ggate * rs; ga2 = ggate * x2 * rs;
                    p1 = __hip_atomic_fetch_add(&hist[ex1], 1, __ATOMIC_RELAXED, __HIP_MEMORY_SCOPE_WORKGROUP); p2 = __hip_atomic_fetch_add(&hist[ex2], 1, __ATOMIC_RELAXED, __HIP_MEMORY_SCOPE_WORKGROUP);
                }
                __syncthreads();
                if (tid < 64) { const int n = hist[tid]; cbase[tid] = n ? (int)__hip_atomic_fetch_add(gcnt + tid, (unsigned)n, __ATOMIC_RELAXED, __HIP_MEMORY_SCOPE_AGENT) : 0; }
                __syncthreads();
                if (tid < 128) {
                    const size_t i1 = (size_t)ex1 * pg8::LIST_CAP + cbase[ex1] + p1, i2 = (size_t)ex2 * pg8::LIST_CAP + cbase[ex2] + p2;
                    ROWLIST[i1] = 2 * t; LGATE[i1] = ga1; ROWLIST[i2] = 2 * t + 1; LGATE[i2] = ga2;
                }
                __syncthreads();
            }
            }
            SEAM(pb + 7);
        }
#define MOE_TILE_TABLE() \
            LAS int* tinfo = (LAS int*)(lds + TINFO_OFF); \
            __syncthreads(); \
            if (tid < 64) tinfo[pg8::TI_CNT + tid] = (int)__hip_atomic_load(ctl + CW_GCNT + 64 * l + tid, __ATOMIC_RELAXED, __HIP_MEMORY_SCOPE_AGENT); \
            __syncthreads(); \
            if (tid == 0) { int tt = 0; for (int e = 0; e < 64; ++e) { const int n = (tinfo[pg8::TI_CNT + e] + 255) >> 8; for (int i = 0; i < n && tt < MAX_TILES; ++i) tinfo[tt++] = e | (i << 8); } tinfo[pg8::TI_CNT + 64] = tt; } \
            __syncthreads(); \
            const int ntl = tinfo[pg8::TI_CNT + 64];
        if (PHON(9) && IN(pb + 9)) {
            for (int rep = 0; rep < NREP(9); ++rep) {
            MOE_TILE_TABLE();
            pg8::Gemm g{2048, 1024, 1024}; pg8::GatherOrder S; S.init(tinfo, ntl, 2, G, bx, XHL, ROWLIST, W13L(l), (size_t)512 * 1024 * 2, (size_t)256 * 1024 * 2);
            { pg8::Unit uu;
              for (int ui = 0; ui < pg8::MOE_LDS_UNITS; ++ui) if (S.next(ui, uu) && tid < 256) tinfo[pg8::TI_ROWOFF + ui * 256 + tid] = (int)S.row_off(uu, tid, 2048);
              __syncthreads(); }
            pg8::EpiSwiglu E{HS};
            pg8::gemm_phase<pg8::EpiSwiglu, pg8::GatherOrder, true>(lds + RING_OFF, g, S, E);
            }
            SEAM(pb + 9);
        }
        if (PHON(10) && IN(pb + 10)) {
            for (int rep = 0; rep < NREP(10); ++rep) {
            MOE_TILE_TABLE();
            pg8::Gemm g{256, 256, 256}; pg8::MoeOrder S; S.init(tinfo, ntl, 4, G, bx, HS, (size_t)256 * 256 * 2, W2TL(l), (size_t)1024 * 256 * 2, (size_t)256 * 256 * 2);
            { pg8::Unit uu;
              for (int ui = 0; ui < pg8::MOE_LDS_UNITS; ++ui) if (S.next(ui, uu) && tid < 256) {
                  const int ti = tinfo[uu.pm], e = ti & 255, r = (ti >> 8) * 256 + tid; const bool ok = r < tinfo[pg8::TI_CNT + e]; const size_t li = (size_t)e * pg8::LIST_CAP + r;
                  tinfo[pg8::TI_ROWOFF + ui * 256 + tid] = ok ? ROWLIST[li] : 0; tinfo[pg8::TI_ROWOFF + pg8::MOE_LDS_UNITS * 256 + ui * 256 + tid] = ok ? __float_as_int(LGATE[li]) : 0; }
              __syncthreads(); }
            pg8::EpiMoeOut E{YB, tinfo, ROWLIST, LGATE};
            pg8::gemm_phase<pg8::EpiMoeOut, pg8::MoeOrder, true>(lds + RING_OFF, g, S, E);
            }
            SEAM(pb + 10);
        }
        if (PHON(11) && IN(pb + 11)) {
            f32x4 gv[4], bv[4];
#pragma unroll
            for (int jj = 0; jj < 4; ++jj) { const int c = 8 * lane + 512 * (jj >> 1) + 4 * (jj & 1); gv[jj] = *(const f32x4*)(ln_g + (size_t)(l * 2 + 1) * 1024 + c); bv[jj] = *(const f32x4*)(ln_b + (size_t)(l * 2 + 1) * 1024 + c); }
            const bool lastl = (l == DEPTH - 1);
            for (int m = gw; m < NTOK; m += NGW) {
                u32x4* xh = (u32x4*)(XHL + (size_t)m * 2048) + lane;
                const u32x4* y0 = (const u32x4*)(YB + (size_t)(2 * m) * 1024) + lane; const u32x4* y1 = (const u32x4*)(YB + (size_t)(2 * m + 1) * 1024) + lane;
                const F8 x0 = bf8(xh[0]), x1 = bf8(xh[64]), a0 = bf8(y0[0]), a1 = bf8(y0[64]), c0 = bf8(y1[0]), c1 = bf8(y1[64]);
                f32x4 v[4] = {x0.a * DN_ALPHA + (a0.a + c0.a), x0.b * DN_ALPHA + (a0.b + c0.b), x1.a * DN_ALPHA + (a1.a + c1.a), x1.b * DN_ALPHA + (a1.b + c1.b)}; float s = 0.f;
#pragma unroll
                for (int jj = 0; jj < 4; ++jj) s += (v[jj].x + v[jj].y) + (v[jj].z + v[jj].w);
                const float mean = wave_sum(s) * (1.f / 1024.f); float s2 = 0.f;
#pragma unroll
                for (int jj = 0; jj < 4; ++jj) { v[jj] = v[jj] - mean; s2 += (v[jj].x * v[jj].x + v[jj].y * v[jj].y) + (v[jj].z * v[jj].z + v[jj].w * v[jj].w); }
                const float rstd = 1.0f / sqrtf(wave_sum(s2) * (1.f / 1024.f) + LN_EPS);
#pragma unroll
                for (int jj = 0; jj < 4; ++jj) v[jj] = v[jj] * rstd * gv[jj] + bv[jj];
                if (lastl) { f32x4* orow = (f32x4*)(kargs()->out + (size_t)m * 1024) + 2 * lane;
                    orow[0] = v[0]; orow[1] = v[1]; orow[128] = v[2]; orow[129] = v[3];
                } else { xh[0] = pk8(v[0], v[1]); xh[64] = pk8(v[2], v[3]); }
            }
            SEAM(pb + 11);
        }
    }
#undef IN
#undef SEAM
}
#undef ws
#undef in_x
#undef in_pos
#undef ln_g
#undef ln_b
#undef w_in
#undef q_norm
#undef w_uq
#undef kv_norm
#undef w_ukv
#undef w_o
#undef pool_w
#undef pool_b
#undef pool_scale
#undef w_grp
#undef b_grp
#undef w_exp
#undef b_exp
#undef w1
#undef w3
#undef w2
#undef COS
#undef SIN
#undef CNT
#undef TILE
#undef AE
#undef APOS
#undef AG
#undef RSLOT
#undef RGATE
#undef WIN
#undef WUQ
#undef WUK
#undef WUV
#undef WO
#undef WP
#undef WR
#undef W13L
#undef W2TL
#undef FB
#undef XHL
#undef LATB
#undef CQ
#undef CKV
#undef KR
#undef QB
#undef KN
#undef VT
#undef OB
#undef POOLED
#undef LG
#undef ROWLIST
#undef LGATE
#undef HS
#undef YB

static bool phase_exists(int p) {
    if (p == 0) return true;
    const int l = (p - 1) / PPL, k = (p - 1) % PPL;
    if (k == 8 || k == 6) return false;
    if (k >= 5) return true;
    return (l & 1) == 0 ? true : (k < 2);
}
extern "C" void kernel_launch(void* const* d_in, const int* in_sizes, int n_in, void* d_out, int out_size, void* d_ws, size_t ws_size, hipStream_t stream) {
    static int grid = 0;
    if (grid == 0) {
        if (n_in != 20 || in_sizes[0] != NTOK * D_MODEL || out_size != NTOK * D_MODEL || ws_size < WS_END) { fprintf(stderr, "kernel_launch: unexpected shapes / workspace (%zu < %zu)\n", ws_size, (size_t)WS_END); grid = -1; return; }
        int dev = 0, cus = 0, per_cu = 0;
        if (hipGetDevice(&dev) != hipSuccess || hipDeviceGetAttribute(&cus, hipDeviceAttributeMultiprocessorCount, dev) != hipSuccess) { grid = -1; return; }
        if (hipFuncSetAttribute((const void*)mk_fwd, hipFuncAttributeMaxDynamicSharedMemorySize, LDS_BYTES) != hipSuccess) { fprintf(stderr, "kernel_launch: hipFuncSetAttribute failed\n"); grid = -1; return; }
        if (hipOccupancyMaxActiveBlocksPerMultiprocessor(&per_cu, (const void*)mk_fwd, NWAVES * 64, LDS_BYTES) != hipSuccess || per_cu < 1) fprintf(stderr, "kernel_launch: occupancy query reports %d\n", per_cu);
        (void)hipGetLastError();
        grid = cus;
    }
    if (grid < 0) return;
    if (hipMemsetAsync((char*)d_ws + WS_CTL, 0, CTL_ZERO_BYTES, stream) != hipSuccess) return;
    Args a{};
    for (int i = 0; i < 20; ++i) a.in[i] = d_in[i];
    a.out = (float*)d_out; a.ws = (unsigned char*)d_ws;
#if MK_ONE_LAUNCH
    a.ph_lo = 0; a.ph_hi = NPHASE;
    hipLaunchKernelGGL(mk_fwd, dim3(grid), dim3(NWAVES * 64), LDS_BYTES, stream, a);
#else
    for (int p = 0; p < NPHASE; ++p) {
        if (!phase_exists(p)) continue;
        a.ph_lo = p; a.ph_hi = p + 1;
        hipLaunchKernelGGL(mk_fwd, dim3(grid), dim3(NWAVES * 64), LDS_BYTES, stream, a);
    }
#endif
}
```

```cpp
#include <hip/hip_runtime.h>
#include <cstdio>
#include <cstdint>

#ifndef MK_ONE_LAUNCH
#define MK_ONE_LAUNCH 1
#endif

#define LAS __attribute__((address_space(3)))
#define GAS __attribute__((address_space(1)))

constexpr int D_MODEL = 1024, BATCH = 4, SEQ = 8192, DEPTH = 4, NTOK = BATCH * SEQ;
constexpr int N_HEADS = 16, QK_NOPE = 64, QK_ROPE = 32, V_HEAD = 64, Q_LORA = 256, KV_LORA = 128, LAT = Q_LORA + KV_LORA + QK_ROPE;
constexpr int QPITCH = N_HEADS * (QK_NOPE + QK_ROPE);
constexpr int N_GROUPS = 8, EPG = 8, N_EXPERTS = 64, D_EXPERT = 256;
constexpr int MAX_TILES = 320;
constexpr float DN_ALPHA = 1.681792830507429f;
constexpr float LN_EPS = 1e-5f, RMS_EPS = 1e-6f;
constexpr float QSCALE = 0.14724444602590306f;
constexpr int LGP = 80;

constexpr size_t MiB = 1u << 20;
constexpr size_t WS_CTL = 0, CTL_ZERO_BYTES = 1 * MiB;
constexpr size_t WS_COS = 1 * MiB, WS_SIN = 3 * MiB;
constexpr size_t WS_CNT = 5 * MiB;
constexpr size_t WS_TILE = 5 * MiB + 65536;
constexpr size_t WS_AE = 5 * MiB + 131072, WS_APOS = WS_AE + 262144, WS_AG = WS_APOS + 262144;
constexpr size_t WS_RSLOT = 6 * MiB, WS_RGATE = 6 * MiB + 512 * 1024;
constexpr size_t WS_WIN = 8 * MiB;
constexpr size_t WS_WUQ = 10 * MiB;
constexpr size_t WS_WUK = 12 * MiB;
constexpr size_t WS_WUV = 13 * MiB;
constexpr size_t WS_WO = 14 * MiB;
constexpr size_t WS_WP = 18 * MiB;
constexpr size_t WS_WR = 19 * MiB;
constexpr size_t WS_W13 = 24 * MiB;
constexpr size_t WS_W2T = 88 * MiB;
constexpr size_t WS_W13B = 184 * MiB;
constexpr size_t WS_W2TB = 760 * MiB;
constexpr size_t WS_FB = 120 * MiB;
constexpr size_t WS_XHL = 248 * MiB;
constexpr size_t WS_R1 = 376 * MiB;
constexpr size_t WS_LAT = WS_R1;
constexpr size_t WS_CQ = WS_R1 + 64 * MiB;
constexpr size_t WS_CKV = WS_R1 + 80 * MiB;
constexpr size_t WS_KR = WS_R1 + 88 * MiB;
constexpr size_t WS_Q = WS_R1 + 92 * MiB;
constexpr size_t WS_KN = WS_R1 + 188 * MiB;
constexpr size_t WS_VT = WS_R1 + 252 * MiB;
constexpr size_t WS_O = WS_R1 + 316 * MiB;
constexpr size_t WS_POOLED = WS_R1;
constexpr size_t WS_LG = WS_R1;
constexpr size_t WS_LIST = WS_R1 + 20 * MiB;
constexpr size_t WS_LGATE = WS_R1 + 36 * MiB;
constexpr size_t WS_HS = WS_R1 + 180 * MiB;
constexpr size_t WS_Y = WS_R1 + 220 * MiB;
constexpr size_t WS_END = 792 * MiB;
static_assert(WS_O + 64 * MiB <= WS_END && WS_Y + 128 * MiB <= WS_END, "ws map");

constexpr int CW_TMO = 0, CW_CODE = 1, CW_BAR = 4096, CW_GCNT = 16384;

constexpr int RING_OFF = 0, RING_BYTES = 131072, SCR_WAVE = 17408;
constexpr int LDSCTL_OFF = 8 * SCR_WAVE, MISC_OFF = LDSCTL_OFF + 320, TINFO_OFF = LDSCTL_OFF + 1024;
constexpr int LDS_BYTES = 155648;
static_assert(TINFO_OFF + (512 + 2 * 5 * 256) * 4 <= LDS_BYTES && LDS_BYTES <= 163840, "LDS map");

typedef unsigned short bf16_t;
typedef short bf16x8 __attribute__((ext_vector_type(8)));
typedef float f32x4 __attribute__((ext_vector_type(4)));
typedef float f32x16 __attribute__((ext_vector_type(16)));
typedef unsigned u32x4 __attribute__((ext_vector_type(4)));
typedef unsigned u32x2 __attribute__((ext_vector_type(2)));
typedef float f32x2_t __attribute__((ext_vector_type(2)));
typedef __bf16 bf16x2_t __attribute__((ext_vector_type(2)));
#define RLX_AGENT __ATOMIC_RELAXED, __HIP_MEMORY_SCOPE_AGENT
#define LDS_WAIT() asm volatile("s_waitcnt lgkmcnt(0)" ::: "memory")
#define VM_WAIT() asm volatile("s_waitcnt vmcnt(0)" ::: "memory")

__device__ __forceinline__ unsigned cvtpk(float lo, float hi) { f32x2_t v = {lo, hi}; bf16x2_t b = __builtin_convertvector(v, bf16x2_t); return __builtin_bit_cast(unsigned, b); }
__device__ __forceinline__ int opaque(int x) { asm volatile("" : "+v"(x)); return x; }
__device__ __forceinline__ int opaque_s(int x) { asm volatile("" : "+s"(x)); return x; }
__device__ __forceinline__ float bflo(unsigned u) { return __uint_as_float(u << 16); }
__device__ __forceinline__ float bfhi(unsigned u) { return __uint_as_float(u & 0xffff0000u); }
__device__ __forceinline__ float wave_sum(float v) {
#pragma unroll
    for (int o = 1; o < 64; o <<= 1) v += __shfl_xor(v, o);
    return v;
}
__device__ __forceinline__ void split4(const f32x4 v, u32x2& h, u32x2& l) {
    h.x = cvtpk(v.x, v.y); h.y = cvtpk(v.z, v.w);
    l.x = cvtpk(v.x - bflo(h.x), v.y - bfhi(h.x)); l.y = cvtpk(v.z - bflo(h.y), v.w - bfhi(h.y));
}
__device__ __forceinline__ f32x4 join4(const u32x2 h, const u32x2 l) {
    return (f32x4){bflo(h.x) + bflo(l.x), bfhi(h.x) + bfhi(l.x), bflo(h.y) + bflo(l.y), bfhi(h.y) + bfhi(l.y)};
}
struct F8 { f32x4 a, b; };
__device__ __forceinline__ F8 bf8(const u32x4 w) { F8 r; r.a = (f32x4){bflo(w.x), bfhi(w.x), bflo(w.y), bfhi(w.y)}; r.b = (f32x4){bflo(w.z), bfhi(w.z), bflo(w.w), bfhi(w.w)}; return r; }
__device__ __forceinline__ u32x4 pk8(const f32x4 a, const f32x4 b) { u32x4 w; w.x = cvtpk(a.x, a.y); w.y = cvtpk(a.z, a.w); w.z = cvtpk(b.x, b.y); w.w = cvtpk(b.z, b.w); return w; }
__device__ __forceinline__ f32x4 bf4(const u32x2 h) { return (f32x4){bflo(h.x), bfhi(h.x), bflo(h.y), bfhi(h.y)}; }

namespace pg8 {
constexpr int BM = 256, BK = 64, HALF = 128, HTB = HALF * BK * 2, STAGE_BYTES = 8 * HTB, NXCD = 8, WGM = 8;
__host__ __device__ __forceinline__ int lds_byte(int r, int c) { const int st = (r >> 4) * 2 + (c >> 5), rr = r & 15, cc = c & 31, ob = rr * 64 + cc * 2; return st * 1024 + (ob ^ (((ob >> 9) & 1) << 5)); }
__host__ __device__ __forceinline__ void stage_rc(int b, int& R, int& C) { const int st = b / 1024, sb = b % 1024, swz = sb ^ (((sb >> 9) & 1) << 5); R = (st >> 1) * 16 + swz / 64; C = (st & 1) * 32 + (swz % 64) / 2; }
__host__ __device__ __forceinline__ int perm32(int rho) { const int n = rho >> 4, i = rho & 15; return 8 * (i >> 2) + 4 * n + (i & 3); }

struct Unit { int pm, pn, ui; };
struct Gemm { int lda, ldb, K; };

struct DenseOrder {
    int nM, nN, nwg, G, c;
    const char* A; const char* B; size_t a_pm, a_pn, b_pn;
    __device__ __forceinline__ void init(int M, int N, int G_, int c_, const void* A_, size_t a_pm_, size_t a_pn_, const void* B_, size_t b_pn_) {
        nM = M / BM; nN = N / BM; nwg = nM * nN; G = G_; c = c_; A = (const char*)A_; B = (const char*)B_; a_pm = a_pm_; a_pn = a_pn_; b_pn = b_pn_; }
    __device__ __forceinline__ bool next(int i, Unit& u) const {
        const long L = (long)i * G + c; if (L >= nwg) return false;
        int wgid = (int)L; { const int q = nwg / NXCD, r = nwg % NXCD, xcd = wgid % NXCD, off = wgid / NXCD; wgid = (xcd < r ? xcd * (q + 1) : r * (q + 1) + (xcd - r) * q) + off; }
        const int nig = WGM * nN, gid = wgid / nig, fm = gid * WGM, gsz = (nM - fm) < WGM ? (nM - fm) : WGM;
        u.pm = fm + ((wgid % nig) % gsz); u.pn = (wgid % nig) / gsz; u.ui = i; return true;
    }
    __device__ __forceinline__ const char* a_base(const Unit& u) const { return A + (size_t)u.pm * a_pm + (size_t)u.pn * a_pn; }
    __device__ __forceinline__ unsigned a_voff(const Unit&, int R, int C, int lda) const { return (unsigned)(R * lda + C) * 2u; }
    __device__ __forceinline__ const char* b_base(const Unit& u) const { return B + (size_t)u.pn * b_pn; }
};
constexpr int TI_CNT = 320, LIST_CAP = 65536, TI_ROWOFF = 512, MOE_LDS_UNITS = 5;
struct MoeOrder {
    const LAS int* tinfo; int ntiles, nN, nwg, G, c;
    const char* A; const char* W; size_t a_tile, w_e, w_pn;
    __device__ __forceinline__ void init(const LAS int* ti, int ntiles_, int nN_, int G_, int c_, const void* A_, size_t a_tile_, const void* W_, size_t w_e_, size_t w_pn_) {
        tinfo = ti; ntiles = ntiles_; nN = nN_; nwg = ntiles_ * nN_; G = G_; c = c_; A = (const char*)A_; a_tile = a_tile_; W = (const char*)W_; w_e = w_e_; w_pn = w_pn_; }
    __device__ __forceinline__ bool next(int i, Unit& u) const {
        const long L = (long)i * G + c; if (L >= nwg) return false;
        int wgid = (int)L; { const int q = nwg / NXCD, r = nwg % NXCD, xcd = wgid % NXCD, off = wgid / NXCD; wgid = (xcd < r ? xcd * (q + 1) : r * (q + 1) + (xcd - r) * q) + off; }
        u.pm = wgid / nN; u.pn = wgid % nN; u.ui = i; return true;
    }
    __device__ __forceinline__ const char* a_base(const Unit& u) const { return A + (size_t)u.pm * a_tile; }
    __device__ __forceinline__ const char* b_base(const Unit& u) const { const int e = __builtin_amdgcn_readfirstlane(tinfo[u.pm]) & 255; return W + (size_t)e * w_e + (size_t)u.pn * w_pn; }
    __device__ __forceinline__ unsigned a_voff(const Unit&, int R, int C, int lda) const { return (unsigned)(R * lda + C) * 2u; }
};
struct GatherOrder {
    const LAS int* tinfo; int ntiles, nN, nwg, G, c;
    const char* A; const int* list; const char* W; size_t w_e, w_pn; const LAS unsigned* rowoff;
    __device__ __forceinline__ void init(const LAS int* ti, int ntiles_, int nN_, int G_, int c_, const void* A_, const int* list_, const void* W_, size_t w_e_, size_t w_pn_) {
        rowoff = (const LAS unsigned*)(ti + TI_ROWOFF); tinfo = ti; ntiles = ntiles_; nN = nN_; nwg = ntiles_ * nN_; G = G_; c = c_; A = (const char*)A_; list = list_; W = (const char*)W_; w_e = w_e_; w_pn = w_pn_; }
    __device__ __forceinline__ bool next(int i, Unit& u) const {
        const long L = (long)i * G + c; if (L >= nwg) return false;
        int wgid = (int)L; { const int q = nwg / NXCD, r = nwg % NXCD, xcd = wgid % NXCD, off = wgid / NXCD; wgid = (xcd < r ? xcd * (q + 1) : r * (q + 1) + (xcd - r) * q) + off; }
        u.pm = wgid / nN; u.pn = wgid % nN; u.ui = i; return true;
    }
    __device__ __forceinline__ const char* a_base(const Unit&) const { return A; }
    __device__ __forceinline__ const char* b_base(const Unit& u) const { const int e = __builtin_amdgcn_readfirstlane(tinfo[u.pm]) & 255; return W + (size_t)e * w_e + (size_t)u.pn * w_pn; }
    __device__ __forceinline__ unsigned row_off(const Unit& u, int R, int lda) const {
        const int ti = tinfo[u.pm], e = ti & 255, r = (ti >> 8) * 256 + R; const int n = tinfo[TI_CNT + e];
        const int ga = (r < n) ? list[(size_t)e * LIST_CAP + r] : 0;
        return (unsigned)(ga >> 1) * (unsigned)(lda * 2); }
    __device__ __forceinline__ unsigned a_voff(const Unit& u, int R, int C, int lda) const {
        return (u.ui < MOE_LDS_UNITS ? rowoff[u.ui * 256 + R] : row_off(u, R, lda)) + (unsigned)C * 2u; }
};

#define ACC_T const f32x4 (&acc)[2][2][4][2]
__device__ __forceinline__ u32x4 pack_acc(const f32x4 v0, const f32x4 v1) { u32x4 w; w.x = cvtpk(v0[0], v0[1]); w.y = cvtpk(v0[2], v0[3]); w.z = cvtpk(v1[0], v1[1]); w.w = cvtpk(v1[2], v1[3]); return w; }
struct EpiBf16 {
    static constexpr bool PERM = true, AFTER_DRAIN = false;
    bf16_t* O; size_t ldc;
    __device__ __forceinline__ void operator()(ACC_T, const Unit& u, int wr, int wc, int fr, int fq) const {
        const int row0 = u.pm * BM + wr * 64 + fr, col0 = u.pn * BM + wc * 32 + 8 * fq;
#pragma unroll
        for (int ai = 0; ai < 2; ++ai)
#pragma unroll
            for (int m = 0; m < 4; ++m) { bf16_t* rowp = O + (size_t)(row0 + ai * HALF + m * 16) * ldc + col0;
#pragma unroll
                for (int bj = 0; bj < 2; ++bj) { const f32x4 v0 = acc[ai][bj][m][0], v1 = acc[ai][bj][m][1];
                    u32x4 w; w.x = cvtpk(v0[0], v0[1]); w.y = cvtpk(v0[2], v0[3]); w.z = cvtpk(v1[0], v1[1]); w.w = cvtpk(v1[2], v1[3]);
                    *(u32x4*)(rowp + bj * HALF) = w; } }
    }
};
struct EpiF32 {
    static constexpr bool PERM = false, AFTER_DRAIN = false;
    float* O; size_t ldc;
    __device__ __forceinline__ void operator()(ACC_T, const Unit& u, int wr, int wc, int fr, int fq) const {
        const int row0 = u.pm * BM + wr * 64 + fr, col0 = u.pn * BM + wc * 32 + 4 * fq;
#pragma unroll
        for (int ai = 0; ai < 2; ++ai)
#pragma unroll
            for (int m = 0; m < 4; ++m) { float* rowp = O + (size_t)(row0 + ai * HALF + m * 16) * ldc + col0;
#pragma unroll
                for (int bj = 0; bj < 2; ++bj)
#pragma unroll
                    for (int n = 0; n < 2; ++n) *(f32x4*)(rowp + bj * HALF + n * 16) = acc[ai][bj][m][n]; }
    }
};
struct EpiLatNorm {
    static constexpr bool PERM = true, AFTER_DRAIN = true;
    bf16_t* CQo; bf16_t* CKVo; bf16_t* KRo; const float* gq; const float* gk; const float* cs; const float* sn;
    __device__ __forceinline__ void fused(f32x4 (&acc)[2][2][4][2], const Unit& u, int wr, int wc, int fr, int fq, LAS unsigned char* lds, int lane) const {
        LAS float* P = (LAS float*)lds;
        const int nbj = (u.pn == 0) ? 2 : 1;
#pragma unroll
        for (int ai = 0; ai < 2; ++ai)
#pragma unroll
            for (int m = 0; m < 4; ++m) { float ss = 0.f;
#pragma unroll
                for (int bj = 0; bj < 2; ++bj) if (bj < nbj) {
#pragma unroll
                    for (int n = 0; n < 2; ++n) { const f32x4 v = acc[ai][bj][m][n]; ss += (v[0] * v[0] + v[1] * v[1]) + (v[2] * v[2] + v[3] * v[3]); } }
                ss += __shfl_xor(ss, 16); ss += __shfl_xor(ss, 32);
                if (fq == 0) P[(ai * HALF + wr * 64 + m * 16 + fr) * 4 + wc] = ss; }
        asm volatile("s_waitcnt lgkmcnt(0)" ::: "memory"); __builtin_amdgcn_s_barrier(); asm volatile("" ::: "memory");
        const float inv_dim = (u.pn == 0) ? (1.f / 256.f) : (1.f / 128.f);
#pragma unroll
        for (int ai = 0; ai < 2; ++ai)
#pragma unroll
            for (int m = 0; m < 4; ++m) { const int rl = ai * HALF + wr * 64 + m * 16 + fr; const size_t row = (size_t)u.pm * BM + rl;
                const f32x4 p4 = *(const LAS f32x4*)(P + rl * 4); const float rs = 1.0f / sqrtf(((p4[0] + p4[1]) + (p4[2] + p4[3])) * inv_dim + RMS_EPS);
                if (u.pn == 0) {
#pragma unroll
                    for (int bj = 0; bj < 2; ++bj) { const int col = bj * HALF + wc * 32 + 8 * fq; const f32x4 g0 = *(const f32x4*)(gq + col), g1 = *(const f32x4*)(gq + col + 4);
                        *(u32x4*)(CQo + row * 256 + col) = pack_acc(acc[ai][bj][m][0] * rs * g0, acc[ai][bj][m][1] * rs * g1); }
                } else {
                    { const int col = wc * 32 + 8 * fq; const f32x4 g0 = *(const f32x4*)(gk + col), g1 = *(const f32x4*)(gk + col + 4);
                      *(u32x4*)(CKVo + row * 128 + col) = pack_acc(acc[ai][0][m][0] * rs * g0, acc[ai][0][m][1] * rs * g1); }
                    if (wc == 0) {
                        const f32x4 v0 = acc[ai][1][m][0], v1 = acc[ai][1][m][1];
                        f32x4 q0, q1;
#pragma unroll
                        for (int e = 0; e < 4; ++e) { q0[e] = __shfl_xor(v0[e], 32); q1[e] = __shfl_xor(v1[e], 32); }
                        const int i0 = 8 * (fq & 1);
                        const f32x4 c0 = *(const f32x4*)(cs + row * 16 + i0), c1 = *(const f32x4*)(cs + row * 16 + i0 + 4), s0 = *(const f32x4*)(sn + row * 16 + i0), s1 = *(const f32x4*)(sn + row * 16 + i0 + 4);
                        const bool first = fq < 2;
                        const f32x4 y0 = first ? (v0 * c0 - q0 * s0) : (v0 * c0 + q0 * s0), y1 = first ? (v1 * c1 - q1 * s1) : (v1 * c1 + q1 * s1);
                        const u32x4 yk = pack_acc(y0, y1); const int p0 = 16 * (fq >> 1) + 4 * (fq & 1);
                        *(u32x2*)(KRo + row * 32 + p0) = (u32x2){yk.x, yk.y}; *(u32x2*)(KRo + row * 32 + p0 + 8) = (u32x2){yk.z, yk.w};
                    }
                } }
    }
};
struct EpiQ {
    static constexpr bool PERM = true, AFTER_DRAIN = false;
    bf16_t* Q; const float* cs; const float* sn;
    __device__ __forceinline__ void operator()(ACC_T, const Unit& u, int wr, int wc, int fr, int fq) const {
        const int row0 = u.pm * BM + wr * 64 + fr;
        if (u.pn < 4) {
#pragma unroll
            for (int ai = 0; ai < 2; ++ai)
#pragma unroll
                for (int m = 0; m < 4; ++m) { const int row = row0 + ai * HALF + m * 16;
#pragma unroll
                    for (int bj = 0; bj < 2; ++bj) { const int col = u.pn * BM + bj * HALF + wc * 32 + 8 * fq; const f32x4 v0 = acc[ai][bj][m][0], v1 = acc[ai][bj][m][1];
                        u32x4 w; w.x = cvtpk(v0[0], v0[1]); w.y = cvtpk(v0[2], v0[3]); w.z = cvtpk(v1[0], v1[1]); w.w = cvtpk(v1[2], v1[3]);
                        *(u32x4*)(Q + (size_t)row * QPITCH + (col >> 6) * 96 + (col & 63)) = w; } }
        } else {
            const int head = (u.pn - 4) * 8 + 2 * wc + (fq >> 1), i0 = 8 * (fq & 1);
#pragma unroll
            for (int ai = 0; ai < 2; ++ai)
#pragma unroll
                for (int m = 0; m < 4; ++m) { const int row = row0 + ai * HALF + m * 16;
                    const f32x4 c0 = *(const f32x4*)(cs + (size_t)row * 16 + i0), c1 = *(const f32x4*)(cs + (size_t)row * 16 + i0 + 4);
                    const f32x4 s0 = *(const f32x4*)(sn + (size_t)row * 16 + i0), s1 = *(const f32x4*)(sn + (size_t)row * 16 + i0 + 4);
                    const f32x4 a0 = acc[ai][0][m][0], a1 = acc[ai][0][m][1], b0 = acc[ai][1][m][0], b1 = acc[ai][1][m][1];
                    const f32x4 y10 = a0 * c0 - b0 * s0, y11 = a1 * c1 - b1 * s1, y20 = b0 * c0 + a0 * s0, y21 = b1 * c1 + a1 * s1;
                    u32x4 w1, w2; w1.x = cvtpk(y10[0], y10[1]); w1.y = cvtpk(y10[2], y10[3]); w1.z = cvtpk(y11[0], y11[1]); w1.w = cvtpk(y11[2], y11[3]);
                    w2.x = cvtpk(y20[0], y20[1]); w2.y = cvtpk(y20[2], y20[3]); w2.z = cvtpk(y21[0], y21[1]); w2.w = cvtpk(y21[2], y21[3]);
                    bf16_t* qp = Q + (size_t)row * QPITCH + head * 96 + 64 + i0;
                    *(u32x4*)qp = w1; *(u32x4*)(qp + 16) = w2; asm volatile("" ::: "memory"); }
        }
    }
};
struct EpiPool {
    static constexpr bool PERM = true, AFTER_DRAIN = false;
    bf16_t* F; const float* bias; const float* scale;
    __device__ __forceinline__ void operator()(ACC_T, const Unit& u, int wr, int wc, int fr, int fq) const {
        const int row0 = u.pm * BM + wr * 64 + fr, col0 = u.pn * BM + wc * 32 + 8 * fq;
#pragma unroll
        for (int bj = 0; bj < 2; ++bj) { const int c = col0 + bj * HALF;
            const f32x4 b0 = *(const f32x4*)(bias + c), b1 = *(const f32x4*)(bias + c + 4), s0 = *(const f32x4*)(scale + c), s1 = *(const f32x4*)(scale + c + 4);
#pragma unroll
            for (int ai = 0; ai < 2; ++ai)
#pragma unroll
                for (int m = 0; m < 4; ++m) { const f32x4 v0 = (acc[ai][bj][m][0] + b0) * s0, v1 = (acc[ai][bj][m][1] + b1) * s1;
                    u32x4 w; w.x = cvtpk(v0[0], v0[1]); w.y = cvtpk(v0[2], v0[3]); w.z = cvtpk(v1[0], v1[1]); w.w = cvtpk(v1[2], v1[3]);
                    *(u32x4*)(F + (size_t)(row0 + ai * HALF + m * 16) * 1024 + c) = w; } }
    }
};
struct EpiRouter {
    static constexpr bool PERM = false, AFTER_DRAIN = false;
    float* LG;
    __device__ __forceinline__ void operator()(ACC_T, const Unit& u, int wr, int wc, int fr, int fq) const {
        const int row0 = u.pm * BM + wr * 64 + fr;
#pragma unroll
        for (int ai = 0; ai < 2; ++ai)
#pragma unroll
            for (int m = 0; m < 4; ++m) { float* lr = LG + ((size_t)u.pn * NTOK + (size_t)(row0 + ai * HALF + m * 16)) * LGP;
#pragma unroll
                for (int n = 0; n < 2; ++n) { const int j = wc * 32 + 16 * n + 4 * fq; if (j < 72) *(f32x4*)(lr + j) = acc[ai][0][m][n] + acc[ai][1][m][n]; } }
    }
};
struct EpiSwiglu {
    static constexpr bool PERM = true, AFTER_DRAIN = false;
    bf16_t* H;
    __device__ __forceinline__ void operator()(ACC_T, const Unit& u, int wr, int wc, int fr, int fq) const {
        const int row0 = u.pm * BM + wr * 64 + fr, col0 = u.pn * HALF + wc * 32 + 8 * fq;
#pragma unroll
        for (int ai = 0; ai < 2; ++ai)
#pragma unroll
            for (int m = 0; m < 4; ++m) { float h[8];
#pragma unroll
                for (int n = 0; n < 2; ++n)
#pragma unroll
                    for (int e = 0; e < 4; ++e) { const float a = acc[ai][0][m][n][e], b = acc[ai][1][m][n][e];
                        h[n * 4 + e] = a * __builtin_amdgcn_rcpf(1.0f + __builtin_amdgcn_exp2f(-1.4426950408889634f * a)) * b; }
                u32x4 w; w.x = cvtpk(h[0], h[1]); w.y = cvtpk(h[2], h[3]); w.z = cvtpk(h[4], h[5]); w.w = cvtpk(h[6], h[7]);
                *(u32x4*)(H + (size_t)(row0 + ai * HALF + m * 16) * D_EXPERT + col0) = w; }
    }
};
struct EpiMoeOut {
    static constexpr bool PERM = true, AFTER_DRAIN = false;
    bf16_t* Y; const LAS int* tinfo; const int* list; const float* lgate;
    __device__ __forceinline__ void operator()(ACC_T, const Unit& u, int wr, int wc, int fr, int fq) const {
        const int ti = tinfo[u.pm], e = ti & 255, n = tinfo[TI_CNT + e], r0 = (ti >> 8) * 256 + wr * 64 + fr, col0 = u.pn * BM + wc * 32 + 8 * fq;
#pragma unroll
        for (int ai = 0; ai < 2; ++ai)
#pragma unroll
            for (int m = 0; m < 4; ++m) { const int r = r0 + ai * HALF + m * 16;
                if (r < n) { int ga; float g;
                    if (u.ui < MOE_LDS_UNITS) { const int rl = u.ui * 256 + (r & 255); ga = tinfo[TI_ROWOFF + rl]; g = __int_as_float(tinfo[TI_ROWOFF + MOE_LDS_UNITS * 256 + rl]); }
                    else { const size_t li = (size_t)e * LIST_CAP + r; ga = list[li]; g = lgate[li]; }
                    bf16_t* yp = Y + (size_t)ga * D_MODEL + col0;
#pragma unroll
                    for (int bj = 0; bj < 2; ++bj) { const f32x4 v0 = acc[ai][bj][m][0] * g, v1 = acc[ai][bj][m][1] * g;
                        u32x4 w; w.x = cvtpk(v0[0], v0[1]); w.y = cvtpk(v0[2], v0[3]); w.z = cvtpk(v1[0], v1[1]); w.w = cvtpk(v1[2], v1[3]);
                        *(u32x4*)(yp + bj * HALF) = w; } }
                if (m & 1) asm volatile("" ::: "memory"); }
    }
};
#undef ACC_T

template <class Epi, class Sched, bool ALIGN_EPI>
__device__ __forceinline__ void gemm_phase(LAS unsigned char* lds, const Gemm g, const Sched& S, const Epi& E) {
    const int tid = opaque(threadIdx.x), wid = __builtin_amdgcn_readfirstlane(tid >> 6), lane = tid & 63, wr = wid >> 2, wc = wid & 3, fr = lane & 15, fq = lane >> 4;
    const int K = opaque_s(g.K), nt = K / BK;
    unsigned voffB[2]; int Rr[2], Cc[2];
#pragma unroll
    for (int i = 0; i < 2; ++i) { int R, C; stage_rc(tid * 16 + i * 8192, R, C); const int Rb = Epi::PERM ? ((R & ~31) + perm32(R & 31)) : R;
        Rr[i] = R; Cc[i] = C; voffB[i] = (unsigned)(Rb * g.ldb + C) * 2u; }
    const size_t kstep = (size_t)(BK * 2);
    const size_t hstepB = (size_t)HALF * g.ldb * 2;
    const unsigned ldsw = (unsigned)wid * 1024u;
    const int aoff = lds_byte(wr * 64 + fr, fq * 8), boff = lds_byte(wc * 32 + fr, fq * 8);
#define PG8_SA(b, h) (((b) * 2 + (h)) * HTB)
#define PG8_SB(b, h) ((4 + (b) * 2 + (h)) * HTB)
#define PG8_STAGE(bufoff, gbase, voff) do { _Pragma("unroll") for (int _i = 0; _i < 2; ++_i) \
        __builtin_amdgcn_global_load_lds((const unsigned*)((const char*)(gbase) + (voff)[_i]), (LAS unsigned*)(lds + (bufoff) + ldsw + _i * 8192), 16, 0, 0); } while (0)
#define PG8_LDA(dst, b, h) do { _Pragma("unroll") for (int m = 0; m < 4; ++m) _Pragma("unroll") for (int k = 0; k < 2; ++k) dst[m][k] = *(const LAS bf16x8*)(lds + PG8_SA(b, h) + aoff + m * 2048 + k * 1024); } while (0)
#define PG8_LDB(dst, b, h) do { _Pragma("unroll") for (int n = 0; n < 2; ++n) _Pragma("unroll") for (int k = 0; k < 2; ++k) dst[n][k] = *(const LAS bf16x8*)(lds + PG8_SB(b, h) + boff + n * 2048 + k * 1024); } while (0)
#define PG8_MMA(ai, bj, At, Bt) do { __builtin_amdgcn_s_setprio(1); _Pragma("unroll") for (int m = 0; m < 4; ++m) _Pragma("unroll") for (int n = 0; n < 2; ++n) _Pragma("unroll") for (int k = 0; k < 2; ++k) \
        acc[ai][bj][m][n] = __builtin_amdgcn_mfma_f32_16x16x32_bf16(Bt[n][k], At[m][k], acc[ai][bj][m][n], 0, 0, 0); __builtin_amdgcn_s_setprio(0); } while (0)
#define PG8_WAIT_V(n) asm volatile("s_waitcnt vmcnt(" #n ")" ::: "memory")
#define PG8_WAIT_L(n) asm volatile("s_waitcnt lgkmcnt(" #n ")" ::: "memory")
#define PG8_BAR __builtin_amdgcn_s_barrier()
#define PG8_SCHED __builtin_amdgcn_sched_barrier(0)
    Unit cur, nxt; int ui = 0;
    if (!S.next(0, cur)) return;
    f32x4 acc[2][2][4][2];
#pragma unroll
    for (int a = 0; a < 2; ++a)
#pragma unroll
        for (int b = 0; b < 2; ++b)
#pragma unroll
            for (int m = 0; m < 4; ++m)
#pragma unroll
                for (int n = 0; n < 2; ++n) acc[a][b][m][n] = (f32x4){0.f, 0.f, 0.f, 0.f};
    bf16x8 At[4][2], B0[2][2], B1[2][2];
    const char* cA = S.a_base(cur); const char* cB = S.b_base(cur);
    unsigned vA[2][2], vN[2][2];
#pragma unroll
    for (int h = 0; h < 2; ++h)
#pragma unroll
        for (int i = 0; i < 2; ++i) { vA[h][i] = S.a_voff(cur, Rr[i] + h * HALF, Cc[i], g.lda); vN[h][i] = vA[h][i]; }
    PG8_STAGE(PG8_SB(0, 0), cB, voffB); PG8_STAGE(PG8_SB(0, 1), cB + hstepB, voffB); PG8_STAGE(PG8_SA(0, 0), cA, vA[0]); PG8_STAGE(PG8_SA(0, 1), cA, vA[1]);
    if (wr == 1) PG8_BAR;
    PG8_WAIT_V(2); PG8_BAR;
    PG8_STAGE(PG8_SB(1, 0), cB + kstep, voffB); PG8_STAGE(PG8_SA(1, 0), cA + kstep, vA[0]); PG8_STAGE(PG8_SB(1, 1), cB + hstepB + kstep, voffB);
    PG8_WAIT_V(6); PG8_BAR;
    for (;;) {
        const bool has_next = S.next(ui + 1, nxt);
        const char* nA = has_next ? S.a_base(nxt) : cA; const char* nB = has_next ? S.b_base(nxt) : cB;
        if (has_next) {
#pragma unroll
            for (int h = 0; h < 2; ++h)
#pragma unroll
                for (int i = 0; i < 2; ++i) vN[h][i] = S.a_voff(nxt, Rr[i] + h * HALF, Cc[i], g.lda);
        }
#pragma nounroll
        for (int t = 0; t < nt; t += 2) {
            const bool last = (t == nt - 2);
            const char* a1 = cA + (size_t)(t + 1) * kstep;
            const char* a2 = last ? nA : cA + (size_t)(t + 2) * kstep; const char* b2 = last ? nB : cB + (size_t)(t + 2) * kstep;
            const char* a3 = a2 + kstep; const char* b3 = b2 + kstep;
            unsigned w0[2], w1[2];
#pragma unroll
            for (int i = 0; i < 2; ++i) { w0[i] = last ? vN[0][i] : vA[0][i]; w1[i] = last ? vN[1][i] : vA[1][i]; }
            PG8_LDB(B0, 0, 0); PG8_LDB(B1, 0, 1); PG8_SCHED; PG8_LDA(At, 0, 0); PG8_STAGE(PG8_SA(1, 1), a1, vA[1]);
            PG8_WAIT_V(8); PG8_WAIT_L(0); PG8_BAR; PG8_MMA(0, 0, At, B0); PG8_MMA(0, 1, At, B1); PG8_BAR; PG8_SCHED;
            PG8_LDA(At, 0, 1); PG8_STAGE(PG8_SB(0, 0), b2, voffB); PG8_STAGE(PG8_SB(0, 1), b2 + hstepB, voffB); PG8_STAGE(PG8_SA(0, 0), a2, w0);
            PG8_WAIT_V(8); PG8_WAIT_L(0); PG8_BAR; PG8_MMA(1, 0, At, B0); PG8_MMA(1, 1, At, B1); PG8_BAR; PG8_SCHED;
            PG8_LDB(B0, 1, 0); PG8_LDB(B1, 1, 1); PG8_SCHED; PG8_LDA(At, 1, 0); PG8_STAGE(PG8_SA(0, 1), a2, w1);
            PG8_WAIT_V(8); PG8_WAIT_L(0); PG8_BAR; PG8_MMA(0, 0, At, B0); PG8_MMA(0, 1, At, B1); PG8_BAR; PG8_SCHED;
            PG8_LDA(At, 1, 1); PG8_STAGE(PG8_SB(1, 0), b3, voffB); PG8_STAGE(PG8_SB(1, 1), b3 + hstepB, voffB); PG8_STAGE(PG8_SA(1, 0), a3, w0);
            PG8_WAIT_V(8); PG8_WAIT_L(0); PG8_BAR; PG8_MMA(1, 0, At, B0); PG8_MMA(1, 1, At, B1); PG8_BAR; PG8_SCHED;
        }
        if constexpr (ALIGN_EPI) { if (wr == 0) PG8_BAR; }
        if constexpr (!Epi::AFTER_DRAIN) E(acc, cur, wr, wc, fr, fq);
        if (!has_next) break;
#pragma unroll
        for (int a = 0; a < 2; ++a)
#pragma unroll
            for (int b = 0; b < 2; ++b)
#pragma unroll
                for (int m = 0; m < 4; ++m)
#pragma unroll
                    for (int n = 0; n < 2; ++n) acc[a][b][m][n] = (f32x4){0.f, 0.f, 0.f, 0.f};
        cur = nxt; cA = nA; cB = nB; ++ui;
#pragma unroll
        for (int h = 0; h < 2; ++h)
#pragma unroll
            for (int i = 0; i < 2; ++i) vA[h][i] = vN[h][i];
        if constexpr (ALIGN_EPI) { if (wr == 1) PG8_BAR; }
    }
    PG8_WAIT_V(0);
    if constexpr (!ALIGN_EPI) { if (wr == 0) PG8_BAR; }
    PG8_BAR;
    if constexpr (Epi::AFTER_DRAIN) E.fused(acc, cur, wr, wc, fr, fq, lds, lane);
#undef PG8_SA
#undef PG8_SB
#undef PG8_STAGE
#undef PG8_LDA
#undef PG8_LDB
#undef PG8_MMA
#undef PG8_WAIT_V
#undef PG8_WAIT_L
#undef PG8_BAR
#undef PG8_SCHED
}
}

namespace att {
constexpr int KSLOT = 12288, VSLOT = 8192, LDS_K = 0, LDS_V = 3 * KSLOT, LDS_BYTES = LDS_V + 3 * VSLOT;
constexpr float THR = 6.0f;
__device__ __forceinline__ int nx3(int s) { return s == 2 ? 0 : s + 1; }
__device__ __forceinline__ int pv3(int s) { return s == 0 ? 2 : s - 1; }
__device__ __forceinline__ void glds16(const void* g, LAS unsigned char* l) { __builtin_amdgcn_global_load_lds((const unsigned*)g, (LAS unsigned*)l, 16, 0, 0); }

template <bool FIRST, bool GEN>
__device__ __forceinline__ void att_step(f32x16& c0, f32x16& c1, f32x16& n0, f32x16& n1, f32x16& o0, f32x16& o1, f32x16& negm, float& mhat, float& lsum, u32x4 (&pw)[4], const bf16x8 (&qr)[6],
                                         const LAS unsigned char* kb_next, const LAS unsigned char* vb_prev, bool act_prev, bool act_cur, bool act_nxt, int jb, int qrel, int hi) {
    const bool do_pv = !FIRST && (!GEN || act_prev), do_cur = !GEN || act_cur, do_qk = !GEN || act_nxt;
    bf16x8 vfr[8], kfa[6], kfb[6];
    if (do_pv) {
#pragma unroll
        for (int kc2 = 0; kc2 < 4; ++kc2) { vfr[2 * kc2] = *(const LAS bf16x8*)(vb_prev + kc2 * 2048); vfr[2 * kc2 + 1] = *(const LAS bf16x8*)(vb_prev + kc2 * 2048 + 512); }
    }
    if (do_qk) {
#pragma unroll
        for (int d0 = 0; d0 < 3; ++d0) { kfa[2 * d0] = *(const LAS bf16x8*)(kb_next + d0 * 2048); kfa[2 * d0 + 1] = *(const LAS bf16x8*)(kb_next + d0 * 2048 + 512); }
    }
    __builtin_amdgcn_sched_barrier(0);
    float rm = 0.f;
    if (do_cur) {
        if ((GEN || FIRST) && jb >= 0) {
            const int kb0 = 64 * jb + 8 * hi;
#pragma unroll
            for (int r = 0; r < 16; ++r) { const int key = kb0 + (r & 3) + 4 * ((r >> 2) & 1) + 16 * (r >> 3);
                if (key > qrel) c0[r] = -INFINITY; if (key + 32 > qrel) c1[r] = -INFINITY; }
        }
        float ra = fmaxf(fmaxf(c0[0], c0[1]), c1[0]), rb = fmaxf(fmaxf(c0[2], c0[3]), c1[1]);
        ra = fmaxf(fmaxf(ra, c1[2]), c1[3]);
#pragma unroll
        for (int r = 4; r < 16; r += 4) { ra = fmaxf(fmaxf(ra, c0[r]), c0[r + 1]); rb = fmaxf(fmaxf(rb, c0[r + 2]), c0[r + 3]); ra = fmaxf(fmaxf(ra, c1[r]), c1[r + 1]); rb = fmaxf(fmaxf(rb, c1[r + 2]), c1[r + 3]); }
        rm = fmaxf(ra, rb);
        { auto rr = __builtin_amdgcn_permlane32_swap(__float_as_uint(rm), __float_as_uint(rm), false, false); rm = fmaxf(__uint_as_float(rr[0]), __uint_as_float(rr[1])); }
    }
    if (do_pv) {
#pragma unroll
        for (int kc2 = 0; kc2 < 4; ++kc2) {
            const bf16x8 pf = __builtin_bit_cast(bf16x8, pw[kc2]);
            o0 = __builtin_amdgcn_mfma_f32_32x32x16_bf16(vfr[2 * kc2], pf, o0, 0, 0, 0);
            o1 = __builtin_amdgcn_mfma_f32_32x32x16_bf16(vfr[2 * kc2 + 1], pf, o1, 0, 0, 0);
        }
    }
    __builtin_amdgcn_sched_barrier(0);
    if (do_qk) {
#pragma unroll
        for (int d0 = 0; d0 < 3; ++d0) { kfb[2 * d0] = *(const LAS bf16x8*)(kb_next + (d0 + 3) * 2048); kfb[2 * d0 + 1] = *(const LAS bf16x8*)(kb_next + (d0 + 3) * 2048 + 512); }
    }
    __builtin_amdgcn_sched_barrier(0);
    if (do_cur) {
        if (FIRST) {
            mhat = rm;
#pragma unroll
            for (int r = 0; r < 16; ++r) { c0[r] -= rm; c1[r] -= rm; negm[r] = -rm; }
        } else if (__any(rm > THR)) {
            const float dl = fmaxf(rm, 0.f); mhat += dl;
            const float f = __builtin_amdgcn_exp2f(-dl); lsum *= f;
#pragma unroll
            for (int r = 0; r < 16; ++r) { c0[r] -= dl; c1[r] -= dl; o0[r] *= f; o1[r] *= f; negm[r] = -mhat; }
        }
    }
    if (do_qk) {
        n0 = __builtin_amdgcn_mfma_f32_32x32x16_bf16(kfa[0], qr[0], negm, 0, 0, 0);
        n1 = __builtin_amdgcn_mfma_f32_32x32x16_bf16(kfa[1], qr[0], negm, 0, 0, 0);
#pragma unroll
        for (int d0 = 1; d0 < 3; ++d0) { n0 = __builtin_amdgcn_mfma_f32_32x32x16_bf16(kfa[2 * d0], qr[d0], n0, 0, 0, 0); n1 = __builtin_amdgcn_mfma_f32_32x32x16_bf16(kfa[2 * d0 + 1], qr[d0], n1, 0, 0, 0); }
#pragma unroll
        for (int d0 = 0; d0 < 3; ++d0) { n0 = __builtin_amdgcn_mfma_f32_32x32x16_bf16(kfb[2 * d0], qr[d0 + 3], n0, 0, 0, 0); n1 = __builtin_amdgcn_mfma_f32_32x32x16_bf16(kfb[2 * d0 + 1], qr[d0 + 3], n1, 0, 0, 0); }
    }
    if (do_cur) {
        float sa = 0.f, sb = 0.f;
#pragma unroll
        for (int r = 0; r < 16; ++r) { c0[r] = __builtin_amdgcn_exp2f(c0[r]); c1[r] = __builtin_amdgcn_exp2f(c1[r]); sa += c0[r]; sb += c1[r]; }
        lsum += sa + sb;
#pragma unroll
        for (int i = 0; i < 2; ++i) {
            pw[i] = (u32x4){cvtpk(c0[8 * i], c0[8 * i + 1]), cvtpk(c0[8 * i + 2], c0[8 * i + 3]), cvtpk(c0[8 * i + 4], c0[8 * i + 5]), cvtpk(c0[8 * i + 6], c0[8 * i + 7])};
            pw[2 + i] = (u32x4){cvtpk(c1[8 * i], c1[8 * i + 1]), cvtpk(c1[8 * i + 2], c1[8 * i + 3]), cvtpk(c1[8 * i + 4], c1[8 * i + 5]), cvtpk(c1[8 * i + 6], c1[8 * i + 7])};
        }
        asm volatile("" : "+v"(pw[0]), "+v"(pw[1]), "+v"(pw[2]), "+v"(pw[3]), "+v"(lsum));
    }
    __builtin_amdgcn_sched_barrier(0);
}

__device__ __forceinline__ void attn_unit(int b, int h, int qb, const bf16_t* __restrict__ CQm, const bf16_t* __restrict__ WQh, const float* __restrict__ csT, const float* __restrict__ snT, const bf16_t* __restrict__ KN, const bf16_t* __restrict__ KR, const bf16_t* __restrict__ VT, bf16_t* __restrict__ O, LAS unsigned char* lds) {
    const int tid = opaque(threadIdx.x), lane = tid & 63, r32 = lane & 31, hi = lane >> 5;
    const int w = __builtin_amdgcn_readfirstlane(tid >> 6);
    const size_t tok0 = (size_t)b * SEQ;
    const int q0 = qb * 256, NT = 4 * (qb + 1);
    const bf16_t* ksrc = KN + (tok0 + lane) * 1024 + h * 64 + 8 * w;
    const bf16_t* rsrc = KR + (tok0 + lane) * 32 + 8 * (w & 3);
    const bf16_t* vsrc = VT + (size_t)(h * 64 + lane) * NTOK + tok0 + 8 * w;
#define ATT_ISSUE_K(t, slot) do { glds16(ksrc + (size_t)(t) * 65536, lds + LDS_K + (slot) * KSLOT + w * 1024); \
        if (w < 4) glds16(rsrc + (size_t)(t) * 2048, lds + LDS_K + (slot) * KSLOT + (8 + w) * 1024); } while (0)
#define ATT_ISSUE_V(t, slot) glds16(vsrc + (size_t)(t) * 64, lds + LDS_V + (slot) * VSLOT + w * 1024)
    ATT_ISSUE_K(0, 0); ATT_ISSUE_K(1, 1); ATT_ISSUE_K(2, 2); ATT_ISSUE_V(0, 0);
    bf16x8 qr[6];
    bf16x8 cqf[16];
    { const bf16_t* cqp = CQm + (tok0 + q0 + w * 32 + r32) * 256 + hi * 8;
#pragma unroll
      for (int ks = 0; ks < 16; ++ks) cqf[ks] = *(const bf16x8*)(cqp + ks * 16); }
    { const bf16_t* wsrc = WQh + (size_t)r32 * 256 + hi * 8;
#pragma unroll
      for (int q_ = 0; q_ < 6; ++q_) { const int q = w * 6 + q_, mt = q >> 4, ks = q & 15;
          glds16(wsrc + (size_t)mt * 32 * 256 + ks * 16, lds + LDS_BYTES + q * 1024); } }
    const int kvp = (r32 & 19) | ((r32 & 4) << 1) | ((r32 & 8) >> 1);
    const LAS unsigned char* kf = lds + LDS_K + hi * 1024 + kvp * 16;
    const LAS unsigned char* vf = lds + LDS_V + hi * 1024 + r32 * 16;
    float mhat = 0.f, lsum = 0.f;
    f32x16 o0 = {}, o1 = {}, negm = {}, sA0 = {}, sA1 = {}, sB0, sB1;
    u32x4 pw[4] = {};
    const int qrel = w * 32 + r32, wb = w >> 1;
    asm volatile("s_waitcnt vmcnt(0)" ::: "memory");
    __builtin_amdgcn_s_barrier();
    asm volatile("" ::: "memory");
    { f32x16 qa[3] = {};
      const LAS unsigned char* wl = lds + LDS_BYTES + lane * 16;
#pragma unroll
      for (int ks = 0; ks < 16; ++ks) {
#pragma unroll
          for (int mt = 0; mt < 3; ++mt) { const bf16x8 wf = *(const LAS bf16x8*)(wl + (mt * 16 + ks) * 1024); qa[mt] = __builtin_amdgcn_mfma_f32_32x32x16_bf16(wf, cqf[ks], qa[mt], 0, 0, 0); }
      }
      { const size_t ro = (tok0 + q0 + w * 32 + r32) * 16 + 4 * hi;
        const f32x4 cl = *(const f32x4*)(csT + ro), ch = *(const f32x4*)(csT + ro + 8), sl = *(const f32x4*)(snT + ro), sh = *(const f32x4*)(snT + ro + 8);
#pragma unroll
        for (int r = 0; r < 8; ++r) { const float cv = (r < 4) ? cl[r & 3] : ch[r & 3], sv = (r < 4) ? sl[r & 3] : sh[r & 3]; const float x1 = qa[2][r], x2 = qa[2][r + 8];
            qa[2][r] = x1 * cv - x2 * sv; qa[2][r + 8] = x2 * cv + x1 * sv; } }
#pragma unroll
      for (int mt = 0; mt < 3; ++mt)
#pragma unroll
          for (int s2 = 0; s2 < 2; ++s2) { u32x4 pk; pk.x = cvtpk(qa[mt][8 * s2], qa[mt][8 * s2 + 1]); pk.y = cvtpk(qa[mt][8 * s2 + 2], qa[mt][8 * s2 + 3]); pk.z = cvtpk(qa[mt][8 * s2 + 4], qa[mt][8 * s2 + 5]); pk.w = cvtpk(qa[mt][8 * s2 + 6], qa[mt][8 * s2 + 7]);
              qr[2 * mt + s2] = __builtin_bit_cast(bf16x8, pk); } }
#pragma unroll
    for (int d0 = 0; d0 < 6; ++d0) {
        const bf16x8 k0 = *(const LAS bf16x8*)(kf + d0 * 2048), k1 = *(const LAS bf16x8*)(kf + d0 * 2048 + 512);
        sA0 = __builtin_amdgcn_mfma_f32_32x32x16_bf16(k0, qr[d0], sA0, 0, 0, 0);
        sA1 = __builtin_amdgcn_mfma_f32_32x32x16_bf16(k1, qr[d0], sA1, 0, 0, 0);
    }
    int st = 0;
#define ATT_SYNC(t) do { \
        if ((t) == 0 || (t) + 2 >= NT) asm volatile("s_waitcnt vmcnt(0)" ::: "memory"); \
        else if (w < 4) asm volatile("s_waitcnt vmcnt(3)" ::: "memory"); \
        else asm volatile("s_waitcnt vmcnt(2)" ::: "memory"); \
        __builtin_amdgcn_s_barrier(); asm volatile("" ::: "memory"); \
        if ((t) + 3 < NT) ATT_ISSUE_K((t) + 3, st); \
        if ((t) + 1 < NT) ATT_ISSUE_V((t) + 1, nx3(st)); } while (0)
#define ATT_ACT(tt) (((tt) - (NT - 4)) < 0 || ((tt) - (NT - 4)) <= wb)
#define ATT_STEP(FIRST, GEN, C0, C1, N0, N1, t) do { ATT_SYNC(t); \
        att_step<FIRST, GEN>(C0, C1, N0, N1, o0, o1, negm, mhat, lsum, pw, qr, kf + nx3(st) * KSLOT, vf + pv3(st) * VSLOT, \
                             (t) > 0 && ATT_ACT((t) - 1), ATT_ACT(t), (t) + 1 < NT && ATT_ACT((t) + 1), (t) - (NT - 4), qrel, hi); \
        st = nx3(st); } while (0)
    ATT_STEP(true, true, sA0, sA1, sB0, sB1, 0);
    int t = 1;
    const int ts = (NT > 4) ? NT - 5 : 1;
    for (; t + 1 < ts; t += 2) {
        ATT_STEP(false, false, sB0, sB1, sA0, sA1, t);
        ATT_STEP(false, false, sA0, sA1, sB0, sB1, t + 1);
    }
    if (NT > 4) { ATT_STEP(false, true, sB0, sB1, sA0, sA1, NT - 5); ATT_STEP(false, true, sA0, sA1, sB0, sB1, NT - 4); }
    ATT_STEP(false, true, sB0, sB1, sA0, sA1, NT - 3);
    ATT_STEP(false, true, sA0, sA1, sB0, sB1, NT - 2);
    ATT_STEP(false, true, sB0, sB1, sA0, sA1, NT - 1);
    if (ATT_ACT(NT - 1)) {
        const LAS unsigned char* vb = vf + pv3(st) * VSLOT;
#pragma unroll
        for (int kc2 = 0; kc2 < 4; ++kc2) {
            const bf16x8 v0 = *(const LAS bf16x8*)(vb + kc2 * 2048), v1 = *(const LAS bf16x8*)(vb + kc2 * 2048 + 512);
            const bf16x8 pf = __builtin_bit_cast(bf16x8, pw[kc2]);
            o0 = __builtin_amdgcn_mfma_f32_32x32x16_bf16(v0, pf, o0, 0, 0, 0);
            o1 = __builtin_amdgcn_mfma_f32_32x32x16_bf16(v1, pf, o1, 0, 0, 0);
        }
    }
    { auto rr = __builtin_amdgcn_permlane32_swap(__float_as_uint(lsum), __float_as_uint(lsum), false, false); lsum = __uint_as_float(rr[0]) + __uint_as_float(rr[1]); }
    const float inv = 1.0f / lsum;
    bf16_t* op = O + (tok0 + q0 + w * 32 + r32) * 1024 + h * 64 + 4 * hi;
#pragma unroll
    for (int g = 0; g < 4; ++g) {
        u32x2 a, c; a.x = cvtpk(o0[4 * g] * inv, o0[4 * g + 1] * inv); a.y = cvtpk(o0[4 * g + 2] * inv, o0[4 * g + 3] * inv);
        c.x = cvtpk(o1[4 * g] * inv, o1[4 * g + 1] * inv); c.y = cvtpk(o1[4 * g + 2] * inv, o1[4 * g + 3] * inv);
        *(u32x2*)(op + 8 * g) = a; *(u32x2*)(op + 32 + 8 * g) = c;
    }
    asm volatile("s_waitcnt lgkmcnt(0)" ::: "memory");
    __builtin_amdgcn_s_barrier();
#undef ATT_ISSUE_K
#undef ATT_ISSUE_V
#undef ATT_SYNC
#undef ATT_ACT
#undef ATT_STEP
}
}

#define XB_TMO      128
#define XB_XCNT(j)  (256  + 64 * (j))
#define XB_XSUB(j)  (1280 + 64 * (j))
#define XB_XGEN(j)  (2304 + 64 * (j))
#define XB_TOP      3328
#define XB_TOPGEN   3392
#define XCD_BAR_WORDS 3456
#define XB_SPIN_CAP (1u << 18)
__device__ __forceinline__ unsigned xb_ld(unsigned* p)              { return __hip_atomic_load(p, __ATOMIC_RELAXED, __HIP_MEMORY_SCOPE_AGENT); }
__device__ __forceinline__ unsigned xb_add(unsigned* p, unsigned v) { return __hip_atomic_fetch_add(p, v, __ATOMIC_RELAXED, __HIP_MEMORY_SCOPE_AGENT); }
__device__ __forceinline__ unsigned xb_xcc_id() { return (unsigned)__builtin_amdgcn_s_getreg((3 << 11) | 20) & 0xFu; }
#define XB_SPIN(cond, bar) do { unsigned _sp = 0; while (cond) { __builtin_amdgcn_s_sleep(1); \
    if ((++_sp & 255u) == 0u) { if (xb_ld(&(bar)[XB_TMO])) break; if (_sp > XB_SPIN_CAP) { atomicAdd(&(bar)[XB_TMO], 1u); break; } } } } while (0)
struct XcdBarrier { unsigned* bar; unsigned x; volatile LAS unsigned* st; };
__device__ __forceinline__ XcdBarrier xcd_barrier_post(unsigned* bar, volatile LAS unsigned* st) {
    XcdBarrier b; b.bar = bar; b.x = xb_xcc_id(); b.st = st;
    if (threadIdx.x == 0) (void)xb_add(&bar[XB_XCNT(b.x)], 1u);
    return b;
}
__device__ __forceinline__ void xcd_barrier_complete(unsigned* bar, unsigned x, unsigned& nloc, unsigned& nx) {
    const unsigned G = gridDim.x * gridDim.y * gridDim.z;
    unsigned sum, cnt, mine, sp = 0u;
    for (;;) {
        sum = 0u; cnt = 0u; mine = 0u;
#pragma unroll
        for (unsigned j = 0; j < 16; ++j) { const unsigned c = xb_ld(&bar[XB_XCNT(j)]); sum += c; cnt += (c > 0u) ? 1u : 0u; mine = (j == x) ? c : mine; }
        if (sum == G) break;
        __builtin_amdgcn_s_sleep(1);
        if ((++sp & 255u) == 0u) { if (xb_ld(&bar[XB_TMO])) break; if (sp > XB_SPIN_CAP) { atomicAdd(&bar[XB_TMO], 1u); break; } }
    }
    nloc = mine > 0u ? mine : 1u; nx = cnt > 0u ? cnt : 1u;
}
__device__ __forceinline__ void xcd_barrier(const XcdBarrier& b) {
    asm volatile("s_waitcnt vmcnt(0)" ::: "memory");
    __syncthreads();
    if (threadIdx.x == 0) {
        unsigned* bar = b.bar;
        __builtin_amdgcn_s_waitcnt(0);
        unsigned nloc = b.st[0], nx = b.st[1];
        if (nloc == 0u) { xcd_barrier_complete(bar, b.x, nloc, nx); b.st[0] = nloc; b.st[1] = nx; }
        const unsigned old = xb_add(&bar[XB_XSUB(b.x)], 1u);
        const unsigned gen = old / nloc;
        if (old + 1u == (gen + 1u) * nloc) {
            __builtin_amdgcn_fence(__ATOMIC_RELEASE, "agent");
            asm volatile("s_waitcnt vmcnt(0)" ::: "memory");
            const unsigned og = xb_add(&bar[XB_TOP], 1u);
            const unsigned tg = og / nx;
            if (og + 1u == (tg + 1u) * nx) xb_add(&bar[XB_TOPGEN], 1u);
            else XB_SPIN(xb_ld(&bar[XB_TOPGEN]) == tg, bar);
            __builtin_amdgcn_fence(__ATOMIC_ACQUIRE, "agent");
            xb_add(&bar[XB_XGEN(b.x)], 1u);
            asm volatile("s_waitcnt vmcnt(0)" ::: "memory");
        } else {
            XB_SPIN(xb_ld(&bar[XB_XGEN(b.x)]) == gen, bar);
            __builtin_amdgcn_fence(__ATOMIC_ACQUIRE, "agent");
            asm volatile("s_waitcnt vmcnt(0)" ::: "memory");
        }
    }
    __syncthreads();
}

struct Args { const void* in[20]; float* out; unsigned char* ws; int ph_lo, ph_hi; };
typedef const __attribute__((address_space(4))) Args* KArgs;
__device__ __forceinline__ KArgs kargs() { KArgs p = (KArgs)__builtin_amdgcn_kernarg_segment_ptr(); asm volatile("" : "+s"(p)); return p; }
constexpr int NWAVES = 8;
constexpr int PPL = 12;
constexpr int NPHASE = 1 + DEPTH * PPL;

__constant__ double c_invf[16] = {1.0, 0.5623413251903491, 0.31622776601683794, 0.1778279410038923, 0.1, 0.05623413251903491, 0.03162277660168379, 0.01778279410038923,
                                  0.01, 0.005623413251903491, 0.0031622776601683794, 0.0017782794100389228, 0.001, 0.0005623413251903491, 0.00031622776601683794, 0.00017782794100389227};

__device__ __forceinline__ void transpose_item(const float* __restrict__ W, int ldw, int k0, int n0, bf16_t* __restrict__ WT, int ldt, int drow0, float mul, LAS float* scr, int lane, int swz = 0) {
#pragma unroll 8
    for (int i = 0; i < 32; ++i) { const int kk = 2 * i + (lane >> 5); scr[kk * 33 + (lane & 31)] = W[(size_t)(k0 + kk) * ldw + n0 + (lane & 31)]; }
    LDS_WAIT(); asm volatile("" ::: "memory");
    const int c = lane & 7;
#pragma unroll
    for (int j = 0; j < 4; ++j) { const int n = (lane >> 3) + 8 * j; const LAS float* s = scr + (8 * c) * 33 + n;
        u32x4 o; o.x = cvtpk(s[0 * 33] * mul, s[1 * 33] * mul); o.y = cvtpk(s[2 * 33] * mul, s[3 * 33] * mul); o.z = cvtpk(s[4 * 33] * mul, s[5 * 33] * mul); o.w = cvtpk(s[6 * 33] * mul, s[7 * 33] * mul);
        const int nd = swz ? ((n & ~12) | ((n & 4) << 1) | ((n & 8) >> 1)) : n;
        *(u32x4*)(WT + (size_t)(drow0 + nd) * ldt + k0 + 8 * c) = o; }
    LDS_WAIT(); asm volatile("" ::: "memory");
}

struct ConvItem { const float* src; bf16_t* dst; int ldw, ldt; };
__device__ __forceinline__ void conv_load(const ConvItem& c, f32x4 (&v)[16], int lane) {
    const float* src = c.src + (size_t)(lane >> 4) * c.ldw + 4 * (lane & 15);
#pragma unroll
    for (int i = 0; i < 16; ++i) v[i] = *(const f32x4*)(src + (size_t)(4 * i) * c.ldw);
}
__device__ __forceinline__ void conv_finish(const ConvItem& c, const f32x4 (&v)[16], LAS float* scr, int lane) {
#pragma unroll
    for (int i = 0; i < 16; ++i) *(LAS f32x4*)(scr + (4 * i + (lane >> 4)) * 68 + 4 * (lane & 15)) = v[i];
    LDS_WAIT(); asm volatile("" ::: "memory");
    bf16_t* dst = c.dst + (size_t)lane * c.ldt;
#pragma unroll
    for (int cc = 0; cc < 8; ++cc) { const LAS float* sp = scr + (8 * cc) * 68 + lane;
        u32x4 o; o.x = cvtpk(sp[0], sp[68]); o.y = cvtpk(sp[2 * 68], sp[3 * 68]); o.z = cvtpk(sp[4 * 68], sp[5 * 68]); o.w = cvtpk(sp[6 * 68], sp[7 * 68]);
        *(u32x4*)(dst + 8 * cc) = o; }
    LDS_WAIT(); asm volatile("" ::: "memory");
}

__device__ __forceinline__ void sincos_d(double a, float& s, float& c) {
    const double TWO_PI_HI = 6.283185307179586, TWO_PI_LO = 2.4492935982947064e-16, INV_2PI = 0.15915494309189535;
    const double n = __builtin_rint(a * INV_2PI);
    double r = __builtin_fma(-n, TWO_PI_HI, a); r = __builtin_fma(-n, TWO_PI_LO, r);
    const double HALF_PI = 1.5707963267948966, HALF_PI_LO = 6.123233995736766e-17;
    const double qd = __builtin_rint(r * 0.6366197723675814);
    double y = __builtin_fma(-qd, HALF_PI, r); y = __builtin_fma(-qd, HALF_PI_LO, y);
    const int q = ((int)qd) & 3;
    const double y2 = y * y;
    double sp = -7.647163731819816e-13; sp = sp * y2 + 1.6059043836821613e-10; sp = sp * y2 - 2.505210838544172e-08; sp = sp * y2 + 2.7557319223985893e-06; sp = sp * y2 - 0.0001984126984126984;
    sp = sp * y2 + 0.008333333333333333; sp = sp * y2 - 0.16666666666666666; sp = y + y * y2 * sp;
    double cp = 4.779477332387385e-14; cp = cp * y2 - 1.1470745597729725e-11; cp = cp * y2 + 2.08767569878681e-09; cp = cp * y2 - 2.755731922398589e-07; cp = cp * y2 + 2.48015873015873e-05;
    cp = cp * y2 - 0.001388888888888889; cp = cp * y2 + 0.041666666666666664; cp = cp * y2 - 0.5; cp = 1.0 + y2 * cp;
    double ss, cc;
    if (q == 0) { ss = sp; cc = cp; } else if (q == 1) { ss = cp; cc = -sp; } else if (q == 2) { ss = -sp; cc = -cp; } else { ss = -cp; cc = sp; }
    s = (float)ss; c = (float)cc;
}

__global__ void __launch_bounds__(NWAVES * 64, 2) mk_fwd(Args args_unused) {
    extern __shared__ __attribute__((aligned(16))) unsigned char lds_raw[];
    LAS unsigned char* lds = (LAS unsigned char*)lds_raw;
    volatile LAS unsigned* MISC = (volatile LAS unsigned*)(lds + MISC_OFF);
    int tid = threadIdx.x, lane = tid & 63, wave = __builtin_amdgcn_readfirstlane(tid >> 6);
    const int G = gridDim.x, bx = blockIdx.x;
    const int vcu = (G % 8 == 0) ? (bx % 8) * (G / 8) + bx / 8 : bx;
    int gw = vcu * NWAVES + wave; const int NGW = G * NWAVES;
#define ws (kargs()->ws)
    unsigned* ctl = (unsigned*)(ws + WS_CTL);
    for (int u = tid; u < (LDS_BYTES - LDSCTL_OFF) / 4; u += NWAVES * 64) ((LAS unsigned*)(lds + LDSCTL_OFF))[u] = 0u;
    __syncthreads();
    XcdBarrier bar; bar.bar = ctl + CW_BAR; bar.x = 0; bar.st = nullptr;
#if MK_ONE_LAUNCH
    bar = xcd_barrier_post(ctl + CW_BAR, MISC + 8);
#endif
    const int lo = kargs()->ph_lo, hi = kargs()->ph_hi;
#ifndef MK_REP_MASK
#define MK_REP_MASK 0u
#endif
#define NREP(b) (1 + (int)((MK_REP_MASK >> (b)) & 1u))
#ifndef MK_PH_MASK
#define MK_PH_MASK 0xffffffffu
#endif
#define PHON(b) ((MK_PH_MASK >> (b)) & 1u)
#define IN(k) (lo <= (k) && (k) < hi)
#if MK_ONE_LAUNCH
#define SEAM(k) do { if ((k) + 1 < hi) xcd_barrier(bar); } while (0)
#else
#define SEAM(k) do { } while (0)
#endif
#define in_x ((const float*)kargs()->in[0])
#define in_pos ((const int*)kargs()->in[1])
#define ln_g ((const float*)kargs()->in[2])
#define ln_b ((const float*)kargs()->in[3])
#define w_in ((const float*)kargs()->in[4])
#define q_norm ((const float*)kargs()->in[5])
#define w_uq ((const float*)kargs()->in[6])
#define kv_norm ((const float*)kargs()->in[7])
#define w_ukv ((const float*)kargs()->in[8])
#define w_o ((const float*)kargs()->in[9])
#define pool_w ((const float*)kargs()->in[10])
#define pool_b ((const float*)kargs()->in[11])
#define pool_scale ((const float*)kargs()->in[12])
#define w_grp ((const float*)kargs()->in[13])
#define b_grp ((const float*)kargs()->in[14])
#define w_exp ((const float*)kargs()->in[15])
#define b_exp ((const float*)kargs()->in[16])
#define w1 ((const float*)kargs()->in[17])
#define w3 ((const float*)kargs()->in[18])
#define w2 ((const float*)kargs()->in[19])
#define COS ((float*)(ws + WS_COS))
#define SIN ((float*)(ws + WS_SIN))
#define CNT ((int*)(ws + WS_CNT))
#define TILE ((int*)(ws + WS_TILE))
#define AE ((int*)(ws + WS_AE))
#define APOS ((int*)(ws + WS_APOS))
#define AG ((float*)(ws + WS_AG))
#define RSLOT ((int*)(ws + WS_RSLOT))
#define RGATE ((float*)(ws + WS_RGATE))
#define WIN ((bf16_t*)(ws + WS_WIN))
#define WUQ ((bf16_t*)(ws + WS_WUQ))
#define WUK ((bf16_t*)(ws + WS_WUK))
#define WUV ((bf16_t*)(ws + WS_WUV))
#define WO ((bf16_t*)(ws + WS_WO))
#define WP ((bf16_t*)(ws + WS_WP))
#define WR ((bf16_t*)(ws + WS_WR))
#define W13L(ll) ((bf16_t*)(ws + (((ll) & 1) ? WS_W13B : WS_W13)))
#define W2TL(ll) ((bf16_t*)(ws + (((ll) & 1) ? WS_W2TB : WS_W2T)))
#define FB ((bf16_t*)(ws + WS_FB))
#define XHL ((bf16_t*)(ws + WS_XHL))
#define LATB ((float*)(ws + WS_LAT))
#define CQ ((bf16_t*)(ws + WS_CQ))
#define CKV ((bf16_t*)(ws + WS_CKV))
#define KR ((bf16_t*)(ws + WS_KR))
#define QB ((bf16_t*)(ws + WS_Q))
#define KN ((bf16_t*)(ws + WS_KN))
#define VT ((bf16_t*)(ws + WS_VT))
#define OB ((bf16_t*)(ws + WS_O))
#define POOLED ((bf16_t*)(ws + WS_POOLED))
#define LG ((float*)(ws + WS_LG))
#define ROWLIST ((int*)(ws + WS_LIST))
#define LGATE ((float*)(ws + WS_LGATE))
#define HS ((bf16_t*)(ws + WS_HS))
#define YB ((bf16_t*)(ws + WS_Y))
    LAS float* scr = (LAS float*)(lds + RING_OFF + wave * SCR_WAVE);

    if (PHON(12) && IN(0)) {
        for (int m = gw; m < NTOK; m += NGW) {
            const f32x4* xr = (const f32x4*)(in_x + (size_t)m * D_MODEL) + 2 * lane; u32x4* oh = (u32x4*)(XHL + (size_t)m * 2048) + lane;
#pragma unroll
            for (int j = 0; j < 2; ++j) oh[64 * j] = pk8(xr[128 * j], xr[128 * j + 1]);
        }
        for (int idx = gw * 64 + lane; idx < NTOK * 16; idx += NGW * 64) { float s, c; sincos_d((double)in_pos[idx >> 4] * c_invf[idx & 15], s, c); COS[idx] = c; SIN[idx] = s; }
        for (int idx = gw * 64 + lane; idx < DEPTH * 64 * 3072; idx += NGW * 64) {
            const int l = idx / (64 * 3072), r0 = idx % (64 * 3072), ks = r0 / 3072, r1 = r0 % 3072, part = r1 / 1536, r2 = r1 % 1536, nb = r2 / 512, r3 = r2 % 512, hh = r3 / 256, n = (r3 % 256) / 8, jj = r3 % 8;
            const int col = 32 * nb + n, k = 64 * (ks >> 2) + 32 * hh + 8 * (ks & 3) + jj;
            float v = 0.f;
            if (col < 72) { const float wv = (col < 8) ? w_grp[((size_t)l * 1024 + k) * 8 + col] : w_exp[((size_t)l * 1024 + k) * 64 + (col - 8)];
                const float whi = bflo(cvtpk(wv, 0.f)); v = part ? (wv - whi) : whi; }
            WR[idx] = (bf16_t)(cvtpk(v, 0.f) & 0xffffu);
        }
        for (int idx = gw * 64 + lane; idx < 2 * 96 * 1024 / 8; idx += NGW * 64) { const int j = idx / (96 * 128), r = idx % (96 * 128); *(u32x4*)(WIN + ((size_t)j * 512 + 416) * 1024 + (size_t)r * 8) = (u32x4){0u, 0u, 0u, 0u}; }
        constexpr int I_IN = 16 * 13, I_UQ = 4 * 48, I_UKV = 2 * 64, I_O = 16 * 32, I_P = 4 * 8;
        constexpr int NIT = 2 * (I_IN + I_UQ + I_UKV + I_O) + 8 * I_P;
        for (int it = gw; it < NIT; it += NGW) {
            int r = it;
            if (r < 2 * I_IN) { const int j = r / I_IN, q = r % I_IN, kb = q / 13, nb = q % 13;
                transpose_item(w_in + (size_t)j * 1024 * LAT, LAT, 64 * kb, 32 * nb, WIN + (size_t)j * 512 * 1024, 1024, 32 * nb, 1.f, scr, lane); continue; } r -= 2 * I_IN;
            if (r < 2 * I_UQ) { const int j = r / I_UQ, q = r % I_UQ, kb = q / 48, nb = q % 48;
                transpose_item(w_uq + (size_t)j * 256 * QPITCH, QPITCH, 64 * kb, 32 * nb, WUQ + (size_t)j * 1536 * 256, 256, 32 * nb, QSCALE, scr, lane); continue; } r -= 2 * I_UQ;
            if (r < 2 * I_UKV) { const int j = r / I_UKV, q = r % I_UKV, kb = q / 64, nb = q % 64; const int n0 = 32 * nb, head = n0 >> 7, r0 = n0 & 127;
                if (r0 < 64) transpose_item(w_ukv + (size_t)j * 128 * 2048, 2048, 64 * kb, n0, WUK + (size_t)j * 1024 * 128, 128, head * 64 + r0, 1.f, scr, lane, 1);
                else transpose_item(w_ukv + (size_t)j * 128 * 2048, 2048, 64 * kb, n0, WUV + (size_t)j * 1024 * 128, 128, head * 64 + r0 - 64, 1.f, scr, lane);
                continue; } r -= 2 * I_UKV;
            if (r < 2 * I_O) { const int j = r / I_O, q = r % I_O, kb = q / 32, nb = q % 32;
                transpose_item(w_o + (size_t)j * 1024 * 1024, 1024, 64 * kb, 32 * nb, WO + (size_t)j * 1024 * 1024, 1024, 32 * nb, 1.f, scr, lane); continue; } r -= 2 * I_O;
            { const int jg = r / I_P, q = r % I_P, kb = q / 8, nb = q % 8;
                transpose_item(pool_w + (size_t)jg * 65536, 256, 64 * kb, 32 * nb, WP + (size_t)jg * 65536, 256, 32 * nb, 1.f, scr, lane); }
        }
        SEAM(0);
    }

    for (int l = 0; l < DEPTH; ++l) {
        const int pb = 1 + PPL * l, j = l >> 1;
        tid = opaque(threadIdx.x); lane = tid & 63; wave = __builtin_amdgcn_readfirstlane(tid >> 6); gw = vcu * NWAVES + wave; scr = (LAS float*)(lds + RING_OFF + wave * SCR_WAVE);
        const bool mla = (l & 1) == 0;
#define MOE_CONV_DECODE(it, C) do { const int cl = l + ((it) >= 12288 ? 1 : 0); int r = (it) - ((it) >= 12288 ? 12288 : 0); \
            if (r < 8192) { const int which = r >> 12, q = r & 4095, e = q >> 6, kb = (q >> 2) & 15, nb = q & 3; const int n0 = 64 * nb; \
                C.src = (which ? w3 : w1) + ((size_t)cl * 64 + e) * 1024 * 256 + (size_t)(64 * kb) * 256 + n0; C.ldw = 256; \
                C.dst = W13L(cl) + (size_t)e * 512 * 1024 + (size_t)((n0 >> 7) * 256 + (n0 & 127) + which * 128) * 1024 + 64 * kb; C.ldt = 1024; } \
            else { r -= 8192; const int e = r >> 6, kb = (r >> 4) & 3, nb = r & 15; \
                C.src = w2 + ((size_t)cl * 64 + e) * 256 * 1024 + (size_t)(64 * kb) * 1024 + 64 * nb; C.ldw = 1024; \
                C.dst = W2TL(cl) + (size_t)e * 1024 * 256 + (size_t)(64 * nb) * 256 + 64 * kb; C.ldt = 256; } } while (0)

        if (mla) {
            if (PHON(0) && IN(pb + 0)) {
                for (int rep = 0; rep < NREP(0); ++rep) { if (rep) __syncthreads();
                pg8::Gemm g{2048, 1024, 1024}; pg8::DenseOrder S; S.init(NTOK, 512, G, bx, XHL, (size_t)256 * 2048 * 2, 0, WIN + (size_t)j * 512 * 1024, (size_t)256 * 1024 * 2);
                if (G == 256) { pg8::EpiLatNorm E{CQ, CKV, KR, q_norm + j * 256, kv_norm + j * 128, COS, SIN};
                    pg8::gemm_phase<pg8::EpiLatNorm, pg8::DenseOrder, true>(lds + RING_OFF, g, S, E); }
                else { pg8::EpiF32 E{LATB, 512};
                    pg8::gemm_phase<pg8::EpiF32, pg8::DenseOrder, true>(lds + RING_OFF, g, S, E); }
                }
                SEAM(pb + 0);
            }
            if (PHON(1) && IN(pb + 1) && G != 256) {
                const float* gq = q_norm + j * 256; const float* gk = kv_norm + j * 128;
                const f32x4 gqv = *(const f32x4*)(gq + 4 * lane); const f32x4 gkv = *(const f32x4*)(gk + 4 * (lane & 31));
                for (int m = gw; m < NTOK; m += NGW) {
                    const float* lr = LATB + (size_t)m * 512;
                    const f32x4 a = *(const f32x4*)(lr + 4 * lane), c = *(const f32x4*)(lr + 256 + 4 * lane);
                    const float sq = wave_sum(a.x * a.x + a.y * a.y + a.z * a.z + a.w * a.w);
                    const float sk = wave_sum(lane < 32 ? (c.x * c.x + c.y * c.y + c.z * c.z + c.w * c.w) : 0.f);
                    const float rq = 1.0f / sqrtf(sq * (1.f / 256.f) + RMS_EPS), rk = 1.0f / sqrtf(sk * (1.f / 128.f) + RMS_EPS);
                    { u32x2 o; o.x = cvtpk(a.x * rq * gqv.x, a.y * rq * gqv.y); o.y = cvtpk(a.z * rq * gqv.z, a.w * rq * gqv.w); *((u32x2*)(CQ + (size_t)m * 256) + lane) = o; }
                    if (lane < 32) { u32x2 o; o.x = cvtpk(c.x * rk * gkv.x, c.y * rk * gkv.y); o.y = cvtpk(c.z * rk * gkv.z, c.w * rk * gkv.w); *((u32x2*)(CKV + (size_t)m * 128) + lane) = o; }
                    f32x4 p; p.x = __shfl_xor(c.x, 4); p.y = __shfl_xor(c.y, 4); p.z = __shfl_xor(c.z, 4); p.w = __shfl_xor(c.w, 4);
                    if (lane >= 32 && lane < 40) {
                        const f32x4 cv = *(const f32x4*)(COS + (size_t)m * 16 + 4 * (lane & 3)), sv = *(const f32x4*)(SIN + (size_t)m * 16 + 4 * (lane & 3));
                        f32x4 y; if (lane < 36) y = c * cv - p * sv; else y = c * cv + p * sv;
                        u32x2 o; o.x = cvtpk(y.x, y.y); o.y = cvtpk(y.z, y.w); { const int Lp = lane - 32; *(u32x2*)(KR + (size_t)m * 32 + 16 * (Lp >> 2) + 8 * (Lp & 1) + 4 * ((Lp >> 1) & 1)) = o; }
                    }
                }
                SEAM(pb + 1);
            }
            if (PHON(2) && IN(pb + 2)) {
                for (int rep = 0; rep < NREP(2); ++rep) {
                { pg8::Gemm g{128, 128, 128}; pg8::DenseOrder S; S.init(NTOK, 1024, G, bx, CKV, (size_t)256 * 128 * 2, 0, WUK + (size_t)j * 1024 * 128, (size_t)256 * 128 * 2);
                  pg8::EpiBf16 E{KN, 1024};
                  pg8::gemm_phase<pg8::EpiBf16, pg8::DenseOrder, true>(lds + RING_OFF, g, S, E); }
                { pg8::Gemm g{128, 128, 128}; pg8::DenseOrder S; S.init(1024, NTOK, G, bx, WUV + (size_t)j * 1024 * 128, (size_t)256 * 128 * 2, 0, CKV, (size_t)256 * 128 * 2);
                  pg8::EpiBf16 E{VT, (size_t)NTOK};
                  pg8::gemm_phase<pg8::EpiBf16, pg8::DenseOrder, true>(lds + RING_OFF, g, S, E); }
                }
                SEAM(pb + 2);
            }
            if (PHON(3) && IN(pb + 3)) {
                for (int rep = 0; rep < NREP(3); ++rep) {
                int cj = 0;
                for (int i = 0;; ++i) {
                    const int L = i * G + vcu; if (L >= 2048) break;
                    const int sl = L & 255, rnd = L >> 8;
                    const int bh = (sl >> 5) + 8 * rnd, qb = (rnd & 1) ? 31 - (sl & 31) : (sl & 31);
                    att::attn_unit(bh >> 4, bh & 15, qb, CQ, WUQ + ((size_t)j * 1536 + (bh & 15) * 96) * 256, COS, SIN, KN, KR, VT, OB, lds + RING_OFF);
                    if (rep == 0 && i < 6) {
                        int it0 = gw + cj * NGW, it1 = it0 + NGW; cj += 2;
                        it0 = it0 < 2 * 12288 ? it0 : 2 * 12288 - 1; it1 = it1 < 2 * 12288 ? it1 : 2 * 12288 - 1;
                        ConvItem c0, c1; f32x4 v0[16], v1[16];
                        MOE_CONV_DECODE(it0, c0); conv_load(c0, v0, lane);
                        MOE_CONV_DECODE(it1, c1); conv_load(c1, v1, lane);
                        conv_finish(c0, v0, scr, lane);
                        conv_finish(c1, v1, scr, lane);
                        __syncthreads();
                    }
                }
                if (rep == 0) { for (;; ++cj) { const int it = gw + cj * NGW; if (it >= 2 * 12288) break; ConvItem c0; f32x4 v0[16]; MOE_CONV_DECODE(it, c0); conv_load(c0, v0, lane); conv_finish(c0, v0, scr, lane); } __syncthreads(); }
                }
                SEAM(pb + 3);
            }
            if (PHON(4) && IN(pb + 4)) {
                for (int rep = 0; rep < NREP(4); ++rep) {
                pg8::Gemm g{1024, 1024, 1024}; pg8::DenseOrder S; S.init(NTOK, 1024, G, bx, OB, (size_t)256 * 1024 * 2, 0, WO + (size_t)j * 1024 * 1024, (size_t)256 * 1024 * 2);
                pg8::EpiBf16 E{FB, 1024};
                pg8::gemm_phase<pg8::EpiBf16, pg8::DenseOrder, true>(lds + RING_OFF, g, S, E);
                }
                SEAM(pb + 4);
            }
        } else {
            if (PHON(13) && IN(pb + 0)) {
                for (int rep = 0; rep < NREP(13); ++rep) {
                for (int it = gw; it < 2 * (NTOK / 32); it += NGW) {
                    const int q = it & 1, t0 = (it >> 1) * 32, s0 = t0 & (SEQ - 1), grp = 2 * q + (lane >> 5), win = 2 << grp;
                    const bf16_t* xb = XHL + grp * 256 + 8 * (lane & 31);
                    bf16_t* pout = POOLED + grp * 256 + 8 * (lane & 31);
                    f32x4 Sa = {0.f, 0.f, 0.f, 0.f}, Sb = {0.f, 0.f, 0.f, 0.f};
#pragma unroll
                    for (int jj = 1; jj < 16; ++jj) { if (jj < win && s0 - jj >= 0) { const F8 r = bf8(*(const u32x4*)(xb + (size_t)(t0 - jj) * 2048)); Sa += r.a; Sb += r.b; } }
                    for (int tb = 0; tb < 32; tb += 8) {
                        u32x4 xn[8], xe[8];
#pragma unroll
                        for (int i = 0; i < 8; ++i) { const int t = t0 + tb + i; xn[i] = *(const u32x4*)(xb + (size_t)t * 2048);
                            xe[i] = (s0 + tb + i - win + 1 >= 0) ? *(const u32x4*)(xb + (size_t)(t - win + 1) * 2048) : (u32x4){0u, 0u, 0u, 0u}; }
#pragma unroll
                        for (int i = 0; i < 8; ++i) { const int sI = s0 + tb + i; const F8 xv = bf8(xn[i]), ev = bf8(xe[i]);
                            Sa += xv.a; Sb += xv.b;
                            const float rc = 1.0f / (float)((sI + 1 < win) ? sI + 1 : win);
                            *(u32x4*)(pout + (size_t)(t0 + tb + i) * 1024) = pk8(Sa * rc - xv.a, Sb * rc - xv.b);
                            Sa -= ev.a; Sb -= ev.b; }
                    }
                }
                }
                SEAM(pb + 0);
            }
            if (PHON(14) && IN(pb + 1)) {
                for (int rep = 0; rep < NREP(14); ++rep) {
                pg8::Gemm g{1024, 256, 256}; pg8::DenseOrder S; S.init(NTOK, 1024, G, bx, POOLED, (size_t)256 * 1024 * 2, (size_t)256 * 2, WP + (size_t)j * 4 * 65536, (size_t)65536 * 2);
                pg8::EpiPool E{FB, pool_b + j * 1024, pool_scale + j * 1024};
                pg8::gemm_phase<pg8::EpiPool, pg8::DenseOrder, true>(lds + RING_OFF, g, S, E);
                }
                SEAM(pb + 1);
            }
        }
        if (PHON(5) && IN(pb + 5)) {
                for (int rep = 0; rep < NREP(5); ++rep) {
            f32x4 gv[4], bv[4];
#pragma unroll
            for (int jj = 0; jj < 4; ++jj) { const int c = 8 * lane + 512 * (jj >> 1) + 4 * (jj & 1); gv[jj] = *(const f32x4*)(ln_g + (size_t)(l * 2 + 0) * 1024 + c); bv[jj] = *(const f32x4*)(ln_b + (size_t)(l * 2 + 0) * 1024 + c); }
            for (int m = gw; m < NTOK; m += NGW) {
                u32x4* xh = (u32x4*)(XHL + (size_t)m * 2048) + lane; const u32x4* fr2 = (const u32x4*)(FB + (size_t)m * 1024) + lane;
                const F8 x0 = bf8(xh[0]), x1 = bf8(xh[64]), f0 = bf8(fr2[0]), f1 = bf8(fr2[64]);
                f32x4 v[4] = {x0.a * DN_ALPHA + f0.a, x0.b * DN_ALPHA + f0.b, x1.a * DN_ALPHA + f1.a, x1.b * DN_ALPHA + f1.b}; float s = 0.f;
#pragma unroll
                for (int jj = 0; jj < 4; ++jj) s += (v[jj].x + v[jj].y) + (v[jj].z + v[jj].w);
                const float mean = wave_sum(s) * (1.f / 1024.f); float s2 = 0.f;
#pragma unroll
                for (int jj = 0; jj < 4; ++jj) { v[jj] = v[jj] - mean; s2 += (v[jj].x * v[jj].x + v[jj].y * v[jj].y) + (v[jj].z * v[jj].z + v[jj].w * v[jj].w); }
                const float rstd = 1.0f / sqrtf(wave_sum(s2) * (1.f / 1024.f) + LN_EPS);
#pragma unroll
                for (int jj = 0; jj < 4; ++jj) v[jj] = v[jj] * rstd * gv[jj] + bv[jj];
#pragma unroll
                for (int j = 0; j < 2; ++j) { const u32x4 h = pk8(v[2 * j], v[2 * j + 1]); const F8 hf = bf8(h);
                    xh[64 * j] = h; xh[128 + 64 * j] = pk8(v[2 * j] - hf.a, v[2 * j + 1] - hf.b); }
            }
            }
                SEAM(pb + 5);
        }
        if (PHON(7) && IN(pb + 7)) {
            for (int rep = 0; rep < NREP(7); ++rep) {
            LAS unsigned char* rl = lds + RING_OFF;
            LAS float* RED = (LAS float*)rl; LAS float* LT = (LAS float*)(rl + 49152); LAS int* hist = (LAS int*)(rl + 98816); LAS int* cbase = hist + 64;
            const float* bg = b_grp + l * 8; const float* be = b_exp + l * 64;
            unsigned* gcnt = ctl + CW_GCNT + 64 * l;
            const int rb = wave & 3, kh = wave >> 2, r32 = lane & 31, hh = lane >> 5;
            const bf16_t* wr_l = WR + (size_t)l * 64 * 3072;
            for (int c = bx; c < 256; c += G) {
                __syncthreads();
                const bf16_t* xrow = XHL + (size_t)(c * 128 + rb * 32 + r32) * 2048 + 512 * kh + 32 * hh;
#define RK_STAGE(it, buf) do { _Pragma("unroll") for (int q_ = 0; q_ < 6; ++q_) { const int q = wave * 6 + q_, khp = q / 24, sp = (q % 24) / 6, pc = q % 6; \
                    __builtin_amdgcn_global_load_lds((const unsigned*)(wr_l + (size_t)(32 * khp + 4 * (it) + sp) * 3072 + pc * 512 + lane * 8), (LAS unsigned*)(rl + (buf) * 49152 + q * 1024), 16, 0, 0); } } while (0)
#define RK_LOADA(AH, AL, it) do { _Pragma("unroll") for (int s_ = 0; s_ < 4; ++s_) { AH[s_] = *(const bf16x8*)(xrow + 64 * (it) + 8 * s_); AL[s_] = *(const bf16x8*)(xrow + 1024 + 64 * (it) + 8 * s_); } } while (0)
#define RK_COMPUTE(AH, AL, buf) do { const LAS unsigned char* bb = rl + (buf) * 49152 + kh * 24576 + hh * 512 + r32 * 16; \
                    _Pragma("unroll") for (int s_ = 0; s_ < 4; ++s_) { _Pragma("unroll") for (int nb = 0; nb < 3; ++nb) { \
                        const bf16x8 wh = *(const LAS bf16x8*)(bb + s_ * 6144 + nb * 1024), wl = *(const LAS bf16x8*)(bb + s_ * 6144 + 3072 + nb * 1024); \
                        acc[nb] = __builtin_amdgcn_mfma_f32_32x32x16_bf16(AH[s_], wh, acc[nb], 0, 0, 0); \
                        acc[nb] = __builtin_amdgcn_mfma_f32_32x32x16_bf16(AL[s_], wh, acc[nb], 0, 0, 0); \
                        acc[nb] = __builtin_amdgcn_mfma_f32_32x32x16_bf16(AH[s_], wl, acc[nb], 0, 0, 0); } } } while (0)
                f32x16 acc[3] = {};
                bf16x8 a0h[4], a0l[4], a1h[4], a1l[4];
                RK_STAGE(0, 0); RK_LOADA(a0h, a0l, 0);
                for (int it = 0; it < 8; it += 2) {
                    asm volatile("s_waitcnt vmcnt(0)" ::: "memory"); __builtin_amdgcn_s_barrier(); asm volatile("" ::: "memory");
                    RK_STAGE(it + 1, 1); RK_LOADA(a1h, a1l, it + 1);
                    RK_COMPUTE(a0h, a0l, 0);
                    asm volatile("s_waitcnt vmcnt(0) lgkmcnt(0)" ::: "memory"); __builtin_amdgcn_s_barrier(); asm volatile("" ::: "memory");
                    if (it + 2 < 8) { RK_STAGE(it + 2, 0); RK_LOADA(a0h, a0l, it + 2); }
                    RK_COMPUTE(a1h, a1l, 1);
                    asm volatile("s_waitcnt lgkmcnt(0)" ::: "memory");
                }
#undef RK_STAGE
#undef RK_LOADA
#undef RK_COMPUTE
                if (kh == 1) {
#pragma unroll
                    for (int nb = 0; nb < 3; ++nb)
#pragma unroll
                        for (int q = 0; q < 4; ++q) *(LAS f32x4*)(RED + ((rb * 3 + nb) * 64 + lane) * 16 + 4 * q) = (f32x4){acc[nb][4 * q], acc[nb][4 * q + 1], acc[nb][4 * q + 2], acc[nb][4 * q + 3]};
                }
                __syncthreads();
                if (kh == 0) {
#pragma unroll
                    for (int nb = 0; nb < 3; ++nb)
#pragma unroll
                        for (int q = 0; q < 4; ++q) { const f32x4 o = *(const LAS f32x4*)(RED + ((rb * 3 + nb) * 64 + lane) * 16 + 4 * q);
#pragma unroll
                            for (int e = 0; e < 4; ++e) { const int r = 4 * q + e; LT[(rb * 32 + (r & 3) + 8 * (r >> 2) + 4 * hh) * 97 + nb * 32 + r32] = acc[nb][r] + o[e]; } }
                }
                if (tid < 64) hist[tid] = 0;
                __syncthreads();
                int ex1 = 0, ex2 = 0, p1 = 0, p2 = 0; float ga1 = 0.f, ga2 = 0.f;
                const int t = c * 128 + tid;
                if (tid < 128) {
                    const LAS float* lg = LT + tid * 97;
                    float gl[8];
#pragma unroll
                    for (int i = 0; i < 8; ++i) gl[i] = lg[i] + bg[i];
                    int gs = 0; float gm = gl[0];
#pragma unroll
                    for (int i = 1; i < 8; ++i) if (gl[i] > gm) { gm = gl[i]; gs = i; }
                    float se = 0.f;
#pragma unroll
                    for (int i = 0; i < 8; ++i) se += __expf(gl[i] - gm);
                    const float ggate = 1.0f / se;
                    float el[8];
#pragma unroll
                    for (int i = 0; i < 8; ++i) el[i] = lg[8 + gs * 8 + i] + be[gs * 8 + i];
                    int i1 = 0; float m1 = el[0];
#pragma unroll
                    for (int i = 1; i < 8; ++i) if (el[i] > m1) { m1 = el[i]; i1 = i; }
                    int i2 = -1; float m2 = -INFINITY;
#pragma unroll
                    for (int i = 0; i < 8; ++i) if (i != i1 && el[i] > m2) { m2 = el[i]; i2 = i; }
                    const float x2 = __expf(m2 - m1), rs = 1.0f / (1.0f + x2);
                    ex1 = gs * 8 + i1; ex2 = gs * 8 + i2; ga1 = ggate * rs; ga2 = ggate * x2 * rs;
                    p1 = __hip_atomic_fetch_add(&hist[ex1], 1, __ATOMIC_RELAXED, __HIP_MEMORY_SCOPE_WORKGROUP); p2 = __hip_atomic_fetch_add(&hist[ex2], 1, __ATOMIC_RELAXED, __HIP_MEMORY_SCOPE_WORKGROUP);
                }
                __syncthreads();
                if (tid < 64) { const int n = hist[tid]; cbase[tid] = n ? (int)__hip_atomic_fetch_add(gcnt + tid, (unsigned)n, __ATOMIC_RELAXED, __HIP_MEMORY_SCOPE_AGENT) : 0; }
                __syncthreads();
                if (tid < 128) {
                    const size_t i1 = (size_t)ex1 * pg8::LIST_CAP + cbase[ex1] + p1, i2 = (size_t)ex2 * pg8::LIST_CAP + cbase[ex2] + p2;
                    ROWLIST[i1] = 2 * t; LGATE[i1] = ga1; ROWLIST[i2] = 2 * t + 1; LGATE[i2] = ga2;
                }
                __syncthreads();
            }
            }
            SEAM(pb + 7);
        }
#define MOE_TILE_TABLE() \
            LAS int* tinfo = (LAS int*)(lds + TINFO_OFF); \
            __syncthreads(); \
            if (tid < 64) tinfo[pg8::TI_CNT + tid] = (int)__hip_atomic_load(ctl + CW_GCNT + 64 * l + tid, __ATOMIC_RELAXED, __HIP_MEMORY_SCOPE_AGENT); \
            __syncthreads(); \
            if (tid == 0) { int tt = 0; for (int e = 0; e < 64; ++e) { const int n = (tinfo[pg8::TI_CNT + e] + 255) >> 8; for (int i = 0; i < n && tt < MAX_TILES; ++i) tinfo[tt++] = e | (i << 8); } tinfo[pg8::TI_CNT + 64] = tt; } \
            __syncthreads(); \
            const int ntl = tinfo[pg8::TI_CNT + 64];
        if (PHON(9) && IN(pb + 9)) {
            for (int rep = 0; rep < NREP(9); ++rep) {
            MOE_TILE_TABLE();
            pg8::Gemm g{2048, 1024, 1024}; pg8::GatherOrder S; S.init(tinfo, ntl, 2, G, bx, XHL, ROWLIST, W13L(l), (size_t)512 * 1024 * 2, (size_t)256 * 1024 * 2);
            { pg8::Unit uu;
              for (int ui = 0; ui < pg8::MOE_LDS_UNITS; ++ui) if (S.next(ui, uu) && tid < 256) tinfo[pg8::TI_ROWOFF + ui * 256 + tid] = (int)S.row_off(uu, tid, 2048);
              __syncthreads(); }
            pg8::EpiSwiglu E{HS};
            pg8::gemm_phase<pg8::EpiSwiglu, pg8::GatherOrder, true>(lds + RING_OFF, g, S, E);
            }
            SEAM(pb + 9);
        }
        if (PHON(10) && IN(pb + 10)) {
            for (int rep = 0; rep < NREP(10); ++rep) {
            MOE_TILE_TABLE();
            pg8::Gemm g{256, 256, 256}; pg8::MoeOrder S; S.init(tinfo, ntl, 4, G, bx, HS, (size_t)256 * 256 * 2, W2TL(l), (size_t)1024 * 256 * 2, (size_t)256 * 256 * 2);
            { pg8::Unit uu;
              for (int ui = 0; ui < pg8::MOE_LDS_UNITS; ++ui) if (S.next(ui, uu) && tid < 256) {
                  const int ti = tinfo[uu.pm], e = ti & 255, r = (ti >> 8) * 256 + tid; const bool ok = r < tinfo[pg8::TI_CNT + e]; const size_t li = (size_t)e * pg8::LIST_CAP + r;
                  tinfo[pg8::TI_ROWOFF + ui * 256 + tid] = ok ? ROWLIST[li] : 0; tinfo[pg8::TI_ROWOFF + pg8::MOE_LDS_UNITS * 256 + ui * 256 + tid] = ok ? __float_as_int(LGATE[li]) : 0; }
              __syncthreads(); }
            pg8::EpiMoeOut E{YB, tinfo, ROWLIST, LGATE};
            pg8::gemm_phase<pg8::EpiMoeOut, pg8::MoeOrder, true>(lds + RING_OFF, g, S, E);
            }
            SEAM(pb + 10);
        }
        if (PHON(11) && IN(pb + 11)) {
            f32x4 gv[4], bv[4];
#pragma unroll
            for (int jj = 0; jj < 4; ++jj) { const int c = 8 * lane + 512 * (jj >> 1) + 4 * (jj & 1); gv[jj] = *(const f32x4*)(ln_g + (size_t)(l * 2 + 1) * 1024 + c); bv[jj] = *(const f32x4*)(ln_b + (size_t)(l * 2 + 1) * 1024 + c); }
            const bool lastl = (l == DEPTH - 1);
            for (int m = gw; m < NTOK; m += NGW) {
                u32x4* xh = (u32x4*)(XHL + (size_t)m * 2048) + lane;
                const u32x4* y0 = (const u32x4*)(YB + (size_t)(2 * m) * 1024) + lane; const u32x4* y1 = (const u32x4*)(YB + (size_t)(2 * m + 1) * 1024) + lane;
                const F8 x0 = bf8(xh[0]), x1 = bf8(xh[64]), a0 = bf8(y0[0]), a1 = bf8(y0[64]), c0 = bf8(y1[0]), c1 = bf8(y1[64]);
                f32x4 v[4] = {x0.a * DN_ALPHA + (a0.a + c0.a), x0.b * DN_ALPHA + (a0.b + c0.b), x1.a * DN_ALPHA + (a1.a + c1.a), x1.b * DN_ALPHA + (a1.b + c1.b)}; float s = 0.f;
#pragma unroll
                for (int jj = 0; jj < 4; ++jj) s += (v[jj].x + v[jj].y) + (v[jj].z + v[jj].w);
                const float mean = wave_sum(s) * (1.f / 1024.f); float s2 = 0.f;
#pragma unroll
                for (int jj = 0; jj < 4; ++jj) { v[jj] = v[jj] - mean; s2 += (v[jj].x * v[jj].x + v[jj].y * v[jj].y) + (v[jj].z * v[jj].z + v[jj].w * v[jj].w); }
                const float rstd = 1.0f / sqrtf(wave_sum(s2) * (1.f / 1024.f) + LN_EPS);
#pragma unroll
                for (int jj = 0; jj < 4; ++jj) v[jj] = v[jj] * rstd * gv[jj] + bv[jj];
                if (lastl) { f32x4* orow = (f32x4*)(kargs()->out + (size_t)m * 1024) + 2 * lane;
                    orow[0] = v[0]; orow[1] = v[1]; orow[128] = v[2]; orow[129] = v[3];
                } else { xh[0] = pk8(v[0], v[1]); xh[64] = pk8(v[2], v[3]); }
            }
            SEAM(pb + 11);
        }
    }
#undef IN
#undef SEAM
}
#undef ws
#undef in_x
#undef in_pos
#undef ln_g
#undef ln_b
#undef w_in
#undef q_norm
#undef w_uq
#undef kv_norm
#undef w_ukv
#undef w_o
#undef pool_w
#undef pool_b
#undef pool_scale
#undef w_grp
#undef b_grp
#undef w_exp
#undef b_exp
#undef w1
#undef w3
#undef w2
#undef COS
#undef SIN
#undef CNT
#undef TILE
#undef AE
#undef APOS
#undef AG
#undef RSLOT
#undef RGATE
#undef WIN
#undef WUQ
#undef WUK
#undef WUV
#undef WO
#undef WP
#undef WR
#undef W13L
#undef W2TL
#undef FB
#undef XHL
#undef LATB
#undef CQ
#undef CKV
#undef KR
#undef QB
#undef KN
#undef VT
#undef OB
#undef POOLED
#undef LG
#undef ROWLIST
#undef LGATE
#undef HS
#undef YB

static bool phase_exists(int p) {
    if (p == 0) return true;
    const int l = (p - 1) / PPL, k = (p - 1) % PPL;
    if (k == 8 || k == 6) return false;
    if (k >= 5) return true;
    return (l & 1) == 0 ? true : (k < 2);
}
extern "C" void kernel_launch(void* const* d_in, const int* in_sizes, int n_in, void* d_out, int out_size, void* d_ws, size_t ws_size, hipStream_t stream) {
    static int grid = 0;
    if (grid == 0) {
        if (n_in != 20 || in_sizes[0] != NTOK * D_MODEL || out_size != NTOK * D_MODEL || ws_size < WS_END) { fprintf(stderr, "kernel_launch: unexpected shapes / workspace (%zu < %zu)\n", ws_size, (size_t)WS_END); grid = -1; return; }
        int dev = 0, cus = 0, per_cu = 0;
        if (hipGetDevice(&dev) != hipSuccess || hipDeviceGetAttribute(&cus, hipDeviceAttributeMultiprocessorCount, dev) != hipSuccess) { grid = -1; return; }
        if (hipFuncSetAttribute((const void*)mk_fwd, hipFuncAttributeMaxDynamicSharedMemorySize, LDS_BYTES) != hipSuccess) { fprintf(stderr, "kernel_launch: hipFuncSetAttribute failed\n"); grid = -1; return; }
        if (hipOccupancyMaxActiveBlocksPerMultiprocessor(&per_cu, (const void*)mk_fwd, NWAVES * 64, LDS_BYTES) != hipSuccess || per_cu < 1) fprintf(stderr, "kernel_launch: occupancy query reports %d\n", per_cu);
        (void)hipGetLastError();
        grid = cus;
    }
    if (grid < 0) return;
    if (hipMemsetAsync((char*)d_ws + WS_CTL, 0, CTL_ZERO_BYTES, stream) != hipSuccess) return;
    Args a{};
    for (int i = 0; i < 20; ++i) a.in[i] = d_in[i];
    a.out = (float*)d_out; a.ws = (unsigned char*)d_ws;
#if MK_ONE_LAUNCH
    a.ph_lo = 0; a.ph_hi = NPHASE;
    hipLaunchKernelGGL(mk_fwd, dim3(grid), dim3(NWAVES * 64), LDS_BYTES, stream, a);
#else
    for (int p = 0; p < NPHASE; ++p) {
        if (!phase_exists(p)) continue;
        a.ph_lo = p; a.ph_hi = p + 1;
        hipLaunchKernelGGL(mk_fwd, dim3(grid), dim3(NWAVES * 64), LDS_BYTES, stream, a);
    }
#endif
}
```
